# Optimizing an MI355X kernel written in HIP

```python
import jax, jax.numpy as jnp
from jax import lax
import numpy as np

D_MODEL = 2048
BATCH = 4
SEQ = 4096
DEPTH = 1

RWKV_HEADS = 16
RWKV_HEAD_DIM = 64
RWKV_WIDTH = RWKV_HEADS * RWKV_HEAD_DIM
DECAY_LORA = 64
ICLR_LORA = 64
GATE_LORA = 160
RWKV_GN_EPS = 64e-5

ATTN_GROUPS = ((128, 1), (512, 4), (2048, 16))
N_GROUPS = 3
HEADS_PER_GROUP = 4
ATTN_HEAD_DIM = 128
ATTN_WIDTH = N_GROUPS * HEADS_PER_GROUP * ATTN_HEAD_DIM
ATTN_OUT_WIDTH = HEADS_PER_GROUP * ATTN_HEAD_DIM
ROPE_DIM = ATTN_HEAD_DIM // 4
ROPE_THETA = 500000.0

N_EXPERTS = 32
TOP_K = 4
EXPERT_FF = 2048
SWIGLU_LIMIT = 7.0
SWIGLU_ALPHA = 1.702

NORM_EPS = 1e-5

SHIFT_WIDTH = 3 * RWKV_WIDTH + DECAY_LORA + ICLR_LORA + GATE_LORA
IN_WIDTH = SHIFT_WIDTH + 3 * ATTN_WIDTH + 2 * D_MODEL

kernel_name = "hybrid_rwkv7_dilated_attn_moe_block"


def rms_norm(x, g):
    xf = x.astype(jnp.float32)
    y = xf * lax.rsqrt(jnp.mean(xf * xf, axis=-1, keepdims=True) + NORM_EPS)
    return (y * g.astype(jnp.float32)).astype(x.dtype)


def split_cols(t, widths):
    outs, off = [], 0
    for wd in widths:
        outs.append(t[..., off:off + wd])
        off += wd
    return outs


def token_shift(z):
    return jnp.pad(z, ((0, 0), (1, 0), (0, 0)))[:, :-1]


def rwkv7_scan(r, w, k, v, kk, a):
    B, S, H, N = r.shape

    def step(state, inp):
        r_t, w_t, k_t, v_t, kk_t, a_t = inp
        sa = jnp.einsum('bhvk,bhk->bhv', state, -kk_t)
        state = (state * w_t[:, :, None, :]
                 + sa[..., None] * (kk_t * a_t)[:, :, None, :]
                 + v_t[..., None] * k_t[:, :, None, :])
        y_t = jnp.einsum('bhvk,bhk->bhv', state, r_t)
        return state, y_t

    xs = tuple(jnp.swapaxes(t, 0, 1) for t in (r, w, k, v, kk, a))
    state0 = jnp.zeros((B, H, N, N), jnp.float32)
    _, ys = lax.scan(step, state0, xs)
    return jnp.swapaxes(ys, 0, 1)


def rwkv7_branch(zr, zk, zv, zw, za, zg, w0, w2_decay, a0, a2_iclr, g2_gate,
                 k_k, k_a, r_k, ln_x_w, ln_x_b, w_o_rwkv):
    B, S, _ = zr.shape
    H, N = RWKV_HEADS, RWKV_HEAD_DIM
    f32 = jnp.float32
    r = zr.astype(f32)
    k = zk.astype(f32)
    v = zv.astype(f32)
    w_raw = w0 + jnp.tanh(zw.astype(f32)) @ w2_decay
    log_w = -jax.nn.softplus(-w_raw) - 0.5
    decay = jnp.exp(-jnp.exp(log_w))
    a = jax.nn.sigmoid(a0 + za.astype(f32) @ a2_iclr)
    g = jax.nn.sigmoid(zg.astype(f32)) @ g2_gate

    heads = lambda t: t.reshape(B, S, H, N)
    kk = heads(k * k_k)
    kk = kk / jnp.maximum(jnp.sqrt(jnp.sum(kk * kk, axis=-1, keepdims=True)), 1e-12)
    k = k * (1.0 + (a - 1.0) * k_a)
    r, k, v, a, decay = heads(r), heads(k), heads(v), heads(a), heads(decay)

    y = rwkv7_scan(r, decay, k, v, kk, a)
    mean = jnp.mean(y, axis=-1, keepdims=True)
    var = jnp.var(y, axis=-1, keepdims=True)
    y = ((y - mean) * lax.rsqrt(var + RWKV_GN_EPS)).reshape(B, S, RWKV_WIDTH)
    y = y * ln_x_w + ln_x_b
    bonus = jnp.sum(r * k * r_k, axis=-1, keepdims=True) * v
    y = y + bonus.reshape(B, S, RWKV_WIDTH)
    return (y * g) @ w_o_rwkv


def partial_rotary(t, positions):
    half = ROPE_DIM // 2
    inv_freq = ROPE_THETA ** (-jnp.arange(half, dtype=jnp.float32) / half)
    ang = positions.astype(jnp.float32)[..., None] * inv_freq
    cos = jnp.cos(ang)[:, :, None, None, :]
    sin = jnp.sin(ang)[:, :, None, None, :]
    t = t.astype(jnp.float32)
    x1 = t[..., :half]
    x2 = t[..., half:ROPE_DIM]
    return jnp.concatenate([x1 * cos - x2 * sin, x2 * cos + x1 * sin, t[..., ROPE_DIM:]], axis=-1)


def dilated_window_attention(q, k, v, window, dilation):
    B, S, H, E = q.shape
    blk = window // dilation
    L = S // dilation
    nb = -(-L // blk)
    Lp = nb * blk

    def to_blocks(t):
        t = t.reshape(B, L, dilation, H, E).transpose(0, 2, 3, 1, 4)
        t = jnp.pad(t, ((0, 0), (0, 0), (0, 0), (0, Lp - L), (0, 0)))
        return t.reshape(B, dilation, H, nb, blk, E)

    def with_prev(t):
        prev = jnp.pad(t, ((0, 0), (0, 0), (0, 0), (1, 0), (0, 0), (0, 0)))[:, :, :, :-1]
        return jnp.concatenate([prev, t], axis=4)

    qb, kb, vb = to_blocks(q), to_blocks(k), to_blocks(v)
    kc, vc = with_prev(kb), with_prev(vb)
    s = jnp.einsum('bdhnqe,bdhnke->bdhnqk', qb, kc) * (E ** -0.5)
    qi = jnp.arange(blk)[:, None]
    kj = jnp.arange(2 * blk)[None, :]
    dist = blk + qi - kj
    band = (dist >= 0) & (dist <= blk)
    key_sub = jnp.arange(nb)[:, None, None] * blk + kj[None] - blk
    mask = band[None] & (key_sub >= 0)
    s = jnp.where(mask, s.astype(jnp.float32), -jnp.inf)
    m = jnp.max(s, axis=-1, keepdims=True)
    p = jnp.exp(s - m)
    l = jnp.sum(p, axis=-1)
    o = jnp.einsum('bdhnqk,bdhnke->bdhnqe', p, vc) / l[..., None]

    def from_blocks(t):
        t = t.reshape((B, dilation, H, Lp) + t.shape[5:])[:, :, :, :L]
        t = jnp.moveaxis(t, 3, 1)
        return t.reshape((B, S, H) + t.shape[4:])

    return from_blocks(o), from_blocks(m[..., 0]), from_blocks(l)


def hybrid_mixer(h, positions, w_in, shift_mu, w0, w2_decay, a0, a2_iclr, g2_gate,
                 k_k, k_a, r_k, ln_x_w, ln_x_b, w_o_rwkv, w_o_attn, w_out):
    B, S, _ = h.shape
    proj = h @ w_in

    z = proj[..., :SHIFT_WIDTH]
    z = z + (token_shift(z) - z) * shift_mu
    zr, zk, zv, zw, za, zg = split_cols(
        z, (RWKV_WIDTH, RWKV_WIDTH, RWKV_WIDTH, DECAY_LORA, ICLR_LORA, GATE_LORA))
    y_a = rwkv7_branch(zr, zk, zv, zw, za, zg, w0, w2_decay, a0, a2_iclr, g2_gate,
                       k_k, k_a, r_k, ln_x_w, ln_x_b, w_o_rwkv)

    q, k, v, gate_a, gate_b = split_cols(
        proj[..., SHIFT_WIDTH:], (ATTN_WIDTH, ATTN_WIDTH, ATTN_WIDTH, D_MODEL, D_MODEL))
    shape5 = (B, S, N_GROUPS, HEADS_PER_GROUP, ATTN_HEAD_DIM)
    q = partial_rotary(q.reshape(shape5), positions)
    k = partial_rotary(k.reshape(shape5), positions)
    v = v.reshape(shape5).astype(jnp.float32)
    outs, ms, ls = [], [], []
    for gi, (window, dilation) in enumerate(ATTN_GROUPS):
        o_g, m_g, l_g = dilated_window_attention(q[:, :, gi], k[:, :, gi], v[:, :, gi], window, dilation)
        outs.append(o_g)
        ms.append(m_g)
        ls.append(l_g)
    m_all = jnp.stack(ms)
    wts = jnp.stack(ls) * jnp.exp(m_all - jnp.max(m_all, axis=0, keepdims=True))
    o = jnp.einsum('gbsh,gbshe->bshe', wts, jnp.stack(outs)) / jnp.sum(wts, axis=0)[..., None]
    y_b = o.reshape(B, S, ATTN_OUT_WIDTH) @ w_o_attn

    merged = (jax.nn.sigmoid(gate_a.astype(jnp.float32)) * y_a
              + jax.nn.sigmoid(gate_b.astype(jnp.float32)) * y_b)
    return merged @ w_out


def moe_ffn(h, w_router, b_router, w1, b1, w2, b2):
    B, S, D = h.shape
    t = h.reshape(-1, D)
    T = t.shape[0]
    logits = (t @ w_router).astype(jnp.float32) + b_router.astype(jnp.float32)
    top_val, top_idx = lax.top_k(logits, TOP_K)
    gates = jax.nn.softmax(top_val, axis=-1)
    flat_e = top_idx.reshape(-1)
    order = jnp.argsort(flat_e)
    e_sorted = flat_e[order]
    tok = order // TOP_K
    group_sizes = jnp.bincount(flat_e, length=N_EXPERTS).astype(jnp.int32)
    xs = t[tok]
    hid = lax.ragged_dot(xs, w1, group_sizes) + b1[e_sorted]
    x_glu = jnp.minimum(hid[:, :EXPERT_FF], SWIGLU_LIMIT)
    x_lin = jnp.clip(hid[:, EXPERT_FF:], -SWIGLU_LIMIT, SWIGLU_LIMIT)
    act = x_glu * jax.nn.sigmoid(SWIGLU_ALPHA * x_glu) * (x_lin + 1.0)
    out = lax.ragged_dot(act.astype(w2.dtype), w2, group_sizes) + b2[e_sorted]
    out = out.astype(jnp.float32) * gates.reshape(-1)[order][:, None]
    y = jnp.zeros((T, D), jnp.float32).at[tok].add(out)
    return y.reshape(B, S, D)


def setup_inputs(seed: int = 0) -> dict:
    key = jax.random.key(seed)
    ks = jax.random.split(key, 32)
    f32 = jnp.float32
    nrm = lambda k, shape, scale: jax.random.normal(k, shape, f32) * scale
    x = nrm(ks[0], (BATCH, SEQ, D_MODEL), 1.0)
    offsets = jax.random.randint(ks[1], (BATCH, 1), 0, 4096, dtype=jnp.int32)
    positions = (offsets + jnp.arange(SEQ, dtype=jnp.int32)[None, :]).astype(jnp.int32)
    return {
        "x": x,
        "positions": positions,
        "norm_mix": 1.0 + nrm(ks[2], (DEPTH, D_MODEL), 0.02),
        "w_in": nrm(ks[3], (DEPTH, D_MODEL, IN_WIDTH), D_MODEL ** -0.5),
        "shift_mu": jax.random.uniform(ks[4], (DEPTH, SHIFT_WIDTH), f32),
        "w0": jax.random.uniform(ks[5], (DEPTH, RWKV_WIDTH), f32, -6.0, 1.0),
        "w2_decay": nrm(ks[6], (DEPTH, DECAY_LORA, RWKV_WIDTH), 0.5 * DECAY_LORA ** -0.5),
        "a0": nrm(ks[7], (DEPTH, RWKV_WIDTH), 0.5),
        "a2_iclr": nrm(ks[8], (DEPTH, ICLR_LORA, RWKV_WIDTH), 0.5 * ICLR_LORA ** -0.5),
        "g2_gate": nrm(ks[9], (DEPTH, GATE_LORA, RWKV_WIDTH), GATE_LORA ** -0.5),
        "k_k": 0.85 + nrm(ks[10], (DEPTH, RWKV_WIDTH), 0.05),
        "k_a": 1.0 + nrm(ks[11], (DEPTH, RWKV_WIDTH), 0.05),
        "r_k": nrm(ks[12], (DEPTH, RWKV_HEADS, RWKV_HEAD_DIM), 0.1),
        "ln_x_w": 1.0 + nrm(ks[13], (DEPTH, RWKV_WIDTH), 0.02),
        "ln_x_b": nrm(ks[14], (DEPTH, RWKV_WIDTH), 0.01),
        "w_o_rwkv": nrm(ks[15], (DEPTH, RWKV_WIDTH, D_MODEL), RWKV_WIDTH ** -0.5),
        "w_o_attn": nrm(ks[16], (DEPTH, ATTN_OUT_WIDTH, D_MODEL), ATTN_OUT_WIDTH ** -0.5),
        "w_out": nrm(ks[17], (DEPTH, D_MODEL, D_MODEL), D_MODEL ** -0.5),
        "norm_ffn": 1.0 + nrm(ks[18], (DEPTH, D_MODEL), 0.02),
        "w_router": nrm(ks[19], (DEPTH, D_MODEL, N_EXPERTS), D_MODEL ** -0.5),
        "b_router": nrm(ks[20], (DEPTH, N_EXPERTS), 0.01),
        "w1": nrm(ks[21], (DEPTH, N_EXPERTS, D_MODEL, 2 * EXPERT_FF), D_MODEL ** -0.5),
        "b1": nrm(ks[22], (DEPTH, N_EXPERTS, 2 * EXPERT_FF), 0.01),
        "w2": nrm(ks[23], (DEPTH, N_EXPERTS, EXPERT_FF, D_MODEL), EXPERT_FF ** -0.5),
        "b2": nrm(ks[24], (DEPTH, N_EXPERTS, D_MODEL), 0.01),
        "norm_final": 1.0 + nrm(ks[25], (D_MODEL,), 0.02),
    }


def reference(x, positions, norm_mix, w_in, shift_mu, w0, w2_decay, a0, a2_iclr, g2_gate,
              k_k, k_a, r_k, ln_x_w, ln_x_b, w_o_rwkv, w_o_attn, w_out, norm_ffn,
              w_router, b_router, w1, b1, w2, b2, norm_final):
    for layer in range(DEPTH):
        h = rms_norm(x, norm_mix[layer])
        mix = hybrid_mixer(h, positions, w_in[layer], shift_mu[layer], w0[layer], w2_decay[layer],
                           a0[layer], a2_iclr[layer], g2_gate[layer], k_k[layer], k_a[layer],
                           r_k[layer], ln_x_w[layer], ln_x_b[layer], w_o_rwkv[layer],
                           w_o_attn[layer], w_out[layer])
        x = x + mix.astype(x.dtype)
        h = rms_norm(x, norm_ffn[layer])
        x = x + moe_ffn(h, w_router[layer], b_router[layer], w1[layer], b1[layer],
                        w2[layer], b2[layer]).astype(x.dtype)
    return rms_norm(x, norm_final)
```

```cpp
#include <hip/hip_runtime.h>
#include <cstdio>
#include <cstdint>
#include <cmath>
namespace pg8 {
#define PG8_LAS __attribute__((address_space(3)))
typedef unsigned short bf16_t;
typedef short bf16x8 __attribute__((ext_vector_type(8)));
typedef float f32x4 __attribute__((ext_vector_type(4)));
typedef unsigned u32x4 __attribute__((ext_vector_type(4)));
constexpr int BM = 256, BK = 64, HALF = 128, HTB = HALF * BK * 2  , STAGE_BYTES = 8 * HTB, NXCD = 8, WGM = 8;

__host__ __device__ __forceinline__ int lds_byte(int r, int c) { const int st = (r >> 4) * 2 + (c >> 5), rr = r & 15, cc = c & 31, ob = rr * 64 + cc * 2; return st * 1024 + (ob ^ (((ob >> 9) & 1) << 5)); }
__host__ __device__ __forceinline__ void stage_rc(int b, int& R, int& C) { const int st = b / 1024, sb = b % 1024, swz = sb ^ (((sb >> 9) & 1) << 5); R = (st >> 1) * 16 + swz / 64; C = (st & 1) * 32 + (swz % 64) / 2; }
__host__ __device__ __forceinline__ int perm32(int rho) { const int n = rho >> 4, i = rho & 15; return 8 * (i >> 2) + 4 * n + (i & 3); }

struct Unit { int pm, pn; };
struct Gemm { const bf16_t* A; const bf16_t* Bt; int M, N, K; };

struct StaticOrder {
    int nM, nN, nwg, G, c;
    __host__ __device__ void init(int M, int N, int G_, int c_) { nM = M / BM; nN = N / BM; nwg = nM * nN; G = G_; c = c_; }
    __host__ __device__ bool next(int i, Unit& u) const {
        const long L = (long)i * G + c; if (L >= nwg) return false;
        int wgid = (int)L; { const int q = nwg / NXCD, r = nwg % NXCD, xcd = wgid % NXCD, off = wgid / NXCD; wgid = (xcd < r ? xcd * (q + 1) : r * (q + 1) + (xcd - r) * q) + off; }
        const int nig = WGM * nN, gid = wgid / nig, fm = gid * WGM, gsz = (nM - fm) < WGM ? (nM - fm) : WGM;
        u.pm = fm + ((wgid % nig) % gsz); u.pn = (wgid % nig) / gsz; return true;
    }
    __device__ __forceinline__ void a_ready(const Unit&) const {}
    __device__ __forceinline__ void done(const Unit&) const {}
};

__device__ __forceinline__ unsigned cvt_pk_bf16(float lo, float hi) { unsigned r; asm volatile("v_cvt_pk_bf16_f32 %0, %1, %2" : "=v"(r) : "v"(lo), "v"(hi)); return r; }
typedef float f32x2 __attribute__((ext_vector_type(2)));

template <class Epi, class Sched, bool ALIGN_EPI = false, bool SP2 = false>
__device__ __forceinline__ void gemm_phase(PG8_LAS unsigned char* lds, const Gemm g, const Sched& S, const Epi& E) {
    const int tid = threadIdx.x, wid = __builtin_amdgcn_readfirstlane(tid >> 6), lane = tid & 63, wr = wid >> 2, wc = wid & 3, fr = lane & 15, fq = lane >> 4;
    const int K = g.K, nt = K / BK;
    unsigned voffA[2], voffB[2];
#pragma unroll
    for (int i = 0; i < 2; ++i) { int R, C; stage_rc(tid * 16 + i * 8192, R, C); const int Rb = Epi::PERM ? ((R & ~31) + perm32(R & 31)) : R;
        voffA[i] = (unsigned)(R * K + C) * 2u; voffB[i] = (unsigned)(Rb * K + C) * 2u; }
    const size_t kstep = (size_t)(BK * 2);
    const size_t hstep = (size_t)HALF * K * 2;
    const size_t tstep = 2 * hstep;
    const unsigned ldsw = (unsigned)wid * 1024u;
    const int aoff = lds_byte(wr * 64 + fr, fq * 8), boff = lds_byte(wc * 32 + fr, fq * 8);
#define PG8_SA(b, h) (((b) * 2 + (h)) * HTB)
#define PG8_SB(b, h) ((4 + (b) * 2 + (h)) * HTB)
#define PG8_STAGE(bufoff, gbase, voff) do { _Pragma("unroll") for (int _i = 0; _i < 2; ++_i) \
        __builtin_amdgcn_global_load_lds((const unsigned*)((const char*)(gbase) + (voff)[_i]), (PG8_LAS unsigned*)(lds + (bufoff) + ldsw + _i * 8192), 16, 0, 0); } while (0)
#define PG8_LDA(dst, b, h) do { _Pragma("unroll") for (int m = 0; m < 4; ++m) _Pragma("unroll") for (int k = 0; k < 2; ++k) dst[m][k] = *(const PG8_LAS bf16x8*)(lds + PG8_SA(b, h) + aoff + m * 2048 + k * 1024); } while (0)
#define PG8_LDB(dst, b, h) do { _Pragma("unroll") for (int n = 0; n < 2; ++n) _Pragma("unroll") for (int k = 0; k < 2; ++k) dst[n][k] = *(const PG8_LAS bf16x8*)(lds + PG8_SB(b, h) + boff + n * 2048 + k * 1024); } while (0)
#define PG8_MMA(ai, bj, At, Bt) do { __builtin_amdgcn_s_setprio(1); _Pragma("unroll") for (int m = 0; m < 4; ++m) _Pragma("unroll") for (int n = 0; n < 2; ++n) _Pragma("unroll") for (int k = 0; k < 2; ++k) \
        acc[ai][bj][m][n] = __builtin_amdgcn_mfma_f32_16x16x32_bf16(Bt[n][k], At[m][k], acc[ai][bj][m][n], 0, 0, 0); __builtin_amdgcn_s_setprio(0); } while (0)
#define PG8_WAIT_V(n) asm volatile("s_waitcnt vmcnt(" #n ")" ::: "memory")
#define PG8_WAIT_L(n) asm volatile("s_waitcnt lgkmcnt(" #n ")" ::: "memory")
#define PG8_BAR __builtin_amdgcn_s_barrier()
#define PG8_SCHED __builtin_amdgcn_sched_barrier(0)
    Unit cur, nxt; int ui = 0;
    if (!S.next(0, cur)) return;
    f32x4 acc[2][2][4][2];
#pragma unroll
    for (int a = 0; a < 2; ++a)
#pragma unroll
        for (int b = 0; b < 2; ++b)
#pragma unroll
            for (int m = 0; m < 4; ++m)
#pragma unroll
                for (int n = 0; n < 2; ++n) acc[a][b][m][n] = (f32x4){0.f, 0.f, 0.f, 0.f};
    bf16x8 At[4][2], B0[2][2], B1[2][2];
    const char* cA = (const char*)g.A + (size_t)cur.pm * tstep; const char* cB = (const char*)g.Bt + (size_t)cur.pn * tstep;
    S.a_ready(cur);
    if constexpr (SP2) {
        PG8_STAGE(PG8_SB(0, 0), cB, voffB); PG8_STAGE(PG8_SB(0, 1), cB + hstep, voffB); PG8_STAGE(PG8_SA(0, 0), cA, voffA); PG8_STAGE(PG8_SA(0, 1), cA + hstep, voffA);
        if (wr == 1) PG8_BAR;
        PG8_WAIT_V(2); PG8_BAR;
        PG8_STAGE(PG8_SB(1, 0), cB + kstep, voffB); PG8_STAGE(PG8_SA(1, 0), cA + kstep, voffA); PG8_STAGE(PG8_SB(1, 1), cB + hstep + kstep, voffB);
        PG8_WAIT_V(6); PG8_BAR;
    } else {
        PG8_STAGE(PG8_SB(0, 0), cB, voffB); PG8_STAGE(PG8_SA(0, 0), cA, voffA); PG8_STAGE(PG8_SB(0, 1), cB + hstep, voffB); PG8_STAGE(PG8_SA(0, 1), cA + hstep, voffA);
        if (wr == 1) PG8_BAR;
        PG8_WAIT_V(4); PG8_BAR;
        PG8_STAGE(PG8_SB(1, 0), cB + kstep, voffB); PG8_STAGE(PG8_SA(1, 0), cA + kstep, voffA); PG8_STAGE(PG8_SB(1, 1), cB + hstep + kstep, voffB);
        PG8_WAIT_V(6); PG8_BAR;
    }
    for (;;) {
        const bool has_next = S.next(ui + 1, nxt);
        const char* nA = has_next ? (const char*)g.A + (size_t)nxt.pm * tstep : cA; const char* nB = has_next ? (const char*)g.Bt + (size_t)nxt.pn * tstep : cB;
        for (int t = 0; t < nt; t += 2) {
            const bool last = (t == nt - 2);
            const char* a1 = cA + (size_t)(t + 1) * kstep;
            const char* a2 = last ? nA : cA + (size_t)(t + 2) * kstep; const char* b2 = last ? nB : cB + (size_t)(t + 2) * kstep;
            const char* a3 = a2 + kstep; const char* b3 = b2 + kstep;
            if (last && has_next) S.a_ready(nxt);
            if constexpr (SP2) {
            PG8_LDB(B0, 0, 0); PG8_LDB(B1, 0, 1); PG8_SCHED; PG8_LDA(At, 0, 0); PG8_STAGE(PG8_SA(1, 1), a1 + hstep, voffA);
            PG8_WAIT_V(8); PG8_WAIT_L(0); PG8_BAR; PG8_MMA(0, 0, At, B0); PG8_MMA(0, 1, At, B1); PG8_BAR; PG8_SCHED;
            PG8_LDA(At, 0, 1); PG8_STAGE(PG8_SB(0, 0), b2, voffB); PG8_STAGE(PG8_SB(0, 1), b2 + hstep, voffB); PG8_STAGE(PG8_SA(0, 0), a2, voffA);
            PG8_WAIT_V(8); PG8_WAIT_L(0); PG8_BAR; PG8_MMA(1, 0, At, B0); PG8_MMA(1, 1, At, B1); PG8_BAR; PG8_SCHED;
            PG8_LDB(B0, 1, 0); PG8_LDB(B1, 1, 1); PG8_SCHED; PG8_LDA(At, 1, 0); PG8_STAGE(PG8_SA(0, 1), a2 + hstep, voffA);
            PG8_WAIT_V(8); PG8_WAIT_L(0); PG8_BAR; PG8_MMA(0, 0, At, B0); PG8_MMA(0, 1, At, B1); PG8_BAR; PG8_SCHED;
            PG8_LDA(At, 1, 1); PG8_STAGE(PG8_SB(1, 0), b3, voffB); PG8_STAGE(PG8_SB(1, 1), b3 + hstep, voffB); PG8_STAGE(PG8_SA(1, 0), a3, voffA);
            PG8_WAIT_V(8); PG8_WAIT_L(0); PG8_BAR; PG8_MMA(1, 0, At, B0); PG8_MMA(1, 1, At, B1); PG8_BAR; PG8_SCHED;
            } else {
            PG8_LDB(B0, 0, 0); PG8_SCHED; PG8_LDA(At, 0, 0); PG8_STAGE(PG8_SA(1, 1), a1 + hstep, voffA);
            PG8_WAIT_L(8); PG8_BAR; PG8_WAIT_L(0); PG8_MMA(0, 0, At, B0); PG8_BAR; PG8_SCHED;
            PG8_LDB(B1, 0, 1); PG8_STAGE(PG8_SB(0, 0), b2, voffB);
            PG8_BAR; PG8_WAIT_L(0); PG8_MMA(0, 1, At, B1); PG8_BAR;
            PG8_LDA(At, 0, 1); PG8_STAGE(PG8_SA(0, 0), a2, voffA);
            PG8_BAR; PG8_WAIT_L(0); PG8_MMA(1, 0, At, B0); PG8_BAR; PG8_SCHED;
            PG8_STAGE(PG8_SB(0, 1), b2 + hstep, voffB);
            PG8_WAIT_V(6); PG8_BAR; PG8_MMA(1, 1, At, B1); PG8_BAR;
            PG8_LDB(B0, 1, 0); PG8_SCHED; PG8_LDA(At, 1, 0); PG8_STAGE(PG8_SA(0, 1), a2 + hstep, voffA);
            PG8_WAIT_L(8); PG8_BAR; PG8_WAIT_L(0); PG8_MMA(0, 0, At, B0); PG8_BAR; PG8_SCHED;
            PG8_LDB(B1, 1, 1); PG8_STAGE(PG8_SB(1, 0), b3, voffB);
            PG8_BAR; PG8_WAIT_L(0); PG8_MMA(0, 1, At, B1); PG8_BAR;
            PG8_LDA(At, 1, 1); PG8_STAGE(PG8_SA(1, 0), a3, voffA);
            PG8_BAR; PG8_WAIT_L(0); PG8_MMA(1, 0, At, B0); PG8_BAR; PG8_SCHED;
            PG8_STAGE(PG8_SB(1, 1), b3 + hstep, voffB);
            PG8_WAIT_V(6); PG8_BAR; PG8_MMA(1, 1, At, B1); PG8_BAR;
            }
        }
        if constexpr (ALIGN_EPI) { if (wr == 0) PG8_BAR; }
        if constexpr (!Epi::AFTER_DRAIN) { E(acc, cur, wr, wc, fr, fq); S.done(cur); }
        if (!has_next) break;
#pragma unroll
        for (int a = 0; a < 2; ++a)
#pragma unroll
            for (int b = 0; b < 2; ++b)
#pragma unroll
                for (int m = 0; m < 4; ++m)
#pragma unroll
                    for (int n = 0; n < 2; ++n) acc[a][b][m][n] = (f32x4){0.f, 0.f, 0.f, 0.f};
        cur = nxt; cA = nA; cB = nB; ++ui;
        if constexpr (ALIGN_EPI) { if (wr == 1) PG8_BAR; }
    }
    PG8_WAIT_V(0);
    if constexpr (!ALIGN_EPI) { if (wr == 0) PG8_BAR; }
    PG8_BAR;
    if constexpr (Epi::AFTER_DRAIN) { E.fused(acc, cur, wr, wc, fr, fq, lds, wid, lane); S.done(cur); }
#undef PG8_SA
#undef PG8_SB
#undef PG8_STAGE
#undef PG8_LDA
#undef PG8_LDB
#undef PG8_MMA
#undef PG8_WAIT_V
#undef PG8_WAIT_L
#undef PG8_BAR
#undef PG8_SCHED
}
}


constexpr int NB = 4, SEQ = 4096, T = NB * SEQ, D = 2048;
constexpr int RW = 1024, NH = 16, HD = 64;
constexpr int IN_W = 12064, SHIFT_W = 3360;
constexpr int ZPW = 3584, QKVW = 4608, GATEW = 4096, NPROJ = 12288;
constexpr int NE = 32, FF = 2048;
constexpr int XS_ROWS = T * 4 + NE * 256;
constexpr int NWAVES = 8, NTHREADS = 512;
constexpr float NORM_EPS = 1e-5f, GN_EPS = 64e-5f;
constexpr float QSCALE = 0.08838834764831845f * 1.4426950408889634f;

#ifndef MK_ONE_LAUNCH
#define MK_ONE_LAUNCH 0
#endif
constexpr int NPHASES = 13;

constexpr size_t MiB = 1ull << 20;
constexpr size_t WS_CTL = 0, CTL_ZERO_BYTES = 1 * MiB;
constexpr size_t WS_WIN = 1 * MiB;
constexpr size_t WS_W1 = WS_WIN + 48 * MiB;
constexpr size_t WS_W2 = WS_W1 + 512 * MiB;
constexpr size_t WS_WOR = WS_W2 + 256 * MiB;
constexpr size_t WS_WOA = WS_WOR + 4 * MiB;
constexpr size_t WS_WOUT = WS_WOA + 2 * MiB;
constexpr size_t WS_H = WS_WOUT + 8 * MiB;
constexpr size_t WS_ZP = WS_H + 64 * MiB;
constexpr size_t WS_QKV = WS_ZP + 112 * MiB;
constexpr size_t WS_GATES = WS_QKV + 144 * MiB;
constexpr size_t WS_ROT = WS_GATES + 128 * MiB;
constexpr size_t WS_SC = WS_ROT + 2 * MiB;
constexpr size_t WS_G = WS_SC + 384 * MiB;
constexpr size_t WS_BONUS = WS_G + 32 * MiB;
constexpr size_t WS_Y = WS_BONUS + 1 * MiB;
constexpr size_t WS_ATTO = WS_Y + 64 * MiB;
constexpr size_t WS_ATTML = WS_ATTO + 48 * MiB;
constexpr size_t WS_YAIN = WS_ATTML + 2 * MiB;
constexpr size_t WS_OIN = WS_YAIN + 32 * MiB;
constexpr size_t WS_MERGED = WS_OIN + 16 * MiB;
constexpr size_t WS_X1 = WS_MERGED + 64 * MiB;
constexpr size_t WS_TOPK = WS_X1 + 128 * MiB;
constexpr size_t WS_ROWS = WS_TOPK + 1 * MiB;
constexpr size_t WS_XS = WS_ROWS + 1 * MiB;
constexpr size_t WS_ACT = WS_XS + 288 * MiB;
constexpr size_t WS_OUTK = WS_ACT + 288 * MiB;
constexpr size_t WS_END = WS_OUTK + 256 * MiB;
constexpr size_t SC_STRIDE = (size_t)T * RW;
enum { SC_KK = 0, SC_W = 1, SC_BB = 2, SC_K = 3, SC_R = 4, SC_V = 5 };

constexpr int CW_TMO = 0, CW_CODE = 1, CW_BAR = 4096, CW_CNT = 8192;

constexpr int RING_BYTES = 131072;
constexpr int TAB_OFF = RING_BYTES;
constexpr int MISC_OFF = TAB_OFF + 512;
constexpr int LDS_BYTES = 147456;

#define GAS __attribute__((address_space(1)))
#define LAS __attribute__((address_space(3)))
typedef unsigned short bf16;
typedef unsigned u32x4 __attribute__((ext_vector_type(4)));
typedef unsigned u32x2 __attribute__((ext_vector_type(2)));
typedef float f32x4 __attribute__((ext_vector_type(4)));
typedef short bf16x8 __attribute__((ext_vector_type(8)));
typedef short bf16x4 __attribute__((ext_vector_type(4)));
typedef GAS unsigned gu32;
#define RLX_AGENT __ATOMIC_RELAXED, __HIP_MEMORY_SCOPE_AGENT
#define LDS_WAIT() asm volatile("s_waitcnt lgkmcnt(0)" ::: "memory")
#define VM_WAIT() asm volatile("s_waitcnt vmcnt(0)" ::: "memory")
__device__ __forceinline__ unsigned f2bf(float f) { unsigned u = __builtin_bit_cast(unsigned, f); return (u + 0x7fffu + ((u >> 16) & 1u)) >> 16; }
__device__ __forceinline__ unsigned pk2(float lo, float hi) { return f2bf(lo) | (f2bf(hi) << 16); }
__device__ __forceinline__ float bflo(unsigned w) { return __uint_as_float(w << 16); }
__device__ __forceinline__ float bfhi(unsigned w) { return __uint_as_float(w & 0xffff0000u); }
__device__ __forceinline__ float bf2f(bf16 h) { return __uint_as_float((unsigned)h << 16); }
__device__ __forceinline__ float sigmoidf_(float x) { return 1.0f / (1.0f + __expf(-x)); }
__device__ __forceinline__ float wave_sum(float v) {
#pragma unroll
    for (int o = 1; o < 64; o <<= 1) v += __shfl_xor(v, o);
    return v;
}
__device__ __forceinline__ u32x4 pack8(const f32x4& a, const f32x4& b) { u32x4 w; w.x = pk2(a[0], a[1]); w.y = pk2(a[2], a[3]); w.z = pk2(b[0], b[1]); w.w = pk2(b[2], b[3]); return w; }
__device__ __forceinline__ void unpack8(const u32x4& w, f32x4& a, f32x4& b) { a = (f32x4){bflo(w.x), bfhi(w.x), bflo(w.y), bfhi(w.y)}; b = (f32x4){bflo(w.z), bfhi(w.z), bflo(w.w), bfhi(w.w)}; }

#define XB_TMO      128
#define XB_XCNT(j)  (256  + 64 * (j))
#define XB_XSUB(j)  (1280 + 64 * (j))
#define XB_XGEN(j)  (2304 + 64 * (j))
#define XB_TOP      3328
#define XB_TOPGEN   3392
#define XCD_BAR_WORDS 3456
#define XB_SPIN_CAP (1u << 18)

__device__ __forceinline__ unsigned xb_ld(unsigned* p)              { return __hip_atomic_load(p, __ATOMIC_RELAXED, __HIP_MEMORY_SCOPE_AGENT); }
__device__ __forceinline__ unsigned xb_add(unsigned* p, unsigned v) { return __hip_atomic_fetch_add(p, v, __ATOMIC_RELAXED, __HIP_MEMORY_SCOPE_AGENT); }
__device__ __forceinline__ unsigned xb_xcc_id() { return (unsigned)__builtin_amdgcn_s_getreg((3 << 11) | 20) & 0xFu; }
#define XB_SPIN(cond, bar) do { unsigned _sp = 0; while (cond) { __builtin_amdgcn_s_sleep(1); \
    if ((++_sp & 255u) == 0u) { if (xb_ld(&(bar)[XB_TMO])) break; if (_sp > XB_SPIN_CAP) { atomicAdd(&(bar)[XB_TMO], 1u); break; } } } } while (0)

struct XcdBarrier {
    unsigned* bar; unsigned x;
    volatile LAS unsigned* st;
};

__device__ __forceinline__ XcdBarrier xcd_barrier_post(unsigned* bar, volatile LAS unsigned* st) {
    XcdBarrier b; b.bar = bar; b.x = xb_xcc_id(); b.st = st;
    if (threadIdx.x == 0) (void)xb_add(&bar[XB_XCNT(b.x)], 1u);
    return b;
}
__device__ __forceinline__ void xcd_barrier_complete(unsigned* bar, unsigned x, unsigned& nloc, unsigned& nx) {
    const unsigned G = gridDim.x * gridDim.y * gridDim.z;
    unsigned sum, cnt, mine, sp = 0u;
    for (;;) {
        sum = 0u; cnt = 0u; mine = 0u;
#pragma unroll
        for (unsigned j = 0; j < 16; ++j) { const unsigned c = xb_ld(&bar[XB_XCNT(j)]); sum += c; cnt += (c > 0u) ? 1u : 0u; mine = (j == x) ? c : mine; }
        if (sum == G) break;
        __builtin_amdgcn_s_sleep(1);
        if ((++sp & 255u) == 0u) { if (xb_ld(&bar[XB_TMO])) break; if (sp > XB_SPIN_CAP) { atomicAdd(&bar[XB_TMO], 1u); break; } }
    }
    nloc = mine > 0u ? mine : 1u; nx = cnt > 0u ? cnt : 1u;
}

__device__ __forceinline__ void xcd_barrier(const XcdBarrier& b) {
    asm volatile("s_waitcnt vmcnt(0)" ::: "memory");
    __syncthreads();
    if (threadIdx.x == 0) {
        unsigned* bar = b.bar;
        __builtin_amdgcn_s_waitcnt(0);
        unsigned nloc = b.st[0], nx = b.st[1];
        if (nloc == 0u) { xcd_barrier_complete(bar, b.x, nloc, nx); b.st[0] = nloc; b.st[1] = nx; }
        const unsigned old = xb_add(&bar[XB_XSUB(b.x)], 1u);
        const unsigned gen = old / nloc;
        if (old + 1u == (gen + 1u) * nloc) {
            __builtin_amdgcn_fence(__ATOMIC_RELEASE, "agent");
            asm volatile("s_waitcnt vmcnt(0)" ::: "memory");
            const unsigned og = xb_add(&bar[XB_TOP], 1u);
            const unsigned tg = og / nx;
            if (og + 1u == (tg + 1u) * nx) xb_add(&bar[XB_TOPGEN], 1u);
            else XB_SPIN(xb_ld(&bar[XB_TOPGEN]) == tg, bar);
            __builtin_amdgcn_fence(__ATOMIC_ACQUIRE, "agent");
            xb_add(&bar[XB_XGEN(b.x)], 1u);
            asm volatile("s_waitcnt vmcnt(0)" ::: "memory");
        } else {
            XB_SPIN(xb_ld(&bar[XB_XGEN(b.x)]) == gen, bar);
            __builtin_amdgcn_fence(__ATOMIC_ACQUIRE, "agent");
            asm volatile("s_waitcnt vmcnt(0)" ::: "memory");
        }
    }
    __syncthreads();
}


struct Ptrs {
    const float *x, *norm_mix, *w_in, *shift_mu, *w0, *w2_decay, *a0, *a2_iclr, *g2_gate, *k_k, *k_a, *r_k, *ln_x_w, *ln_x_b, *w_o_rwkv, *w_o_attn, *w_out, *norm_ffn, *w_router, *b_router, *w1, *b1, *w2, *b2, *norm_final;
    const int* positions;
    float* out;
    bf16 *WIN, *W1, *W2, *WOR, *WOA, *WOUT, *H, *ZP, *QKV, *GATES, *G, *ATTO, *YAIN, *OIN, *MERGED, *XS, *ACT, *OUTK;
    float *ROT, *SC, *BONUS, *Y, *ATTML, *X1, *TOPK_GATE, *ROWGATE;
    int *TOPK_E, *TOPK_POS, *ROWTOK;
    gu32* ctl;
};

using pg8::Unit;
__device__ __forceinline__ void store8(bf16* p, const f32x4& a, const f32x4& b) { *(u32x4*)p = pack8(a, b); }

struct EpiProj {
    static constexpr bool PERM = true, AFTER_DRAIN = false;
    bf16* ZP; bf16* QKV; bf16* GATES; const float* ROT;
    __device__ __forceinline__ void operator()(const f32x4 (&acc)[2][2][4][2], const Unit& u, int wr, int wc, int fr, int fq) const {
        const int pn = u.pn, rbase = u.pm * 256 + wr * 64 + fr, cw = wc * 32 + 8 * fq;
        if (pn < 14) {
#pragma unroll
            for (int ai = 0; ai < 2; ++ai)
#pragma unroll
                for (int m = 0; m < 4; ++m) { bf16* rp = ZP + (size_t)(rbase + ai * 128 + m * 16) * ZPW + pn * 256 + cw;
#pragma unroll
                    for (int bj = 0; bj < 2; ++bj) store8(rp + bj * 128, acc[ai][bj][m][0], acc[ai][bj][m][1]); }
        } else if (pn < 32) {
            const int t = pn - 14; const bool rot = (t < 12) && (wc == 0); const float sc = (t < 6) ? QSCALE : 1.0f; const float sg = (fq < 2) ? -1.0f : 1.0f;
#pragma unroll
            for (int ai = 0; ai < 2; ++ai)
#pragma unroll
                for (int m = 0; m < 4; ++m) { const int row = rbase + ai * 128 + m * 16; bf16* rp = QKV + (size_t)row * QKVW + t * 256 + cw;
                    f32x4 c0 = {1.f, 1.f, 1.f, 1.f}, c1 = c0, s0 = {0.f, 0.f, 0.f, 0.f}, s1 = s0;
                    if (rot) { const float* rt = ROT + (size_t)row * 32 + 8 * (fq & 1); c0 = *(const f32x4*)rt; c1 = *(const f32x4*)(rt + 4); s0 = *(const f32x4*)(rt + 16); s1 = *(const f32x4*)(rt + 20); }
#pragma unroll
                    for (int bj = 0; bj < 2; ++bj) { f32x4 v0 = acc[ai][bj][m][0], v1 = acc[ai][bj][m][1];
                        if (rot) { f32x4 p0, p1;
#pragma unroll
                            for (int j = 0; j < 4; ++j) { p0[j] = __shfl_xor(v0[j], 32); p1[j] = __shfl_xor(v1[j], 32); }
                            v0 = v0 * c0 + (p0 * s0) * sg; v1 = v1 * c1 + (p1 * s1) * sg; }
                        v0 = v0 * sc; v1 = v1 * sc; store8(rp + bj * 128, v0, v1); } }
        } else {
            const int t = pn - 32;
#pragma unroll
            for (int ai = 0; ai < 2; ++ai)
#pragma unroll
                for (int m = 0; m < 4; ++m) { bf16* rp = GATES + (size_t)(rbase + ai * 128 + m * 16) * GATEW + t * 256 + cw;
#pragma unroll
                    for (int bj = 0; bj < 2; ++bj) { f32x4 v0 = acc[ai][bj][m][0], v1 = acc[ai][bj][m][1];
#pragma unroll
                        for (int j = 0; j < 4; ++j) { v0[j] = sigmoidf_(v0[j]); v1[j] = sigmoidf_(v1[j]); }
                        store8(rp + bj * 128, v0, v1); } }
        }
    }
};

template <int STAGE> struct EpiMerge {
    static constexpr bool PERM = true, AFTER_DRAIN = false;
    bf16* MERGED; const bf16* GATES;
    __device__ __forceinline__ void operator()(const f32x4 (&acc)[2][2][4][2], const Unit& u, int wr, int wc, int fr, int fq) const {
        const int rbase = u.pm * 256 + wr * 64 + fr, cb = u.pn * 256 + wc * 32 + 8 * fq;
#pragma unroll
        for (int ai = 0; ai < 2; ++ai)
#pragma unroll
            for (int m = 0; m < 4; ++m) { const int row = rbase + ai * 128 + m * 16;
#pragma unroll
                for (int bj = 0; bj < 2; ++bj) { const int col = cb + bj * 128;
                    const u32x4 gw = *(const u32x4*)(GATES + (size_t)row * GATEW + STAGE * 2048 + col); f32x4 g0, g1; unpack8(gw, g0, g1);
                    f32x4 v0 = acc[ai][bj][m][0] * g0, v1 = acc[ai][bj][m][1] * g1; bf16* dp = MERGED + (size_t)row * D + col;
                    if (STAGE == 1) { const u32x4 tw = *(const u32x4*)dp; f32x4 t0, t1; unpack8(tw, t0, t1); v0 = v0 + t0; v1 = v1 + t1; }
                    store8(dp, v0, v1); } }
    }
};

struct EpiResid {
    static constexpr bool PERM = false, AFTER_DRAIN = false;
    const float* X; float* X1;
    __device__ __forceinline__ void operator()(const f32x4 (&acc)[2][2][4][2], const Unit& u, int wr, int wc, int fr, int fq) const {
        const int rbase = u.pm * 256 + wr * 64 + fr, cb = u.pn * 256 + wc * 32 + 4 * fq;
#pragma unroll
        for (int ai = 0; ai < 2; ++ai)
#pragma unroll
            for (int m = 0; m < 4; ++m) { const size_t ro = (size_t)(rbase + ai * 128 + m * 16) * D;
#pragma unroll
                for (int bj = 0; bj < 2; ++bj)
#pragma unroll
                    for (int n = 0; n < 2; ++n) { const int col = cb + bj * 128 + n * 16; *(f32x4*)(X1 + ro + col) = *(const f32x4*)(X + ro + col) + acc[ai][bj][m][n]; } }
    }
};

struct EpiMoe1 {
    static constexpr bool PERM = true, AFTER_DRAIN = false;
    bf16* ACT; const float* b1;
    __device__ __forceinline__ void operator()(const f32x4 (&acc)[2][2][4][2], const Unit& u, int wr, int wc, int fr, int fq) const {
        const int e = u.pn >> 4, pnl = u.pn & 15, rbase = u.pm * 256 + wr * 64 + fr, col = pnl * 128 + wc * 32 + 8 * fq;
        const float* bg = b1 + (size_t)e * 4096 + col; const float* bl = bg + 2048;
        const f32x4 bg0 = *(const f32x4*)bg, bg1 = *(const f32x4*)(bg + 4), bl0 = *(const f32x4*)bl, bl1 = *(const f32x4*)(bl + 4);
#pragma unroll
        for (int ai = 0; ai < 2; ++ai)
#pragma unroll
            for (int m = 0; m < 4; ++m) { const int row = rbase + ai * 128 + m * 16;
                f32x4 g0 = acc[ai][0][m][0] + bg0, g1 = acc[ai][0][m][1] + bg1, l0 = acc[ai][1][m][0] + bl0, l1 = acc[ai][1][m][1] + bl1, o0, o1;
#pragma unroll
                for (int j = 0; j < 4; ++j) {
                    { const float xg = fminf(g0[j], 7.0f), xl = fminf(fmaxf(l0[j], -7.0f), 7.0f); o0[j] = xg * sigmoidf_(1.702f * xg) * (xl + 1.0f); }
                    { const float xg = fminf(g1[j], 7.0f), xl = fminf(fmaxf(l1[j], -7.0f), 7.0f); o1[j] = xg * sigmoidf_(1.702f * xg) * (xl + 1.0f); } }
                store8(ACT + (size_t)row * FF + col, o0, o1); }
    }
};

struct EpiMoe2 {
    static constexpr bool PERM = true, AFTER_DRAIN = false;
    bf16* OUTK; const float* b2; const int* ROWTOK; const float* ROWGATE;
    __device__ __forceinline__ void operator()(const f32x4 (&acc)[2][2][4][2], const Unit& u, int wr, int wc, int fr, int fq) const {
        const int e = u.pn >> 3, pnl = u.pn & 7, rbase = u.pm * 256 + wr * 64 + fr, cb = pnl * 256 + wc * 32 + 8 * fq;
        f32x4 bv[2][2];
#pragma unroll
        for (int bj = 0; bj < 2; ++bj) { const float* bp = b2 + (size_t)e * D + cb + bj * 128; bv[bj][0] = *(const f32x4*)bp; bv[bj][1] = *(const f32x4*)(bp + 4); }
#pragma unroll
        for (int ai = 0; ai < 2; ++ai)
#pragma unroll
            for (int m = 0; m < 4; ++m) { const int row = rbase + ai * 128 + m * 16; const int p = ROWTOK[row];
                if (p >= 0) { const float gt = ROWGATE[row];
#pragma unroll
                    for (int bj = 0; bj < 2; ++bj) { const f32x4 v0 = (acc[ai][bj][m][0] + bv[bj][0]) * gt, v1 = (acc[ai][bj][m][1] + bv[bj][1]) * gt; store8(OUTK + (size_t)p * D + cb + bj * 128, v0, v1); } } }
    }
};

struct MoeOrder {
    const LAS int* toff; int npn, G, c;
    __device__ __forceinline__ bool next(int i, Unit& u) const {
        const int L = i * G + c, NT = toff[32];
        if (L >= NT * npn) return false;
        int e = 0;
#pragma unroll 1
        for (int j = 1; j < 32; ++j) e += (L >= toff[j] * npn) ? 1 : 0;
        const int t0 = toff[e], te = toff[e + 1] - t0, rem = L - t0 * npn;
        const int pnl = rem / te, pml = rem - pnl * te;
        u.pm = __builtin_amdgcn_readfirstlane(t0 + pml); u.pn = __builtin_amdgcn_readfirstlane(e * npn + pnl); return true;
    }
    __device__ __forceinline__ void a_ready(const Unit&) const {}
    __device__ __forceinline__ void done(const Unit&) const {}
};

__device__ __forceinline__ void tr_item(const float* src, int ldn, int k0, int c0, bf16* dst, size_t dstrow0, int K, LAS float* scr, int lane) {
    f32x4 v[8];
#pragma unroll
    for (int i = 0; i < 8; ++i) v[i] = *(const GAS f32x4*)(src + (size_t)(k0 + 8 * i + (lane >> 3)) * ldn + c0 + 4 * (lane & 7));
#pragma unroll
    for (int i = 0; i < 8; ++i) { LAS float* p = scr + (8 * i + (lane >> 3)) * 33 + 4 * (lane & 7); p[0] = v[i].x; p[1] = v[i].y; p[2] = v[i].z; p[3] = v[i].w; }
    LDS_WAIT(); asm volatile("" ::: "memory");
    const int c = lane & 7;
#pragma unroll
    for (int j = 0; j < 4; ++j) { const int n = (lane >> 3) + 8 * j; const LAS float* s = scr + (8 * c) * 33 + n;
        u32x4 o; o.x = pk2(s[0 * 33], s[1 * 33]); o.y = pk2(s[2 * 33], s[3 * 33]); o.z = pk2(s[4 * 33], s[5 * 33]); o.w = pk2(s[6 * 33], s[7 * 33]);
        *(GAS u32x4*)(dst + (dstrow0 + n) * (size_t)K + k0 + 8 * c) = o; }
    LDS_WAIT(); asm volatile("" ::: "memory");
}
__device__ __forceinline__ void rms_row_to_bf16(const float* xrow, const float* g, bf16* orow, int lane) {
    f32x4 v[8]; float s = 0.f;
#pragma unroll
    for (int j = 0; j < 8; ++j) { v[j] = *(const GAS f32x4*)(xrow + 4 * lane + 256 * j); s += (v[j].x * v[j].x + v[j].y * v[j].y) + (v[j].z * v[j].z + v[j].w * v[j].w); }
    const float rs = 1.0f / sqrtf(wave_sum(s) * (1.0f / D) + NORM_EPS);
#pragma unroll
    for (int j = 0; j < 8; ++j) { const f32x4 gv = *(const GAS f32x4*)(g + 4 * lane + 256 * j); u32x2 w; w.x = pk2(v[j].x * rs * gv.x, v[j].y * rs * gv.y); w.y = pk2(v[j].z * rs * gv.z, v[j].w * rs * gv.w);
        *(GAS u32x2*)(orow + 4 * lane + 256 * j) = w; }
}
__device__ __forceinline__ void p0_prologue(const Ptrs& P, LAS unsigned char* lds, int tid, int wave, int lane) {
    LAS float* scr = (LAS float*)(lds + wave * 8704);
    const int gw = blockIdx.x * NWAVES + wave, NGW = gridDim.x * NWAVES;
    constexpr int I_IN = 32 * 377, I_W1 = NE * 32 * 128, I_W2 = NE * 32 * 64, I_OR = 16 * 64, I_OA = 8 * 64, I_OUT = 32 * 64;
    constexpr int NITEMS = I_IN + I_W1 + I_W2 + I_OR + I_OA + I_OUT;
    for (int it = gw; it < NITEMS; it += NGW) {
        int r = it;
        if (r < I_IN) { const int kb = r / 377, nb = r % 377, c0 = 32 * nb; tr_item(P.w_in, IN_W, 64 * kb, c0, P.WIN, (size_t)(c0 < SHIFT_W ? c0 : c0 + 224), D, scr, lane); continue; }
        r -= I_IN;
        if (r < I_W1) { const int e = r >> 12, q = r & 4095, kb = q >> 7, nb = q & 127, c0 = 32 * nb;
            tr_item(P.w1 + (size_t)e * D * 4096, 4096, 64 * kb, c0, P.W1, (size_t)e * 4096 + ((c0 & 2047) >> 7) * 256 + (c0 >> 11) * 128 + (c0 & 127), D, scr, lane); continue; }
        r -= I_W1;
        if (r < I_W2) { const int e = r >> 11, q = r & 2047, kb = q >> 6, nb = q & 63; tr_item(P.w2 + (size_t)e * FF * D, D, 64 * kb, 32 * nb, P.W2, (size_t)e * D + 32 * nb, FF, scr, lane); continue; }
        r -= I_W2;
        if (r < I_OR) { const int kb = r >> 6, nb = r & 63; tr_item(P.w_o_rwkv, D, 64 * kb, 32 * nb, P.WOR, (size_t)32 * nb, RW, scr, lane); continue; }
        r -= I_OR;
        if (r < I_OA) { const int kb = r >> 6, nb = r & 63; tr_item(P.w_o_attn, D, 64 * kb, 32 * nb, P.WOA, (size_t)32 * nb, 512, scr, lane); continue; }
        r -= I_OA;
        { const int kb = r >> 6, nb = r & 63; tr_item(P.w_out, D, 64 * kb, 32 * nb, P.WOUT, (size_t)32 * nb, D, scr, lane); }
    }
    { const int gt = blockIdx.x * NTHREADS + tid, NGT = gridDim.x * NTHREADS; GAS u32x4* z = (GAS u32x4*)(P.WIN + (size_t)SHIFT_W * D);
      for (int i = gt; i < 224 * D / 8; i += NGT) z[i] = (u32x4){0u, 0u, 0u, 0u}; }
    for (int m = gw; m < T; m += NGW) rms_row_to_bf16(P.x + (size_t)m * D, P.norm_mix, P.H + (size_t)m * D, lane);
    { const int gt = blockIdx.x * NTHREADS + tid, NGT = gridDim.x * NTHREADS;
      for (int i = gt; i < T * 16; i += NGT) { const int m = i >> 4, f = i & 15; const float inv = exp2f(-(float)f * (18.931568569324174f / 16.0f));
          const float ang = (float)P.positions[m] * inv; double rev = (double)ang * 0.15915494309189535; rev -= floor(rev); const float rv = (float)rev; const float sn = __builtin_amdgcn_sinf(rv), cs = __builtin_amdgcn_cosf(rv); P.ROT[(size_t)m * 32 + f] = cs; P.ROT[(size_t)m * 32 + 16 + f] = sn; } }
}

__device__ __forceinline__ void p2_rwkv_prep(const Ptrs& P, LAS unsigned char* lds, int tid, int wave, int lane) {
    LAS float* lin = (LAS float*)lds;
    for (int blk = blockIdx.x; blk < T / 8; blk += gridDim.x) {
        const int m0 = blk * 8;
        __syncthreads();
        for (int idx = tid; idx < 8 * 288; idx += NTHREADS) { const int tk = idx / 288, j = idx - tk * 288, m = m0 + tk, col = 3072 + j;
            const float p = bf2f(P.ZP[(size_t)m * ZPW + col]); const float pp = (m % SEQ) ? bf2f(P.ZP[(size_t)(m - 1) * ZPW + col]) : 0.0f;
            const float z = p + (pp - p) * P.shift_mu[col];
            lin[idx] = (j < 64) ? tanhf(z) : ((j < 128) ? z : sigmoidf_(z)); }
        __syncthreads();
        float aw[2][8], aa[2][8], ag[2][8];
#pragma unroll
        for (int cc = 0; cc < 2; ++cc)
#pragma unroll
            for (int tk = 0; tk < 8; ++tk) { aw[cc][tk] = 0.f; aa[cc][tk] = 0.f; ag[cc][tk] = 0.f; }
#pragma unroll 2
        for (int j = 0; j < 64; ++j) { const float w0_ = P.w2_decay[j * RW + tid], w1_ = P.w2_decay[j * RW + tid + 512], a0_ = P.a2_iclr[j * RW + tid], a1_ = P.a2_iclr[j * RW + tid + 512];
#pragma unroll
            for (int tk = 0; tk < 8; ++tk) { const float lw = lin[tk * 288 + j], la = lin[tk * 288 + 64 + j]; aw[0][tk] += lw * w0_; aw[1][tk] += lw * w1_; aa[0][tk] += la * a0_; aa[1][tk] += la * a1_; } }
#pragma unroll 2
        for (int j = 0; j < 160; ++j) { const float g0_ = P.g2_gate[j * RW + tid], g1_ = P.g2_gate[j * RW + tid + 512];
#pragma unroll
            for (int tk = 0; tk < 8; ++tk) { const float lg = lin[tk * 288 + 128 + j]; ag[0][tk] += lg * g0_; ag[1][tk] += lg * g1_; } }
#pragma unroll
        for (int cc = 0; cc < 2; ++cc) { const int c = tid + 512 * cc, head = wave + 8 * cc;
            const float mu_r = P.shift_mu[c], mu_k = P.shift_mu[1024 + c], mu_v = P.shift_mu[2048 + c], w0c = P.w0[c], a0c = P.a0[c], kkc = P.k_k[c], kac = P.k_a[c], rkc = P.r_k[c];
#pragma unroll
            for (int tk = 0; tk < 8; ++tk) { const int m = m0 + tk; const bf16* zp = P.ZP + (size_t)m * ZPW; const bool hasp = (m % SEQ) != 0; const bf16* zq = zp - ZPW;
                const float pr = bf2f(zp[c]), pk = bf2f(zp[1024 + c]), pv = bf2f(zp[2048 + c]);
                const float qr = hasp ? bf2f(zq[c]) : 0.f, qk = hasp ? bf2f(zq[1024 + c]) : 0.f, qv = hasp ? bf2f(zq[2048 + c]) : 0.f;
                const float r = pr + (qr - pr) * mu_r, k = pk + (qk - pk) * mu_k, v = pv + (qv - pv) * mu_v;
                const float sgw = sigmoidf_(w0c + aw[cc][tk]); const float decay = __expf(-0.6065306597126334f * sgw);
                const float a = sigmoidf_(a0c + aa[cc][tk]); const float g = ag[cc][tk];
                const float kkp = k * kkc; const float ss = wave_sum(kkp * kkp); const float kk = kkp / fmaxf(sqrtf(ss), 1e-12f);
                const float kn = k * (1.0f + (a - 1.0f) * kac); const float bb = kk * a;
                const float bon = wave_sum(r * kn * rkc);
                const size_t o = (size_t)m * RW + c;
                P.SC[SC_KK * SC_STRIDE + o] = kk; P.SC[SC_W * SC_STRIDE + o] = decay; P.SC[SC_BB * SC_STRIDE + o] = bb; P.SC[SC_K * SC_STRIDE + o] = kn; P.SC[SC_R * SC_STRIDE + o] = r; P.SC[SC_V * SC_STRIDE + o] = v;
                P.G[o] = (bf16)f2bf(g);
                if (lane == 0) P.BONUS[(size_t)m * NH + head] = bon; } }
    }
}

__device__ __forceinline__ f32x4 mfma16(bf16x8 a, bf16x8 b, f32x4 c) { return __builtin_amdgcn_mfma_f32_16x16x32_bf16(a, b, c, 0, 0, 0); }
__device__ __forceinline__ void p3_attention(const Ptrs& P, LAS unsigned char* lds, int tid, int wave, int lane) {
    const int fr = lane & 15, fq = lane >> 4;
    LAS unsigned char* Ks = lds; LAS unsigned char* Vt = lds + 34816;
    for (int u = blockIdx.x; u < NB * 12 * 32; u += gridDim.x) {
        const int b = u / 384, r = u - b * 384, gh = r >> 5, idx = r & 31, g = gh >> 2;
        const int d = (g == 0) ? 1 : ((g == 1) ? 4 : 16), nb = 32 / d, c = idx / nb, n = idx - c * nb;
        const int qi = wave * 16 + fr; const size_t mq = (size_t)b * SEQ + (size_t)(n * 128 + qi) * d + c;
        const bf16* qrow = P.QKV + mq * QKVW + gh * 128;
        bf16x8 qf[4];
#pragma unroll
        for (int ks = 0; ks < 4; ++ks) qf[ks] = *(const GAS bf16x8*)(qrow + 32 * ks + 8 * fq);
        f32x4 o[8];
#pragma unroll
        for (int dt = 0; dt < 8; ++dt) o[dt] = (f32x4){0.f, 0.f, 0.f, 0.f};
        float mrun = -1e30f, lrun = 0.f;
        for (int kb = (n == 0) ? 1 : 0; kb < 2; ++kb) {
            const int kblk = n - 1 + kb;
            __syncthreads();
#pragma unroll
            for (int i = 0; i < 4; ++i) { const int p = tid + 512 * i, key = p >> 4, part = p & 15; const size_t mk = (size_t)b * SEQ + (size_t)(kblk * 128 + key) * d + c;
                *(LAS u32x4*)(Ks + key * 272 + part * 16) = *(const GAS u32x4*)(P.QKV + mk * QKVW + 1536 + gh * 128 + part * 8); }
#pragma unroll
            for (int i = 0; i < 4; ++i) { const int key = tid & 127, part = (tid >> 7) + 4 * i; const size_t mk = (size_t)b * SEQ + (size_t)(kblk * 128 + key) * d + c;
                const u32x4 v = *(const GAS u32x4*)(P.QKV + mk * QKVW + 3072 + gh * 128 + part * 8);
                LAS unsigned char* vp = Vt + (8 * part) * 272 + key * 2;
                *(LAS unsigned short*)(vp + 0 * 272) = (unsigned short)(v.x & 0xffffu); *(LAS unsigned short*)(vp + 1 * 272) = (unsigned short)(v.x >> 16);
                *(LAS unsigned short*)(vp + 2 * 272) = (unsigned short)(v.y & 0xffffu); *(LAS unsigned short*)(vp + 3 * 272) = (unsigned short)(v.y >> 16);
                *(LAS unsigned short*)(vp + 4 * 272) = (unsigned short)(v.z & 0xffffu); *(LAS unsigned short*)(vp + 5 * 272) = (unsigned short)(v.z >> 16);
                *(LAS unsigned short*)(vp + 6 * 272) = (unsigned short)(v.w & 0xffffu); *(LAS unsigned short*)(vp + 7 * 272) = (unsigned short)(v.w >> 16); }
            __syncthreads();
            f32x4 s[8];
#pragma unroll
            for (int kt = 0; kt < 8; ++kt) { s[kt] = (f32x4){0.f, 0.f, 0.f, 0.f};
#pragma unroll
                for (int ks = 0; ks < 4; ++ks) { const bf16x8 a = *(const LAS bf16x8*)(Ks + (kt * 16 + fr) * 272 + (32 * ks + 8 * fq) * 2); s[kt] = mfma16(a, qf[ks], s[kt]); } }
            float mx = -1e30f;
#pragma unroll
            for (int kt = 0; kt < 8; ++kt)
#pragma unroll
                for (int rg = 0; rg < 4; ++rg) { const int j = kt * 16 + 4 * fq + rg; const bool ok = (kb == 0) ? (j >= qi) : (j <= qi); const float sv = ok ? s[kt][rg] : -1e30f; s[kt][rg] = sv; mx = fmaxf(mx, sv); }
            mx = fmaxf(mx, __shfl_xor(mx, 16)); mx = fmaxf(mx, __shfl_xor(mx, 32));
            const float mnew = fmaxf(mrun, mx), alpha = exp2f(mrun - mnew); mrun = mnew;
            float ls = 0.f;
#pragma unroll
            for (int kt = 0; kt < 8; ++kt)
#pragma unroll
                for (int rg = 0; rg < 4; ++rg) { const float p = exp2f(s[kt][rg] - mnew); s[kt][rg] = p; ls += p; }
            lrun = lrun * alpha + ls;
#pragma unroll
            for (int dt = 0; dt < 8; ++dt) o[dt] = o[dt] * alpha;
#pragma unroll
            for (int pi = 0; pi < 4; ++pi) {
                const u32x4 bw = pack8(s[2 * pi], s[2 * pi + 1]); const bf16x8 bfrag = __builtin_bit_cast(bf16x8, bw);
#pragma unroll
                for (int dt = 0; dt < 8; ++dt) { const LAS unsigned char* vp = Vt + (dt * 16 + fr) * 272 + (2 * pi * 16 + 4 * fq) * 2;
                    const u32x2 lo = *(const LAS u32x2*)vp, hi = *(const LAS u32x2*)(vp + 32);
                    const u32x4 aw = {lo.x, lo.y, hi.x, hi.y}; o[dt] = mfma16(__builtin_bit_cast(bf16x8, aw), bfrag, o[dt]); } }
        }
        lrun += __shfl_xor(lrun, 16); lrun += __shfl_xor(lrun, 32);
        bf16* orow = P.ATTO + (mq * 12 + gh) * 128;
#pragma unroll
        for (int dt = 0; dt < 8; ++dt) { u32x2 w; w.x = pk2(o[dt][0], o[dt][1]); w.y = pk2(o[dt][2], o[dt][3]); *(GAS u32x2*)(orow + dt * 16 + 4 * fq) = w; }
        if (fq == 0) { P.ATTML[(mq * 12 + gh) * 2] = mrun; P.ATTML[(mq * 12 + gh) * 2 + 1] = lrun; }
    }
}

__device__ __forceinline__ float dpp_add(float x, const int ctrl_sel) {
    int y;
    if (ctrl_sel == 0) y = __builtin_amdgcn_update_dpp(0, __float_as_int(x), 0xB1, 0xF, 0xF, false);
    else if (ctrl_sel == 1) y = __builtin_amdgcn_update_dpp(0, __float_as_int(x), 0x4E, 0xF, 0xF, false);
    else if (ctrl_sel == 2) y = __builtin_amdgcn_update_dpp(0, __float_as_int(x), 0x141, 0xF, 0xF, false);
    else y = __builtin_amdgcn_update_dpp(0, __float_as_int(x), 0x140, 0xF, 0xF, false);
    return x + __int_as_float(y);
}
__device__ __forceinline__ float row16_sum(float x) { x = dpp_add(x, 0); x = dpp_add(x, 1); x = dpp_add(x, 2); x = dpp_add(x, 3); return x; }
__device__ __forceinline__ void p4_scan(const Ptrs& P, LAS unsigned char* lds, int tid, int wave, int lane) {
    constexpr int CH = 32, NCH = SEQ / CH, STEP_F = 6 * 64, BUF_F = CH * STEP_F;
    LAS float* buf = (LAS float*)lds;
    for (int unit = blockIdx.x; unit < 256; unit += gridDim.x) {
        const int bh = unit >> 2, rgp = unit & 3, b = bh >> 4, h = bh & 15;
        const size_t off0 = (size_t)b * SEQ * RW + h * 64;
        const int ltid = tid - 256;
        __syncthreads();
        if (wave >= 4) {
#pragma unroll
            for (int i = 0; i < 12; ++i) { const int idx = ltid + 256 * i, arr = idx >> 9, rem = idx & 511, st = rem >> 4, q = rem & 15;
                *(LAS f32x4*)(buf + (st * 6 + arr) * 64 + 4 * q) = *(const GAS f32x4*)(P.SC + arr * SC_STRIDE + off0 + (size_t)st * RW + 4 * q); }
        }
        __syncthreads();
        const int rr = lane >> 4, kq = lane & 15, vrow = rgp * 16 + (wave & 3) * 4 + rr;
        float S0 = 0.f, S1 = 0.f, S2 = 0.f, S3 = 0.f;
        for (int ch = 0; ch < NCH; ++ch) {
            if (wave >= 4) {
                if (ch + 1 < NCH) { LAS float* nb = buf + ((ch + 1) & 1) * BUF_F;
#pragma unroll
                    for (int i = 0; i < 12; ++i) { const int idx = ltid + 256 * i, arr = idx >> 9, rem = idx & 511, st = rem >> 4, q = rem & 15;
                        *(LAS f32x4*)(nb + (st * 6 + arr) * 64 + 4 * q) = *(const GAS f32x4*)(P.SC + arr * SC_STRIDE + off0 + (size_t)((ch + 1) * CH + st) * RW + 4 * q); } }
            } else {
                const LAS float* cb = buf + (ch & 1) * BUF_F;
                float* yp = P.Y + off0 + (size_t)(ch * CH) * RW + vrow;
#pragma unroll 4
                for (int st = 0; st < CH; ++st) { const LAS float* sp = cb + st * STEP_F;
                    const f32x4 kk = *(const LAS f32x4*)(sp + 0 * 64 + 4 * kq), w = *(const LAS f32x4*)(sp + 1 * 64 + 4 * kq), bb = *(const LAS f32x4*)(sp + 2 * 64 + 4 * kq),
                                k = *(const LAS f32x4*)(sp + 3 * 64 + 4 * kq), r = *(const LAS f32x4*)(sp + 4 * 64 + 4 * kq); const float vv = sp[5 * 64 + vrow];
                    float sa = (S0 * kk.x + S1 * kk.y) + (S2 * kk.z + S3 * kk.w); sa = -row16_sum(sa);
                    S0 = S0 * w.x + (sa * bb.x + vv * k.x); S1 = S1 * w.y + (sa * bb.y + vv * k.y); S2 = S2 * w.z + (sa * bb.z + vv * k.z); S3 = S3 * w.w + (sa * bb.w + vv * k.w);
                    float y = (S0 * r.x + S1 * r.y) + (S2 * r.z + S3 * r.w); y = row16_sum(y);
                    if (kq == 0) yp[(size_t)st * RW] = y; }
            }
            __syncthreads();
        }
    }
}

__device__ __forceinline__ void p5_post(const Ptrs& P, int tid, int wave, int lane) {
    for (int m = blockIdx.x; m < T; m += gridDim.x) {
#pragma unroll
        for (int cc = 0; cc < 2; ++cc) { const int c = tid + 512 * cc, head = wave + 8 * cc; const size_t o = (size_t)m * RW + c;
            const float y = P.Y[o]; const float mean = wave_sum(y) * (1.0f / 64.0f); const float dv = y - mean; const float var = wave_sum(dv * dv) * (1.0f / 64.0f);
            float yn = dv * (1.0f / sqrtf(var + GN_EPS)) * P.ln_x_w[c] + P.ln_x_b[c];
            yn += P.BONUS[(size_t)m * NH + head] * P.SC[SC_V * SC_STRIDE + o];
            P.YAIN[o] = (bf16)f2bf(yn * bf2f(P.G[o])); }
        { const int hh = tid >> 7, dd = tid & 127; float mm[3], ll[3], ov[3]; float M = -1e30f;
#pragma unroll
          for (int g = 0; g < 3; ++g) { const size_t q = (size_t)m * 12 + g * 4 + hh; mm[g] = P.ATTML[q * 2]; ll[g] = P.ATTML[q * 2 + 1]; ov[g] = bf2f(P.ATTO[q * 128 + dd]); M = fmaxf(M, mm[g]); }
          float num = 0.f, den = 0.f;
#pragma unroll
          for (int g = 0; g < 3; ++g) { const float wg = exp2f(mm[g] - M); num += wg * ov[g]; den += wg * ll[g]; }
          P.OIN[(size_t)m * 512 + tid] = (bf16)f2bf(num / den); }
    }
}

__device__ __forceinline__ void p8_router(const Ptrs& P, LAS unsigned char* lds, int tid, int wave, int lane) {
    LAS float* Wl = (LAS float*)lds;
    const int e = lane & 31, kh = lane >> 5;
    for (int grp = blockIdx.x; grp < T / 64; grp += gridDim.x) {
        const int m0 = grp * 64 + wave * 8;
        float rs[8], acc[8];
#pragma unroll
        for (int tk = 0; tk < 8; ++tk) { const float* xr = P.X1 + (size_t)(m0 + tk) * D; f32x4 v[8]; float s = 0.f;
#pragma unroll
            for (int j = 0; j < 8; ++j) { v[j] = *(const GAS f32x4*)(xr + 4 * lane + 256 * j); s += (v[j].x * v[j].x + v[j].y * v[j].y) + (v[j].z * v[j].z + v[j].w * v[j].w); }
            const float r = 1.0f / sqrtf(wave_sum(s) * (1.0f / D) + NORM_EPS); rs[tk] = r; acc[tk] = 0.f;
            bf16* hr = P.H + (size_t)(m0 + tk) * D;
#pragma unroll
            for (int j = 0; j < 8; ++j) { const f32x4 gv = *(const GAS f32x4*)(P.norm_ffn + 4 * lane + 256 * j); u32x2 w; w.x = pk2(v[j].x * r * gv.x, v[j].y * r * gv.y); w.y = pk2(v[j].z * r * gv.z, v[j].w * r * gv.w);
                *(GAS u32x2*)(hr + 4 * lane + 256 * j) = w; } }
#pragma unroll 1
        for (int hf = 0; hf < 2; ++hf) {
            __syncthreads();
            for (int idx = tid; idx < 8192; idx += NTHREADS) { const int k = idx >> 3, q = idx & 7; const float g = P.norm_ffn[hf * 1024 + k];
                *(LAS f32x4*)(Wl + k * 32 + 4 * q) = *(const GAS f32x4*)(P.w_router + (size_t)(hf * 1024 + k) * NE + 4 * q) * g; }
            __syncthreads();
            const float* xb = P.X1 + (size_t)m0 * D + hf * 1024 + kh * 512; const LAS float* wb = Wl + (kh * 512) * 32 + e;
#pragma unroll 2
            for (int i = 0; i < 512; i += 4) { const float w0 = wb[(i + 0) * 32], w1 = wb[(i + 1) * 32], w2 = wb[(i + 2) * 32], w3 = wb[(i + 3) * 32];
#pragma unroll
                for (int tk = 0; tk < 8; ++tk) { const f32x4 xv = *(const GAS f32x4*)(xb + (size_t)tk * D + i); acc[tk] += (xv.x * w0 + xv.y * w1) + (xv.z * w2 + xv.w * w3); } }
        }
        const float be = P.b_router[e];
#pragma unroll
        for (int tk = 0; tk < 8; ++tk) { float v = (acc[tk] + __shfl_xor(acc[tk], 32)) * rs[tk] + be;
            int sel[4]; float val[4];
#pragma unroll
            for (int k = 0; k < 4; ++k) { float mx = v;
#pragma unroll
                for (int o = 1; o < 32; o <<= 1) mx = fmaxf(mx, __shfl_xor(mx, o));
                const unsigned long long bal = __ballot(v == mx); const int s_ = __ffsll((unsigned long long)(bal & 0xffffffffull)) - 1;
                sel[k] = s_; val[k] = mx; v = (e == s_) ? -3.0e38f : v; }
            const float e1 = __expf(val[1] - val[0]), e2 = __expf(val[2] - val[0]), e3 = __expf(val[3] - val[0]); const float inv = 1.0f / (1.0f + e1 + e2 + e3);
            const float gate[4] = {inv, e1 * inv, e2 * inv, e3 * inv};
            if (lane == 0) { const int m = m0 + tk;
#pragma unroll
                for (int k = 0; k < 4; ++k) { const unsigned pos = __hip_atomic_fetch_add((unsigned*)(P.ctl + CW_CNT + 64 * sel[k]), 1u, RLX_AGENT);
                    P.TOPK_E[m * 4 + k] = sel[k]; P.TOPK_POS[m * 4 + k] = (int)pos; P.TOPK_GATE[m * 4 + k] = gate[k]; } }
        }
    }
}

__device__ __forceinline__ void moe_tables(const Ptrs& P, LAS int* tab, int tid) {
    if (tid == 0) { int acc = 0;
        for (int e = 0; e < NE; ++e) { tab[e] = acc; const int c = (int)__hip_atomic_load((unsigned*)(P.ctl + CW_CNT + 64 * e), RLX_AGENT); acc += (c + 255) >> 8; tab[64 + e] = c; }
        tab[32] = acc; }
    __syncthreads();
}

__device__ __forceinline__ void p9_gather(const Ptrs& P, LAS unsigned char* lds, int tid, int wave, int lane) {
    LAS int* tab = (LAS int*)(lds + TAB_OFF);
    moe_tables(P, tab, tid);
    const int gw = blockIdx.x * NWAVES + wave, NGW = gridDim.x * NWAVES;
    for (int p = gw; p < T * 4; p += NGW) { const int e = P.TOPK_E[p], pos = P.TOPK_POS[p]; const int row = tab[e] * 256 + pos;
        const GAS u32x4* src = (const GAS u32x4*)(P.H + (size_t)(p >> 2) * D); GAS u32x4* dst = (GAS u32x4*)(P.XS + (size_t)row * D);
#pragma unroll
        for (int i = 0; i < 4; ++i) dst[lane + 64 * i] = src[lane + 64 * i];
        if (lane == 0) { P.ROWTOK[row] = p; P.ROWGATE[row] = P.TOPK_GATE[p]; } }
    for (int e = blockIdx.x; e < NE; e += gridDim.x) { const int cnt = tab[64 + e], r0 = tab[e] * 256, rend = tab[e + 1] * 256;
        for (int r = r0 + cnt + tid; r < rend; r += NTHREADS) { P.ROWTOK[r] = -1; P.ROWGATE[r] = 0.f; } }
}

__device__ __forceinline__ void p12_final(const Ptrs& P, int tid, int wave, int lane) {
    const int gw = blockIdx.x * NWAVES + wave, NGW = gridDim.x * NWAVES;
    for (int m = gw; m < T; m += NGW) {
        f32x4 v[8]; float s = 0.f;
#pragma unroll
        for (int j = 0; j < 8; ++j) { const int col = 4 * lane + 256 * j; v[j] = *(const GAS f32x4*)(P.X1 + (size_t)m * D + col);
#pragma unroll
            for (int k = 0; k < 4; ++k) { const u32x2 w = *(const GAS u32x2*)(P.OUTK + ((size_t)m * 4 + k) * D + col); v[j].x += bflo(w.x); v[j].y += bfhi(w.x); v[j].z += bflo(w.y); v[j].w += bfhi(w.y); }
            s += (v[j].x * v[j].x + v[j].y * v[j].y) + (v[j].z * v[j].z + v[j].w * v[j].w); }
        const float rs = 1.0f / sqrtf(wave_sum(s) * (1.0f / D) + NORM_EPS);
#pragma unroll
        for (int j = 0; j < 8; ++j) { const int col = 4 * lane + 256 * j; const f32x4 g = *(const GAS f32x4*)(P.norm_final + col); *(GAS f32x4*)(P.out + (size_t)m * D + col) = v[j] * rs * g; }
    }
}

struct Args { const void* in[26]; float* out; unsigned char* ws; int ph_lo, ph_hi; };
__global__ void __launch_bounds__(NTHREADS, 2) fwd(Args args) {
    extern __shared__ __attribute__((aligned(16))) unsigned char lds_raw[];
    LAS unsigned char* lds = (LAS unsigned char*)lds_raw;
    const int tid = threadIdx.x, lane = tid & 63, wave = __builtin_amdgcn_readfirstlane(tid >> 6);
    unsigned char* ws = args.ws;
    Ptrs P;
    P.x = (const float*)args.in[0]; P.positions = (const int*)args.in[1]; P.norm_mix = (const float*)args.in[2]; P.w_in = (const float*)args.in[3]; P.shift_mu = (const float*)args.in[4];
    P.w0 = (const float*)args.in[5]; P.w2_decay = (const float*)args.in[6]; P.a0 = (const float*)args.in[7]; P.a2_iclr = (const float*)args.in[8]; P.g2_gate = (const float*)args.in[9];
    P.k_k = (const float*)args.in[10]; P.k_a = (const float*)args.in[11]; P.r_k = (const float*)args.in[12]; P.ln_x_w = (const float*)args.in[13]; P.ln_x_b = (const float*)args.in[14];
    P.w_o_rwkv = (const float*)args.in[15]; P.w_o_attn = (const float*)args.in[16]; P.w_out = (const float*)args.in[17]; P.norm_ffn = (const float*)args.in[18]; P.w_router = (const float*)args.in[19];
    P.b_router = (const float*)args.in[20]; P.w1 = (const float*)args.in[21]; P.b1 = (const float*)args.in[22]; P.w2 = (const float*)args.in[23]; P.b2 = (const float*)args.in[24]; P.norm_final = (const float*)args.in[25];
    P.out = args.out; P.ctl = (gu32*)(ws + WS_CTL);
    P.WIN = (bf16*)(ws + WS_WIN); P.W1 = (bf16*)(ws + WS_W1); P.W2 = (bf16*)(ws + WS_W2); P.WOR = (bf16*)(ws + WS_WOR); P.WOA = (bf16*)(ws + WS_WOA); P.WOUT = (bf16*)(ws + WS_WOUT);
    P.H = (bf16*)(ws + WS_H); P.ZP = (bf16*)(ws + WS_ZP); P.QKV = (bf16*)(ws + WS_QKV); P.GATES = (bf16*)(ws + WS_GATES); P.ROT = (float*)(ws + WS_ROT); P.SC = (float*)(ws + WS_SC);
    P.G = (bf16*)(ws + WS_G); P.BONUS = (float*)(ws + WS_BONUS); P.Y = (float*)(ws + WS_Y); P.ATTO = (bf16*)(ws + WS_ATTO); P.ATTML = (float*)(ws + WS_ATTML); P.YAIN = (bf16*)(ws + WS_YAIN);
    P.OIN = (bf16*)(ws + WS_OIN); P.MERGED = (bf16*)(ws + WS_MERGED); P.X1 = (float*)(ws + WS_X1);
    P.TOPK_E = (int*)(ws + WS_TOPK); P.TOPK_POS = P.TOPK_E + T * 4; P.TOPK_GATE = (float*)(P.TOPK_POS + T * 4);
    P.ROWTOK = (int*)(ws + WS_ROWS); P.ROWGATE = (float*)(P.ROWTOK + XS_ROWS);
    P.XS = (bf16*)(ws + WS_XS); P.ACT = (bf16*)(ws + WS_ACT); P.OUTK = (bf16*)(ws + WS_OUTK);

    for (int u = tid; u < (LDS_BYTES - TAB_OFF) / 4; u += NTHREADS) ((LAS unsigned*)(lds + TAB_OFF))[u] = 0u;
    __syncthreads();
#if MK_ONE_LAUNCH
    XcdBarrier bar = xcd_barrier_post((unsigned*)(P.ctl + CW_BAR), (volatile LAS unsigned*)(lds + MISC_OFF));
#define GRID_BAR() xcd_barrier(bar)
#else
#define GRID_BAR() do { } while (0)
#endif
    const int lo = args.ph_lo, hi = args.ph_hi;
#ifndef PHASE_MASK
#define PHASE_MASK 0x1fff
#endif
#define IN(k) (((PHASE_MASK >> (k)) & 1) && lo <= (k) && (k) < hi)
#define SEAM(k) do { if (IN(k) && IN((k) + 1)) GRID_BAR(); } while (0)
    const int G = gridDim.x, c = blockIdx.x;

    if (IN(0)) { p0_prologue(P, lds, tid, wave, lane); SEAM(0); }
    if (IN(1)) { pg8::Gemm g{P.H, P.WIN, T, NPROJ, D}; pg8::StaticOrder S; S.init(T, NPROJ, G, c); EpiProj E{P.ZP, P.QKV, P.GATES, P.ROT};
        pg8::gemm_phase<EpiProj, pg8::StaticOrder, true, true>(lds, g, S, E); SEAM(1); }
    if (IN(2)) { p2_rwkv_prep(P, lds, tid, wave, lane); SEAM(2); }
    if (IN(3)) { p3_attention(P, lds, tid, wave, lane); SEAM(3); }
    if (IN(4)) { p4_scan(P, lds, tid, wave, lane); SEAM(4); }
    if (IN(5)) { p5_post(P, tid, wave, lane); SEAM(5); }
    if (IN(6)) {
        { pg8::Gemm g{P.YAIN, P.WOR, T, D, RW}; pg8::StaticOrder S; S.init(T, D, G, c); EpiMerge<0> E{P.MERGED, P.GATES}; pg8::gemm_phase<EpiMerge<0>, pg8::StaticOrder, true, true>(lds, g, S, E); }
        VM_WAIT(); __builtin_amdgcn_fence(__ATOMIC_ACQUIRE, "agent"); VM_WAIT(); __syncthreads();
        { pg8::Gemm g{P.OIN, P.WOA, T, D, 512}; pg8::StaticOrder S; S.init(T, D, G, c); EpiMerge<1> E{P.MERGED, P.GATES}; pg8::gemm_phase<EpiMerge<1>, pg8::StaticOrder, true, true>(lds, g, S, E); }
        SEAM(6); }
    if (IN(7)) { pg8::Gemm g{P.MERGED, P.WOUT, T, D, D}; pg8::StaticOrder S; S.init(T, D, G, c); EpiResid E{P.x, P.X1}; pg8::gemm_phase<EpiResid, pg8::StaticOrder, true, true>(lds, g, S, E); SEAM(7); }
    if (IN(8)) { p8_router(P, lds, tid, wave, lane); SEAM(8); }
    if (IN(9)) { p9_gather(P, lds, tid, wave, lane); SEAM(9); }
    if (IN(10)) { LAS int* tab = (LAS int*)(lds + TAB_OFF); moe_tables(P, tab, tid);
        pg8::Gemm g{P.XS, P.W1, XS_ROWS, NE * 4096, D}; MoeOrder S{tab, 16, G, c}; EpiMoe1 E{P.ACT, P.b1};
        pg8::gemm_phase<EpiMoe1, MoeOrder, true, true>(lds, g, S, E); SEAM(10); }
    if (IN(11)) { LAS int* tab = (LAS int*)(lds + TAB_OFF); moe_tables(P, tab, tid);
        pg8::Gemm g{P.ACT, P.W2, XS_ROWS, NE * D, FF}; MoeOrder S{tab, 8, G, c}; EpiMoe2 E{P.OUTK, P.b2, P.ROWTOK, P.ROWGATE};
        pg8::gemm_phase<EpiMoe2, MoeOrder, true, true>(lds, g, S, E); SEAM(11); }
    if (IN(12)) { p12_final(P, tid, wave, lane); }
#undef IN
#undef SEAM
}

extern "C" void kernel_launch(void* const* d_in, const int* in_sizes, int n_in, void* d_out, int out_size, void* d_ws, size_t ws_size, hipStream_t stream) {
    static int grid = 0;
    if (grid == 0) {
        if (n_in != 26 || out_size != T * D || ws_size < WS_END) { fprintf(stderr, "kernel_launch: unexpected shapes (n_in %d, out %d, ws %zu, need %zu); nothing launched\n", n_in, out_size, ws_size, (size_t)WS_END); grid = -1; return; }
        int dev = 0, cus = 0, per_cu = 0;
        if (hipGetDevice(&dev) != hipSuccess || hipDeviceGetAttribute(&cus, hipDeviceAttributeMultiprocessorCount, dev) != hipSuccess) { grid = -1; return; }
        if (hipFuncSetAttribute((const void*)fwd, hipFuncAttributeMaxDynamicSharedMemorySize, LDS_BYTES) != hipSuccess) { fprintf(stderr, "kernel_launch: hipFuncSetAttribute failed\n"); grid = -1; return; }
        if (hipOccupancyMaxActiveBlocksPerMultiprocessor(&per_cu, (const void*)fwd, NTHREADS, LDS_BYTES) != hipSuccess || per_cu < 1) fprintf(stderr, "kernel_launch: occupancy query says %d\n", per_cu);
        (void)hipGetLastError();
        grid = cus;
    }
    if (grid < 0) return;
    if (hipMemsetAsync((char*)d_ws + WS_CTL, 0, CTL_ZERO_BYTES, stream) != hipSuccess) return;
    Args a{};
    for (int i = 0; i < 26; ++i) a.in[i] = d_in[i];
    a.out = (float*)d_out; a.ws = (unsigned char*)d_ws;
#if MK_ONE_LAUNCH
    a.ph_lo = 0; a.ph_hi = NPHASES;
    hipLaunchKernelGGL(fwd, dim3(grid), dim3(NTHREADS), LDS_BYTES, stream, a);
#else
    for (int ph = 0; ph < NPHASES; ++ph) { a.ph_lo = ph; a.ph_hi = ph + 1; hipLaunchKernelGGL(fwd, dim3(grid), dim3(NTHREADS), LDS_BYTES, stream, a); }
#endif
}
```

```cpp
#include <hip/hip_runtime.h>
#include <cstdio>
#include <cstdint>
#include <cmath>
namespace pg8 {
#define PG8_LAS __attribute__((address_space(3)))
typedef unsigned short bf16_t;
typedef short bf16x8 __attribute__((ext_vector_type(8)));
typedef float f32x4 __attribute__((ext_vector_type(4)));
typedef unsigned u32x4 __attribute__((ext_vector_type(4)));
constexpr int BM = 256, BK = 64, HALF = 128, HTB = HALF * BK * 2  , STAGE_BYTES = 8 * HTB, NXCD = 8, WGM = 8;

__host__ __device__ __forceinline__ int lds_byte(int r, int c) { const int st = (r >> 4) * 2 + (c >> 5), rr = r & 15, cc = c & 31, ob = rr * 64 + cc * 2; return st * 1024 + (ob ^ (((ob >> 9) & 1) << 5)); }
__host__ __device__ __forceinline__ void stage_rc(int b, int& R, int& C) { const int st = b / 1024, sb = b % 1024, swz = sb ^ (((sb >> 9) & 1) << 5); R = (st >> 1) * 16 + swz / 64; C = (st & 1) * 32 + (swz % 64) / 2; }
__host__ __device__ __forceinline__ int perm32(int rho) { const int n = rho >> 4, i = rho & 15; return 8 * (i >> 2) + 4 * n + (i & 3); }

struct Unit { int pm, pn; };
struct Gemm { const bf16_t* A; const bf16_t* Bt; int M, N, K; };

struct StaticOrder {
    int nM, nN, nwg, G, c;
    __host__ __device__ void init(int M, int N, int G_, int c_) { nM = M / BM; nN = N / BM; nwg = nM * nN; G = G_; c = c_; }
    __host__ __device__ bool next(int i, Unit& u) const {
        const long L = (long)i * G + c; if (L >= nwg) return false;
        int wgid = (int)L; { const int q = nwg / NXCD, r = nwg % NXCD, xcd = wgid % NXCD, off = wgid / NXCD; wgid = (xcd < r ? xcd * (q + 1) : r * (q + 1) + (xcd - r) * q) + off; }
        const int nig = WGM * nN, gid = wgid / nig, fm = gid * WGM, gsz = (nM - fm) < WGM ? (nM - fm) : WGM;
        u.pm = fm + ((wgid % nig) % gsz); u.pn = (wgid % nig) / gsz; return true;
    }
    __device__ __forceinline__ void a_ready(const Unit&) const {}
    __device__ __forceinline__ void done(const Unit&) const {}
};

__device__ __forceinline__ unsigned cvt_pk_bf16(float lo, float hi) { unsigned r; asm volatile("v_cvt_pk_bf16_f32 %0, %1, %2" : "=v"(r) : "v"(lo), "v"(hi)); return r; }
typedef float f32x2 __attribute__((ext_vector_type(2)));

template <class Epi, class Sched, bool ALIGN_EPI = false, bool SP2 = false>
__device__ __forceinline__ void gemm_phase(PG8_LAS unsigned char* lds, const Gemm g, const Sched& S, const Epi& E) {
    const int tid = threadIdx.x, wid = __builtin_amdgcn_readfirstlane(tid >> 6), lane = tid & 63, wr = wid >> 2, wc = wid & 3, fr = lane & 15, fq = lane >> 4;
    const int K = g.K, nt = K / BK;
    unsigned voffA[2], voffB[2];
#pragma unroll
    for (int i = 0; i < 2; ++i) { int R, C; stage_rc(tid * 16 + i * 8192, R, C); const int Rb = Epi::PERM ? ((R & ~31) + perm32(R & 31)) : R;
        voffA[i] = (unsigned)(R * K + C) * 2u; voffB[i] = (unsigned)(Rb * K + C) * 2u; }
    const size_t kstep = (size_t)(BK * 2);
    const size_t hstep = (size_t)HALF * K * 2;
    const size_t tstep = 2 * hstep;
    const unsigned ldsw = (unsigned)wid * 1024u;
    const int aoff = lds_byte(wr * 64 + fr, fq * 8), boff = lds_byte(wc * 32 + fr, fq * 8);
#define PG8_SA(b, h) (((b) * 2 + (h)) * HTB)
#define PG8_SB(b, h) ((4 + (b) * 2 + (h)) * HTB)
#define PG8_STAGE(bufoff, gbase, voff) do { _Pragma("unroll") for (int _i = 0; _i < 2; ++_i) \
        __builtin_amdgcn_global_load_lds((const unsigned*)((const char*)(gbase) + (voff)[_i]), (PG8_LAS unsigned*)(lds + (bufoff) + ldsw + _i * 8192), 16, 0, 0); } while (0)
#define PG8_LDA(dst, b, h) do { _Pragma("unroll") for (int m = 0; m < 4; ++m) _Pragma("unroll") for (int k = 0; k < 2; ++k) dst[m][k] = *(const PG8_LAS bf16x8*)(lds + PG8_SA(b, h) + aoff + m * 2048 + k * 1024); } while (0)
#define PG8_LDB(dst, b, h) do { _Pragma("unroll") for (int n = 0; n < 2; ++n) _Pragma("unroll") for (int k = 0; k < 2; ++k) dst[n][k] = *(const PG8_LAS bf16x8*)(lds + PG8_SB(b, h) + boff + n * 2048 + k * 1024); } while (0)
#define PG8_MMA(ai, bj, At, Bt) do { __builtin_amdgcn_s_setprio(1); _Pragma("unroll") for (int m = 0; m < 4; ++m) _Pragma("unroll") for (int n = 0; n < 2; ++n) _Pragma("unroll") for (int k = 0; k < 2; ++k) \
        acc[ai][bj][m][n] = __builtin_amdgcn_mfma_f32_16x16x32_bf16(Bt[n][k], At[m][k], acc[ai][bj][m][n], 0, 0, 0); __builtin_amdgcn_s_setprio(0); } while (0)
#define PG8_WAIT_V(n) asm volatile("s_waitcnt vmcnt(" #n ")" ::: "memory")
#define PG8_WAIT_L(n) asm volatile("s_waitcnt lgkmcnt(" #n ")" ::: "memory")
#define PG8_BAR __builtin_amdgcn_s_barrier()
#define PG8_SCHED __builtin_amdgcn_sched_barrier(0)
    Unit cur, nxt; int ui = 0;
    if (!S.next(0, cur)) return;
    f32x4 acc[2][2][4][2];
#pragma unroll
    for (int a = 0; a < 2; ++a)
#pragma unroll
        for (int b = 0; b < 2; ++b)
#pragma unroll
            for (int m = 0; m < 4; ++m)
#pragma unroll
                for (int n = 0; n < 2; ++n) acc[a][b][m][n] = (f32x4){0.f, 0.f, 0.f, 0.f};
    bf16x8 At[4][2], B0[2][2], B1[2][2];
    const char* cA = (const char*)g.A + (size_t)cur.pm * tstep; const char* cB = (const char*)g.Bt + (size_t)cur.pn * tstep;
    S.a_ready(cur);
    if constexpr (SP2) {
        PG8_STAGE(PG8_SB(0, 0), cB, voffB); PG8_STAGE(PG8_SB(0, 1), cB + hstep, voffB); PG8_STAGE(PG8_SA(0, 0), cA, voffA); PG8_STAGE(PG8_SA(0, 1), cA + hstep, voffA);
        if (wr == 1) PG8_BAR;
        PG8_WAIT_V(2); PG8_BAR;
        PG8_STAGE(PG8_SB(1, 0), cB + kstep, voffB); PG8_STAGE(PG8_SA(1, 0), cA + kstep, voffA); PG8_STAGE(PG8_SB(1, 1), cB + hstep + kstep, voffB);
        PG8_WAIT_V(6); PG8_BAR;
    } else {
        PG8_STAGE(PG8_SB(0, 0), cB, voffB); PG8_STAGE(PG8_SA(0, 0), cA, voffA); PG8_STAGE(PG8_SB(0, 1), cB + hstep, voffB); PG8_STAGE(PG8_SA(0, 1), cA + hstep, voffA);
        if (wr == 1) PG8_BAR;
        PG8_WAIT_V(4); PG8_BAR;
        PG8_STAGE(PG8_SB(1, 0), cB + kstep, voffB); PG8_STAGE(PG8_SA(1, 0), cA + kstep, voffA); PG8_STAGE(PG8_SB(1, 1), cB + hstep + kstep, voffB);
        PG8_WAIT_V(6); PG8_BAR;
    }
    for (;;) {
        const bool has_next = S.next(ui + 1, nxt);
        const char* nA = has_next ? (const char*)g.A + (size_t)nxt.pm * tstep : cA; const char* nB = has_next ? (const char*)g.Bt + (size_t)nxt.pn * tstep : cB;
        for (int t = 0; t < nt; t += 2) {
            const bool last = (t == nt - 2);
            const char* a1 = cA + (size_t)(t + 1) * kstep;
            const char* a2 = last ? nA : cA + (size_t)(t + 2) * kstep; const char* b2 = last ? nB : cB + (size_t)(t + 2) * kstep;
            const char* a3 = a2 + kstep; const char* b3 = b2 + kstep;
            if (last && has_next) S.a_ready(nxt);
            if constexpr (SP2) {
            PG8_LDB(B0, 0, 0); PG8_LDB(B1, 0, 1); PG8_SCHED; PG8_LDA(At, 0, 0); PG8_STAGE(PG8_SA(1, 1), a1 + hstep, voffA);
            PG8_WAIT_V(8); PG8_WAIT_L(0); PG8_BAR; PG8_MMA(0, 0, At, B0); PG8_MMA(0, 1, At, B1); PG8_BAR; PG8_SCHED;
            PG8_LDA(At, 0, 1); PG8_STAGE(PG8_SB(0, 0), b2, voffB); PG8_STAGE(PG8_SB(0, 1), b2 + hstep, voffB); PG8_STAGE(PG8_SA(0, 0), a2, voffA);
            PG8_WAIT_V(8); PG8_WAIT_L(0); PG8_BAR; PG8_MMA(1, 0, At, B0); PG8_MMA(1, 1, At, B1); PG8_BAR; PG8_SCHED;
            PG8_LDB(B0, 1, 0); PG8_LDB(B1, 1, 1); PG8_SCHED; PG8_LDA(At, 1, 0); PG8_STAGE(PG8_SA(0, 1), a2 + hstep, voffA);
            PG8_WAIT_V(8); PG8_WAIT_L(0); PG8_BAR; PG8_MMA(0, 0, At, B0); PG8_MMA(0, 1, At, B1); PG8_BAR; PG8_SCHED;
            PG8_LDA(At, 1, 1); PG8_STAGE(PG8_SB(1, 0), b3, voffB); PG8_STAGE(PG8_SB(1, 1), b3 + hstep, voffB); PG8_STAGE(PG8_SA(1, 0), a3, voffA);
            PG8_WAIT_V(8); PG8_WAIT_L(0); PG8_BAR; PG8_MMA(1, 0, At, B0); PG8_MMA(1, 1, At, B1); PG8_BAR; PG8_SCHED;
            } else {
            PG8_LDB(B0, 0, 0); PG8_SCHED; PG8_LDA(At, 0, 0); PG8_STAGE(PG8_SA(1, 1), a1 + hstep, voffA);
            PG8_WAIT_L(8); PG8_BAR; PG8_WAIT_L(0); PG8_MMA(0, 0, At, B0); PG8_BAR; PG8_SCHED;
            PG8_LDB(B1, 0, 1); PG8_STAGE(PG8_SB(0, 0), b2, voffB);
            PG8_BAR; PG8_WAIT_L(0); PG8_MMA(0, 1, At, B1); PG8_BAR;
            PG8_LDA(At, 0, 1); PG8_STAGE(PG8_SA(0, 0), a2, voffA);
            PG8_BAR; PG8_WAIT_L(0); PG8_MMA(1, 0, At, B0); PG8_BAR; PG8_SCHED;
            PG8_STAGE(PG8_SB(0, 1), b2 + hstep, voffB);
            PG8_WAIT_V(6); PG8_BAR; PG8_MMA(1, 1, At, B1); PG8_BAR;
            PG8_LDB(B0, 1, 0); PG8_SCHED; PG8_LDA(At, 1, 0); PG8_STAGE(PG8_SA(0, 1), a2 + hstep, voffA);
            PG8_WAIT_L(8); PG8_BAR; PG8_WAIT_L(0); PG8_MMA(0, 0, At, B0); PG8_BAR; PG8_SCHED;
            PG8_LDB(B1, 1, 1); PG8_STAGE(PG8_SB(1, 0), b3, voffB);
            PG8_BAR; PG8_WAIT_L(0); PG8_MMA(0, 1, At, B1); PG8_BAR;
            PG8_LDA(At, 1, 1); PG8_STAGE(PG8_SA(1, 0), a3, voffA);
            PG8_BAR; PG8_WAIT_L(0); PG8_MMA(1, 0, At, B0); PG8_BAR; PG8_SCHED;
            PG8_STAGE(PG8_SB(1, 1), b3 + hstep, voffB);
            PG8_WAIT_V(6); PG8_BAR; PG8_MMA(1, 1, At, B1); PG8_BAR;
            }
        }
        if constexpr (ALIGN_EPI) { if (wr == 0) PG8_BAR; }
        if constexpr (!Epi::AFTER_DRAIN) { E(acc, cur, wr, wc, fr, fq); S.done(cur); }
        if (!has_next) break;
#pragma unroll
        for (int a = 0; a < 2; ++a)
#pragma unroll
            for (int b = 0; b < 2; ++b)
#pragma unroll
                for (int m = 0; m < 4; ++m)
#pragma unroll
                    for (int n = 0; n < 2; ++n) acc[a][b][m][n] = (f32x4){0.f, 0.f, 0.f, 0.f};
        cur = nxt; cA = nA; cB = nB; ++ui;
        if constexpr (ALIGN_EPI) { if (wr == 1) PG8_BAR; }
    }
    PG8_WAIT_V(0);
    if constexpr (!ALIGN_EPI) { if (wr == 0) PG8_BAR; }
    PG8_BAR;
    if constexpr (Epi::AFTER_DRAIN) { E.fused(acc, cur, wr, wc, fr, fq, lds, wid, lane); S.done(cur); }
#undef PG8_SA
#undef PG8_SB
#undef PG8_STAGE
#undef PG8_LDA
#undef PG8_LDB
#undef PG8_MMA
#undef PG8_WAIT_V
#undef PG8_WAIT_L
#undef PG8_BAR
#undef PG8_SCHED
}
}


constexpr int NB = 4, SEQ = 4096, T = NB * SEQ, D = 2048;
constexpr int RW = 1024, NH = 16, HD = 64;
constexpr int IN_W = 12064, SHIFT_W = 3360;
constexpr int ZPW = 3584, QKVW = 4608, GATEW = 4096, NPROJ = 12288;
constexpr int NE = 32, FF = 2048;
constexpr int XS_ROWS = T * 4 + NE * 256;
constexpr int NWAVES = 8, NTHREADS = 512;
constexpr float NORM_EPS = 1e-5f, GN_EPS = 64e-5f;
constexpr float QSCALE = 0.08838834764831845f * 1.4426950408889634f;

#ifndef MK_ONE_LAUNCH
#define MK_ONE_LAUNCH 1
#endif
constexpr int NPHASES = 13;

constexpr size_t MiB = 1ull << 20;
constexpr size_t WS_CTL = 0, CTL_ZERO_BYTES = 1 * MiB;
constexpr size_t WS_WIN = 1 * MiB;
constexpr size_t WS_W1 = WS_WIN + 48 * MiB;
constexpr size_t WS_W2 = WS_W1 + 512 * MiB;
constexpr size_t WS_WOR = WS_W2 + 256 * MiB;
constexpr size_t WS_WOA = WS_WOR + 4 * MiB;
constexpr size_t WS_WOUT = WS_WOA + 2 * MiB;
constexpr size_t WS_H = WS_WOUT + 8 * MiB;
constexpr size_t WS_ZP = WS_H + 64 * MiB;
constexpr size_t WS_QKV = WS_ZP + 112 * MiB;
constexpr size_t WS_GATES = WS_QKV + 144 * MiB;
constexpr size_t WS_ROT = WS_GATES + 128 * MiB;
constexpr size_t WS_SC = WS_ROT + 2 * MiB;
constexpr size_t WS_G = WS_SC + 384 * MiB;
constexpr size_t WS_BONUS = WS_G + 32 * MiB;
constexpr size_t WS_Y = WS_BONUS + 1 * MiB;
constexpr size_t WS_ATTO = WS_Y + 64 * MiB;
constexpr size_t WS_ATTML = WS_ATTO + 48 * MiB;
constexpr size_t WS_YAIN = WS_ATTML + 2 * MiB;
constexpr size_t WS_OIN = WS_YAIN + 32 * MiB;
constexpr size_t WS_MERGED = WS_OIN + 16 * MiB;
constexpr size_t WS_X1 = WS_MERGED + 64 * MiB;
constexpr size_t WS_TOPK = WS_X1 + 128 * MiB;
constexpr size_t WS_ROWS = WS_TOPK + 1 * MiB;
constexpr size_t WS_XS = WS_ROWS + 1 * MiB;
constexpr size_t WS_ACT = WS_XS + 288 * MiB;
constexpr size_t WS_OUTK = WS_ACT + 288 * MiB;
constexpr size_t WS_END = WS_OUTK + 256 * MiB;
constexpr size_t SC_STRIDE = (size_t)T * RW;
enum { SC_KK = 0, SC_W = 1, SC_BB = 2, SC_K = 3, SC_R = 4, SC_V = 5 };

constexpr int CW_TMO = 0, CW_CODE = 1, CW_BAR = 4096, CW_CNT = 8192;

constexpr int RING_BYTES = 131072;
constexpr int TAB_OFF = RING_BYTES;
constexpr int MISC_OFF = TAB_OFF + 512;
constexpr int LDS_BYTES = 147456;

#define GAS __attribute__((address_space(1)))
#define LAS __attribute__((address_space(3)))
typedef unsigned short bf16;
typedef unsigned u32x4 __attribute__((ext_vector_type(4)));
typedef unsigned u32x2 __attribute__((ext_vector_type(2)));
typedef float f32x4 __attribute__((ext_vector_type(4)));
typedef short bf16x8 __attribute__((ext_vector_type(8)));
typedef short bf16x4 __attribute__((ext_vector_type(4)));
typedef GAS unsigned gu32;
#define RLX_AGENT __ATOMIC_RELAXED, __HIP_MEMORY_SCOPE_AGENT
#define LDS_WAIT() asm volatile("s_waitcnt lgkmcnt(0)" ::: "memory")
#define VM_WAIT() asm volatile("s_waitcnt vmcnt(0)" ::: "memory")
__device__ __forceinline__ unsigned f2bf(float f) { unsigned u = __builtin_bit_cast(unsigned, f); return (u + 0x7fffu + ((u >> 16) & 1u)) >> 16; }
__device__ __forceinline__ unsigned pk2(float lo, float hi) { return f2bf(lo) | (f2bf(hi) << 16); }
__device__ __forceinline__ float bflo(unsigned w) { return __uint_as_float(w << 16); }
__device__ __forceinline__ float bfhi(unsigned w) { return __uint_as_float(w & 0xffff0000u); }
__device__ __forceinline__ float bf2f(bf16 h) { return __uint_as_float((unsigned)h << 16); }
__device__ __forceinline__ float sigmoidf_(float x) { return 1.0f / (1.0f + __expf(-x)); }
__device__ __forceinline__ float wave_sum(float v) {
#pragma unroll
    for (int o = 1; o < 64; o <<= 1) v += __shfl_xor(v, o);
    return v;
}
__device__ __forceinline__ u32x4 pack8(const f32x4& a, const f32x4& b) { u32x4 w; w.x = pk2(a[0], a[1]); w.y = pk2(a[2], a[3]); w.z = pk2(b[0], b[1]); w.w = pk2(b[2], b[3]); return w; }
__device__ __forceinline__ void unpack8(const u32x4& w, f32x4& a, f32x4& b) { a = (f32x4){bflo(w.x), bfhi(w.x), bflo(w.y), bfhi(w.y)}; b = (f32x4){bflo(w.z), bfhi(w.z), bflo(w.w), bfhi(w.w)}; }

#define XB_TMO      128
#define XB_XCNT(j)  (256  + 64 * (j))
#define XB_XSUB(j)  (1280 + 64 * (j))
#define XB_XGEN(j)  (2304 + 64 * (j))
#define XB_TOP      3328
#define XB_TOPGEN   3392
#define XCD_BAR_WORDS 3456
#define XB_SPIN_CAP (1u << 18)

__device__ __forceinline__ unsigned xb_ld(unsigned* p)              { return __hip_atomic_load(p, __ATOMIC_RELAXED, __HIP_MEMORY_SCOPE_AGENT); }
__device__ __forceinline__ unsigned xb_add(unsigned* p, unsigned v) { return __hip_atomic_fetch_add(p, v, __ATOMIC_RELAXED, __HIP_MEMORY_SCOPE_AGENT); }
__device__ __forceinline__ unsigned xb_xcc_id() { return (unsigned)__builtin_amdgcn_s_getreg((3 << 11) | 20) & 0xFu; }
#define XB_SPIN(cond, bar) do { unsigned _sp = 0; while (cond) { __builtin_amdgcn_s_sleep(1); \
    if ((++_sp & 255u) == 0u) { if (xb_ld(&(bar)[XB_TMO])) break; if (_sp > XB_SPIN_CAP) { atomicAdd(&(bar)[XB_TMO], 1u); break; } } } } while (0)

struct XcdBarrier {
    unsigned* bar; unsigned x;
    volatile LAS unsigned* st;
};

__device__ __forceinline__ XcdBarrier xcd_barrier_post(unsigned* bar, volatile LAS unsigned* st) {
    XcdBarrier b; b.bar = bar; b.x = xb_xcc_id(); b.st = st;
    if (threadIdx.x == 0) (void)xb_add(&bar[XB_XCNT(b.x)], 1u);
    return b;
}
__device__ __forceinline__ void xcd_barrier_complete(unsigned* bar, unsigned x, unsigned& nloc, unsigned& nx) {
    const unsigned G = gridDim.x * gridDim.y * gridDim.z;
    unsigned sum, cnt, mine, sp = 0u;
    for (;;) {
        sum = 0u; cnt = 0u; mine = 0u;
#pragma unroll
        for (unsigned j = 0; j < 16; ++j) { const unsigned c = xb_ld(&bar[XB_XCNT(j)]); sum += c; cnt += (c > 0u) ? 1u : 0u; mine = (j == x) ? c : mine; }
        if (sum == G) break;
        __builtin_amdgcn_s_sleep(1);
        if ((++sp & 255u) == 0u) { if (xb_ld(&bar[XB_TMO])) break; if (sp > XB_SPIN_CAP) { atomicAdd(&bar[XB_TMO], 1u); break; } }
    }
    nloc = mine > 0u ? mine : 1u; nx = cnt > 0u ? cnt : 1u;
}

__device__ __forceinline__ void xcd_barrier(const XcdBarrier& b) {
    asm volatile("s_waitcnt vmcnt(0)" ::: "memory");
    __syncthreads();
    if (threadIdx.x == 0) {
        unsigned* bar = b.bar;
        __builtin_amdgcn_s_waitcnt(0);
        unsigned nloc = b.st[0], nx = b.st[1];
        if (nloc == 0u) { xcd_barrier_complete(bar, b.x, nloc, nx); b.st[0] = nloc; b.st[1] = nx; }
        const unsigned old = xb_add(&bar[XB_XSUB(b.x)], 1u);
        const unsigned gen = old / nloc;
        if (old + 1u == (gen + 1u) * nloc) {
            __builtin_amdgcn_fence(__ATOMIC_RELEASE, "agent");
            asm volatile("s_waitcnt vmcnt(0)" ::: "memory");
            const unsigned og = xb_add(&bar[XB_TOP], 1u);
            const unsigned tg = og / nx;
            if (og + 1u == (tg + 1u) * nx) xb_add(&bar[XB_TOPGEN], 1u);
            else XB_SPIN(xb_ld(&bar[XB_TOPGEN]) == tg, bar);
            __builtin_amdgcn_fence(__ATOMIC_ACQUIRE, "agent");
            xb_add(&bar[XB_XGEN(b.x)], 1u);
            asm volatile("s_waitcnt vmcnt(0)" ::: "memory");
        } else {
            XB_SPIN(xb_ld(&bar[XB_XGEN(b.x)]) == gen, bar);
            __builtin_amdgcn_fence(__ATOMIC_ACQUIRE, "agent");
            asm volatile("s_waitcnt vmcnt(0)" ::: "memory");
        }
    }
    __syncthreads();
}


struct Ptrs {
    const float *x, *norm_mix, *w_in, *shift_mu, *w0, *w2_decay, *a0, *a2_iclr, *g2_gate, *k_k, *k_a, *r_k, *ln_x_w, *ln_x_b, *w_o_rwkv, *w_o_attn, *w_out, *norm_ffn, *w_router, *b_router, *w1, *b1, *w2, *b2, *norm_final;
    const int* positions;
    float* out;
    bf16 *WIN, *W1, *W2, *WOR, *WOA, *WOUT, *H, *ZP, *QKV, *GATES, *G, *ATTO, *YAIN, *OIN, *MERGED, *XS, *ACT, *OUTK;
    float *ROT, *SC, *BONUS, *Y, *ATTML, *X1, *TOPK_GATE, *ROWGATE;
    int *TOPK_E, *TOPK_POS, *ROWTOK;
    gu32* ctl;
};

using pg8::Unit;
__device__ __forceinline__ void store8(bf16* p, const f32x4& a, const f32x4& b) { *(u32x4*)p = pack8(a, b); }

struct EpiProj {
    static constexpr bool PERM = true, AFTER_DRAIN = false;
    bf16* ZP; bf16* QKV; bf16* GATES; const float* ROT;
    __device__ __forceinline__ void operator()(const f32x4 (&acc)[2][2][4][2], const Unit& u, int wr, int wc, int fr, int fq) const {
        const int pn = u.pn, rbase = u.pm * 256 + wr * 64 + fr, cw = wc * 32 + 8 * fq;
        if (pn < 14) {
#pragma unroll
            for (int ai = 0; ai < 2; ++ai)
#pragma unroll
                for (int m = 0; m < 4; ++m) { bf16* rp = ZP + (size_t)(rbase + ai * 128 + m * 16) * ZPW + pn * 256 + cw;
#pragma unroll
                    for (int bj = 0; bj < 2; ++bj) store8(rp + bj * 128, acc[ai][bj][m][0], acc[ai][bj][m][1]); }
        } else if (pn < 32) {
            const int t = pn - 14; const bool rot = (t < 12) && (wc == 0); const float sc = (t < 6) ? QSCALE : 1.0f; const float sg = (fq < 2) ? -1.0f : 1.0f;
#pragma unroll
            for (int ai = 0; ai < 2; ++ai)
#pragma unroll
                for (int m = 0; m < 4; ++m) { const int row = rbase + ai * 128 + m * 16; bf16* rp = QKV + (size_t)row * QKVW + t * 256 + cw;
                    f32x4 c0 = {1.f, 1.f, 1.f, 1.f}, c1 = c0, s0 = {0.f, 0.f, 0.f, 0.f}, s1 = s0;
                    if (rot) { const float* rt = ROT + (size_t)row * 32 + 8 * (fq & 1); c0 = *(const f32x4*)rt; c1 = *(const f32x4*)(rt + 4); s0 = *(const f32x4*)(rt + 16); s1 = *(const f32x4*)(rt + 20); }
#pragma unroll
                    for (int bj = 0; bj < 2; ++bj) { f32x4 v0 = acc[ai][bj][m][0], v1 = acc[ai][bj][m][1];
                        if (rot) { f32x4 p0, p1;
#pragma unroll
                            for (int j = 0; j < 4; ++j) { p0[j] = __shfl_xor(v0[j], 32); p1[j] = __shfl_xor(v1[j], 32); }
                            v0 = v0 * c0 + (p0 * s0) * sg; v1 = v1 * c1 + (p1 * s1) * sg; }
                        v0 = v0 * sc; v1 = v1 * sc; store8(rp + bj * 128, v0, v1); } }
        } else {
            const int t = pn - 32;
#pragma unroll
            for (int ai = 0; ai < 2; ++ai)
#pragma unroll
                for (int m = 0; m < 4; ++m) { bf16* rp = GATES + (size_t)(rbase + ai * 128 + m * 16) * GATEW + t * 256 + cw;
#pragma unroll
                    for (int bj = 0; bj < 2; ++bj) { f32x4 v0 = acc[ai][bj][m][0], v1 = acc[ai][bj][m][1];
#pragma unroll
                        for (int j = 0; j < 4; ++j) { v0[j] = sigmoidf_(v0[j]); v1[j] = sigmoidf_(v1[j]); }
                        store8(rp + bj * 128, v0, v1); } }
        }
    }
};

template <int STAGE> struct EpiMerge {
    static constexpr bool PERM = true, AFTER_DRAIN = false;
    bf16* MERGED; const bf16* GATES;
    __device__ __forceinline__ void operator()(const f32x4 (&acc)[2][2][4][2], const Unit& u, int wr, int wc, int fr, int fq) const {
        const int rbase = u.pm * 256 + wr * 64 + fr, cb = u.pn * 256 + wc * 32 + 8 * fq;
#pragma unroll
        for (int ai = 0; ai < 2; ++ai)
#pragma unroll
            for (int m = 0; m < 4; ++m) { const int row = rbase + ai * 128 + m * 16;
#pragma unroll
                for (int bj = 0; bj < 2; ++bj) { const int col = cb + bj * 128;
                    const u32x4 gw = *(const u32x4*)(GATES + (size_t)row * GATEW + STAGE * 2048 + col); f32x4 g0, g1; unpack8(gw, g0, g1);
                    f32x4 v0 = acc[ai][bj][m][0] * g0, v1 = acc[ai][bj][m][1] * g1; bf16* dp = MERGED + (size_t)row * D + col;
                    if (STAGE == 1) { const u32x4 tw = *(const u32x4*)dp; f32x4 t0, t1; unpack8(tw, t0, t1); v0 = v0 + t0; v1 = v1 + t1; }
                    store8(dp, v0, v1); } }
    }
};

struct EpiResid {
    static constexpr bool PERM = false, AFTER_DRAIN = false;
    const float* X; float* X1;
    __device__ __forceinline__ void operator()(const f32x4 (&acc)[2][2][4][2], const Unit& u, int wr, int wc, int fr, int fq) const {
        const int rbase = u.pm * 256 + wr * 64 + fr, cb = u.pn * 256 + wc * 32 + 4 * fq;
#pragma unroll
        for (int ai = 0; ai < 2; ++ai)
#pragma unroll
            for (int m = 0; m < 4; ++m) { const size_t ro = (size_t)(rbase + ai * 128 + m * 16) * D;
#pragma unroll
                for (int bj = 0; bj < 2; ++bj)
#pragma unroll
                    for (int n = 0; n < 2; ++n) { const int col = cb + bj * 128 + n * 16; *(f32x4*)(X1 + ro + col) = *(const f32x4*)(X + ro + col) + acc[ai][bj][m][n]; } }
    }
};

struct EpiMoe1 {
    static constexpr bool PERM = true, AFTER_DRAIN = false;
    bf16* ACT; const float* b1;
    __device__ __forceinline__ void operator()(const f32x4 (&acc)[2][2][4][2], const Unit& u, int wr, int wc, int fr, int fq) const {
        const int e = u.pn >> 4, pnl = u.pn & 15, rbase = u.pm * 256 + wr * 64 + fr, col = pnl * 128 + wc * 32 + 8 * fq;
        const float* bg = b1 + (size_t)e * 4096 + col; const float* bl = bg + 2048;
        const f32x4 bg0 = *(const f32x4*)bg, bg1 = *(const f32x4*)(bg + 4), bl0 = *(const f32x4*)bl, bl1 = *(const f32x4*)(bl + 4);
#pragma unroll
        for (int ai = 0; ai < 2; ++ai)
#pragma unroll
            for (int m = 0; m < 4; ++m) { const int row = rbase + ai * 128 + m * 16;
                f32x4 g0 = acc[ai][0][m][0] + bg0, g1 = acc[ai][0][m][1] + bg1, l0 = acc[ai][1][m][0] + bl0, l1 = acc[ai][1][m][1] + bl1, o0, o1;
#pragma unroll
                for (int j = 0; j < 4; ++j) {
                    { const float xg = fminf(g0[j], 7.0f), xl = fminf(fmaxf(l0[j], -7.0f), 7.0f); o0[j] = xg * sigmoidf_(1.702f * xg) * (xl + 1.0f); }
                    { const float xg = fminf(g1[j], 7.0f), xl = fminf(fmaxf(l1[j], -7.0f), 7.0f); o1[j] = xg * sigmoidf_(1.702f * xg) * (xl + 1.0f); } }
                store8(ACT + (size_t)row * FF + col, o0, o1); }
    }
};

struct EpiMoe2 {
    static constexpr bool PERM = true, AFTER_DRAIN = false;
    bf16* OUTK; const float* b2; const int* ROWTOK; const float* ROWGATE;
    __device__ __forceinline__ void operator()(const f32x4 (&acc)[2][2][4][2], const Unit& u, int wr, int wc, int fr, int fq) const {
        const int e = u.pn >> 3, pnl = u.pn & 7, rbase = u.pm * 256 + wr * 64 + fr, cb = pnl * 256 + wc * 32 + 8 * fq;
        f32x4 bv[2][2];
#pragma unroll
        for (int bj = 0; bj < 2; ++bj) { const float* bp = b2 + (size_t)e * D + cb + bj * 128; bv[bj][0] = *(const f32x4*)bp; bv[bj][1] = *(const f32x4*)(bp + 4); }
#pragma unroll
        for (int ai = 0; ai < 2; ++ai)
#pragma unroll
            for (int m = 0; m < 4; ++m) { const int row = rbase + ai * 128 + m * 16; const int p = ROWTOK[row];
                if (p >= 0) { const float gt = ROWGATE[row];
#pragma unroll
                    for (int bj = 0; bj < 2; ++bj) { const f32x4 v0 = (acc[ai][bj][m][0] + bv[bj][0]) * gt, v1 = (acc[ai][bj][m][1] + bv[bj][1]) * gt; store8(OUTK + (size_t)p * D + cb + bj * 128, v0, v1); } } }
    }
};

struct MoeOrder {
    const LAS int* toff; int npn, G, c;
    __device__ __forceinline__ bool next(int i, Unit& u) const {
        const int L = i * G + c, NT = toff[32];
        if (L >= NT * npn) return false;
        int e = 0;
#pragma unroll 1
        for (int j = 1; j < 32; ++j) e += (L >= toff[j] * npn) ? 1 : 0;
        const int t0 = toff[e], te = toff[e + 1] - t0, rem = L - t0 * npn;
        const int pnl = rem / te, pml = rem - pnl * te;
        u.pm = __builtin_amdgcn_readfirstlane(t0 + pml); u.pn = __builtin_amdgcn_readfirstlane(e * npn + pnl); return true;
    }
    __device__ __forceinline__ void a_ready(const Unit&) const {}
    __device__ __forceinline__ void done(const Unit&) const {}
};

__device__ __forceinline__ void tr_item(const float* src, int ldn, int k0, int c0, bf16* dst, size_t dstrow0, int K, LAS float* scr, int lane) {
    f32x4 v[8];
#pragma unroll
    for (int i = 0; i < 8; ++i) v[i] = *(const GAS f32x4*)(src + (size_t)(k0 + 8 * i + (lane >> 3)) * ldn + c0 + 4 * (lane & 7));
#pragma unroll
    for (int i = 0; i < 8; ++i) { LAS float* p = scr + (8 * i + (lane >> 3)) * 33 + 4 * (lane & 7); p[0] = v[i].x; p[1] = v[i].y; p[2] = v[i].z; p[3] = v[i].w; }
    LDS_WAIT(); asm volatile("" ::: "memory");
    const int c = lane & 7;
#pragma unroll
    for (int j = 0; j < 4; ++j) { const int n = (lane >> 3) + 8 * j; const LAS float* s = scr + (8 * c) * 33 + n;
        u32x4 o; o.x = pk2(s[0 * 33], s[1 * 33]); o.y = pk2(s[2 * 33], s[3 * 33]); o.z = pk2(s[4 * 33], s[5 * 33]); o.w = pk2(s[6 * 33], s[7 * 33]);
        *(GAS u32x4*)(dst + (dstrow0 + n) * (size_t)K + k0 + 8 * c) = o; }
    LDS_WAIT(); asm volatile("" ::: "memory");
}
__device__ __forceinline__ void rms_row_to_bf16(const float* xrow, const float* g, bf16* orow, int lane) {
    f32x4 v[8]; float s = 0.f;
#pragma unroll
    for (int j = 0; j < 8; ++j) { v[j] = *(const GAS f32x4*)(xrow + 4 * lane + 256 * j); s += (v[j].x * v[j].x + v[j].y * v[j].y) + (v[j].z * v[j].z + v[j].w * v[j].w); }
    const float rs = 1.0f / sqrtf(wave_sum(s) * (1.0f / D) + NORM_EPS);
#pragma unroll
    for (int j = 0; j < 8; ++j) { const f32x4 gv = *(const GAS f32x4*)(g + 4 * lane + 256 * j); u32x2 w; w.x = pk2(v[j].x * rs * gv.x, v[j].y * rs * gv.y); w.y = pk2(v[j].z * rs * gv.z, v[j].w * rs * gv.w);
        *(GAS u32x2*)(orow + 4 * lane + 256 * j) = w; }
}
__device__ __forceinline__ void p0_prologue(const Ptrs& P, LAS unsigned char* lds, int tid, int wave, int lane) {
    LAS float* scr = (LAS float*)(lds + wave * 8704);
    const int gw = blockIdx.x * NWAVES + wave, NGW = gridDim.x * NWAVES;
    constexpr int I_IN = 32 * 377, I_W1 = NE * 32 * 128, I_W2 = NE * 32 * 64, I_OR = 16 * 64, I_OA = 8 * 64, I_OUT = 32 * 64;
    constexpr int NITEMS = I_IN + I_W1 + I_W2 + I_OR + I_OA + I_OUT;
    for (int it = gw; it < NITEMS; it += NGW) {
        int r = it;
        if (r < I_IN) { const int kb = r / 377, nb = r % 377, c0 = 32 * nb; tr_item(P.w_in, IN_W, 64 * kb, c0, P.WIN, (size_t)(c0 < SHIFT_W ? c0 : c0 + 224), D, scr, lane); continue; }
        r -= I_IN;
        if (r < I_W1) { const int e = r >> 12, q = r & 4095, kb = q >> 7, nb = q & 127, c0 = 32 * nb;
            tr_item(P.w1 + (size_t)e * D * 4096, 4096, 64 * kb, c0, P.W1, (size_t)e * 4096 + ((c0 & 2047) >> 7) * 256 + (c0 >> 11) * 128 + (c0 & 127), D, scr, lane); continue; }
        r -= I_W1;
        if (r < I_W2) { const int e = r >> 11, q = r & 2047, kb = q >> 6, nb = q & 63; tr_item(P.w2 + (size_t)e * FF * D, D, 64 * kb, 32 * nb, P.W2, (size_t)e * D + 32 * nb, FF, scr, lane); continue; }
        r -= I_W2;
        if (r < I_OR) { const int kb = r >> 6, nb = r & 63; tr_item(P.w_o_rwkv, D, 64 * kb, 32 * nb, P.WOR, (size_t)32 * nb, RW, scr, lane); continue; }
        r -= I_OR;
        if (r < I_OA) { const int kb = r >> 6, nb = r & 63; tr_item(P.w_o_attn, D, 64 * kb, 32 * nb, P.WOA, (size_t)32 * nb, 512, scr, lane); continue; }
        r -= I_OA;
        { const int kb = r >> 6, nb = r & 63; tr_item(P.w_out, D, 64 * kb, 32 * nb, P.WOUT, (size_t)32 * nb, D, scr, lane); }
    }
    { const int gt = blockIdx.x * NTHREADS + tid, NGT = gridDim.x * NTHREADS; GAS u32x4* z = (GAS u32x4*)(P.WIN + (size_t)SHIFT_W * D);
      for (int i = gt; i < 224 * D / 8; i += NGT) z[i] = (u32x4){0u, 0u, 0u, 0u}; }
    for (int m = gw; m < T; m += NGW) rms_row_to_bf16(P.x + (size_t)m * D, P.norm_mix, P.H + (size_t)m * D, lane);
    { const int gt = blockIdx.x * NTHREADS + tid, NGT = gridDim.x * NTHREADS;
      for (int i = gt; i < T * 16; i += NGT) { const int m = i >> 4, f = i & 15; const float inv = exp2f(-(float)f * (18.931568569324174f / 16.0f));
          const float ang = (float)P.positions[m] * inv; double rev = (double)ang * 0.15915494309189535; rev -= floor(rev); const float rv = (float)rev; const float sn = __builtin_amdgcn_sinf(rv), cs = __builtin_amdgcn_cosf(rv); P.ROT[(size_t)m * 32 + f] = cs; P.ROT[(size_t)m * 32 + 16 + f] = sn; } }
}

__device__ __forceinline__ void p2_rwkv_prep(const Ptrs& P, LAS unsigned char* lds, int tid, int wave, int lane) {
    LAS float* lin = (LAS float*)lds;
    for (int blk = blockIdx.x; blk < T / 8; blk += gridDim.x) {
        const int m0 = blk * 8;
        __syncthreads();
        for (int idx = tid; idx < 8 * 288; idx += NTHREADS) { const int tk = idx / 288, j = idx - tk * 288, m = m0 + tk, col = 3072 + j;
            const float p = bf2f(P.ZP[(size_t)m * ZPW + col]); const float pp = (m % SEQ) ? bf2f(P.ZP[(size_t)(m - 1) * ZPW + col]) : 0.0f;
            const float z = p + (pp - p) * P.shift_mu[col];
            lin[idx] = (j < 64) ? tanhf(z) : ((j < 128) ? z : sigmoidf_(z)); }
        __syncthreads();
        float aw[2][8], aa[2][8], ag[2][8];
#pragma unroll
        for (int cc = 0; cc < 2; ++cc)
#pragma unroll
            for (int tk = 0; tk < 8; ++tk) { aw[cc][tk] = 0.f; aa[cc][tk] = 0.f; ag[cc][tk] = 0.f; }
#pragma unroll 2
        for (int j = 0; j < 64; ++j) { const float w0_ = P.w2_decay[j * RW + tid], w1_ = P.w2_decay[j * RW + tid + 512], a0_ = P.a2_iclr[j * RW + tid], a1_ = P.a2_iclr[j * RW + tid + 512];
#pragma unroll
            for (int tk = 0; tk < 8; ++tk) { const float lw = lin[tk * 288 + j], la = lin[tk * 288 + 64 + j]; aw[0][tk] += lw * w0_; aw[1][tk] += lw * w1_; aa[0][tk] += la * a0_; aa[1][tk] += la * a1_; } }
#pragma unroll 2
        for (int j = 0; j < 160; ++j) { const float g0_ = P.g2_gate[j * RW + tid], g1_ = P.g2_gate[j * RW + tid + 512];
#pragma unroll
            for (int tk = 0; tk < 8; ++tk) { const float lg = lin[tk * 288 + 128 + j]; ag[0][tk] += lg * g0_; ag[1][tk] += lg * g1_; } }
#pragma unroll
        for (int cc = 0; cc < 2; ++cc) { const int c = tid + 512 * cc, head = wave + 8 * cc;
            const float mu_r = P.shift_mu[c], mu_k = P.shift_mu[1024 + c], mu_v = P.shift_mu[2048 + c], w0c = P.w0[c], a0c = P.a0[c], kkc = P.k_k[c], kac = P.k_a[c], rkc = P.r_k[c];
#pragma unroll
            for (int tk = 0; tk < 8; ++tk) { const int m = m0 + tk; const bf16* zp = P.ZP + (size_t)m * ZPW; const bool hasp = (m % SEQ) != 0; const bf16* zq = zp - ZPW;
                const float pr = bf2f(zp[c]), pk = bf2f(zp[1024 + c]), pv = bf2f(zp[2048 + c]);
                const float qr = hasp ? bf2f(zq[c]) : 0.f, qk = hasp ? bf2f(zq[1024 + c]) : 0.f, qv = hasp ? bf2f(zq[2048 + c]) : 0.f;
                const float r = pr + (qr - pr) * mu_r, k = pk + (qk - pk) * mu_k, v = pv + (qv - pv) * mu_v;
                const float sgw = sigmoidf_(w0c + aw[cc][tk]); const float decay = __expf(-0.6065306597126334f * sgw);
                const float a = sigmoidf_(a0c + aa[cc][tk]); const float g = ag[cc][tk];
                const float kkp = k * kkc; const float ss = wave_sum(kkp * kkp); const float kk = kkp / fmaxf(sqrtf(ss), 1e-12f);
                const float kn = k * (1.0f + (a - 1.0f) * kac); const float bb = kk * a;
                const float bon = wave_sum(r * kn * rkc);
                const size_t o = (size_t)m * RW + c;
                P.SC[SC_KK * SC_STRIDE + o] = kk; P.SC[SC_W * SC_STRIDE + o] = decay; P.SC[SC_BB * SC_STRIDE + o] = bb; P.SC[SC_K * SC_STRIDE + o] = kn; P.SC[SC_R * SC_STRIDE + o] = r; P.SC[SC_V * SC_STRIDE + o] = v;
                P.G[o] = (bf16)f2bf(g);
                if (lane == 0) P.BONUS[(size_t)m * NH + head] = bon; } }
    }
}

__device__ __forceinline__ f32x4 mfma16(bf16x8 a, bf16x8 b, f32x4 c) { return __builtin_amdgcn_mfma_f32_16x16x32_bf16(a, b, c, 0, 0, 0); }
__device__ __forceinline__ void p3_attention(const Ptrs& P, LAS unsigned char* lds, int tid, int wave, int lane) {
    const int fr = lane & 15, fq = lane >> 4;
    LAS unsigned char* Ks = lds; LAS unsigned char* Vt = lds + 34816;
    for (int u = blockIdx.x; u < NB * 12 * 32; u += gridDim.x) {
        const int b = u / 384, r = u - b * 384, gh = r >> 5, idx = r & 31, g = gh >> 2;
        const int d = (g == 0) ? 1 : ((g == 1) ? 4 : 16), nb = 32 / d, c = idx / nb, n = idx - c * nb;
        const int qi = wave * 16 + fr; const size_t mq = (size_t)b * SEQ + (size_t)(n * 128 + qi) * d + c;
        const bf16* qrow = P.QKV + mq * QKVW + gh * 128;
        bf16x8 qf[4];
#pragma unroll
        for (int ks = 0; ks < 4; ++ks) qf[ks] = *(const GAS bf16x8*)(qrow + 32 * ks + 8 * fq);
        f32x4 o[8];
#pragma unroll
        for (int dt = 0; dt < 8; ++dt) o[dt] = (f32x4){0.f, 0.f, 0.f, 0.f};
        float mrun = -1e30f, lrun = 0.f;
        for (int kb = (n == 0) ? 1 : 0; kb < 2; ++kb) {
            const int kblk = n - 1 + kb;
            __syncthreads();
#pragma unroll
            for (int i = 0; i < 4; ++i) { const int p = tid + 512 * i, key = p >> 4, part = p & 15; const size_t mk = (size_t)b * SEQ + (size_t)(kblk * 128 + key) * d + c;
                *(LAS u32x4*)(Ks + key * 272 + part * 16) = *(const GAS u32x4*)(P.QKV + mk * QKVW + 1536 + gh * 128 + part * 8); }
#pragma unroll
            for (int i = 0; i < 4; ++i) { const int key = tid & 127, part = (tid >> 7) + 4 * i; const size_t mk = (size_t)b * SEQ + (size_t)(kblk * 128 + key) * d + c;
                const u32x4 v = *(const GAS u32x4*)(P.QKV + mk * QKVW + 3072 + gh * 128 + part * 8);
                LAS unsigned char* vp = Vt + (8 * part) * 272 + key * 2;
                *(LAS unsigned short*)(vp + 0 * 272) = (unsigned short)(v.x & 0xffffu); *(LAS unsigned short*)(vp + 1 * 272) = (unsigned short)(v.x >> 16);
                *(LAS unsigned short*)(vp + 2 * 272) = (unsigned short)(v.y & 0xffffu); *(LAS unsigned short*)(vp + 3 * 272) = (unsigned short)(v.y >> 16);
                *(LAS unsigned short*)(vp + 4 * 272) = (unsigned short)(v.z & 0xffffu); *(LAS unsigned short*)(vp + 5 * 272) = (unsigned short)(v.z >> 16);
                *(LAS unsigned short*)(vp + 6 * 272) = (unsigned short)(v.w & 0xffffu); *(LAS unsigned short*)(vp + 7 * 272) = (unsigned short)(v.w >> 16); }
            __syncthreads();
            f32x4 s[8];
#pragma unroll
            for (int kt = 0; kt < 8; ++kt) { s[kt] = (f32x4){0.f, 0.f, 0.f, 0.f};
#pragma unroll
                for (int ks = 0; ks < 4; ++ks) { const bf16x8 a = *(const LAS bf16x8*)(Ks + (kt * 16 + fr) * 272 + (32 * ks + 8 * fq) * 2); s[kt] = mfma16(a, qf[ks], s[kt]); } }
            float mx = -1e30f;
#pragma unroll
            for (int kt = 0; kt < 8; ++kt)
#pragma unroll
                for (int rg = 0; rg < 4; ++rg) { const int j = kt * 16 + 4 * fq + rg; const bool ok = (kb == 0) ? (j >= qi) : (j <= qi); const float sv = ok ? s[kt][rg] : -1e30f; s[kt][rg] = sv; mx = fmaxf(mx, sv); }
            mx = fmaxf(mx, __shfl_xor(mx, 16)); mx = fmaxf(mx, __shfl_xor(mx, 32));
            const float mnew = fmaxf(mrun, mx), alpha = exp2f(mrun - mnew); mrun = mnew;
            float ls = 0.f;
#pragma unroll
            for (int kt = 0; kt < 8; ++kt)
#pragma unroll
                for (int rg = 0; rg < 4; ++rg) { const float p = exp2f(s[kt][rg] - mnew); s[kt][rg] = p; ls += p; }
            lrun = lrun * alpha + ls;
#pragma unroll
            for (int dt = 0; dt < 8; ++dt) o[dt] = o[dt] * alpha;
#pragma unroll
            for (int pi = 0; pi < 4; ++pi) {
                const u32x4 bw = pack8(s[2 * pi], s[2 * pi + 1]); const bf16x8 bfrag = __builtin_bit_cast(bf16x8, bw);
#pragma unroll
                for (int dt = 0; dt < 8; ++dt) { const LAS unsigned char* vp = Vt + (dt * 16 + fr) * 272 + (2 * pi * 16 + 4 * fq) * 2;
                    const u32x2 lo = *(const LAS u32x2*)vp, hi = *(const LAS u32x2*)(vp + 32);
                    const u32x4 aw = {lo.x, lo.y, hi.x, hi.y}; o[dt] = mfma16(__builtin_bit_cast(bf16x8, aw), bfrag, o[dt]); } }
        }
        lrun += __shfl_xor(lrun, 16); lrun += __shfl_xor(lrun, 32);
        bf16* orow = P.ATTO + (mq * 12 + gh) * 128;
#pragma unroll
        for (int dt = 0; dt < 8; ++dt) { u32x2 w; w.x = pk2(o[dt][0], o[dt][1]); w.y = pk2(o[dt][2], o[dt][3]); *(GAS u32x2*)(orow + dt * 16 + 4 * fq) = w; }
        if (fq == 0) { P.ATTML[(mq * 12 + gh) * 2] = mrun; P.ATTML[(mq * 12 + gh) * 2 + 1] = lrun; }
    }
}

__device__ __forceinline__ float dpp_add(float x, const int ctrl_sel) {
    int y;
    if (ctrl_sel == 0) y = __builtin_amdgcn_update_dpp(0, __float_as_int(x), 0xB1, 0xF, 0xF, false);
    else if (ctrl_sel == 1) y = __builtin_amdgcn_update_dpp(0, __float_as_int(x), 0x4E, 0xF, 0xF, false);
    else if (ctrl_sel == 2) y = __builtin_amdgcn_update_dpp(0, __float_as_int(x), 0x141, 0xF, 0xF, false);
    else y = __builtin_amdgcn_update_dpp(0, __float_as_int(x), 0x140, 0xF, 0xF, false);
    return x + __int_as_float(y);
}
__device__ __forceinline__ float row16_sum(float x) { x = dpp_add(x, 0); x = dpp_add(x, 1); x = dpp_add(x, 2); x = dpp_add(x, 3); return x; }
__device__ __forceinline__ void p4_scan(const Ptrs& P, LAS unsigned char* lds, int tid, int wave, int lane) {
    constexpr int CH = 32, NCH = SEQ / CH, STEP_F = 6 * 64, BUF_F = CH * STEP_F;
    LAS float* buf = (LAS float*)lds;
    for (int unit = blockIdx.x; unit < 256; unit += gridDim.x) {
        const int bh = unit >> 2, rgp = unit & 3, b = bh >> 4, h = bh & 15;
        const size_t off0 = (size_t)b * SEQ * RW + h * 64;
        const int ltid = tid - 256;
        __syncthreads();
        if (wave >= 4) {
#pragma unroll
            for (int i = 0; i < 12; ++i) { const int idx = ltid + 256 * i, arr = idx >> 9, rem = idx & 511, st = rem >> 4, q = rem & 15;
                *(LAS f32x4*)(buf + (st * 6 + arr) * 64 + 4 * q) = *(const GAS f32x4*)(P.SC + arr * SC_STRIDE + off0 + (size_t)st * RW + 4 * q); }
        }
        __syncthreads();
        const int rr = lane >> 4, kq = lane & 15, vrow = rgp * 16 + (wave & 3) * 4 + rr;
        float S0 = 0.f, S1 = 0.f, S2 = 0.f, S3 = 0.f;
        for (int ch = 0; ch < NCH; ++ch) {
            if (wave >= 4) {
                if (ch + 1 < NCH) { LAS float* nb = buf + ((ch + 1) & 1) * BUF_F;
#pragma unroll
                    for (int i = 0; i < 12; ++i) { const int idx = ltid + 256 * i, arr = idx >> 9, rem = idx & 511, st = rem >> 4, q = rem & 15;
                        *(LAS f32x4*)(nb + (st * 6 + arr) * 64 + 4 * q) = *(const GAS f32x4*)(P.SC + arr * SC_STRIDE + off0 + (size_t)((ch + 1) * CH + st) * RW + 4 * q); } }
            } else {
                const LAS float* cb = buf + (ch & 1) * BUF_F;
                float* yp = P.Y + off0 + (size_t)(ch * CH) * RW + vrow;
#pragma unroll 4
                for (int st = 0; st < CH; ++st) { const LAS float* sp = cb + st * STEP_F;
                    const f32x4 kk = *(const LAS f32x4*)(sp + 0 * 64 + 4 * kq), w = *(const LAS f32x4*)(sp + 1 * 64 + 4 * kq), bb = *(const LAS f32x4*)(sp + 2 * 64 + 4 * kq),
                                k = *(const LAS f32x4*)(sp + 3 * 64 + 4 * kq), r = *(const LAS f32x4*)(sp + 4 * 64 + 4 * kq); const float vv = sp[5 * 64 + vrow];
                    float sa = (S0 * kk.x + S1 * kk.y) + (S2 * kk.z + S3 * kk.w); sa = -row16_sum(sa);
                    S0 = S0 * w.x + (sa * bb.x + vv * k.x); S1 = S1 * w.y + (sa * bb.y + vv * k.y); S2 = S2 * w.z + (sa * bb.z + vv * k.z); S3 = S3 * w.w + (sa * bb.w + vv * k.w);
                    float y = (S0 * r.x + S1 * r.y) + (S2 * r.z + S3 * r.w); y = row16_sum(y);
                    if (kq == 0) yp[(size_t)st * RW] = y; }
            }
            __syncthreads();
        }
    }
}

__device__ __forceinline__ void p5_post(const Ptrs& P, int tid, int wave, int lane) {
    for (int m = blockIdx.x; m < T; m += gridDim.x) {
#pragma unroll
        for (int cc = 0; cc < 2; ++cc) { const int c = tid + 512 * cc, head = wave + 8 * cc; const size_t o = (size_t)m * RW + c;
            const float y = P.Y[o]; const float mean = wave_sum(y) * (1.0f / 64.0f); const float dv = y - mean; const float var = wave_sum(dv * dv) * (1.0f / 64.0f);
            float yn = dv * (1.0f / sqrtf(var + GN_EPS)) * P.ln_x_w[c] + P.ln_x_b[c];
            yn += P.BONUS[(size_t)m * NH + head] * P.SC[SC_V * SC_STRIDE + o];
            P.YAIN[o] = (bf16)f2bf(yn * bf2f(P.G[o])); }
        { const int hh = tid >> 7, dd = tid & 127; float mm[3], ll[3], ov[3]; float M = -1e30f;
#pragma unroll
          for (int g = 0; g < 3; ++g) { const size_t q = (size_t)m * 12 + g * 4 + hh; mm[g] = P.ATTML[q * 2]; ll[g] = P.ATTML[q * 2 + 1]; ov[g] = bf2f(P.ATTO[q * 128 + dd]); M = fmaxf(M, mm[g]); }
          float num = 0.f, den = 0.f;
#pragma unroll
          for (int g = 0; g < 3; ++g) { const float wg = exp2f(mm[g] - M); num += wg * ov[g]; den += wg * ll[g]; }
          P.OIN[(size_t)m * 512 + tid] = (bf16)f2bf(num / den); }
    }
}

__device__ __forceinline__ void p8_router(const Ptrs& P, LAS unsigned char* lds, int tid, int wave, int lane) {
    LAS float* Wl = (LAS float*)lds;
    const int e = lane & 31, kh = lane >> 5;
    for (int grp = blockIdx.x; grp < T / 64; grp += gridDim.x) {
        const int m0 = grp * 64 + wave * 8;
        float rs[8], acc[8];
#pragma unroll
        for (int tk = 0; tk < 8; ++tk) { const float* xr = P.X1 + (size_t)(m0 + tk) * D; f32x4 v[8]; float s = 0.f;
#pragma unroll
            for (int j = 0; j < 8; ++j) { v[j] = *(const GAS f32x4*)(xr + 4 * lane + 256 * j); s += (v[j].x * v[j].x + v[j].y * v[j].y) + (v[j].z * v[j].z + v[j].w * v[j].w); }
            const float r = 1.0f / sqrtf(wave_sum(s) * (1.0f / D) + NORM_EPS); rs[tk] = r; acc[tk] = 0.f;
            bf16* hr = P.H + (size_t)(m0 + tk) * D;
#pragma unroll
            for (int j = 0; j < 8; ++j) { const f32x4 gv = *(const GAS f32x4*)(P.norm_ffn + 4 * lane + 256 * j); u32x2 w; w.x = pk2(v[j].x * r * gv.x, v[j].y * r * gv.y); w.y = pk2(v[j].z * r * gv.z, v[j].w * r * gv.w);
                *(GAS u32x2*)(hr + 4 * lane + 256 * j) = w; } }
#pragma unroll 1
        for (int hf = 0; hf < 2; ++hf) {
            __syncthreads();
            for (int idx = tid; idx < 8192; idx += NTHREADS) { const int k = idx >> 3, q = idx & 7; const float g = P.norm_ffn[hf * 1024 + k];
                *(LAS f32x4*)(Wl + k * 32 + 4 * q) = *(const GAS f32x4*)(P.w_router + (size_t)(hf * 1024 + k) * NE + 4 * q) * g; }
            __syncthreads();
            const float* xb = P.X1 + (size_t)m0 * D + hf * 1024 + kh * 512; const LAS float* wb = Wl + (kh * 512) * 32 + e;
#pragma unroll 2
            for (int i = 0; i < 512; i += 4) { const float w0 = wb[(i + 0) * 32], w1 = wb[(i + 1) * 32], w2 = wb[(i + 2) * 32], w3 = wb[(i + 3) * 32];
#pragma unroll
                for (int tk = 0; tk < 8; ++tk) { const f32x4 xv = *(const GAS f32x4*)(xb + (size_t)tk * D + i); acc[tk] += (xv.x * w0 + xv.y * w1) + (xv.z * w2 + xv.w * w3); } }
        }
        const float be = P.b_router[e];
#pragma unroll
        for (int tk = 0; tk < 8; ++tk) { float v = (acc[tk] + __shfl_xor(acc[tk], 32)) * rs[tk] + be;
            int sel[4]; float val[4];
#pragma unroll
            for (int k = 0; k < 4; ++k) { float mx = v;
#pragma unroll
                for (int o = 1; o < 32; o <<= 1) mx = fmaxf(mx, __shfl_xor(mx, o));
                const unsigned long long bal = __ballot(v == mx); const int s_ = __ffsll((unsigned long long)(bal & 0xffffffffull)) - 1;
                sel[k] = s_; val[k] = mx; v = (e == s_) ? -3.0e38f : v; }
            const float e1 = __expf(val[1] - val[0]), e2 = __expf(val[2] - val[0]), e3 = __expf(val[3] - val[0]); const float inv = 1.0f / (1.0f + e1 + e2 + e3);
            const float gate[4] = {inv, e1 * inv, e2 * inv, e3 * inv};
            if (lane == 0) { const int m = m0 + tk;
#pragma unroll
                for (int k = 0; k < 4; ++k) { const unsigned pos = __hip_atomic_fetch_add((unsigned*)(P.ctl + CW_CNT + 64 * sel[k]), 1u, RLX_AGENT);
                    P.TOPK_E[m * 4 + k] = sel[k]; P.TOPK_POS[m * 4 + k] = (int)pos; P.TOPK_GATE[m * 4 + k] = gate[k]; } }
        }
    }
}

__device__ __forceinline__ void moe_tables(const Ptrs& P, LAS int* tab, int tid) {
    if (tid == 0) { int acc = 0;
        for (int e = 0; e < NE; ++e) { tab[e] = acc; const int c = (int)__hip_atomic_load((unsigned*)(P.ctl + CW_CNT + 64 * e), RLX_AGENT); acc += (c + 255) >> 8; tab[64 + e] = c; }
        tab[32] = acc; }
    __syncthreads();
}

__device__ __forceinline__ void p9_gather(const Ptrs& P, LAS unsigned char* lds, int tid, int wave, int lane) {
    LAS int* tab = (LAS int*)(lds + TAB_OFF);
    moe_tables(P, tab, tid);
    const int gw = blockIdx.x * NWAVES + wave, NGW = gridDim.x * NWAVES;
    for (int p = gw; p < T * 4; p += NGW) { const int e = P.TOPK_E[p], pos = P.TOPK_POS[p]; const int row = tab[e] * 256 + pos;
        const GAS u32x4* src = (const GAS u32x4*)(P.H + (size_t)(p >> 2) * D); GAS u32x4* dst = (GAS u32x4*)(P.XS + (size_t)row * D);
#pragma unroll
        for (int i = 0; i < 4; ++i) dst[lane + 64 * i] = src[lane + 64 * i];
        if (lane == 0) { P.ROWTOK[row] = p; P.ROWGATE[row] = P.TOPK_GATE[p]; } }
    for (int e = blockIdx.x; e < NE; e += gridDim.x) { const int cnt = tab[64 + e], r0 = tab[e] * 256, rend = tab[e + 1] * 256;
        for (int r = r0 + cnt + tid; r < rend; r += NTHREADS) { P.ROWTOK[r] = -1; P.ROWGATE[r] = 0.f; } }
}

__device__ __forceinline__ void p12_final(const Ptrs& P, int tid, int wave, int lane) {
    const int gw = blockIdx.x * NWAVES + wave, NGW = gridDim.x * NWAVES;
    for (int m = gw; m < T; m += NGW) {
        f32x4 v[8]; float s = 0.f;
#pragma unroll
        for (int j = 0; j < 8; ++j) { const int col = 4 * lane + 256 * j; v[j] = *(const GAS f32x4*)(P.X1 + (size_t)m * D + col);
#pragma unroll
            for (int k = 0; k < 4; ++k) { const u32x2 w = *(const GAS u32x2*)(P.OUTK + ((size_t)m * 4 + k) * D + col); v[j].x += bflo(w.x); v[j].y += bfhi(w.x); v[j].z += bflo(w.y); v[j].w += bfhi(w.y); }
            s += (v[j].x * v[j].x + v[j].y * v[j].y) + (v[j].z * v[j].z + v[j].w * v[j].w); }
        const float rs = 1.0f / sqrtf(wave_sum(s) * (1.0f / D) + NORM_EPS);
#pragma unroll
        for (int j = 0; j < 8; ++j) { const int col = 4 * lane + 256 * j; const f32x4 g = *(const GAS f32x4*)(P.norm_final + col); *(GAS f32x4*)(P.out + (size_t)m * D + col) = v[j] * rs * g; }
    }
}

struct Args { const void* in[26]; float* out; unsigned char* ws; int ph_lo, ph_hi; };
__global__ void __launch_bounds__(NTHREADS, 2) fwd(Args args) {
    extern __shared__ __attribute__((aligned(16))) unsigned char lds_raw[];
    LAS unsigned char* lds = (LAS unsigned char*)lds_raw;
    const int tid = threadIdx.x, lane = tid & 63, wave = __builtin_amdgcn_readfirstlane(tid >> 6);
    unsigned char* ws = args.ws;
    Ptrs P;
    P.x = (const float*)args.in[0]; P.positions = (const int*)args.in[1]; P.norm_mix = (const float*)args.in[2]; P.w_in = (const float*)args.in[3]; P.shift_mu = (const float*)args.in[4];
    P.w0 = (const float*)args.in[5]; P.w2_decay = (const float*)args.in[6]; P.a0 = (const float*)args.in[7]; P.a2_iclr = (const float*)args.in[8]; P.g2_gate = (const float*)args.in[9];
    P.k_k = (const float*)args.in[10]; P.k_a = (const float*)args.in[11]; P.r_k = (const float*)args.in[12]; P.ln_x_w = (const float*)args.in[13]; P.ln_x_b = (const float*)args.in[14];
    P.w_o_rwkv = (const float*)args.in[15]; P.w_o_attn = (const float*)args.in[16]; P.w_out = (const float*)args.in[17]; P.norm_ffn = (const float*)args.in[18]; P.w_router = (const float*)args.in[19];
    P.b_router = (const float*)args.in[20]; P.w1 = (const float*)args.in[21]; P.b1 = (const float*)args.in[22]; P.w2 = (const float*)args.in[23]; P.b2 = (const float*)args.in[24]; P.norm_final = (const float*)args.in[25];
    P.out = args.out; P.ctl = (gu32*)(ws + WS_CTL);
    P.WIN = (bf16*)(ws + WS_WIN); P.W1 = (bf16*)(ws + WS_W1); P.W2 = (bf16*)(ws + WS_W2); P.WOR = (bf16*)(ws + WS_WOR); P.WOA = (bf16*)(ws + WS_WOA); P.WOUT = (bf16*)(ws + WS_WOUT);
    P.H = (bf16*)(ws + WS_H); P.ZP = (bf16*)(ws + WS_ZP); P.QKV = (bf16*)(ws + WS_QKV); P.GATES = (bf16*)(ws + WS_GATES); P.ROT = (float*)(ws + WS_ROT); P.SC = (float*)(ws + WS_SC);
    P.G = (bf16*)(ws + WS_G); P.BONUS = (float*)(ws + WS_BONUS); P.Y = (float*)(ws + WS_Y); P.ATTO = (bf16*)(ws + WS_ATTO); P.ATTML = (float*)(ws + WS_ATTML); P.YAIN = (bf16*)(ws + WS_YAIN);
    P.OIN = (bf16*)(ws + WS_OIN); P.MERGED = (bf16*)(ws + WS_MERGED); P.X1 = (float*)(ws + WS_X1);
    P.TOPK_E = (int*)(ws + WS_TOPK); P.TOPK_POS = P.TOPK_E + T * 4; P.TOPK_GATE = (float*)(P.TOPK_POS + T * 4);
    P.ROWTOK = (int*)(ws + WS_ROWS); P.ROWGATE = (float*)(P.ROWTOK + XS_ROWS);
    P.XS = (bf16*)(ws + WS_XS); P.ACT = (bf16*)(ws + WS_ACT); P.OUTK = (bf16*)(ws + WS_OUTK);

    for (int u = tid; u < (LDS_BYTES - TAB_OFF) / 4; u += NTHREADS) ((LAS unsigned*)(lds + TAB_OFF))[u] = 0u;
    __syncthreads();
#if MK_ONE_LAUNCH
    XcdBarrier bar = xcd_barrier_post((unsigned*)(P.ctl + CW_BAR), (volatile LAS unsigned*)(lds + MISC_OFF));
#define GRID_BAR() xcd_barrier(bar)
#else
#define GRID_BAR() do { } while (0)
#endif
    const int lo = args.ph_lo, hi = args.ph_hi;
#ifndef PHASE_MASK
#define PHASE_MASK 0x1fff
#endif
#define IN(k) (((PHASE_MASK >> (k)) & 1) && lo <= (k) && (k) < hi)
#define SEAM(k) do { if (IN(k) && IN((k) + 1)) GRID_BAR(); } while (0)
    const int G = gridDim.x, c = blockIdx.x;

    if (IN(0)) { p0_prologue(P, lds, tid, wave, lane); SEAM(0); }
    if (IN(1)) { pg8::Gemm g{P.H, P.WIN, T, NPROJ, D}; pg8::StaticOrder S; S.init(T, NPROJ, G, c); EpiProj E{P.ZP, P.QKV, P.GATES, P.ROT};
        pg8::gemm_phase<EpiProj, pg8::StaticOrder, true, true>(lds, g, S, E); SEAM(1); }
    if (IN(2)) { p2_rwkv_prep(P, lds, tid, wave, lane); SEAM(2); }
    if (IN(3)) { p3_attention(P, lds, tid, wave, lane); SEAM(3); }
    if (IN(4)) { p4_scan(P, lds, tid, wave, lane); SEAM(4); }
    if (IN(5)) { p5_post(P, tid, wave, lane); SEAM(5); }
    if (IN(6)) {
        { pg8::Gemm g{P.YAIN, P.WOR, T, D, RW}; pg8::StaticOrder S; S.init(T, D, G, c); EpiMerge<0> E{P.MERGED, P.GATES}; pg8::gemm_phase<EpiMerge<0>, pg8::StaticOrder, true, true>(lds, g, S, E); }
        VM_WAIT(); __builtin_amdgcn_fence(__ATOMIC_ACQUIRE, "agent"); VM_WAIT(); __syncthreads();
        { pg8::Gemm g{P.OIN, P.WOA, T, D, 512}; pg8::StaticOrder S; S.init(T, D, G, c); EpiMerge<1> E{P.MERGED, P.GATES}; pg8::gemm_phase<EpiMerge<1>, pg8::StaticOrder, true, true>(lds, g, S, E); }
        SEAM(6); }
    if (IN(7)) { pg8::Gemm g{P.MERGED, P.WOUT, T, D, D}; pg8::StaticOrder S; S.init(T, D, G, c); EpiResid E{P.x, P.X1}; pg8::gemm_phase<EpiResid, pg8::StaticOrder, true, true>(lds, g, S, E); SEAM(7); }
    if (IN(8)) { p8_router(P, lds, tid, wave, lane); SEAM(8); }
    if (IN(9)) { p9_gather(P, lds, tid, wave, lane); SEAM(9); }
    if (IN(10)) { LAS int* tab = (LAS int*)(lds + TAB_OFF); moe_tables(P, tab, tid);
        pg8::Gemm g{P.XS, P.W1, XS_ROWS, NE * 4096, D}; MoeOrder S{tab, 16, G, c}; EpiMoe1 E{P.ACT, P.b1};
        pg8::gemm_phase<EpiMoe1, MoeOrder, true, true>(lds, g, S, E); SEAM(10); }
    if (IN(11)) { LAS int* tab = (LAS int*)(lds + TAB_OFF); moe_tables(P, tab, tid);
        pg8::Gemm g{P.ACT, P.W2, XS_ROWS, NE * D, FF}; MoeOrder S{tab, 8, G, c}; EpiMoe2 E{P.OUTK, P.b2, P.ROWTOK, P.ROWGATE};
        pg8::gemm_phase<EpiMoe2, MoeOrder, true, true>(lds, g, S, E); SEAM(11); }
    if (IN(12)) { p12_final(P, tid, wave, lane); }
#undef IN
#undef SEAM
}

extern "C" void kernel_launch(void* const* d_in, const int* in_sizes, int n_in, void* d_out, int out_size, void* d_ws, size_t ws_size, hipStream_t stream) {
    static int grid = 0;
    if (grid == 0) {
        if (n_in != 26 || out_size != T * D || ws_size < WS_END) { fprintf(stderr, "kernel_launch: unexpected shapes (n_in %d, out %d, ws %zu, need %zu); nothing launched\n", n_in, out_size, ws_size, (size_t)WS_END); grid = -1; return; }
        int dev = 0, cus = 0, per_cu = 0;
        if (hipGetDevice(&dev) != hipSuccess || hipDeviceGetAttribute(&cus, hipDeviceAttributeMultiprocessorCount, dev) != hipSuccess) { grid = -1; return; }
        if (hipFuncSetAttribute((const void*)fwd, hipFuncAttributeMaxDynamicSharedMemorySize, LDS_BYTES) != hipSuccess) { fprintf(stderr, "kernel_launch: hipFuncSetAttribute failed\n"); grid = -1; return; }
        if (hipOccupancyMaxActiveBlocksPerMultiprocessor(&per_cu, (const void*)fwd, NTHREADS, LDS_BYTES) != hipSuccess || per_cu < 1) fprintf(stderr, "kernel_launch: occupancy query says %d\n", per_cu);
        (void)hipGetLastError();
        grid = cus;
    }
    if (grid < 0) return;
    if (hipMemsetAsync((char*)d_ws + WS_CTL, 0, CTL_ZERO_BYTES, stream) != hipSuccess) return;
    Args a{};
    for (int i = 0; i < 26; ++i) a.in[i] = d_in[i];
    a.out = (float*)d_out; a.ws = (unsigned char*)d_ws;
#if MK_ONE_LAUNCH
    a.ph_lo = 0; a.ph_hi = NPHASES;
    hipLaunchKernelGGL(fwd, dim3(grid), dim3(NTHREADS), LDS_BYTES, stream, a);
#else
    for (int ph = 0; ph < NPHASES; ++ph) { a.ph_lo = ph; a.ph_hi = ph + 1; hipLaunchKernelGGL(fwd, dim3(grid), dim3(NTHREADS), LDS_BYTES, stream, a); }
#endif
}
```

```cpp
#include <hip/hip_runtime.h>
#include <cstdio>
#include <cstdint>
#include <cmath>
namespace pg8 {
#define PG8_LAS __attribute__((address_space(3)))
typedef unsigned short bf16_t;
typedef short bf16x8 __attribute__((ext_vector_type(8)));
typedef float f32x4 __attribute__((ext_vector_type(4)));
typedef unsigned u32x4 __attribute__((ext_vector_type(4)));
constexpr int BM = 256, BK = 64, HALF = 128, HTB = HALF * BK * 2  , STAGE_BYTES = 8 * HTB, NXCD = 8, WGM = 8;

__host__ __device__ __forceinline__ int lds_byte(int r, int c) { const int st = (r >> 4) * 2 + (c >> 5), rr = r & 15, cc = c & 31, ob = rr * 64 + cc * 2; return st * 1024 + (ob ^ (((ob >> 9) & 1) << 5)); }
__host__ __device__ __forceinline__ void stage_rc(int b, int& R, int& C) { const int st = b / 1024, sb = b % 1024, swz = sb ^ (((sb >> 9) & 1) << 5); R = (st >> 1) * 16 + swz / 64; C = (st & 1) * 32 + (swz % 64) / 2; }
__host__ __device__ __forceinline__ int perm32(int rho) { const int n = rho >> 4, i = rho & 15; return 8 * (i >> 2) + 4 * n + (i & 3); }

struct Unit { int pm, pn; };
struct Gemm { const bf16_t* A; const bf16_t* Bt; int M, N, K; };

struct StaticOrder {
    int nM, nN, nwg, G, c;
    __host__ __device__ void init(int M, int N, int G_, int c_) { nM = M / BM; nN = N / BM; nwg = nM * nN; G = G_; c = c_; }
    __host__ __device__ bool next(int i, Unit& u) const {
        const long L = (long)i * G + c; if (L >= nwg) return false;
        int wgid = (int)L; { const int q = nwg / NXCD, r = nwg % NXCD, xcd = wgid % NXCD, off = wgid / NXCD; wgid = (xcd < r ? xcd * (q + 1) : r * (q + 1) + (xcd - r) * q) + off; }
        const int nig = WGM * nN, gid = wgid / nig, fm = gid * WGM, gsz = (nM - fm) < WGM ? (nM - fm) : WGM;
        u.pm = fm + ((wgid % nig) % gsz); u.pn = (wgid % nig) / gsz; return true;
    }
    __device__ __forceinline__ void a_ready(const Unit&) const {}
    __device__ __forceinline__ void done(const Unit&) const {}
};

__device__ __forceinline__ unsigned cvt_pk_bf16(float lo, float hi) { unsigned r; asm volatile("v_cvt_pk_bf16_f32 %0, %1, %2" : "=v"(r) : "v"(lo), "v"(hi)); return r; }
typedef float f32x2 __attribute__((ext_vector_type(2)));

template <class Epi, class Sched, bool ALIGN_EPI = false, bool SP2 = false>
__device__ __forceinline__ void gemm_phase(PG8_LAS unsigned char* lds, const Gemm g, const Sched& S, const Epi& E) {
    const int tid = threadIdx.x, wid = __builtin_amdgcn_readfirstlane(tid >> 6), lane = tid & 63, wr = wid >> 2, wc = wid & 3, fr = lane & 15, fq = lane >> 4;
    const int K = g.K, nt = K / BK;
    unsigned voffA[2], voffB[2];
#pragma unroll
    for (int i = 0; i < 2; ++i) { int R, C; stage_rc(tid * 16 + i * 8192, R, C); const int Rb = Epi::PERM ? ((R & ~31) + perm32(R & 31)) : R;
        voffA[i] = (unsigned)(R * K + C) * 2u; voffB[i] = (unsigned)(Rb * K + C) * 2u; }
    const size_t kstep = (size_t)(BK * 2);
    const size_t hstep = (size_t)HALF * K * 2;
    const size_t tstep = 2 * hstep;
    const unsigned ldsw = (unsigned)wid * 1024u;
    const int aoff = lds_byte(wr * 64 + fr, fq * 8), boff = lds_byte(wc * 32 + fr, fq * 8);
#define PG8_SA(b, h) (((b) * 2 + (h)) * HTB)
#define PG8_SB(b, h) ((4 + (b) * 2 + (h)) * HTB)
#define PG8_STAGE(bufoff, gbase, voff) do { _Pragma("unroll") for (int _i = 0; _i < 2; ++_i) \
        __builtin_amdgcn_global_load_lds((const unsigned*)((const char*)(gbase) + (voff)[_i]), (PG8_LAS unsigned*)(lds + (bufoff) + ldsw + _i * 8192), 16, 0, 0); } while (0)
#define PG8_LDA(dst, b, h) do { _Pragma("unroll") for (int m = 0; m < 4; ++m) _Pragma("unroll") for (int k = 0; k < 2; ++k) dst[m][k] = *(const PG8_LAS bf16x8*)(lds + PG8_SA(b, h) + aoff + m * 2048 + k * 1024); } while (0)
#define PG8_LDB(dst, b, h) do { _Pragma("unroll") for (int n = 0; n < 2; ++n) _Pragma("unroll") for (int k = 0; k < 2; ++k) dst[n][k] = *(const PG8_LAS bf16x8*)(lds + PG8_SB(b, h) + boff + n * 2048 + k * 1024); } while (0)
#define PG8_MMA(ai, bj, At, Bt) do { __builtin_amdgcn_s_setprio(1); _Pragma("unroll") for (int m = 0; m < 4; ++m) _Pragma("unroll") for (int n = 0; n < 2; ++n) _Pragma("unroll") for (int k = 0; k < 2; ++k) \
        acc[ai][bj][m][n] = __builtin_amdgcn_mfma_f32_16x16x32_bf16(Bt[n][k], At[m][k], acc[ai][bj][m][n], 0, 0, 0); __builtin_amdgcn_s_setprio(0); } while (0)
#define PG8_WAIT_V(n) asm volatile("s_waitcnt vmcnt(" #n ")" ::: "memory")
#define PG8_WAIT_L(n) asm volatile("s_waitcnt lgkmcnt(" #n ")" ::: "memory")
#define PG8_BAR __builtin_amdgcn_s_barrier()
#define PG8_SCHED __builtin_amdgcn_sched_barrier(0)
    Unit cur, nxt; int ui = 0;
    if (!S.next(0, cur)) return;
    f32x4 acc[2][2][4][2];
#pragma unroll
    for (int a = 0; a < 2; ++a)
#pragma unroll
        for (int b = 0; b < 2; ++b)
#pragma unroll
            for (int m = 0; m < 4; ++m)
#pragma unroll
                for (int n = 0; n < 2; ++n) acc[a][b][m][n] = (f32x4){0.f, 0.f, 0.f, 0.f};
    bf16x8 At[4][2], B0[2][2], B1[2][2];
    const char* cA = (const char*)g.A + (size_t)cur.pm * tstep; const char* cB = (const char*)g.Bt + (size_t)cur.pn * tstep;
    S.a_ready(cur);
    if constexpr (SP2) {
        PG8_STAGE(PG8_SB(0, 0), cB, voffB); PG8_STAGE(PG8_SB(0, 1), cB + hstep, voffB); PG8_STAGE(PG8_SA(0, 0), cA, voffA); PG8_STAGE(PG8_SA(0, 1), cA + hstep, voffA);
        if (wr == 1) PG8_BAR;
        PG8_WAIT_V(2); PG8_BAR;
        PG8_STAGE(PG8_SB(1, 0), cB + kstep, voffB); PG8_STAGE(PG8_SA(1, 0), cA + kstep, voffA); PG8_STAGE(PG8_SB(1, 1), cB + hstep + kstep, voffB);
        PG8_WAIT_V(6); PG8_BAR;
    } else {
        PG8_STAGE(PG8_SB(0, 0), cB, voffB); PG8_STAGE(PG8_SA(0, 0), cA, voffA); PG8_STAGE(PG8_SB(0, 1), cB + hstep, voffB); PG8_STAGE(PG8_SA(0, 1), cA + hstep, voffA);
        if (wr == 1) PG8_BAR;
        PG8_WAIT_V(4); PG8_BAR;
        PG8_STAGE(PG8_SB(1, 0), cB + kstep, voffB); PG8_STAGE(PG8_SA(1, 0), cA + kstep, voffA); PG8_STAGE(PG8_SB(1, 1), cB + hstep + kstep, voffB);
        PG8_WAIT_V(6); PG8_BAR;
    }
    for (;;) {
        const bool has_next = S.next(ui + 1, nxt);
        const char* nA = has_next ? (const char*)g.A + (size_t)nxt.pm * tstep : cA; const char* nB = has_next ? (const char*)g.Bt + (size_t)nxt.pn * tstep : cB;
        for (int t = 0; t < nt; t += 2) {
            const bool last = (t == nt - 2);
            const char* a1 = cA + (size_t)(t + 1) * kstep;
            const char* a2 = last ? nA : cA + (size_t)(t + 2) * kstep; const char* b2 = last ? nB : cB + (size_t)(t + 2) * kstep;
            const char* a3 = a2 + kstep; const char* b3 = b2 + kstep;
            if (last && has_next) S.a_ready(nxt);
            if constexpr (SP2) {
            PG8_LDB(B0, 0, 0); PG8_LDB(B1, 0, 1); PG8_SCHED; PG8_LDA(At, 0, 0); PG8_STAGE(PG8_SA(1, 1), a1 + hstep, voffA);
            PG8_WAIT_V(8); PG8_WAIT_L(0); PG8_BAR; PG8_MMA(0, 0, At, B0); PG8_MMA(0, 1, At, B1); PG8_BAR; PG8_SCHED;
            PG8_LDA(At, 0, 1); PG8_STAGE(PG8_SB(0, 0), b2, voffB); PG8_STAGE(PG8_SB(0, 1), b2 + hstep, voffB); PG8_STAGE(PG8_SA(0, 0), a2, voffA);
            PG8_WAIT_V(8); PG8_WAIT_L(0); PG8_BAR; PG8_MMA(1, 0, At, B0); PG8_MMA(1, 1, At, B1); PG8_BAR; PG8_SCHED;
            PG8_LDB(B0, 1, 0); PG8_LDB(B1, 1, 1); PG8_SCHED; PG8_LDA(At, 1, 0); PG8_STAGE(PG8_SA(0, 1), a2 + hstep, voffA);
            PG8_WAIT_V(8); PG8_WAIT_L(0); PG8_BAR; PG8_MMA(0, 0, At, B0); PG8_MMA(0, 1, At, B1); PG8_BAR; PG8_SCHED;
            PG8_LDA(At, 1, 1); PG8_STAGE(PG8_SB(1, 0), b3, voffB); PG8_STAGE(PG8_SB(1, 1), b3 + hstep, voffB); PG8_STAGE(PG8_SA(1, 0), a3, voffA);
            PG8_WAIT_V(8); PG8_WAIT_L(0); PG8_BAR; PG8_MMA(1, 0, At, B0); PG8_MMA(1, 1, At, B1); PG8_BAR; PG8_SCHED;
            } else {
            PG8_LDB(B0, 0, 0); PG8_SCHED; PG8_LDA(At, 0, 0); PG8_STAGE(PG8_SA(1, 1), a1 + hstep, voffA);
            PG8_WAIT_L(8); PG8_BAR; PG8_WAIT_L(0); PG8_MMA(0, 0, At, B0); PG8_BAR; PG8_SCHED;
            PG8_LDB(B1, 0, 1); PG8_STAGE(PG8_SB(0, 0), b2, voffB);
            PG8_BAR; PG8_WAIT_L(0); PG8_MMA(0, 1, At, B1); PG8_BAR;
            PG8_LDA(At, 0, 1); PG8_STAGE(PG8_SA(0, 0), a2, voffA);
            PG8_BAR; PG8_WAIT_L(0); PG8_MMA(1, 0, At, B0); PG8_BAR; PG8_SCHED;
            PG8_STAGE(PG8_SB(0, 1), b2 + hstep, voffB);
            PG8_WAIT_V(6); PG8_BAR; PG8_MMA(1, 1, At, B1); PG8_BAR;
            PG8_LDB(B0, 1, 0); PG8_SCHED; PG8_LDA(At, 1, 0); PG8_STAGE(PG8_SA(0, 1), a2 + hstep, voffA);
            PG8_WAIT_L(8); PG8_BAR; PG8_WAIT_L(0); PG8_MMA(0, 0, At, B0); PG8_BAR; PG8_SCHED;
            PG8_LDB(B1, 1, 1); PG8_STAGE(PG8_SB(1, 0), b3, voffB);
            PG8_BAR; PG8_WAIT_L(0); PG8_MMA(0, 1, At, B1); PG8_BAR;
            PG8_LDA(At, 1, 1); PG8_STAGE(PG8_SA(1, 0), a3, voffA);
            PG8_BAR; PG8_WAIT_L(0); PG8_MMA(1, 0, At, B0); PG8_BAR; PG8_SCHED;
            PG8_STAGE(PG8_SB(1, 1), b3 + hstep, voffB);
            PG8_WAIT_V(6); PG8_BAR; PG8_MMA(1, 1, At, B1); PG8_BAR;
            }
        }
        if constexpr (ALIGN_EPI) { if (wr == 0) PG8_BAR; }
        if constexpr (!Epi::AFTER_DRAIN) { E(acc, cur, wr, wc, fr, fq); S.done(cur); }
        if (!has_next) break;
#pragma unroll
        for (int a = 0; a < 2; ++a)
#pragma unroll
            for (int b = 0; b < 2; ++b)
#pragma unroll
                for (int m = 0; m < 4; ++m)
#pragma unroll
                    for (int n = 0; n < 2; ++n) acc[a][b][m][n] = (f32x4){0.f, 0.f, 0.f, 0.f};
        cur = nxt; cA = nA; cB = nB; ++ui;
        if constexpr (ALIGN_EPI) { if (wr == 1) PG8_BAR; }
    }
    PG8_WAIT_V(0);
    if constexpr (!ALIGN_EPI) { if (wr == 0) PG8_BAR; }
    PG8_BAR;
    if constexpr (Epi::AFTER_DRAIN) { E.fused(acc, cur, wr, wc, fr, fq, lds, wid, lane); S.done(cur); }
#undef PG8_SA
#undef PG8_SB
#undef PG8_STAGE
#undef PG8_LDA
#undef PG8_LDB
#undef PG8_MMA
#undef PG8_WAIT_V
#undef PG8_WAIT_L
#undef PG8_BAR
#undef PG8_SCHED
}
}


constexpr int NB = 4, SEQ = 4096, T = NB * SEQ, D = 2048;
constexpr int RW = 1024, NH = 16, HD = 64;
constexpr int IN_W = 12064, SHIFT_W = 3360;
constexpr int ZPW = 3584, QKVW = 4608, GATEW = 4096, NPROJ = 12288;
constexpr int NE = 32, FF = 2048;
constexpr int XS_ROWS = T * 4 + NE * 256;
constexpr int NWAVES = 8, NTHREADS = 512;
constexpr float NORM_EPS = 1e-5f, GN_EPS = 64e-5f;
constexpr float QSCALE = 0.08838834764831845f * 1.4426950408889634f;

#ifndef MK_ONE_LAUNCH
#define MK_ONE_LAUNCH 1
#endif
constexpr int NPHASES = 13;

constexpr size_t MiB = 1ull << 20;
constexpr size_t WS_CTL = 0, CTL_ZERO_BYTES = 1 * MiB;
constexpr size_t WS_WIN = 1 * MiB;
constexpr size_t WS_W1 = WS_WIN + 48 * MiB;
constexpr size_t WS_W2 = WS_W1 + 512 * MiB;
constexpr size_t WS_WOR = WS_W2 + 256 * MiB;
constexpr size_t WS_WOA = WS_WOR + 4 * MiB;
constexpr size_t WS_WOUT = WS_WOA + 2 * MiB;
constexpr size_t WS_H = WS_WOUT + 8 * MiB;
constexpr size_t WS_ZP = WS_H + 64 * MiB;
constexpr size_t WS_QKV = WS_ZP + 112 * MiB;
constexpr size_t WS_GATES = WS_QKV + 144 * MiB;
constexpr size_t WS_ROT = WS_GATES + 128 * MiB;
constexpr size_t WS_SC = WS_ROT + 2 * MiB;
constexpr size_t WS_G = WS_SC + 384 * MiB;
constexpr size_t WS_BONUS = WS_G + 32 * MiB;
constexpr size_t WS_Y = WS_BONUS + 1 * MiB;
constexpr size_t WS_ATTO = WS_Y + 64 * MiB;
constexpr size_t WS_ATTML = WS_ATTO + 48 * MiB;
constexpr size_t WS_YAIN = WS_ATTML + 2 * MiB;
constexpr size_t WS_OIN = WS_YAIN + 32 * MiB;
constexpr size_t WS_MERGED = WS_OIN + 16 * MiB;
constexpr size_t WS_X1 = WS_MERGED + 64 * MiB;
constexpr size_t WS_TOPK = WS_X1 + 128 * MiB;
constexpr size_t WS_ROWS = WS_TOPK + 1 * MiB;
constexpr size_t WS_XS = WS_ROWS + 1 * MiB;
constexpr size_t WS_ACT = WS_XS + 288 * MiB;
constexpr size_t WS_OUTK = WS_ACT + 288 * MiB;
constexpr size_t WS_LORA = WS_OUTK + 256 * MiB;
constexpr size_t WS_END = WS_LORA + 1 * MiB;
constexpr size_t SC_STRIDE = (size_t)T * RW;
enum { SC_KK = 0, SC_W = 1, SC_BB = 2, SC_K = 3, SC_R = 4, SC_V = 5 };

constexpr int CW_TMO = 0, CW_CODE = 1, CW_BAR = 4096, CW_CNT = 8192;

constexpr int RING_BYTES = 131072;
constexpr int TAB_OFF = RING_BYTES;
constexpr int MISC_OFF = TAB_OFF + 512;
constexpr int LDS_BYTES = 147456;

#define GAS __attribute__((address_space(1)))
#define LAS __attribute__((address_space(3)))
typedef unsigned short bf16;
typedef unsigned u32x4 __attribute__((ext_vector_type(4)));
typedef unsigned u32x2 __attribute__((ext_vector_type(2)));
typedef float f32x4 __attribute__((ext_vector_type(4)));
typedef short bf16x8 __attribute__((ext_vector_type(8)));
typedef short bf16x4 __attribute__((ext_vector_type(4)));
typedef GAS unsigned gu32;
#define RLX_AGENT __ATOMIC_RELAXED, __HIP_MEMORY_SCOPE_AGENT
#define LDS_WAIT() asm volatile("s_waitcnt lgkmcnt(0)" ::: "memory")
#define VM_WAIT() asm volatile("s_waitcnt vmcnt(0)" ::: "memory")
__device__ __forceinline__ unsigned f2bf(float f) { unsigned u = __builtin_bit_cast(unsigned, f); return (u + 0x7fffu + ((u >> 16) & 1u)) >> 16; }
__device__ __forceinline__ unsigned pk2(float lo, float hi) { return f2bf(lo) | (f2bf(hi) << 16); }
__device__ __forceinline__ float bflo(unsigned w) { return __uint_as_float(w << 16); }
__device__ __forceinline__ float bfhi(unsigned w) { return __uint_as_float(w & 0xffff0000u); }
__device__ __forceinline__ float bf2f(bf16 h) { return __uint_as_float((unsigned)h << 16); }
__device__ __forceinline__ float sigmoidf_(float x) { return 1.0f / (1.0f + __expf(-x)); }
__device__ __forceinline__ float wave_sum(float v) {
#pragma unroll
    for (int o = 1; o < 64; o <<= 1) v += __shfl_xor(v, o);
    return v;
}
__device__ __forceinline__ u32x4 pack8(const f32x4& a, const f32x4& b) { u32x4 w; w.x = pk2(a[0], a[1]); w.y = pk2(a[2], a[3]); w.z = pk2(b[0], b[1]); w.w = pk2(b[2], b[3]); return w; }
__device__ __forceinline__ void unpack8(const u32x4& w, f32x4& a, f32x4& b) { a = (f32x4){bflo(w.x), bfhi(w.x), bflo(w.y), bfhi(w.y)}; b = (f32x4){bflo(w.z), bfhi(w.z), bflo(w.w), bfhi(w.w)}; }

#define XB_TMO      128
#define XB_XCNT(j)  (256  + 64 * (j))
#define XB_XSUB(j)  (1280 + 64 * (j))
#define XB_XGEN(j)  (2304 + 64 * (j))
#define XB_TOP      3328
#define XB_TOPGEN   3392
#define XCD_BAR_WORDS 3456
#define XB_SPIN_CAP (1u << 18)

__device__ __forceinline__ unsigned xb_ld(unsigned* p)              { return __hip_atomic_load(p, __ATOMIC_RELAXED, __HIP_MEMORY_SCOPE_AGENT); }
__device__ __forceinline__ unsigned xb_add(unsigned* p, unsigned v) { return __hip_atomic_fetch_add(p, v, __ATOMIC_RELAXED, __HIP_MEMORY_SCOPE_AGENT); }
__device__ __forceinline__ unsigned xb_xcc_id() { return (unsigned)__builtin_amdgcn_s_getreg((3 << 11) | 20) & 0xFu; }
#define XB_SPIN(cond, bar) do { unsigned _sp = 0; while (cond) { __builtin_amdgcn_s_sleep(1); \
    if ((++_sp & 255u) == 0u) { if (xb_ld(&(bar)[XB_TMO])) break; if (_sp > XB_SPIN_CAP) { atomicAdd(&(bar)[XB_TMO], 1u); break; } } } } while (0)

struct XcdBarrier {
    unsigned* bar; unsigned x;
    volatile LAS unsigned* st;
};

__device__ __forceinline__ XcdBarrier xcd_barrier_post(unsigned* bar, volatile LAS unsigned* st) {
    XcdBarrier b; b.bar = bar; b.x = xb_xcc_id(); b.st = st;
    if (threadIdx.x == 0) (void)xb_add(&bar[XB_XCNT(b.x)], 1u);
    return b;
}
__device__ __forceinline__ void xcd_barrier_complete(unsigned* bar, unsigned x, unsigned& nloc, unsigned& nx) {
    const unsigned G = gridDim.x * gridDim.y * gridDim.z;
    unsigned sum, cnt, mine, sp = 0u;
    for (;;) {
        sum = 0u; cnt = 0u; mine = 0u;
#pragma unroll
        for (unsigned j = 0; j < 16; ++j) { const unsigned c = xb_ld(&bar[XB_XCNT(j)]); sum += c; cnt += (c > 0u) ? 1u : 0u; mine = (j == x) ? c : mine; }
        if (sum == G) break;
        __builtin_amdgcn_s_sleep(1);
        if ((++sp & 255u) == 0u) { if (xb_ld(&bar[XB_TMO])) break; if (sp > XB_SPIN_CAP) { atomicAdd(&bar[XB_TMO], 1u); break; } }
    }
    nloc = mine > 0u ? mine : 1u; nx = cnt > 0u ? cnt : 1u;
}

__device__ __forceinline__ void xcd_barrier(const XcdBarrier& b) {
    asm volatile("s_waitcnt vmcnt(0)" ::: "memory");
    __syncthreads();
    if (threadIdx.x == 0) {
        unsigned* bar = b.bar;
        __builtin_amdgcn_s_waitcnt(0);
        unsigned nloc = b.st[0], nx = b.st[1];
        if (nloc == 0u) { xcd_barrier_complete(bar, b.x, nloc, nx); b.st[0] = nloc; b.st[1] = nx; }
        const unsigned old = xb_add(&bar[XB_XSUB(b.x)], 1u);
        const unsigned gen = old / nloc;
        if (old + 1u == (gen + 1u) * nloc) {
            __builtin_amdgcn_fence(__ATOMIC_RELEASE, "agent");
            asm volatile("s_waitcnt vmcnt(0)" ::: "memory");
            const unsigned og = xb_add(&bar[XB_TOP], 1u);
            const unsigned tg = og / nx;
            if (og + 1u == (tg + 1u) * nx) xb_add(&bar[XB_TOPGEN], 1u);
            else XB_SPIN(xb_ld(&bar[XB_TOPGEN]) == tg, bar);
            __builtin_amdgcn_fence(__ATOMIC_ACQUIRE, "agent");
            xb_add(&bar[XB_XGEN(b.x)], 1u);
            asm volatile("s_waitcnt vmcnt(0)" ::: "memory");
        } else {
            XB_SPIN(xb_ld(&bar[XB_XGEN(b.x)]) == gen, bar);
            __builtin_amdgcn_fence(__ATOMIC_ACQUIRE, "agent");
            asm volatile("s_waitcnt vmcnt(0)" ::: "memory");
        }
    }
    __syncthreads();
}


struct Ptrs {
    const float *x, *norm_mix, *w_in, *shift_mu, *w0, *w2_decay, *a0, *a2_iclr, *g2_gate, *k_k, *k_a, *r_k, *ln_x_w, *ln_x_b, *w_o_rwkv, *w_o_attn, *w_out, *norm_ffn, *w_router, *b_router, *w1, *b1, *w2, *b2, *norm_final;
    const int* positions;
    float* out;
    bf16 *LW, *LA, *LG, *WIN, *W1, *W2, *WOR, *WOA, *WOUT, *H, *ZP, *QKV, *GATES, *G, *ATTO, *YAIN, *OIN, *MERGED, *XS, *ACT, *OUTK;
    float *ROT, *SC, *BONUS, *Y, *ATTML, *X1, *TOPK_GATE, *ROWGATE;
    int *TOPK_E, *TOPK_POS, *ROWTOK;
    gu32* ctl;
};

using pg8::Unit;
__device__ __forceinline__ void store8(bf16* p, const f32x4& a, const f32x4& b) { *(u32x4*)p = pack8(a, b); }

struct EpiProj {
    static constexpr bool PERM = true, AFTER_DRAIN = false;
    bf16* ZP; bf16* QKV; bf16* GATES; const float* ROT;
    __device__ __forceinline__ void operator()(const f32x4 (&acc)[2][2][4][2], const Unit& u, int wr, int wc, int fr, int fq) const {
        const int pn = u.pn, rbase = u.pm * 256 + wr * 64 + fr, cw = wc * 32 + 8 * fq;
        if (pn < 14) {
#pragma unroll
            for (int ai = 0; ai < 2; ++ai)
#pragma unroll
                for (int m = 0; m < 4; ++m) { bf16* rp = ZP + (size_t)(rbase + ai * 128 + m * 16) * ZPW + pn * 256 + cw;
#pragma unroll
                    for (int bj = 0; bj < 2; ++bj) store8(rp + bj * 128, acc[ai][bj][m][0], acc[ai][bj][m][1]); }
        } else if (pn < 32) {
            const int t = pn - 14; const bool rot = (t < 12) && (wc == 0); const float sc = (t < 6) ? QSCALE : 1.0f; const float sg = (fq < 2) ? -1.0f : 1.0f;
#pragma unroll
            for (int ai = 0; ai < 2; ++ai)
#pragma unroll
                for (int m = 0; m < 4; ++m) { const int row = rbase + ai * 128 + m * 16; bf16* rp = QKV + (size_t)row * QKVW + t * 256 + cw;
                    f32x4 c0 = {1.f, 1.f, 1.f, 1.f}, c1 = c0, s0 = {0.f, 0.f, 0.f, 0.f}, s1 = s0;
                    if (rot) { const float* rt = ROT + (size_t)row * 32 + 8 * (fq & 1); c0 = *(const f32x4*)rt; c1 = *(const f32x4*)(rt + 4); s0 = *(const f32x4*)(rt + 16); s1 = *(const f32x4*)(rt + 20); }
#pragma unroll
                    for (int bj = 0; bj < 2; ++bj) { f32x4 v0 = acc[ai][bj][m][0], v1 = acc[ai][bj][m][1];
                        if (rot) { f32x4 p0, p1;
#pragma unroll
                            for (int j = 0; j < 4; ++j) { p0[j] = __shfl_xor(v0[j], 32); p1[j] = __shfl_xor(v1[j], 32); }
                            v0 = v0 * c0 + (p0 * s0) * sg; v1 = v1 * c1 + (p1 * s1) * sg; }
                        v0 = v0 * sc; v1 = v1 * sc; store8(rp + bj * 128, v0, v1); } }
        } else {
            const int t = pn - 32;
#pragma unroll
            for (int ai = 0; ai < 2; ++ai)
#pragma unroll
                for (int m = 0; m < 4; ++m) { bf16* rp = GATES + (size_t)(rbase + ai * 128 + m * 16) * GATEW + t * 256 + cw;
#pragma unroll
                    for (int bj = 0; bj < 2; ++bj) { f32x4 v0 = acc[ai][bj][m][0], v1 = acc[ai][bj][m][1];
#pragma unroll
                        for (int j = 0; j < 4; ++j) { v0[j] = sigmoidf_(v0[j]); v1[j] = sigmoidf_(v1[j]); }
                        store8(rp + bj * 128, v0, v1); } }
        }
    }
};

template <int STAGE> struct EpiMerge {
    static constexpr bool PERM = true, AFTER_DRAIN = false;
    bf16* MERGED; const bf16* GATES;
    __device__ __forceinline__ void operator()(const f32x4 (&acc)[2][2][4][2], const Unit& u, int wr, int wc, int fr, int fq) const {
        const int rbase = u.pm * 256 + wr * 64 + fr, cb = u.pn * 256 + wc * 32 + 8 * fq;
#pragma unroll
        for (int ai = 0; ai < 2; ++ai)
#pragma unroll
            for (int m = 0; m < 4; ++m) { const int row = rbase + ai * 128 + m * 16;
#pragma unroll
                for (int bj = 0; bj < 2; ++bj) { const int col = cb + bj * 128;
                    const u32x4 gw = *(const u32x4*)(GATES + (size_t)row * GATEW + STAGE * 2048 + col); f32x4 g0, g1; unpack8(gw, g0, g1);
                    f32x4 v0 = acc[ai][bj][m][0] * g0, v1 = acc[ai][bj][m][1] * g1; bf16* dp = MERGED + (size_t)row * D + col;
                    if (STAGE == 1) { const u32x4 tw = *(const u32x4*)dp; f32x4 t0, t1; unpack8(tw, t0, t1); v0 = v0 + t0; v1 = v1 + t1; }
                    store8(dp, v0, v1); } }
    }
};

struct EpiResid {
    static constexpr bool PERM = false, AFTER_DRAIN = false;
    const float* X; float* X1;
    __device__ __forceinline__ void operator()(const f32x4 (&acc)[2][2][4][2], const Unit& u, int wr, int wc, int fr, int fq) const {
        const int rbase = u.pm * 256 + wr * 64 + fr, cb = u.pn * 256 + wc * 32 + 4 * fq;
#pragma unroll
        for (int ai = 0; ai < 2; ++ai)
#pragma unroll
            for (int m = 0; m < 4; ++m) { const size_t ro = (size_t)(rbase + ai * 128 + m * 16) * D;
#pragma unroll
                for (int bj = 0; bj < 2; ++bj)
#pragma unroll
                    for (int n = 0; n < 2; ++n) { const int col = cb + bj * 128 + n * 16; *(f32x4*)(X1 + ro + col) = *(const f32x4*)(X + ro + col) + acc[ai][bj][m][n]; } }
    }
};

struct EpiMoe1 {
    static constexpr bool PERM = true, AFTER_DRAIN = false;
    bf16* ACT; const float* b1;
    __device__ __forceinline__ void operator()(const f32x4 (&acc)[2][2][4][2], const Unit& u, int wr, int wc, int fr, int fq) const {
        const int e = u.pn >> 4, pnl = u.pn & 15, rbase = u.pm * 256 + wr * 64 + fr, col = pnl * 128 + wc * 32 + 8 * fq;
        const float* bg = b1 + (size_t)e * 4096 + col; const float* bl = bg + 2048;
        const f32x4 bg0 = *(const f32x4*)bg, bg1 = *(const f32x4*)(bg + 4), bl0 = *(const f32x4*)bl, bl1 = *(const f32x4*)(bl + 4);
#pragma unroll
        for (int ai = 0; ai < 2; ++ai)
#pragma unroll
            for (int m = 0; m < 4; ++m) { const int row = rbase + ai * 128 + m * 16;
                f32x4 g0 = acc[ai][0][m][0] + bg0, g1 = acc[ai][0][m][1] + bg1, l0 = acc[ai][1][m][0] + bl0, l1 = acc[ai][1][m][1] + bl1, o0, o1;
#pragma unroll
                for (int j = 0; j < 4; ++j) {
                    { const float xg = fminf(g0[j], 7.0f), xl = fminf(fmaxf(l0[j], -7.0f), 7.0f); o0[j] = xg * sigmoidf_(1.702f * xg) * (xl + 1.0f); }
                    { const float xg = fminf(g1[j], 7.0f), xl = fminf(fmaxf(l1[j], -7.0f), 7.0f); o1[j] = xg * sigmoidf_(1.702f * xg) * (xl + 1.0f); } }
                store8(ACT + (size_t)row * FF + col, o0, o1); }
    }
};

struct EpiMoe2 {
    static constexpr bool PERM = true, AFTER_DRAIN = false;
    bf16* OUTK; const float* b2; const int* ROWTOK; const float* ROWGATE;
    __device__ __forceinline__ void operator()(const f32x4 (&acc)[2][2][4][2], const Unit& u, int wr, int wc, int fr, int fq) const {
        const int e = u.pn >> 3, pnl = u.pn & 7, rbase = u.pm * 256 + wr * 64 + fr, cb = pnl * 256 + wc * 32 + 8 * fq;
        f32x4 bv[2][2];
#pragma unroll
        for (int bj = 0; bj < 2; ++bj) { const float* bp = b2 + (size_t)e * D + cb + bj * 128; bv[bj][0] = *(const f32x4*)bp; bv[bj][1] = *(const f32x4*)(bp + 4); }
#pragma unroll
        for (int ai = 0; ai < 2; ++ai)
#pragma unroll
            for (int m = 0; m < 4; ++m) { const int row = rbase + ai * 128 + m * 16; const int p = ROWTOK[row];
                if (p >= 0) { const float gt = ROWGATE[row];
#pragma unroll
                    for (int bj = 0; bj < 2; ++bj) { const f32x4 v0 = (acc[ai][bj][m][0] + bv[bj][0]) * gt, v1 = (acc[ai][bj][m][1] + bv[bj][1]) * gt; store8(OUTK + (size_t)p * D + cb + bj * 128, v0, v1); } } }
    }
};

struct MoeOrder {
    const LAS int* toff; int npn, G, c;
    __device__ __forceinline__ bool next(int i, Unit& u) const {
        const int L = i * G + c, NT = toff[32];
        if (L >= NT * npn) return false;
        int e = 0;
#pragma unroll 1
        for (int j = 1; j < 32; ++j) e += (L >= toff[j] * npn) ? 1 : 0;
        const int t0 = toff[e], te = toff[e + 1] - t0, rem = L - t0 * npn;
        const int pnl = rem / te, pml = rem - pnl * te;
        u.pm = __builtin_amdgcn_readfirstlane(t0 + pml); u.pn = __builtin_amdgcn_readfirstlane(e * npn + pnl); return true;
    }
    __device__ __forceinline__ void a_ready(const Unit&) const {}
    __device__ __forceinline__ void done(const Unit&) const {}
};

__device__ __forceinline__ void tr_item(const float* src, int ldn, int k0, int c0, bf16* dst, size_t dstrow0, int K, LAS float* scr, int lane) {
    f32x4 v[8];
#pragma unroll
    for (int i = 0; i < 8; ++i) v[i] = *(const GAS f32x4*)(src + (size_t)(k0 + 8 * i + (lane >> 3)) * ldn + c0 + 4 * (lane & 7));
#pragma unroll
    for (int i = 0; i < 8; ++i) { LAS float* p = scr + (8 * i + (lane >> 3)) * 33 + 4 * (lane & 7); p[0] = v[i].x; p[1] = v[i].y; p[2] = v[i].z; p[3] = v[i].w; }
    LDS_WAIT(); asm volatile("" ::: "memory");
    const int c = lane & 7;
#pragma unroll
    for (int j = 0; j < 4; ++j) { const int n = (lane >> 3) + 8 * j; const LAS float* s = scr + (8 * c) * 33 + n;
        u32x4 o; o.x = pk2(s[0 * 33], s[1 * 33]); o.y = pk2(s[2 * 33], s[3 * 33]); o.z = pk2(s[4 * 33], s[5 * 33]); o.w = pk2(s[6 * 33], s[7 * 33]);
        *(GAS u32x4*)(dst + (dstrow0 + n) * (size_t)K + k0 + 8 * c) = o; }
    LDS_WAIT(); asm volatile("" ::: "memory");
}
__device__ __forceinline__ void rms_row_to_bf16(const float* xrow, const float* g, bf16* orow, int lane) {
    f32x4 v[8]; float s = 0.f;
#pragma unroll
    for (int j = 0; j < 8; ++j) { v[j] = *(const GAS f32x4*)(xrow + 4 * lane + 256 * j); s += (v[j].x * v[j].x + v[j].y * v[j].y) + (v[j].z * v[j].z + v[j].w * v[j].w); }
    const float rs = 1.0f / sqrtf(wave_sum(s) * (1.0f / D) + NORM_EPS);
#pragma unroll
    for (int j = 0; j < 8; ++j) { const f32x4 gv = *(const GAS f32x4*)(g + 4 * lane + 256 * j); u32x2 w; w.x = pk2(v[j].x * rs * gv.x, v[j].y * rs * gv.y); w.y = pk2(v[j].z * rs * gv.z, v[j].w * rs * gv.w);
        *(GAS u32x2*)(orow + 4 * lane + 256 * j) = w; }
}
__device__ __forceinline__ void p0_prologue(const Ptrs& P, LAS unsigned char* lds, int tid, int wave, int lane) {
    LAS float* scr = (LAS float*)(lds + wave * 8704);
    const int gw = blockIdx.x * NWAVES + wave, NGW = gridDim.x * NWAVES;
    constexpr int I_IN = 32 * 377, I_W1 = NE * 32 * 128, I_W2 = NE * 32 * 64, I_OR = 16 * 64, I_OA = 8 * 64, I_OUT = 32 * 64;
    constexpr int NITEMS = I_IN + I_W1 + I_W2 + I_OR + I_OA + I_OUT;
    for (int it = gw; it < NITEMS; it += NGW) {
        int r = it;
        if (r < I_IN) { const int kb = r / 377, nb = r % 377, c0 = 32 * nb; tr_item(P.w_in, IN_W, 64 * kb, c0, P.WIN, (size_t)(c0 < SHIFT_W ? c0 : c0 + 224), D, scr, lane); continue; }
        r -= I_IN;
        if (r < I_W1) { const int e = r >> 12, q = r & 4095, kb = q >> 7, nb = q & 127, c0 = 32 * nb;
            tr_item(P.w1 + (size_t)e * D * 4096, 4096, 64 * kb, c0, P.W1, (size_t)e * 4096 + ((c0 & 2047) >> 7) * 256 + (c0 >> 11) * 128 + (c0 & 127), D, scr, lane); continue; }
        r -= I_W1;
        if (r < I_W2) { const int e = r >> 11, q = r & 2047, kb = q >> 6, nb = q & 63; tr_item(P.w2 + (size_t)e * FF * D, D, 64 * kb, 32 * nb, P.W2, (size_t)e * D + 32 * nb, FF, scr, lane); continue; }
        r -= I_W2;
        if (r < I_OR) { const int kb = r >> 6, nb = r & 63; tr_item(P.w_o_rwkv, D, 64 * kb, 32 * nb, P.WOR, (size_t)32 * nb, RW, scr, lane); continue; }
        r -= I_OR;
        if (r < I_OA) { const int kb = r >> 6, nb = r & 63; tr_item(P.w_o_attn, D, 64 * kb, 32 * nb, P.WOA, (size_t)32 * nb, 512, scr, lane); continue; }
        r -= I_OA;
        { const int kb = r >> 6, nb = r & 63; tr_item(P.w_out, D, 64 * kb, 32 * nb, P.WOUT, (size_t)32 * nb, D, scr, lane); }
    }
    { const int gt = blockIdx.x * NTHREADS + tid, NGT = gridDim.x * NTHREADS; GAS u32x4* z = (GAS u32x4*)(P.WIN + (size_t)SHIFT_W * D);
      for (int i = gt; i < 224 * D / 8; i += NGT) z[i] = (u32x4){0u, 0u, 0u, 0u}; }
    { const int gt = blockIdx.x * NTHREADS + tid, NGT = gridDim.x * NTHREADS;
      for (int i = gt; i < 1024 * 64; i += NGT) { const int n = i >> 6, k = i & 63; P.LW[i] = (bf16)f2bf(P.w2_decay[k * RW + n]); P.LA[i] = (bf16)f2bf(P.a2_iclr[k * RW + n]); }
      for (int i = gt; i < 1024 * 160; i += NGT) { const int n = i / 160, k = i - n * 160; P.LG[i] = (bf16)f2bf(P.g2_gate[k * RW + n]); } }
    for (int m = gw; m < T; m += NGW) rms_row_to_bf16(P.x + (size_t)m * D, P.norm_mix, P.H + (size_t)m * D, lane);
    { const int gt = blockIdx.x * NTHREADS + tid, NGT = gridDim.x * NTHREADS;
      for (int i = gt; i < T * 16; i += NGT) { const int m = i >> 4, f = i & 15; const float inv = exp2f(-(float)f * (18.931568569324174f / 16.0f));
          const float ang = (float)P.positions[m] * inv; double rev = (double)ang * 0.15915494309189535; rev -= floor(rev); const float rv = (float)rev; const float sn = __builtin_amdgcn_sinf(rv), cs = __builtin_amdgcn_cosf(rv); P.ROT[(size_t)m * 32 + f] = cs; P.ROT[(size_t)m * 32 + 16 + f] = sn; } }
}

template <int CTRL> __device__ __forceinline__ float dppf(float x) { return __builtin_bit_cast(float, __builtin_amdgcn_mov_dpp(__builtin_bit_cast(int, x), CTRL, 0xf, 0xf, true)); }
__device__ __forceinline__ float sum8(float x) { x += dppf<0xB1>(x); x += dppf<0x4E>(x); x += dppf<0x141>(x); return x; }
__device__ __forceinline__ f32x4 mfma16(bf16x8 a, bf16x8 b, f32x4 c) { return __builtin_amdgcn_mfma_f32_16x16x32_bf16(a, b, c, 0, 0, 0); }
__device__ __forceinline__ void p2_rwkv_prep(const Ptrs& P, LAS unsigned char* lds, int tid, int wave, int lane) {
    constexpr int AWP = 144, AGP = 336, SLP = 196;
    LAS unsigned char* AW = lds; LAS unsigned char* AA = lds + 9216; LAS unsigned char* AG = lds + 18432; LAS float* slab = (LAS float*)(lds + 40960);
    const int fr = lane & 15, fq = lane >> 4;
    for (int u = blockIdx.x; u < T / 64; u += gridDim.x) {
        const int m0 = u * 64;
        __syncthreads();
        for (int item = tid; item < 64 * 36; item += NTHREADS) { const int tk = item / 36, c8 = item - tk * 36, m = m0 + tk, col0 = 3072 + 8 * c8;
            const u32x4 pw = *(const GAS u32x4*)(P.ZP + (size_t)m * ZPW + col0); u32x4 qw = {0u, 0u, 0u, 0u}; if (m % SEQ) qw = *(const GAS u32x4*)(P.ZP + (size_t)(m - 1) * ZPW + col0);
            f32x4 p0, p1, q0, q1; unpack8(pw, p0, p1); unpack8(qw, q0, q1);
            const f32x4 mu0 = *(const GAS f32x4*)(P.shift_mu + col0), mu1 = *(const GAS f32x4*)(P.shift_mu + col0 + 4);
            f32x4 z0 = p0 + (q0 - p0) * mu0, z1 = p1 + (q1 - p1) * mu1;
            if (c8 < 8) {
#pragma unroll
                for (int j = 0; j < 4; ++j) { z0[j] = tanhf(z0[j]); z1[j] = tanhf(z1[j]); }
                *(LAS u32x4*)(AW + tk * AWP + c8 * 16) = pack8(z0, z1);
            } else if (c8 < 16) { *(LAS u32x4*)(AA + tk * AWP + (c8 - 8) * 16) = pack8(z0, z1);
            } else {
#pragma unroll
                for (int j = 0; j < 4; ++j) { z0[j] = sigmoidf_(z0[j]); z1[j] = sigmoidf_(z1[j]); }
                *(LAS u32x4*)(AG + tk * AGP + (c8 - 16) * 16) = pack8(z0, z1); } }
        __syncthreads();
        const int ct = wave & 3, tt0 = (wave >> 2) * 2;
        const int etk = tid >> 3, ec8 = tid & 7, em = m0 + etk; const bool ehasp = (em % SEQ) != 0;
#pragma unroll 1
        for (int h = 0; h < NH; ++h) {
            { const int chrow = h * 64 + ct * 16 + fr;
              f32x4 acc[2][3];
#pragma unroll
              for (int t = 0; t < 2; ++t)
#pragma unroll
                  for (int kd = 0; kd < 3; ++kd) acc[t][kd] = (f32x4){0.f, 0.f, 0.f, 0.f};
#pragma unroll
              for (int ks = 0; ks < 2; ++ks) { const bf16x8 wf = *(const GAS bf16x8*)(P.LW + (size_t)chrow * 64 + ks * 32 + 8 * fq), af = *(const GAS bf16x8*)(P.LA + (size_t)chrow * 64 + ks * 32 + 8 * fq);
#pragma unroll
                  for (int t = 0; t < 2; ++t) { const int tok = (tt0 + t) * 16 + fr;
                      acc[t][0] = mfma16(wf, *(const LAS bf16x8*)(AW + tok * AWP + (ks * 32 + 8 * fq) * 2), acc[t][0]);
                      acc[t][1] = mfma16(af, *(const LAS bf16x8*)(AA + tok * AWP + (ks * 32 + 8 * fq) * 2), acc[t][1]); } }
#pragma unroll
              for (int ks = 0; ks < 5; ++ks) { const bf16x8 gf = *(const GAS bf16x8*)(P.LG + (size_t)chrow * 160 + ks * 32 + 8 * fq);
#pragma unroll
                  for (int t = 0; t < 2; ++t) { const int tok = (tt0 + t) * 16 + fr; acc[t][2] = mfma16(gf, *(const LAS bf16x8*)(AG + tok * AGP + (ks * 32 + 8 * fq) * 2), acc[t][2]); } }
#pragma unroll
              for (int t = 0; t < 2; ++t)
#pragma unroll
                  for (int kd = 0; kd < 3; ++kd) *(LAS f32x4*)(slab + ((tt0 + t) * 16 + fr) * SLP + kd * 64 + ct * 16 + 4 * fq) = acc[t][kd]; }
            __syncthreads();
            { const int ch0 = h * 64 + 8 * ec8; const LAS float* sl = slab + etk * SLP + 8 * ec8;
              const bf16* zp = P.ZP + (size_t)em * ZPW + ch0;
              float rr[8], kv[8], vv[8];
#pragma unroll
              for (int sg = 0; sg < 3; ++sg) { const u32x4 pw = *(const GAS u32x4*)(zp + sg * 1024); u32x4 qw = {0u, 0u, 0u, 0u}; if (ehasp) qw = *(const GAS u32x4*)(zp - ZPW + sg * 1024);
                  f32x4 p0, p1, q0, q1; unpack8(pw, p0, p1); unpack8(qw, q0, q1);
                  const f32x4 mu0 = *(const GAS f32x4*)(P.shift_mu + sg * 1024 + ch0), mu1 = *(const GAS f32x4*)(P.shift_mu + sg * 1024 + ch0 + 4);
                  const f32x4 z0 = p0 + (q0 - p0) * mu0, z1 = p1 + (q1 - p1) * mu1;
#pragma unroll
                  for (int j = 0; j < 4; ++j) { if (sg == 0) { rr[j] = z0[j]; rr[4 + j] = z1[j]; } else if (sg == 1) { kv[j] = z0[j]; kv[4 + j] = z1[j]; } else { vv[j] = z0[j]; vv[4 + j] = z1[j]; } } }
              float dec[8], av[8], gv[8], kkp[8], kn[8]; float ss = 0.f, bon = 0.f;
#pragma unroll
              for (int q = 0; q < 2; ++q) { const f32x4 wr_ = *(const LAS f32x4*)(sl + 4 * q), ap = *(const LAS f32x4*)(sl + 64 + 4 * q), gg = *(const LAS f32x4*)(sl + 128 + 4 * q);
                  const f32x4 w0v = *(const GAS f32x4*)(P.w0 + ch0 + 4 * q), a0v = *(const GAS f32x4*)(P.a0 + ch0 + 4 * q), kkv = *(const GAS f32x4*)(P.k_k + ch0 + 4 * q), kav = *(const GAS f32x4*)(P.k_a + ch0 + 4 * q), rkv = *(const GAS f32x4*)(P.r_k + ch0 + 4 * q);
#pragma unroll
                  for (int j = 0; j < 4; ++j) { const int i = 4 * q + j;
                      dec[i] = __expf(-0.6065306597126334f * sigmoidf_(w0v[j] + wr_[j])); av[i] = sigmoidf_(a0v[j] + ap[j]); gv[i] = gg[j];
                      kkp[i] = kv[i] * kkv[j]; ss += kkp[i] * kkp[i]; kn[i] = kv[i] * (1.0f + (av[i] - 1.0f) * kav[j]); bon += rr[i] * kn[i] * rkv[j]; } }
              ss = sum8(ss); bon = sum8(bon);
              const float rn = 1.0f / fmaxf(sqrtf(ss), 1e-12f);
              const size_t o = (size_t)em * RW + ch0;
              f32x4 t0, t1;
#pragma unroll
              for (int j = 0; j < 4; ++j) { t0[j] = -kkp[j] * rn; t1[j] = -kkp[4 + j] * rn; }
              *(GAS f32x4*)(P.SC + SC_KK * SC_STRIDE + o) = t0; *(GAS f32x4*)(P.SC + SC_KK * SC_STRIDE + o + 4) = t1;
#pragma unroll
              for (int j = 0; j < 4; ++j) { t0[j] = -t0[j] * av[j]; t1[j] = -t1[j] * av[4 + j]; }
              *(GAS f32x4*)(P.SC + SC_BB * SC_STRIDE + o) = t0; *(GAS f32x4*)(P.SC + SC_BB * SC_STRIDE + o + 4) = t1;
              *(GAS f32x4*)(P.SC + SC_W * SC_STRIDE + o) = (f32x4){dec[0], dec[1], dec[2], dec[3]}; *(GAS f32x4*)(P.SC + SC_W * SC_STRIDE + o + 4) = (f32x4){dec[4], dec[5], dec[6], dec[7]};
              *(GAS f32x4*)(P.SC + SC_K * SC_STRIDE + o) = (f32x4){kn[0], kn[1], kn[2], kn[3]}; *(GAS f32x4*)(P.SC + SC_K * SC_STRIDE + o + 4) = (f32x4){kn[4], kn[5], kn[6], kn[7]};
              *(GAS f32x4*)(P.SC + SC_R * SC_STRIDE + o) = (f32x4){rr[0], rr[1], rr[2], rr[3]}; *(GAS f32x4*)(P.SC + SC_R * SC_STRIDE + o + 4) = (f32x4){rr[4], rr[5], rr[6], rr[7]};
              *(GAS f32x4*)(P.SC + SC_V * SC_STRIDE + o) = (f32x4){vv[0], vv[1], vv[2], vv[3]}; *(GAS f32x4*)(P.SC + SC_V * SC_STRIDE + o + 4) = (f32x4){vv[4], vv[5], vv[6], vv[7]};
              *(GAS u32x4*)(P.G + o) = pack8((f32x4){gv[0], gv[1], gv[2], gv[3]}, (f32x4){gv[4], gv[5], gv[6], gv[7]});
              if (ec8 == 0) P.BONUS[(size_t)em * NH + h] = bon; }
            __syncthreads();
        }
    }
}

__device__ __forceinline__ void p3_attention(const Ptrs& P, LAS unsigned char* lds, int tid, int wave, int lane) {
    const int fr = lane & 15, fq = lane >> 4;
    LAS unsigned char* Ks = lds; LAS unsigned char* Vt = lds + 34816;
    for (int u = blockIdx.x; u < NB * 12 * 32; u += gridDim.x) {
        const int b = u / 384, r = u - b * 384, gh = r >> 5, idx = r & 31, g = gh >> 2;
        const int d = (g == 0) ? 1 : ((g == 1) ? 4 : 16), nb = 32 / d, c = idx / nb, n = idx - c * nb;
        const int qi = wave * 16 + fr; const size_t mq = (size_t)b * SEQ + (size_t)(n * 128 + qi) * d + c;
        const bf16* qrow = P.QKV + mq * QKVW + gh * 128;
        bf16x8 qf[4];
#pragma unroll
        for (int ks = 0; ks < 4; ++ks) qf[ks] = *(const GAS bf16x8*)(qrow + 32 * ks + 8 * fq);
        f32x4 o[8];
#pragma unroll
        for (int dt = 0; dt < 8; ++dt) o[dt] = (f32x4){0.f, 0.f, 0.f, 0.f};
        float mrun = -1e30f, lrun = 0.f;
        for (int kb = (n == 0) ? 1 : 0; kb < 2; ++kb) {
            const int kblk = n - 1 + kb;
            __syncthreads();
#pragma unroll
            for (int i = 0; i < 4; ++i) { const int p = tid + 512 * i, key = p >> 4, part = p & 15; const size_t mk = (size_t)b * SEQ + (size_t)(kblk * 128 + key) * d + c;
                *(LAS u32x4*)(Ks + key * 272 + part * 16) = *(const GAS u32x4*)(P.QKV + mk * QKVW + 1536 + gh * 128 + part * 8); }
#pragma unroll
            for (int i = 0; i < 4; ++i) { const int key = tid & 127, part = (tid >> 7) + 4 * i; const size_t mk = (size_t)b * SEQ + (size_t)(kblk * 128 + key) * d + c;
                const u32x4 v = *(const GAS u32x4*)(P.QKV + mk * QKVW + 3072 + gh * 128 + part * 8);
                LAS unsigned char* vp = Vt + (8 * part) * 272 + key * 2;
                *(LAS unsigned short*)(vp + 0 * 272) = (unsigned short)(v.x & 0xffffu); *(LAS unsigned short*)(vp + 1 * 272) = (unsigned short)(v.x >> 16);
                *(LAS unsigned short*)(vp + 2 * 272) = (unsigned short)(v.y & 0xffffu); *(LAS unsigned short*)(vp + 3 * 272) = (unsigned short)(v.y >> 16);
                *(LAS unsigned short*)(vp + 4 * 272) = (unsigned short)(v.z & 0xffffu); *(LAS unsigned short*)(vp + 5 * 272) = (unsigned short)(v.z >> 16);
                *(LAS unsigned short*)(vp + 6 * 272) = (unsigned short)(v.w & 0xffffu); *(LAS unsigned short*)(vp + 7 * 272) = (unsigned short)(v.w >> 16); }
            __syncthreads();
            f32x4 s[8];
#pragma unroll
            for (int kt = 0; kt < 8; ++kt) { s[kt] = (f32x4){0.f, 0.f, 0.f, 0.f};
#pragma unroll
                for (int ks = 0; ks < 4; ++ks) { const bf16x8 a = *(const LAS bf16x8*)(Ks + (kt * 16 + fr) * 272 + (32 * ks + 8 * fq) * 2); s[kt] = mfma16(a, qf[ks], s[kt]); } }
            float mx = -1e30f;
#pragma unroll
            for (int kt = 0; kt < 8; ++kt)
#pragma unroll
                for (int rg = 0; rg < 4; ++rg) { const int j = kt * 16 + 4 * fq + rg; const bool ok = (kb == 0) ? (j >= qi) : (j <= qi); const float sv = ok ? s[kt][rg] : -1e30f; s[kt][rg] = sv; mx = fmaxf(mx, sv); }
            mx = fmaxf(mx, __shfl_xor(mx, 16)); mx = fmaxf(mx, __shfl_xor(mx, 32));
            const float mnew = fmaxf(mrun, mx), alpha = exp2f(mrun - mnew); mrun = mnew;
            float ls = 0.f;
#pragma unroll
            for (int kt = 0; kt < 8; ++kt)
#pragma unroll
                for (int rg = 0; rg < 4; ++rg) { const float p = exp2f(s[kt][rg] - mnew); s[kt][rg] = p; ls += p; }
            lrun = lrun * alpha + ls;
#pragma unroll
            for (int dt = 0; dt < 8; ++dt) o[dt] = o[dt] * alpha;
#pragma unroll
            for (int pi = 0; pi < 4; ++pi) {
                const u32x4 bw = pack8(s[2 * pi], s[2 * pi + 1]); const bf16x8 bfrag = __builtin_bit_cast(bf16x8, bw);
#pragma unroll
                for (int dt = 0; dt < 8; ++dt) { const LAS unsigned char* vp = Vt + (dt * 16 + fr) * 272 + (2 * pi * 16 + 4 * fq) * 2;
                    const u32x2 lo = *(const LAS u32x2*)vp, hi = *(const LAS u32x2*)(vp + 32);
                    const u32x4 aw = {lo.x, lo.y, hi.x, hi.y}; o[dt] = mfma16(__builtin_bit_cast(bf16x8, aw), bfrag, o[dt]); } }
        }
        lrun += __shfl_xor(lrun, 16); lrun += __shfl_xor(lrun, 32);
        bf16* orow = P.ATTO + (mq * 12 + gh) * 128;
#pragma unroll
        for (int dt = 0; dt < 8; ++dt) { u32x2 w; w.x = pk2(o[dt][0], o[dt][1]); w.y = pk2(o[dt][2], o[dt][3]); *(GAS u32x2*)(orow + dt * 16 + 4 * fq) = w; }
        if (fq == 0) { P.ATTML[(mq * 12 + gh) * 2] = mrun; P.ATTML[(mq * 12 + gh) * 2 + 1] = lrun; }
    }
}

__device__ __forceinline__ float row32_sum(float x) {
    x += dppf<0xB1>(x); x += dppf<0x4E>(x); x += dppf<0x141>(x); x += dppf<0x140>(x);
    const auto s = __builtin_amdgcn_permlane16_swap(__float_as_uint(x), __float_as_uint(x), false, false);
    return __uint_as_float(s[0]) + __uint_as_float(s[1]);
}
typedef float f32x2 __attribute__((ext_vector_type(2)));
__device__ __forceinline__ void p4_scan(const Ptrs& P, LAS unsigned char* lds, int tid, int wave, int lane) {
    constexpr int CH = 32, NCH = SEQ / CH, STEP_F = 6 * 64, BUF_F = CH * STEP_F;
    LAS float* buf = (LAS float*)lds;
    for (int unit = blockIdx.x; unit < 256; unit += gridDim.x) {
        const int bh = unit >> 2, rgp = unit & 3, b = bh >> 4, h = bh & 15;
        const size_t off0 = (size_t)b * SEQ * RW + h * 64;
        const int rr = lane >> 5, kp = lane & 31, vrow = rgp * 16 + wave * 2 + rr;
        f32x4 nx[6];
        __syncthreads();
#pragma unroll
        for (int i = 0; i < 6; ++i) { const int idx = tid + 512 * i, arr = idx >> 9, rem = idx & 511, st = rem >> 4, q = rem & 15;
            *(LAS f32x4*)(buf + (st * 6 + arr) * 64 + 4 * q) = *(const GAS f32x4*)(P.SC + arr * SC_STRIDE + off0 + (size_t)st * RW + 4 * q); }
        __syncthreads();
        float S0 = 0.f, S1 = 0.f;
#pragma unroll 1
        for (int ch = 0; ch < NCH; ++ch) {
            const bool more = (ch + 1) < NCH;
            if (more) {
#pragma unroll
                for (int i = 0; i < 6; ++i) { const int idx = tid + 512 * i, arr = idx >> 9, rem = idx & 511, st = rem >> 4, q = rem & 15;
                    nx[i] = *(const GAS f32x4*)(P.SC + arr * SC_STRIDE + off0 + (size_t)((ch + 1) * CH + st) * RW + 4 * q); } }
            const LAS float* cb = buf + (ch & 1) * BUF_F;
            float ys = 0.f;
#pragma unroll
            for (int st = 0; st < CH; ++st) { const LAS float* sp = cb + st * STEP_F + 2 * kp;
                const f32x2 kk = *(const LAS f32x2*)(sp), w = *(const LAS f32x2*)(sp + 64), bb = *(const LAS f32x2*)(sp + 128), k = *(const LAS f32x2*)(sp + 192), r = *(const LAS f32x2*)(sp + 256);
                const float vv = cb[st * STEP_F + 320 + vrow];
                const float sa = row32_sum(S0 * kk.x + S1 * kk.y);
                S0 = S0 * w.x + (sa * bb.x + vv * k.x); S1 = S1 * w.y + (sa * bb.y + vv * k.y);
                const float y = row32_sum(S0 * r.x + S1 * r.y);
                ys = (kp == st) ? y : ys; }
            P.Y[off0 + (size_t)(ch * CH + kp) * RW + vrow] = ys;
            if (more) { LAS float* nb = buf + ((ch + 1) & 1) * BUF_F;
#pragma unroll
                for (int i = 0; i < 6; ++i) { const int idx = tid + 512 * i, arr = idx >> 9, rem = idx & 511, st = rem >> 4, q = rem & 15; *(LAS f32x4*)(nb + (st * 6 + arr) * 64 + 4 * q) = nx[i]; } }
            __syncthreads();
        }
    }
}

__device__ __forceinline__ void p5_post(const Ptrs& P, int tid, int wave, int lane) {
    for (int m = blockIdx.x; m < T; m += gridDim.x) {
#pragma unroll
        for (int cc = 0; cc < 2; ++cc) { const int c = tid + 512 * cc, head = wave + 8 * cc; const size_t o = (size_t)m * RW + c;
            const float y = P.Y[o]; const float mean = wave_sum(y) * (1.0f / 64.0f); const float dv = y - mean; const float var = wave_sum(dv * dv) * (1.0f / 64.0f);
            float yn = dv * (1.0f / sqrtf(var + GN_EPS)) * P.ln_x_w[c] + P.ln_x_b[c];
            yn += P.BONUS[(size_t)m * NH + head] * P.SC[SC_V * SC_STRIDE + o];
            P.YAIN[o] = (bf16)f2bf(yn * bf2f(P.G[o])); }
        { const int hh = tid >> 7, dd = tid & 127; float mm[3], ll[3], ov[3]; float M = -1e30f;
#pragma unroll
          for (int g = 0; g < 3; ++g) { const size_t q = (size_t)m * 12 + g * 4 + hh; mm[g] = P.ATTML[q * 2]; ll[g] = P.ATTML[q * 2 + 1]; ov[g] = bf2f(P.ATTO[q * 128 + dd]); M = fmaxf(M, mm[g]); }
          float num = 0.f, den = 0.f;
#pragma unroll
          for (int g = 0; g < 3; ++g) { const float wg = exp2f(mm[g] - M); num += wg * ov[g]; den += wg * ll[g]; }
          P.OIN[(size_t)m * 512 + tid] = (bf16)f2bf(num / den); }
    }
}

__device__ __forceinline__ void p8_router(const Ptrs& P, LAS unsigned char* lds, int tid, int wave, int lane) {
    LAS float* Wl = (LAS float*)lds;
    const int e = lane & 31, kh = lane >> 5;
    for (int grp = blockIdx.x; grp < T / 64; grp += gridDim.x) {
        const int m0 = grp * 64 + wave * 8;
        float rs[8], acc[8];
#pragma unroll
        for (int tk = 0; tk < 8; ++tk) { const float* xr = P.X1 + (size_t)(m0 + tk) * D; f32x4 v[8]; float s = 0.f;
#pragma unroll
            for (int j = 0; j < 8; ++j) { v[j] = *(const GAS f32x4*)(xr + 4 * lane + 256 * j); s += (v[j].x * v[j].x + v[j].y * v[j].y) + (v[j].z * v[j].z + v[j].w * v[j].w); }
            const float r = 1.0f / sqrtf(wave_sum(s) * (1.0f / D) + NORM_EPS); rs[tk] = r; acc[tk] = 0.f;
            bf16* hr = P.H + (size_t)(m0 + tk) * D;
#pragma unroll
            for (int j = 0; j < 8; ++j) { const f32x4 gv = *(const GAS f32x4*)(P.norm_ffn + 4 * lane + 256 * j); u32x2 w; w.x = pk2(v[j].x * r * gv.x, v[j].y * r * gv.y); w.y = pk2(v[j].z * r * gv.z, v[j].w * r * gv.w);
                *(GAS u32x2*)(hr + 4 * lane + 256 * j) = w; } }
#pragma unroll 1
        for (int hf = 0; hf < 2; ++hf) {
            __syncthreads();
            for (int idx = tid; idx < 8192; idx += NTHREADS) { const int k = idx >> 3, q = idx & 7; const float g = P.norm_ffn[hf * 1024 + k];
                *(LAS f32x4*)(Wl + k * 32 + 4 * q) = *(const GAS f32x4*)(P.w_router + (size_t)(hf * 1024 + k) * NE + 4 * q) * g; }
            __syncthreads();
            const float* xb = P.X1 + (size_t)m0 * D + hf * 1024 + kh * 512; const LAS float* wb = Wl + (kh * 512) * 32 + e;
#pragma unroll 2
            for (int i = 0; i < 512; i += 4) { const float w0 = wb[(i + 0) * 32], w1 = wb[(i + 1) * 32], w2 = wb[(i + 2) * 32], w3 = wb[(i + 3) * 32];
#pragma unroll
                for (int tk = 0; tk < 8; ++tk) { const f32x4 xv = *(const GAS f32x4*)(xb + (size_t)tk * D + i); acc[tk] += (xv.x * w0 + xv.y * w1) + (xv.z * w2 + xv.w * w3); } }
        }
        const float be = P.b_router[e];
#pragma unroll
        for (int tk = 0; tk < 8; ++tk) { float v = (acc[tk] + __shfl_xor(acc[tk], 32)) * rs[tk] + be;
            int sel[4]; float val[4];
#pragma unroll
            for (int k = 0; k < 4; ++k) { float mx = v;
#pragma unroll
                for (int o = 1; o < 32; o <<= 1) mx = fmaxf(mx, __shfl_xor(mx, o));
                const unsigned long long bal = __ballot(v == mx); const int s_ = __ffsll((unsigned long long)(bal & 0xffffffffull)) - 1;
                sel[k] = s_; val[k] = mx; v = (e == s_) ? -3.0e38f : v; }
            const float e1 = __expf(val[1] - val[0]), e2 = __expf(val[2] - val[0]), e3 = __expf(val[3] - val[0]); const float inv = 1.0f / (1.0f + e1 + e2 + e3);
            const float gate[4] = {inv, e1 * inv, e2 * inv, e3 * inv};
            if (lane == 0) { const int m = m0 + tk;
#pragma unroll
                for (int k = 0; k < 4; ++k) { const unsigned pos = __hip_atomic_fetch_add((unsigned*)(P.ctl + CW_CNT + 64 * sel[k]), 1u, RLX_AGENT);
                    P.TOPK_E[m * 4 + k] = sel[k]; P.TOPK_POS[m * 4 + k] = (int)pos; P.TOPK_GATE[m * 4 + k] = gate[k]; } }
        }
    }
}

__device__ __forceinline__ void moe_tables(const Ptrs& P, LAS int* tab, int tid) {
    if (tid == 0) { int acc = 0;
        for (int e = 0; e < NE; ++e) { tab[e] = acc; const int c = (int)__hip_atomic_load((unsigned*)(P.ctl + CW_CNT + 64 * e), RLX_AGENT); acc += (c + 255) >> 8; tab[64 + e] = c; }
        tab[32] = acc; }
    __syncthreads();
}

__device__ __forceinline__ void p9_gather(const Ptrs& P, LAS unsigned char* lds, int tid, int wave, int lane) {
    LAS int* tab = (LAS int*)(lds + TAB_OFF);
    moe_tables(P, tab, tid);
    const int gw = blockIdx.x * NWAVES + wave, NGW = gridDim.x * NWAVES;
    for (int p = gw; p < T * 4; p += NGW) { const int e = P.TOPK_E[p], pos = P.TOPK_POS[p]; const int row = tab[e] * 256 + pos;
        const GAS u32x4* src = (const GAS u32x4*)(P.H + (size_t)(p >> 2) * D); GAS u32x4* dst = (GAS u32x4*)(P.XS + (size_t)row * D);
#pragma unroll
        for (int i = 0; i < 4; ++i) dst[lane + 64 * i] = src[lane + 64 * i];
        if (lane == 0) { P.ROWTOK[row] = p; P.ROWGATE[row] = P.TOPK_GATE[p]; } }
    for (int e = blockIdx.x; e < NE; e += gridDim.x) { const int cnt = tab[64 + e], r0 = tab[e] * 256, rend = tab[e + 1] * 256;
        for (int r = r0 + cnt + tid; r < rend; r += NTHREADS) { P.ROWTOK[r] = -1; P.ROWGATE[r] = 0.f; } }
}

__device__ __forceinline__ void p12_final(const Ptrs& P, int tid, int wave, int lane) {
    const int gw = blockIdx.x * NWAVES + wave, NGW = gridDim.x * NWAVES;
    for (int m = gw; m < T; m += NGW) {
        f32x4 v[8]; float s = 0.f;
#pragma unroll
        for (int j = 0; j < 8; ++j) { const int col = 4 * lane + 256 * j; v[j] = *(const GAS f32x4*)(P.X1 + (size_t)m * D + col);
#pragma unroll
            for (int k = 0; k < 4; ++k) { const u32x2 w = *(const GAS u32x2*)(P.OUTK + ((size_t)m * 4 + k) * D + col); v[j].x += bflo(w.x); v[j].y += bfhi(w.x); v[j].z += bflo(w.y); v[j].w += bfhi(w.y); }
            s += (v[j].x * v[j].x + v[j].y * v[j].y) + (v[j].z * v[j].z + v[j].w * v[j].w); }
        const float rs = 1.0f / sqrtf(wave_sum(s) * (1.0f / D) + NORM_EPS);
#pragma unroll
        for (int j = 0; j < 8; ++j) { const int col = 4 * lane + 256 * j; const f32x4 g = *(const GAS f32x4*)(P.norm_final + col); *(GAS f32x4*)(P.out + (size_t)m * D + col) = v[j] * rs * g; }
    }
}

struct Args { const void* in[26]; float* out; unsigned char* ws; int ph_lo, ph_hi; };
__global__ void __launch_bounds__(NTHREADS, 2) fwd(Args args) {
    extern __shared__ __attribute__((aligned(16))) unsigned char lds_raw[];
    LAS unsigned char* lds = (LAS unsigned char*)lds_raw;
    const int tid = threadIdx.x, lane = tid & 63, wave = __builtin_amdgcn_readfirstlane(tid >> 6);
    unsigned char* ws = args.ws;
    Ptrs P;
    P.x = (const float*)args.in[0]; P.positions = (const int*)args.in[1]; P.norm_mix = (const float*)args.in[2]; P.w_in = (const float*)args.in[3]; P.shift_mu = (const float*)args.in[4];
    P.w0 = (const float*)args.in[5]; P.w2_decay = (const float*)args.in[6]; P.a0 = (const float*)args.in[7]; P.a2_iclr = (const float*)args.in[8]; P.g2_gate = (const float*)args.in[9];
    P.k_k = (const float*)args.in[10]; P.k_a = (const float*)args.in[11]; P.r_k = (const float*)args.in[12]; P.ln_x_w = (const float*)args.in[13]; P.ln_x_b = (const float*)args.in[14];
    P.w_o_rwkv = (const float*)args.in[15]; P.w_o_attn = (const float*)args.in[16]; P.w_out = (const float*)args.in[17]; P.norm_ffn = (const float*)args.in[18]; P.w_router = (const float*)args.in[19];
    P.b_router = (const float*)args.in[20]; P.w1 = (const float*)args.in[21]; P.b1 = (const float*)args.in[22]; P.w2 = (const float*)args.in[23]; P.b2 = (const float*)args.in[24]; P.norm_final = (const float*)args.in[25];
    P.out = args.out; P.ctl = (gu32*)(ws + WS_CTL);
    P.WIN = (bf16*)(ws + WS_WIN); P.W1 = (bf16*)(ws + WS_W1); P.W2 = (bf16*)(ws + WS_W2); P.WOR = (bf16*)(ws + WS_WOR); P.WOA = (bf16*)(ws + WS_WOA); P.WOUT = (bf16*)(ws + WS_WOUT);
    P.H = (bf16*)(ws + WS_H); P.ZP = (bf16*)(ws + WS_ZP); P.QKV = (bf16*)(ws + WS_QKV); P.GATES = (bf16*)(ws + WS_GATES); P.ROT = (float*)(ws + WS_ROT); P.SC = (float*)(ws + WS_SC);
    P.G = (bf16*)(ws + WS_G); P.BONUS = (float*)(ws + WS_BONUS); P.Y = (float*)(ws + WS_Y); P.ATTO = (bf16*)(ws + WS_ATTO); P.ATTML = (float*)(ws + WS_ATTML); P.YAIN = (bf16*)(ws + WS_YAIN);
    P.OIN = (bf16*)(ws + WS_OIN); P.MERGED = (bf16*)(ws + WS_MERGED); P.X1 = (float*)(ws + WS_X1);
    P.TOPK_E = (int*)(ws + WS_TOPK); P.TOPK_POS = P.TOPK_E + T * 4; P.TOPK_GATE = (float*)(P.TOPK_POS + T * 4);
    P.ROWTOK = (int*)(ws + WS_ROWS); P.ROWGATE = (float*)(P.ROWTOK + XS_ROWS);
    P.LW = (bf16*)(ws + WS_LORA); P.LA = P.LW + 1024 * 64; P.LG = P.LA + 1024 * 64;
    P.XS = (bf16*)(ws + WS_XS); P.ACT = (bf16*)(ws + WS_ACT); P.OUTK = (bf16*)(ws + WS_OUTK);

    for (int u = tid; u < (LDS_BYTES - TAB_OFF) / 4; u += NTHREADS) ((LAS unsigned*)(lds + TAB_OFF))[u] = 0u;
    __syncthreads();
#if MK_ONE_LAUNCH
    XcdBarrier bar = xcd_barrier_post((unsigned*)(P.ctl + CW_BAR), (volatile LAS unsigned*)(lds + MISC_OFF));
#define GRID_BAR() xcd_barrier(bar)
#else
#define GRID_BAR() do { } while (0)
#endif
    const int lo = args.ph_lo, hi = args.ph_hi;
#ifndef PHASE_MASK
#define PHASE_MASK 0x1fff
#endif
#define IN(k) (((PHASE_MASK >> (k)) & 1) && lo <= (k) && (k) < hi)
#define SEAM(k) do { if (IN(k) && IN((k) + 1)) GRID_BAR(); } while (0)
    const int G = gridDim.x, c = blockIdx.x;

#ifndef REP_MASK
#define REP_MASK 0
#endif
#define REPS(k) (1 + ((REP_MASK >> (k)) & 1))
#define PHASE(k, ...) do { if (IN(k)) { for (int rep_ = 0; rep_ < REPS(k); ++rep_) { if (rep_) GRID_BAR(); __VA_ARGS__ } SEAM(k); } } while (0)
    PHASE(0, p0_prologue(P, lds, tid, wave, lane););
    PHASE(1, { pg8::Gemm g{P.H, P.WIN, T, NPROJ, D}; pg8::StaticOrder S; S.init(T, NPROJ, G, c); EpiProj E{P.ZP, P.QKV, P.GATES, P.ROT};
        pg8::gemm_phase<EpiProj, pg8::StaticOrder, true, true>(lds, g, S, E); });
    PHASE(2, p2_rwkv_prep(P, lds, tid, wave, lane););
    PHASE(3, p3_attention(P, lds, tid, wave, lane););
    PHASE(4, p4_scan(P, lds, tid, wave, lane););
    PHASE(5, p5_post(P, tid, wave, lane););
    PHASE(6, {
        { pg8::Gemm g{P.YAIN, P.WOR, T, D, RW}; pg8::StaticOrder S; S.init(T, D, G, c); EpiMerge<0> E{P.MERGED, P.GATES}; pg8::gemm_phase<EpiMerge<0>, pg8::StaticOrder, true, true>(lds, g, S, E); }
        VM_WAIT(); __builtin_amdgcn_fence(__ATOMIC_ACQUIRE, "agent"); VM_WAIT(); __syncthreads();
        { pg8::Gemm g{P.OIN, P.WOA, T, D, 512}; pg8::StaticOrder S; S.init(T, D, G, c); EpiMerge<1> E{P.MERGED, P.GATES}; pg8::gemm_phase<EpiMerge<1>, pg8::StaticOrder, true, true>(lds, g, S, E); } });
    PHASE(7, { pg8::Gemm g{P.MERGED, P.WOUT, T, D, D}; pg8::StaticOrder S; S.init(T, D, G, c); EpiResid E{P.x, P.X1}; pg8::gemm_phase<EpiResid, pg8::StaticOrder, true, true>(lds, g, S, E); });
    PHASE(8, p8_router(P, lds, tid, wave, lane););
    PHASE(9, p9_gather(P, lds, tid, wave, lane););
    PHASE(10, { LAS int* tab = (LAS int*)(lds + TAB_OFF); moe_tables(P, tab, tid);
        pg8::Gemm g{P.XS, P.W1, XS_ROWS, NE * 4096, D}; MoeOrder S{tab, 16, G, c}; EpiMoe1 E{P.ACT, P.b1};
        pg8::gemm_phase<EpiMoe1, MoeOrder, true, true>(lds, g, S, E); });
    PHASE(11, { LAS int* tab = (LAS int*)(lds + TAB_OFF); moe_tables(P, tab, tid);
        pg8::Gemm g{P.ACT, P.W2, XS_ROWS, NE * D, FF}; MoeOrder S{tab, 8, G, c}; EpiMoe2 E{P.OUTK, P.b2, P.ROWTOK, P.ROWGATE};
        pg8::gemm_phase<EpiMoe2, MoeOrder, true, true>(lds, g, S, E); });
    PHASE(12, p12_final(P, tid, wave, lane););
#undef IN
#undef SEAM
}

extern "C" void kernel_launch(void* const* d_in, const int* in_sizes, int n_in, void* d_out, int out_size, void* d_ws, size_t ws_size, hipStream_t stream) {
    static int grid = 0;
    if (grid == 0) {
        if (n_in != 26 || out_size != T * D || ws_size < WS_END) { fprintf(stderr, "kernel_launch: unexpected shapes (n_in %d, out %d, ws %zu, need %zu); nothing launched\n", n_in, out_size, ws_size, (size_t)WS_END); grid = -1; return; }
        int dev = 0, cus = 0, per_cu = 0;
        if (hipGetDevice(&dev) != hipSuccess || hipDeviceGetAttribute(&cus, hipDeviceAttributeMultiprocessorCount, dev) != hipSuccess) { grid = -1; return; }
        if (hipFuncSetAttribute((const void*)fwd, hipFuncAttributeMaxDynamicSharedMemorySize, LDS_BYTES) != hipSuccess) { fprintf(stderr, "kernel_launch: hipFuncSetAttribute failed\n"); grid = -1; return; }
        if (hipOccupancyMaxActiveBlocksPerMultiprocessor(&per_cu, (const void*)fwd, NTHREADS, LDS_BYTES) != hipSuccess || per_cu < 1) fprintf(stderr, "kernel_launch: occupancy query says %d\n", per_cu);
        (void)hipGetLastError();
        grid = cus;
    }
    if (grid < 0) return;
    if (hipMemsetAsync((char*)d_ws + WS_CTL, 0, CTL_ZERO_BYTES, stream) != hipSuccess) return;
    Args a{};
    for (int i = 0; i < 26; ++i) a.in[i] = d_in[i];
    a.out = (float*)d_out; a.ws = (unsigned char*)d_ws;
#if MK_ONE_LAUNCH
    a.ph_lo = 0; a.ph_hi = NPHASES;
    hipLaunchKernelGGL(fwd, dim3(grid), dim3(NTHREADS), LDS_BYTES, stream, a);
#else
    for (int ph = 0; ph < NPHASES; ++ph) { a.ph_lo = ph; a.ph_hi = ph + 1; hipLaunchKernelGGL(fwd, dim3(grid), dim3(NTHREADS), LDS_BYTES, stream, a); }
#endif
}
```

```cpp
#include <hip/hip_runtime.h>
#include <cstdio>
#include <cstdint>
#include <cmath>
namespace pg8 {
#define PG8_LAS __attribute__((address_space(3)))
typedef unsigned short bf16_t;
typedef short bf16x8 __attribute__((ext_vector_type(8)));
typedef float f32x4 __attribute__((ext_vector_type(4)));
typedef unsigned u32x4 __attribute__((ext_vector_type(4)));
constexpr int BM = 256, BK = 64, HALF = 128, HTB = HALF * BK * 2  , STAGE_BYTES = 8 * HTB, NXCD = 8, WGM = 8;

__host__ __device__ __forceinline__ int lds_byte(int r, int c) { const int st = (r >> 4) * 2 + (c >> 5), rr = r & 15, cc = c & 31, ob = rr * 64 + cc * 2; return st * 1024 + (ob ^ (((ob >> 9) & 1) << 5)); }
__host__ __device__ __forceinline__ void stage_rc(int b, int& R, int& C) { const int st = b / 1024, sb = b % 1024, swz = sb ^ (((sb >> 9) & 1) << 5); R = (st >> 1) * 16 + swz / 64; C = (st & 1) * 32 + (swz % 64) / 2; }
__host__ __device__ __forceinline__ int perm32(int rho) { const int n = rho >> 4, i = rho & 15; return 8 * (i >> 2) + 4 * n + (i & 3); }

struct Unit { int pm, pn; };
struct Gemm { const bf16_t* A; const bf16_t* Bt; int M, N, K; };

struct StaticOrder {
    int nM, nN, nwg, G, c;
    __host__ __device__ void init(int M, int N, int G_, int c_) { nM = M / BM; nN = N / BM; nwg = nM * nN; G = G_; c = c_; }
    __host__ __device__ bool next(int i, Unit& u) const {
        const long L = (long)i * G + c; if (L >= nwg) return false;
        int wgid = (int)L; { const int q = nwg / NXCD, r = nwg % NXCD, xcd = wgid % NXCD, off = wgid / NXCD; wgid = (xcd < r ? xcd * (q + 1) : r * (q + 1) + (xcd - r) * q) + off; }
        const int nig = WGM * nN, gid = wgid / nig, fm = gid * WGM, gsz = (nM - fm) < WGM ? (nM - fm) : WGM;
        u.pm = fm + ((wgid % nig) % gsz); u.pn = (wgid % nig) / gsz; return true;
    }
    __device__ __forceinline__ void a_ready(const Unit&) const {}
    __device__ __forceinline__ void done(const Unit&) const {}
};

__device__ __forceinline__ unsigned cvt_pk_bf16(float lo, float hi) { unsigned r; asm volatile("v_cvt_pk_bf16_f32 %0, %1, %2" : "=v"(r) : "v"(lo), "v"(hi)); return r; }
typedef float f32x2 __attribute__((ext_vector_type(2)));

typedef int i32x4_t __attribute__((ext_vector_type(4)));
typedef int i32x8_t __attribute__((ext_vector_type(8)));
__device__ __forceinline__ f32x4 mfma_fp8(bf16x8 w0, bf16x8 w1, bf16x8 a0, bf16x8 a1, f32x4 c, int sw, int sa) {
    const i32x4_t x0 = __builtin_bit_cast(i32x4_t, w0), x1 = __builtin_bit_cast(i32x4_t, w1), y0 = __builtin_bit_cast(i32x4_t, a0), y1 = __builtin_bit_cast(i32x4_t, a1);
    const i32x8_t X = {x0.x, x0.y, x0.z, x0.w, x1.x, x1.y, x1.z, x1.w}, Y = {y0.x, y0.y, y0.z, y0.w, y1.x, y1.y, y1.z, y1.w};
    return __builtin_amdgcn_mfma_scale_f32_16x16x128_f8f6f4(X, Y, c, 0, 0, 0, sw, 0, sa);
}
template <class Epi, class Sched, bool ALIGN_EPI = false, bool SP2 = false, int FP8W = -1, int FP8A = -1>
__device__ __forceinline__ void gemm_phase(PG8_LAS unsigned char* lds, const Gemm g, const Sched& S, const Epi& E) {
    const int tid = threadIdx.x, wid = __builtin_amdgcn_readfirstlane(tid >> 6), lane = tid & 63, wr = wid >> 2, wc = wid & 3, fr = lane & 15, fq = lane >> 4;
    const int K = g.K, nt = K / BK;
    unsigned voffA[2], voffB[2];
#pragma unroll
    for (int i = 0; i < 2; ++i) { int R, C; stage_rc(tid * 16 + i * 8192, R, C); const int Rb = Epi::PERM ? ((R & ~31) + perm32(R & 31)) : R;
        voffA[i] = (unsigned)(R * K + C) * 2u; voffB[i] = (unsigned)(Rb * K + C) * 2u; }
    const size_t kstep = (size_t)(BK * 2);
    const size_t hstep = (size_t)HALF * K * 2;
    const size_t tstep = 2 * hstep;
    const unsigned ldsw = (unsigned)wid * 1024u;
    const int aoff = lds_byte(wr * 64 + fr, fq * 8), boff = lds_byte(wc * 32 + fr, fq * 8);
#define PG8_SA(b, h) (((b) * 2 + (h)) * HTB)
#define PG8_SB(b, h) ((4 + (b) * 2 + (h)) * HTB)
#define PG8_STAGE(bufoff, gbase, voff) do { _Pragma("unroll") for (int _i = 0; _i < 2; ++_i) \
        __builtin_amdgcn_global_load_lds((const unsigned*)((const char*)(gbase) + (voff)[_i]), (PG8_LAS unsigned*)(lds + (bufoff) + ldsw + _i * 8192), 16, 0, 0); } while (0)
#define PG8_LD8(p) __builtin_shufflevector(*(const PG8_LAS i32x4_t*)(p), *(const PG8_LAS i32x4_t*)((p) + 1024), 0, 1, 2, 3, 4, 5, 6, 7)
#define PG8_LDA(dst, b, h) do { if constexpr (FP8W >= 0) { _Pragma("unroll") for (int m = 0; m < 4; ++m) dst##8[m] = PG8_LD8(lds + PG8_SA(b, h) + aoff + m * 2048); } \
        else { _Pragma("unroll") for (int m = 0; m < 4; ++m) _Pragma("unroll") for (int k = 0; k < 2; ++k) dst[m][k] = *(const PG8_LAS bf16x8*)(lds + PG8_SA(b, h) + aoff + m * 2048 + k * 1024); } } while (0)
#define PG8_LDB(dst, b, h) do { if constexpr (FP8W >= 0) { _Pragma("unroll") for (int n = 0; n < 2; ++n) dst##8[n] = PG8_LD8(lds + PG8_SB(b, h) + boff + n * 2048); } \
        else { _Pragma("unroll") for (int n = 0; n < 2; ++n) _Pragma("unroll") for (int k = 0; k < 2; ++k) dst[n][k] = *(const PG8_LAS bf16x8*)(lds + PG8_SB(b, h) + boff + n * 2048 + k * 1024); } } while (0)
#define PG8_MMA(ai, bj, At, Bt) do { __builtin_amdgcn_s_setprio(1); _Pragma("unroll") for (int m = 0; m < 4; ++m) _Pragma("unroll") for (int n = 0; n < 2; ++n) { \
        if constexpr (FP8W >= 0) asm volatile("v_mfma_scale_f32_16x16x128_f8f6f4 %0, %1, %2, %0, %3, %4 op_sel_hi:[0,0,0]" : "+v"(acc[ai][bj][m][n]) : "v"(Bt##8[n]), "v"(At##8[m]), "v"(fp8sw), "v"(fp8sa)); \
        else { _Pragma("unroll") for (int k = 0; k < 2; ++k) acc[ai][bj][m][n] = __builtin_amdgcn_mfma_f32_16x16x32_bf16(Bt[n][k], At[m][k], acc[ai][bj][m][n], 0, 0, 0); } } \
        __builtin_amdgcn_s_setprio(0); } while (0)
#define PG8_WAIT_V(n) asm volatile("s_waitcnt vmcnt(" #n ")" ::: "memory")
#define PG8_WAIT_L(n) asm volatile("s_waitcnt lgkmcnt(" #n ")" ::: "memory")
#define PG8_BAR __builtin_amdgcn_s_barrier()
#define PG8_SCHED __builtin_amdgcn_sched_barrier(0)
    Unit cur, nxt; int ui = 0;
    if (!S.next(0, cur)) return;
    f32x4 acc[2][2][4][2];
#pragma unroll
    for (int a = 0; a < 2; ++a)
#pragma unroll
        for (int b = 0; b < 2; ++b)
#pragma unroll
            for (int m = 0; m < 4; ++m)
#pragma unroll
                for (int n = 0; n < 2; ++n) acc[a][b][m][n] = (f32x4){0.f, 0.f, 0.f, 0.f};
    const int fp8sw = FP8W, fp8sa = FP8A; (void)fp8sw; (void)fp8sa;
    bf16x8 At[4][2], B0[2][2], B1[2][2]; i32x8_t At8[4], B08[2], B18[2];
    const char* cA = (const char*)g.A + (size_t)cur.pm * tstep; const char* cB = (const char*)g.Bt + (size_t)cur.pn * tstep;
    S.a_ready(cur);
    if constexpr (SP2) {
        PG8_STAGE(PG8_SB(0, 0), cB, voffB); PG8_STAGE(PG8_SB(0, 1), cB + hstep, voffB); PG8_STAGE(PG8_SA(0, 0), cA, voffA); PG8_STAGE(PG8_SA(0, 1), cA + hstep, voffA);
        if (wr == 1) PG8_BAR;
        PG8_WAIT_V(2); PG8_BAR;
        PG8_STAGE(PG8_SB(1, 0), cB + kstep, voffB); PG8_STAGE(PG8_SA(1, 0), cA + kstep, voffA); PG8_STAGE(PG8_SB(1, 1), cB + hstep + kstep, voffB);
        PG8_WAIT_V(6); PG8_BAR;
    } else {
        PG8_STAGE(PG8_SB(0, 0), cB, voffB); PG8_STAGE(PG8_SA(0, 0), cA, voffA); PG8_STAGE(PG8_SB(0, 1), cB + hstep, voffB); PG8_STAGE(PG8_SA(0, 1), cA + hstep, voffA);
        if (wr == 1) PG8_BAR;
        PG8_WAIT_V(4); PG8_BAR;
        PG8_STAGE(PG8_SB(1, 0), cB + kstep, voffB); PG8_STAGE(PG8_SA(1, 0), cA + kstep, voffA); PG8_STAGE(PG8_SB(1, 1), cB + hstep + kstep, voffB);
        PG8_WAIT_V(6); PG8_BAR;
    }
    for (;;) {
        const bool has_next = S.next(ui + 1, nxt);
        const char* nA = has_next ? (const char*)g.A + (size_t)nxt.pm * tstep : cA; const char* nB = has_next ? (const char*)g.Bt + (size_t)nxt.pn * tstep : cB;
        for (int t = 0; t < nt; t += 2) {
            const bool last = (t == nt - 2);
            const char* a1 = cA + (size_t)(t + 1) * kstep;
            const char* a2 = last ? nA : cA + (size_t)(t + 2) * kstep; const char* b2 = last ? nB : cB + (size_t)(t + 2) * kstep;
            const char* a3 = a2 + kstep; const char* b3 = b2 + kstep;
            if (last && has_next) S.a_ready(nxt);
            if constexpr (SP2) {
            PG8_LDB(B0, 0, 0); PG8_LDB(B1, 0, 1); PG8_SCHED; PG8_LDA(At, 0, 0); PG8_STAGE(PG8_SA(1, 1), a1 + hstep, voffA);
            PG8_WAIT_V(8); PG8_WAIT_L(0); PG8_BAR; PG8_MMA(0, 0, At, B0); PG8_MMA(0, 1, At, B1); PG8_BAR; PG8_SCHED;
            PG8_LDA(At, 0, 1); PG8_STAGE(PG8_SB(0, 0), b2, voffB); PG8_STAGE(PG8_SB(0, 1), b2 + hstep, voffB); PG8_STAGE(PG8_SA(0, 0), a2, voffA);
            PG8_WAIT_V(8); PG8_WAIT_L(0); PG8_BAR; PG8_MMA(1, 0, At, B0); PG8_MMA(1, 1, At, B1); PG8_BAR; PG8_SCHED;
            PG8_LDB(B0, 1, 0); PG8_LDB(B1, 1, 1); PG8_SCHED; PG8_LDA(At, 1, 0); PG8_STAGE(PG8_SA(0, 1), a2 + hstep, voffA);
            PG8_WAIT_V(8); PG8_WAIT_L(0); PG8_BAR; PG8_MMA(0, 0, At, B0); PG8_MMA(0, 1, At, B1); PG8_BAR; PG8_SCHED;
            PG8_LDA(At, 1, 1); PG8_STAGE(PG8_SB(1, 0), b3, voffB); PG8_STAGE(PG8_SB(1, 1), b3 + hstep, voffB); PG8_STAGE(PG8_SA(1, 0), a3, voffA);
            PG8_WAIT_V(8); PG8_WAIT_L(0); PG8_BAR; PG8_MMA(1, 0, At, B0); PG8_MMA(1, 1, At, B1); PG8_BAR; PG8_SCHED;
            } else {
            PG8_LDB(B0, 0, 0); PG8_SCHED; PG8_LDA(At, 0, 0); PG8_STAGE(PG8_SA(1, 1), a1 + hstep, voffA);
            PG8_WAIT_L(8); PG8_BAR; PG8_WAIT_L(0); PG8_MMA(0, 0, At, B0); PG8_BAR; PG8_SCHED;
            PG8_LDB(B1, 0, 1); PG8_STAGE(PG8_SB(0, 0), b2, voffB);
            PG8_BAR; PG8_WAIT_L(0); PG8_MMA(0, 1, At, B1); PG8_BAR;
            PG8_LDA(At, 0, 1); PG8_STAGE(PG8_SA(0, 0), a2, voffA);
            PG8_BAR; PG8_WAIT_L(0); PG8_MMA(1, 0, At, B0); PG8_BAR; PG8_SCHED;
            PG8_STAGE(PG8_SB(0, 1), b2 + hstep, voffB);
            PG8_WAIT_V(6); PG8_BAR; PG8_MMA(1, 1, At, B1); PG8_BAR;
            PG8_LDB(B0, 1, 0); PG8_SCHED; PG8_LDA(At, 1, 0); PG8_STAGE(PG8_SA(0, 1), a2 + hstep, voffA);
            PG8_WAIT_L(8); PG8_BAR; PG8_WAIT_L(0); PG8_MMA(0, 0, At, B0); PG8_BAR; PG8_SCHED;
            PG8_LDB(B1, 1, 1); PG8_STAGE(PG8_SB(1, 0), b3, voffB);
            PG8_BAR; PG8_WAIT_L(0); PG8_MMA(0, 1, At, B1); PG8_BAR;
            PG8_LDA(At, 1, 1); PG8_STAGE(PG8_SA(1, 0), a3, voffA);
            PG8_BAR; PG8_WAIT_L(0); PG8_MMA(1, 0, At, B0); PG8_BAR; PG8_SCHED;
            PG8_STAGE(PG8_SB(1, 1), b3 + hstep, voffB);
            PG8_WAIT_V(6); PG8_BAR; PG8_MMA(1, 1, At, B1); PG8_BAR;
            }
        }
        if constexpr (FP8W >= 0) asm volatile("s_nop 15\n\ts_nop 15" ::: "memory");
        if constexpr (ALIGN_EPI) { if (wr == 0) PG8_BAR; }
        if constexpr (!Epi::AFTER_DRAIN) { E(acc, cur, wr, wc, fr, fq); S.done(cur); }
        if (!has_next) break;
#pragma unroll
        for (int a = 0; a < 2; ++a)
#pragma unroll
            for (int b = 0; b < 2; ++b)
#pragma unroll
                for (int m = 0; m < 4; ++m)
#pragma unroll
                    for (int n = 0; n < 2; ++n) acc[a][b][m][n] = (f32x4){0.f, 0.f, 0.f, 0.f};
        cur = nxt; cA = nA; cB = nB; ++ui;
        if constexpr (ALIGN_EPI) { if (wr == 1) PG8_BAR; }
    }
    PG8_WAIT_V(0);
    if constexpr (!ALIGN_EPI) { if (wr == 0) PG8_BAR; }
    PG8_BAR;
    if constexpr (Epi::AFTER_DRAIN) { E.fused(acc, cur, wr, wc, fr, fq, lds, wid, lane); S.done(cur); }
#undef PG8_SA
#undef PG8_SB
#undef PG8_STAGE
#undef PG8_LD8
#undef PG8_LDA
#undef PG8_LDB
#undef PG8_MMA
#undef PG8_WAIT_V
#undef PG8_WAIT_L
#undef PG8_BAR
#undef PG8_SCHED
}
}


constexpr int NB = 4, SEQ = 4096, T = NB * SEQ, D = 2048;
constexpr int RW = 1024, NH = 16, HD = 64;
constexpr int IN_W = 12064, SHIFT_W = 3360;
constexpr int ZPW = 3584, QKVW = 4608, GATEW = 4096, NPROJ = 12288;
constexpr int NE = 32, FF = 2048;
constexpr int XS_ROWS = T * 4 + NE * 256;
constexpr int NWAVES = 8, NTHREADS = 512;
constexpr float NORM_EPS = 1e-5f, GN_EPS = 64e-5f;
constexpr float QSCALE = 0.08838834764831845f * 1.4426950408889634f;

#ifndef MK_ONE_LAUNCH
#define MK_ONE_LAUNCH 1
#endif
constexpr int NPHASES = 14;

constexpr size_t MiB = 1ull << 20;
constexpr size_t WS_CTL = 0, CTL_ZERO_BYTES = 1 * MiB;
constexpr size_t WS_WIN = 1 * MiB;
constexpr size_t WS_W1 = WS_WIN + 48 * MiB;
constexpr size_t WS_W2 = WS_W1 + 512 * MiB;
constexpr size_t WS_WOR = WS_W2 + 256 * MiB;
constexpr size_t WS_WOA = WS_WOR + 4 * MiB;
constexpr size_t WS_WOUT = WS_WOA + 2 * MiB;
constexpr size_t WS_H = WS_WOUT + 8 * MiB;
constexpr size_t WS_ZP = WS_H + 64 * MiB;
constexpr size_t WS_QKV = WS_ZP + 112 * MiB;
constexpr size_t WS_GATES = WS_QKV + 144 * MiB;
constexpr size_t WS_ROT = WS_GATES + 128 * MiB;
constexpr size_t WS_SC = WS_ROT + 2 * MiB;
constexpr size_t WS_G = WS_SC + 384 * MiB;
constexpr size_t WS_BONUS = WS_G + 32 * MiB;
constexpr size_t WS_Y = WS_BONUS + 1 * MiB;
constexpr size_t WS_ATTO = WS_Y + 64 * MiB;
constexpr size_t WS_ATTML = WS_ATTO + 48 * MiB;
constexpr size_t WS_YAIN = WS_ATTML + 2 * MiB;
constexpr size_t WS_OIN = WS_YAIN + 32 * MiB;
constexpr size_t WS_MERGED = WS_OIN + 16 * MiB;
constexpr size_t WS_X1 = WS_MERGED + 64 * MiB;
constexpr size_t WS_TOPK = WS_X1 + 128 * MiB;
constexpr size_t WS_ROWS = WS_TOPK + 1 * MiB;
constexpr size_t WS_XS = WS_ROWS + 1 * MiB;
constexpr size_t WS_ACT = WS_XS + 288 * MiB;
constexpr size_t WS_OUTK = WS_ACT + 288 * MiB;
constexpr size_t WS_LORA = WS_OUTK + 256 * MiB;
constexpr size_t WS_END = WS_LORA + 1 * MiB;
constexpr size_t WS_S1 = WS_XS;
constexpr int NU16 = NB * NH * (SEQ / 16);
constexpr size_t S1_WH = 0, S1_QH = 32 * MiB, S1_BT = 64 * MiB, S1_KT = 96 * MiB, S1_VT = 128 * MiB, S1_U0T = 160 * MiB, S1_Y0T = 224 * MiB, S1_GAM = 288 * MiB;
constexpr size_t SC_STRIDE = (size_t)T * RW;
enum { SC_KK = 0, SC_W = 1, SC_BB = 2, SC_K = 3, SC_R = 4, SC_V = 5 };

constexpr int CW_TMO = 0, CW_CODE = 1, CW_BAR = 4096, CW_CNT = 8192;

constexpr int RING_BYTES = 131072;
constexpr int TAB_OFF = RING_BYTES;
constexpr int MISC_OFF = TAB_OFF + 512;
constexpr int LDS_BYTES = 147456;

#define GAS __attribute__((address_space(1)))
#define LAS __attribute__((address_space(3)))
typedef unsigned short bf16;
typedef unsigned u32x4 __attribute__((ext_vector_type(4)));
typedef unsigned u32x2 __attribute__((ext_vector_type(2)));
typedef float f32x4 __attribute__((ext_vector_type(4)));
typedef short bf16x8 __attribute__((ext_vector_type(8)));
typedef short bf16x4 __attribute__((ext_vector_type(4)));
typedef GAS unsigned gu32;
#define RLX_AGENT __ATOMIC_RELAXED, __HIP_MEMORY_SCOPE_AGENT
#define LDS_WAIT() asm volatile("s_waitcnt lgkmcnt(0)" ::: "memory")
#define VM_WAIT() asm volatile("s_waitcnt vmcnt(0)" ::: "memory")
__device__ __forceinline__ unsigned f2bf(float f) { unsigned u = __builtin_bit_cast(unsigned, f); return (u + 0x7fffu + ((u >> 16) & 1u)) >> 16; }
__device__ __forceinline__ unsigned pk2(float lo, float hi) { return f2bf(lo) | (f2bf(hi) << 16); }
__device__ __forceinline__ float bflo(unsigned w) { return __uint_as_float(w << 16); }
__device__ __forceinline__ float bfhi(unsigned w) { return __uint_as_float(w & 0xffff0000u); }
__device__ __forceinline__ float bf2f(bf16 h) { return __uint_as_float((unsigned)h << 16); }
__device__ __forceinline__ float sigmoidf_(float x) { return 1.0f / (1.0f + __expf(-x)); }
__device__ __forceinline__ float wave_sum(float v) {
#pragma unroll
    for (int o = 1; o < 64; o <<= 1) v += __shfl_xor(v, o);
    return v;
}
__device__ __forceinline__ unsigned pk4_fp8(float a, float b, float c, float d) { int r = __builtin_amdgcn_cvt_pk_fp8_f32(a, b, 0, false); r = __builtin_amdgcn_cvt_pk_fp8_f32(c, d, r, true); return (unsigned)r; }
__device__ __forceinline__ u32x4 pack8(const f32x4& a, const f32x4& b) { u32x4 w; w.x = pk2(a[0], a[1]); w.y = pk2(a[2], a[3]); w.z = pk2(b[0], b[1]); w.w = pk2(b[2], b[3]); return w; }
__device__ __forceinline__ void unpack8(const u32x4& w, f32x4& a, f32x4& b) { a = (f32x4){bflo(w.x), bfhi(w.x), bflo(w.y), bfhi(w.y)}; b = (f32x4){bflo(w.z), bfhi(w.z), bflo(w.w), bfhi(w.w)}; }

#define XB_TMO      128
#define XB_XCNT(j)  (256  + 64 * (j))
#define XB_XSUB(j)  (1280 + 64 * (j))
#define XB_XGEN(j)  (2304 + 64 * (j))
#define XB_TOP      3328
#define XB_TOPGEN   3392
#define XCD_BAR_WORDS 3456
#define XB_SPIN_CAP (1u << 18)

__device__ __forceinline__ unsigned xb_ld(unsigned* p)              { return __hip_atomic_load(p, __ATOMIC_RELAXED, __HIP_MEMORY_SCOPE_AGENT); }
__device__ __forceinline__ unsigned xb_add(unsigned* p, unsigned v) { return __hip_atomic_fetch_add(p, v, __ATOMIC_RELAXED, __HIP_MEMORY_SCOPE_AGENT); }
__device__ __forceinline__ unsigned xb_xcc_id() { return (unsigned)__builtin_amdgcn_s_getreg((3 << 11) | 20) & 0xFu; }
#define XB_SPIN(cond, bar) do { unsigned _sp = 0; while (cond) { __builtin_amdgcn_s_sleep(1); \
    if ((++_sp & 255u) == 0u) { if (xb_ld(&(bar)[XB_TMO])) break; if (_sp > XB_SPIN_CAP) { atomicAdd(&(bar)[XB_TMO], 1u); break; } } } } while (0)

struct XcdBarrier {
    unsigned* bar; unsigned x;
    volatile LAS unsigned* st;
};

__device__ __forceinline__ XcdBarrier xcd_barrier_post(unsigned* bar, volatile LAS unsigned* st) {
    XcdBarrier b; b.bar = bar; b.x = xb_xcc_id(); b.st = st;
    if (threadIdx.x == 0) (void)xb_add(&bar[XB_XCNT(b.x)], 1u);
    return b;
}
__device__ __forceinline__ void xcd_barrier_complete(unsigned* bar, unsigned x, unsigned& nloc, unsigned& nx) {
    const unsigned G = gridDim.x * gridDim.y * gridDim.z;
    unsigned sum, cnt, mine, sp = 0u;
    for (;;) {
        sum = 0u; cnt = 0u; mine = 0u;
#pragma unroll
        for (unsigned j = 0; j < 16; ++j) { const unsigned c = xb_ld(&bar[XB_XCNT(j)]); sum += c; cnt += (c > 0u) ? 1u : 0u; mine = (j == x) ? c : mine; }
        if (sum == G) break;
        __builtin_amdgcn_s_sleep(1);
        if ((++sp & 255u) == 0u) { if (xb_ld(&bar[XB_TMO])) break; if (sp > XB_SPIN_CAP) { atomicAdd(&bar[XB_TMO], 1u); break; } }
    }
    nloc = mine > 0u ? mine : 1u; nx = cnt > 0u ? cnt : 1u;
}

__device__ __forceinline__ void xcd_barrier(const XcdBarrier& b) {
    asm volatile("s_waitcnt vmcnt(0)" ::: "memory");
    __syncthreads();
    if (threadIdx.x == 0) {
        unsigned* bar = b.bar;
        __builtin_amdgcn_s_waitcnt(0);
        unsigned nloc = b.st[0], nx = b.st[1];
        if (nloc == 0u) { xcd_barrier_complete(bar, b.x, nloc, nx); b.st[0] = nloc; b.st[1] = nx; }
        const unsigned old = xb_add(&bar[XB_XSUB(b.x)], 1u);
        const unsigned gen = old / nloc;
        if (old + 1u == (gen + 1u) * nloc) {
            __builtin_amdgcn_fence(__ATOMIC_RELEASE, "agent");
            asm volatile("s_waitcnt vmcnt(0)" ::: "memory");
            const unsigned og = xb_add(&bar[XB_TOP], 1u);
            const unsigned tg = og / nx;
            if (og + 1u == (tg + 1u) * nx) xb_add(&bar[XB_TOPGEN], 1u);
            else XB_SPIN(xb_ld(&bar[XB_TOPGEN]) == tg, bar);
            __builtin_amdgcn_fence(__ATOMIC_ACQUIRE, "agent");
            xb_add(&bar[XB_XGEN(b.x)], 1u);
            asm volatile("s_waitcnt vmcnt(0)" ::: "memory");
        } else {
            XB_SPIN(xb_ld(&bar[XB_XGEN(b.x)]) == gen, bar);
            __builtin_amdgcn_fence(__ATOMIC_ACQUIRE, "agent");
            asm volatile("s_waitcnt vmcnt(0)" ::: "memory");
        }
    }
    __syncthreads();
}


struct Ptrs {
    const float *x, *norm_mix, *w_in, *shift_mu, *w0, *w2_decay, *a0, *a2_iclr, *g2_gate, *k_k, *k_a, *r_k, *ln_x_w, *ln_x_b, *w_o_rwkv, *w_o_attn, *w_out, *norm_ffn, *w_router, *b_router, *w1, *b1, *w2, *b2, *norm_final;
    const int* positions;
    float* out;
    bf16 *LW, *LA, *LG, *WIN, *W1, *W2, *WOR, *WOA, *WOUT, *H, *ZP, *QKV, *GATES, *G, *ATTO, *YAIN, *OIN, *MERGED, *XS, *ACT, *OUTK;
    float *ROT, *SC, *BONUS, *Y, *ATTML, *X1, *TOPK_GATE, *ROWGATE;
    int *TOPK_E, *TOPK_POS, *ROWTOK;
    gu32* ctl;
};

using pg8::Unit;
__device__ __forceinline__ void store8(bf16* p, const f32x4& a, const f32x4& b) { *(u32x4*)p = pack8(a, b); }

struct EpiProj {
    static constexpr bool PERM = true, AFTER_DRAIN = false;
    bf16* ZP; bf16* QKV; bf16* GATES; const float* ROT;
    __device__ __forceinline__ void operator()(const f32x4 (&acc)[2][2][4][2], const Unit& u, int wr, int wc, int fr, int fq) const {
        const int pn = u.pn, rbase = u.pm * 256 + wr * 64 + fr, cw = wc * 32 + 8 * fq;
        if (pn < 14) {
#pragma unroll
            for (int ai = 0; ai < 2; ++ai)
#pragma unroll
                for (int m = 0; m < 4; ++m) { bf16* rp = ZP + (size_t)(rbase + ai * 128 + m * 16) * ZPW + pn * 256 + cw;
#pragma unroll
                    for (int bj = 0; bj < 2; ++bj) store8(rp + bj * 128, acc[ai][bj][m][0], acc[ai][bj][m][1]); }
        } else if (pn < 32) {
            const int t = pn - 14; const bool rot = (t < 12) && (wc == 0); const float sc = (t < 6) ? QSCALE : 1.0f; const float sg = (fq < 2) ? -1.0f : 1.0f;
#pragma unroll
            for (int ai = 0; ai < 2; ++ai)
#pragma unroll
                for (int m = 0; m < 4; ++m) { const int row = rbase + ai * 128 + m * 16; bf16* rp = QKV + (size_t)row * QKVW + t * 256 + cw;
                    f32x4 c0 = {1.f, 1.f, 1.f, 1.f}, c1 = c0, s0 = {0.f, 0.f, 0.f, 0.f}, s1 = s0;
                    if (rot) { const float* rt = ROT + (size_t)row * 32 + 8 * (fq & 1); c0 = *(const f32x4*)rt; c1 = *(const f32x4*)(rt + 4); s0 = *(const f32x4*)(rt + 16); s1 = *(const f32x4*)(rt + 20); }
#pragma unroll
                    for (int bj = 0; bj < 2; ++bj) { f32x4 v0 = acc[ai][bj][m][0], v1 = acc[ai][bj][m][1];
                        if (rot) { f32x4 p0, p1;
#pragma unroll
                            for (int j = 0; j < 4; ++j) { p0[j] = __shfl_xor(v0[j], 32); p1[j] = __shfl_xor(v1[j], 32); }
                            v0 = v0 * c0 + (p0 * s0) * sg; v1 = v1 * c1 + (p1 * s1) * sg; }
                        v0 = v0 * sc; v1 = v1 * sc; store8(rp + bj * 128, v0, v1); } }
        } else {
            const int t = pn - 32;
#pragma unroll
            for (int ai = 0; ai < 2; ++ai)
#pragma unroll
                for (int m = 0; m < 4; ++m) { bf16* rp = GATES + (size_t)(rbase + ai * 128 + m * 16) * GATEW + t * 256 + cw;
#pragma unroll
                    for (int bj = 0; bj < 2; ++bj) { f32x4 v0 = acc[ai][bj][m][0], v1 = acc[ai][bj][m][1];
#pragma unroll
                        for (int j = 0; j < 4; ++j) { v0[j] = sigmoidf_(v0[j]); v1[j] = sigmoidf_(v1[j]); }
                        store8(rp + bj * 128, v0, v1); } }
        }
    }
};

template <int STAGE> struct EpiMerge {
    static constexpr bool PERM = true, AFTER_DRAIN = false;
    bf16* MERGED; const bf16* GATES;
    __device__ __forceinline__ void operator()(const f32x4 (&acc)[2][2][4][2], const Unit& u, int wr, int wc, int fr, int fq) const {
        const int rbase = u.pm * 256 + wr * 64 + fr, cb = u.pn * 256 + wc * 32 + 8 * fq;
#pragma unroll
        for (int ai = 0; ai < 2; ++ai)
#pragma unroll
            for (int m = 0; m < 4; ++m) { const int row = rbase + ai * 128 + m * 16;
#pragma unroll
                for (int bj = 0; bj < 2; ++bj) { const int col = cb + bj * 128;
                    const u32x4 gw = *(const u32x4*)(GATES + (size_t)row * GATEW + STAGE * 2048 + col); f32x4 g0, g1; unpack8(gw, g0, g1);
                    f32x4 v0 = acc[ai][bj][m][0] * g0, v1 = acc[ai][bj][m][1] * g1; bf16* dp = MERGED + (size_t)row * D + col;
                    if (STAGE == 1) { const u32x4 tw = *(const u32x4*)dp; f32x4 t0, t1; unpack8(tw, t0, t1); v0 = v0 + t0; v1 = v1 + t1; }
                    store8(dp, v0, v1); } }
    }
};

struct EpiResid {
    static constexpr bool PERM = false, AFTER_DRAIN = false;
    const float* X; float* X1;
    __device__ __forceinline__ void operator()(const f32x4 (&acc)[2][2][4][2], const Unit& u, int wr, int wc, int fr, int fq) const {
        const int rbase = u.pm * 256 + wr * 64 + fr, cb = u.pn * 256 + wc * 32 + 4 * fq;
#pragma unroll
        for (int ai = 0; ai < 2; ++ai)
#pragma unroll
            for (int m = 0; m < 4; ++m) { const size_t ro = (size_t)(rbase + ai * 128 + m * 16) * D;
#pragma unroll
                for (int bj = 0; bj < 2; ++bj)
#pragma unroll
                    for (int n = 0; n < 2; ++n) { const int col = cb + bj * 128 + n * 16; *(f32x4*)(X1 + ro + col) = *(const f32x4*)(X + ro + col) + acc[ai][bj][m][n]; } }
    }
};

struct EpiMoe1 {
    static constexpr bool PERM = true, AFTER_DRAIN = false;
    bf16* ACT; const float* b1;
    __device__ __forceinline__ void operator()(const f32x4 (&acc)[2][2][4][2], const Unit& u, int wr, int wc, int fr, int fq) const {
        const int e = u.pn >> 4, pnl = u.pn & 15, rbase = u.pm * 256 + wr * 64 + fr, col = pnl * 128 + wc * 32 + 8 * fq;
        const float* bg = b1 + (size_t)e * 4096 + col; const float* bl = bg + 2048;
        const f32x4 bg0 = *(const f32x4*)bg, bg1 = *(const f32x4*)(bg + 4), bl0 = *(const f32x4*)bl, bl1 = *(const f32x4*)(bl + 4);
#pragma unroll
        for (int ai = 0; ai < 2; ++ai)
#pragma unroll
            for (int m = 0; m < 4; ++m) { const int row = rbase + ai * 128 + m * 16;
                f32x4 g0 = acc[ai][0][m][0] + bg0, g1 = acc[ai][0][m][1] + bg1, l0 = acc[ai][1][m][0] + bl0, l1 = acc[ai][1][m][1] + bl1, o0, o1;
#pragma unroll
                for (int j = 0; j < 4; ++j) {
                    { const float xg = fminf(g0[j], 7.0f), xl = fminf(fmaxf(l0[j], -7.0f), 7.0f); o0[j] = xg * sigmoidf_(1.702f * xg) * (xl + 1.0f); }
                    { const float xg = fminf(g1[j], 7.0f), xl = fminf(fmaxf(l1[j], -7.0f), 7.0f); o1[j] = xg * sigmoidf_(1.702f * xg) * (xl + 1.0f); } }
                u32x2 w8; w8.x = pk4_fp8(o0[0] * 8.0f, o0[1] * 8.0f, o0[2] * 8.0f, o0[3] * 8.0f); w8.y = pk4_fp8(o1[0] * 8.0f, o1[1] * 8.0f, o1[2] * 8.0f, o1[3] * 8.0f);
                *(u32x2*)((unsigned char*)ACT + (size_t)row * FF + col) = w8; }
    }
};

struct EpiMoe2 {
    static constexpr bool PERM = true, AFTER_DRAIN = false;
    bf16* OUTK; const float* b2; const int* ROWTOK; const float* ROWGATE;
    __device__ __forceinline__ void operator()(const f32x4 (&acc)[2][2][4][2], const Unit& u, int wr, int wc, int fr, int fq) const {
        const int e = u.pn >> 3, pnl = u.pn & 7, rbase = u.pm * 256 + wr * 64 + fr, cb = pnl * 256 + wc * 32 + 8 * fq;
        f32x4 bv[2][2];
#pragma unroll
        for (int bj = 0; bj < 2; ++bj) { const float* bp = b2 + (size_t)e * D + cb + bj * 128; bv[bj][0] = *(const f32x4*)bp; bv[bj][1] = *(const f32x4*)(bp + 4); }
#pragma unroll
        for (int ai = 0; ai < 2; ++ai)
#pragma unroll
            for (int m = 0; m < 4; ++m) { const int row = rbase + ai * 128 + m * 16; const int p = ROWTOK[row];
                if (p >= 0) { const float gt = ROWGATE[row];
#pragma unroll
                    for (int bj = 0; bj < 2; ++bj) { const f32x4 v0 = (acc[ai][bj][m][0] + bv[bj][0]) * gt, v1 = (acc[ai][bj][m][1] + bv[bj][1]) * gt; store8(OUTK + (size_t)p * D + cb + bj * 128, v0, v1); } } }
    }
};

struct MoeOrder {
    const LAS int* toff; int npn, G, c;
    __device__ __forceinline__ bool next(int i, Unit& u) const {
        const int L = i * G + c, NT = toff[32];
        if (L >= NT * npn) return false;
        int e = 0;
#pragma unroll 1
        for (int j = 1; j < 32; ++j) e += (L >= toff[j] * npn) ? 1 : 0;
        const int t0 = toff[e], te = toff[e + 1] - t0, rem = L - t0 * npn;
        const int pnl = rem / te, pml = rem - pnl * te;
        u.pm = __builtin_amdgcn_readfirstlane(t0 + pml); u.pn = __builtin_amdgcn_readfirstlane(e * npn + pnl); return true;
    }
    __device__ __forceinline__ void a_ready(const Unit&) const {}
    __device__ __forceinline__ void done(const Unit&) const {}
};

__device__ __forceinline__ void tr_item(const float* src, int ldn, int k0, int c0, bf16* dst, size_t dstrow0, int K, LAS float* scr, int lane) {
    f32x4 v[8];
#pragma unroll
    for (int i = 0; i < 8; ++i) v[i] = *(const GAS f32x4*)(src + (size_t)(k0 + 8 * i + (lane >> 3)) * ldn + c0 + 4 * (lane & 7));
#pragma unroll
    for (int i = 0; i < 8; ++i) { LAS float* p = scr + (8 * i + (lane >> 3)) * 33 + 4 * (lane & 7); p[0] = v[i].x; p[1] = v[i].y; p[2] = v[i].z; p[3] = v[i].w; }
    LDS_WAIT(); asm volatile("" ::: "memory");
    const int c = lane & 7;
#pragma unroll
    for (int j = 0; j < 4; ++j) { const int n = (lane >> 3) + 8 * j; const LAS float* s = scr + (8 * c) * 33 + n;
        u32x4 o; o.x = pk2(s[0 * 33], s[1 * 33]); o.y = pk2(s[2 * 33], s[3 * 33]); o.z = pk2(s[4 * 33], s[5 * 33]); o.w = pk2(s[6 * 33], s[7 * 33]);
        *(GAS u32x4*)(dst + (dstrow0 + n) * (size_t)K + k0 + 8 * c) = o; }
    LDS_WAIT(); asm volatile("" ::: "memory");
}
__device__ __forceinline__ void tr_item8(const float* src, int ldn, int k0, int c0, unsigned char* dst, size_t dstrow0, int K, float sc, LAS float* scr, int lane) {
    f32x4 v[8];
#pragma unroll
    for (int i = 0; i < 8; ++i) v[i] = *(const GAS f32x4*)(src + (size_t)(k0 + 8 * i + (lane >> 3)) * ldn + c0 + 4 * (lane & 7));
#pragma unroll
    for (int i = 0; i < 8; ++i) { LAS float* p = scr + (8 * i + (lane >> 3)) * 33 + 4 * (lane & 7); p[0] = v[i].x * sc; p[1] = v[i].y * sc; p[2] = v[i].z * sc; p[3] = v[i].w * sc; }
    LDS_WAIT(); asm volatile("" ::: "memory");
    const int c = lane & 7;
#pragma unroll
    for (int j = 0; j < 4; ++j) { const int n = (lane >> 3) + 8 * j; const LAS float* s = scr + (8 * c) * 33 + n;
        u32x2 o; o.x = pk4_fp8(s[0 * 33], s[1 * 33], s[2 * 33], s[3 * 33]); o.y = pk4_fp8(s[4 * 33], s[5 * 33], s[6 * 33], s[7 * 33]);
        *(GAS u32x2*)(dst + (dstrow0 + n) * (size_t)K + k0 + 8 * c) = o; }
    LDS_WAIT(); asm volatile("" ::: "memory");
}
__device__ __forceinline__ void rms_row_to_bf16(const float* xrow, const float* g, bf16* orow, int lane) {
    f32x4 v[8]; float s = 0.f;
#pragma unroll
    for (int j = 0; j < 8; ++j) { v[j] = *(const GAS f32x4*)(xrow + 4 * lane + 256 * j); s += (v[j].x * v[j].x + v[j].y * v[j].y) + (v[j].z * v[j].z + v[j].w * v[j].w); }
    const float rs = 1.0f / sqrtf(wave_sum(s) * (1.0f / D) + NORM_EPS);
#pragma unroll
    for (int j = 0; j < 8; ++j) { const f32x4 gv = *(const GAS f32x4*)(g + 4 * lane + 256 * j); u32x2 w; w.x = pk2(v[j].x * rs * gv.x, v[j].y * rs * gv.y); w.y = pk2(v[j].z * rs * gv.z, v[j].w * rs * gv.w);
        *(GAS u32x2*)(orow + 4 * lane + 256 * j) = w; }
}
__device__ __forceinline__ void p0_prologue(const Ptrs& P, LAS unsigned char* lds, int tid, int wave, int lane) {
    LAS float* scr = (LAS float*)(lds + wave * 8704);
    const int gw = blockIdx.x * NWAVES + wave, NGW = gridDim.x * NWAVES;
    constexpr int I_IN = 32 * 377, I_W1 = NE * 32 * 128, I_W2 = NE * 32 * 64, I_OR = 16 * 64, I_OA = 8 * 64, I_OUT = 32 * 64;
    constexpr int NITEMS = I_IN + I_W1 + I_W2 + I_OR + I_OA + I_OUT;
    for (int it = gw; it < NITEMS; it += NGW) {
        int r = it;
        if (r < I_IN) { const int kb = r / 377, nb = r % 377, c0 = 32 * nb; tr_item(P.w_in, IN_W, 64 * kb, c0, P.WIN, (size_t)(c0 < SHIFT_W ? c0 : c0 + 224), D, scr, lane); continue; }
        r -= I_IN;
        if (r < I_W1) { const int e = r >> 12, q = r & 4095, kb = q >> 7, nb = q & 127, c0 = 32 * nb;
            tr_item8(P.w1 + (size_t)e * D * 4096, 4096, 64 * kb, c0, (unsigned char*)P.W1, (size_t)e * 4096 + ((c0 & 2047) >> 7) * 256 + (c0 >> 11) * 128 + (c0 & 127), D, 32.0f, scr, lane); continue; }
        r -= I_W1;
        if (r < I_W2) { const int e = r >> 11, q = r & 2047, kb = q >> 6, nb = q & 63; tr_item8(P.w2 + (size_t)e * FF * D, D, 64 * kb, 32 * nb, (unsigned char*)P.W2, (size_t)e * D + 32 * nb, FF, 32.0f, scr, lane); continue; }
        r -= I_W2;
        if (r < I_OR) { const int kb = r >> 6, nb = r & 63; tr_item(P.w_o_rwkv, D, 64 * kb, 32 * nb, P.WOR, (size_t)32 * nb, RW, scr, lane); continue; }
        r -= I_OR;
        if (r < I_OA) { const int kb = r >> 6, nb = r & 63; tr_item(P.w_o_attn, D, 64 * kb, 32 * nb, P.WOA, (size_t)32 * nb, 512, scr, lane); continue; }
        r -= I_OA;
        { const int kb = r >> 6, nb = r & 63; tr_item(P.w_out, D, 64 * kb, 32 * nb, P.WOUT, (size_t)32 * nb, D, scr, lane); }
    }
    { const int gt = blockIdx.x * NTHREADS + tid, NGT = gridDim.x * NTHREADS; GAS u32x4* z = (GAS u32x4*)(P.WIN + (size_t)SHIFT_W * D);
      for (int i = gt; i < 224 * D / 8; i += NGT) z[i] = (u32x4){0u, 0u, 0u, 0u}; }
    { const int gt = blockIdx.x * NTHREADS + tid, NGT = gridDim.x * NTHREADS;
      for (int i = gt; i < 1024 * 64; i += NGT) { const int n = i >> 6, k = i & 63; P.LW[i] = (bf16)f2bf(P.w2_decay[k * RW + n]); P.LA[i] = (bf16)f2bf(P.a2_iclr[k * RW + n]); }
      for (int i = gt; i < 1024 * 160; i += NGT) { const int n = i / 160, k = i - n * 160; P.LG[i] = (bf16)f2bf(P.g2_gate[k * RW + n]); } }
    for (int m = gw; m < T; m += NGW) rms_row_to_bf16(P.x + (size_t)m * D, P.norm_mix, P.H + (size_t)m * D, lane);
    { const int gt = blockIdx.x * NTHREADS + tid, NGT = gridDim.x * NTHREADS;
      for (int i = gt; i < T * 16; i += NGT) { const int m = i >> 4, f = i & 15; const float inv = exp2f(-(float)f * (18.931568569324174f / 16.0f));
          const float ang = (float)P.positions[m] * inv; double rev = (double)ang * 0.15915494309189535; rev -= floor(rev); const float rv = (float)rev; const float sn = __builtin_amdgcn_sinf(rv), cs = __builtin_amdgcn_cosf(rv); P.ROT[(size_t)m * 32 + f] = cs; P.ROT[(size_t)m * 32 + 16 + f] = sn; } }
}

template <int CTRL> __device__ __forceinline__ float dppf(float x) { return __builtin_bit_cast(float, __builtin_amdgcn_mov_dpp(__builtin_bit_cast(int, x), CTRL, 0xf, 0xf, true)); }
__device__ __forceinline__ float sum8(float x) { x += dppf<0xB1>(x); x += dppf<0x4E>(x); x += dppf<0x141>(x); return x; }
__device__ __forceinline__ f32x4 mfma16(bf16x8 a, bf16x8 b, f32x4 c) { return __builtin_amdgcn_mfma_f32_16x16x32_bf16(a, b, c, 0, 0, 0); }
__device__ __forceinline__ void p2_rwkv_prep(const Ptrs& P, LAS unsigned char* lds, int tid, int wave, int lane) {
    constexpr int AWP = 144, AGP = 336, SLP = 196;
    LAS unsigned char* AW = lds; LAS unsigned char* AA = lds + 9216; LAS unsigned char* AG = lds + 18432; LAS float* slab = (LAS float*)(lds + 40960);
    const int fr = lane & 15, fq = lane >> 4;
    for (int u = blockIdx.x; u < T / 64; u += gridDim.x) {
        const int m0 = u * 64;
        __syncthreads();
        for (int item = tid; item < 64 * 36; item += NTHREADS) { const int tk = item / 36, c8 = item - tk * 36, m = m0 + tk, col0 = 3072 + 8 * c8;
            const u32x4 pw = *(const GAS u32x4*)(P.ZP + (size_t)m * ZPW + col0); u32x4 qw = {0u, 0u, 0u, 0u}; if (m % SEQ) qw = *(const GAS u32x4*)(P.ZP + (size_t)(m - 1) * ZPW + col0);
            f32x4 p0, p1, q0, q1; unpack8(pw, p0, p1); unpack8(qw, q0, q1);
            const f32x4 mu0 = *(const GAS f32x4*)(P.shift_mu + col0), mu1 = *(const GAS f32x4*)(P.shift_mu + col0 + 4);
            f32x4 z0 = p0 + (q0 - p0) * mu0, z1 = p1 + (q1 - p1) * mu1;
            if (c8 < 8) {
#pragma unroll
                for (int j = 0; j < 4; ++j) { z0[j] = tanhf(z0[j]); z1[j] = tanhf(z1[j]); }
                *(LAS u32x4*)(AW + tk * AWP + c8 * 16) = pack8(z0, z1);
            } else if (c8 < 16) { *(LAS u32x4*)(AA + tk * AWP + (c8 - 8) * 16) = pack8(z0, z1);
            } else {
#pragma unroll
                for (int j = 0; j < 4; ++j) { z0[j] = sigmoidf_(z0[j]); z1[j] = sigmoidf_(z1[j]); }
                *(LAS u32x4*)(AG + tk * AGP + (c8 - 16) * 16) = pack8(z0, z1); } }
        __syncthreads();
        const int ct = wave & 3, tt0 = (wave >> 2) * 2;
        const int etk = tid >> 3, ec8 = tid & 7, em = m0 + etk; const bool ehasp = (em % SEQ) != 0;
#pragma unroll 1
        for (int h = 0; h < NH; ++h) {
            { const int chrow = h * 64 + ct * 16 + fr;
              f32x4 acc[2][3];
#pragma unroll
              for (int t = 0; t < 2; ++t)
#pragma unroll
                  for (int kd = 0; kd < 3; ++kd) acc[t][kd] = (f32x4){0.f, 0.f, 0.f, 0.f};
#pragma unroll
              for (int ks = 0; ks < 2; ++ks) { const bf16x8 wf = *(const GAS bf16x8*)(P.LW + (size_t)chrow * 64 + ks * 32 + 8 * fq), af = *(const GAS bf16x8*)(P.LA + (size_t)chrow * 64 + ks * 32 + 8 * fq);
#pragma unroll
                  for (int t = 0; t < 2; ++t) { const int tok = (tt0 + t) * 16 + fr;
                      acc[t][0] = mfma16(wf, *(const LAS bf16x8*)(AW + tok * AWP + (ks * 32 + 8 * fq) * 2), acc[t][0]);
                      acc[t][1] = mfma16(af, *(const LAS bf16x8*)(AA + tok * AWP + (ks * 32 + 8 * fq) * 2), acc[t][1]); } }
#pragma unroll
              for (int ks = 0; ks < 5; ++ks) { const bf16x8 gf = *(const GAS bf16x8*)(P.LG + (size_t)chrow * 160 + ks * 32 + 8 * fq);
#pragma unroll
                  for (int t = 0; t < 2; ++t) { const int tok = (tt0 + t) * 16 + fr; acc[t][2] = mfma16(gf, *(const LAS bf16x8*)(AG + tok * AGP + (ks * 32 + 8 * fq) * 2), acc[t][2]); } }
#pragma unroll
              for (int t = 0; t < 2; ++t)
#pragma unroll
                  for (int kd = 0; kd < 3; ++kd) *(LAS f32x4*)(slab + ((tt0 + t) * 16 + fr) * SLP + kd * 64 + ct * 16 + 4 * fq) = acc[t][kd]; }
            __syncthreads();
            { const int ch0 = h * 64 + 8 * ec8; const LAS float* sl = slab + etk * SLP + 8 * ec8;
              const bf16* zp = P.ZP + (size_t)em * ZPW + ch0;
              float rr[8], kv[8], vv[8];
#pragma unroll
              for (int sg = 0; sg < 3; ++sg) { const u32x4 pw = *(const GAS u32x4*)(zp + sg * 1024); u32x4 qw = {0u, 0u, 0u, 0u}; if (ehasp) qw = *(const GAS u32x4*)(zp - ZPW + sg * 1024);
                  f32x4 p0, p1, q0, q1; unpack8(pw, p0, p1); unpack8(qw, q0, q1);
                  const f32x4 mu0 = *(const GAS f32x4*)(P.shift_mu + sg * 1024 + ch0), mu1 = *(const GAS f32x4*)(P.shift_mu + sg * 1024 + ch0 + 4);
                  const f32x4 z0 = p0 + (q0 - p0) * mu0, z1 = p1 + (q1 - p1) * mu1;
#pragma unroll
                  for (int j = 0; j < 4; ++j) { if (sg == 0) { rr[j] = z0[j]; rr[4 + j] = z1[j]; } else if (sg == 1) { kv[j] = z0[j]; kv[4 + j] = z1[j]; } else { vv[j] = z0[j]; vv[4 + j] = z1[j]; } } }
              float dec[8], av[8], gv[8], kkp[8], kn[8]; float ss = 0.f, bon = 0.f;
#pragma unroll
              for (int q = 0; q < 2; ++q) { const f32x4 wr_ = *(const LAS f32x4*)(sl + 4 * q), ap = *(const LAS f32x4*)(sl + 64 + 4 * q), gg = *(const LAS f32x4*)(sl + 128 + 4 * q);
                  const f32x4 w0v = *(const GAS f32x4*)(P.w0 + ch0 + 4 * q), a0v = *(const GAS f32x4*)(P.a0 + ch0 + 4 * q), kkv = *(const GAS f32x4*)(P.k_k + ch0 + 4 * q), kav = *(const GAS f32x4*)(P.k_a + ch0 + 4 * q), rkv = *(const GAS f32x4*)(P.r_k + ch0 + 4 * q);
#pragma unroll
                  for (int j = 0; j < 4; ++j) { const int i = 4 * q + j;
                      dec[i] = __expf(-0.6065306597126334f * sigmoidf_(w0v[j] + wr_[j])); av[i] = sigmoidf_(a0v[j] + ap[j]); gv[i] = gg[j];
                      kkp[i] = kv[i] * kkv[j]; ss += kkp[i] * kkp[i]; kn[i] = kv[i] * (1.0f + (av[i] - 1.0f) * kav[j]); bon += rr[i] * kn[i] * rkv[j]; } }
              ss = sum8(ss); bon = sum8(bon);
              const float rn = 1.0f / fmaxf(sqrtf(ss), 1e-12f);
              const size_t o = (size_t)em * RW + ch0;
              f32x4 t0, t1;
#pragma unroll
              for (int j = 0; j < 4; ++j) { t0[j] = -kkp[j] * rn; t1[j] = -kkp[4 + j] * rn; }
              *(GAS f32x4*)(P.SC + SC_KK * SC_STRIDE + o) = t0; *(GAS f32x4*)(P.SC + SC_KK * SC_STRIDE + o + 4) = t1;
#pragma unroll
              for (int j = 0; j < 4; ++j) { t0[j] = -t0[j] * av[j]; t1[j] = -t1[j] * av[4 + j]; }
              *(GAS f32x4*)(P.SC + SC_BB * SC_STRIDE + o) = t0; *(GAS f32x4*)(P.SC + SC_BB * SC_STRIDE + o + 4) = t1;
              *(GAS f32x4*)(P.SC + SC_W * SC_STRIDE + o) = (f32x4){dec[0], dec[1], dec[2], dec[3]}; *(GAS f32x4*)(P.SC + SC_W * SC_STRIDE + o + 4) = (f32x4){dec[4], dec[5], dec[6], dec[7]};
              *(GAS f32x4*)(P.SC + SC_K * SC_STRIDE + o) = (f32x4){kn[0], kn[1], kn[2], kn[3]}; *(GAS f32x4*)(P.SC + SC_K * SC_STRIDE + o + 4) = (f32x4){kn[4], kn[5], kn[6], kn[7]};
              *(GAS f32x4*)(P.SC + SC_R * SC_STRIDE + o) = (f32x4){rr[0], rr[1], rr[2], rr[3]}; *(GAS f32x4*)(P.SC + SC_R * SC_STRIDE + o + 4) = (f32x4){rr[4], rr[5], rr[6], rr[7]};
              *(GAS f32x4*)(P.SC + SC_V * SC_STRIDE + o) = (f32x4){vv[0], vv[1], vv[2], vv[3]}; *(GAS f32x4*)(P.SC + SC_V * SC_STRIDE + o + 4) = (f32x4){vv[4], vv[5], vv[6], vv[7]};
              *(GAS u32x4*)(P.G + o) = pack8((f32x4){gv[0], gv[1], gv[2], gv[3]}, (f32x4){gv[4], gv[5], gv[6], gv[7]});
              if (ec8 == 0) P.BONUS[(size_t)em * NH + h] = bon; }
            __syncthreads();
        }
    }
}

__device__ __forceinline__ void p3_attention(const Ptrs& P, LAS unsigned char* lds, int tid, int wave, int lane) {
    const int fr = lane & 15, fq = lane >> 4;
    LAS unsigned char* Ks = lds; LAS unsigned char* Vt = lds + 34816;
    for (int u = blockIdx.x; u < NB * 12 * 32; u += gridDim.x) {
        const int b = u / 384, r = u - b * 384, gh = r >> 5, idx = r & 31, g = gh >> 2;
        const int d = (g == 0) ? 1 : ((g == 1) ? 4 : 16), nb = 32 / d, c = idx / nb, n = idx - c * nb;
        const int qi = wave * 16 + fr; const size_t mq = (size_t)b * SEQ + (size_t)(n * 128 + qi) * d + c;
        const bf16* qrow = P.QKV + mq * QKVW + gh * 128;
        bf16x8 qf[4];
#pragma unroll
        for (int ks = 0; ks < 4; ++ks) qf[ks] = *(const GAS bf16x8*)(qrow + 32 * ks + 8 * fq);
        f32x4 o[8];
#pragma unroll
        for (int dt = 0; dt < 8; ++dt) o[dt] = (f32x4){0.f, 0.f, 0.f, 0.f};
        float mrun = -1e30f, lrun = 0.f;
        for (int kb = (n == 0) ? 1 : 0; kb < 2; ++kb) {
            const int kblk = n - 1 + kb;
            __syncthreads();
#pragma unroll
            for (int i = 0; i < 4; ++i) { const int p = tid + 512 * i, key = p >> 4, part = p & 15; const size_t mk = (size_t)b * SEQ + (size_t)(kblk * 128 + key) * d + c;
                *(LAS u32x4*)(Ks + key * 272 + part * 16) = *(const GAS u32x4*)(P.QKV + mk * QKVW + 1536 + gh * 128 + part * 8); }
#pragma unroll
            for (int i = 0; i < 4; ++i) { const int key = tid & 127, part = (tid >> 7) + 4 * i; const size_t mk = (size_t)b * SEQ + (size_t)(kblk * 128 + key) * d + c;
                const u32x4 v = *(const GAS u32x4*)(P.QKV + mk * QKVW + 3072 + gh * 128 + part * 8);
                LAS unsigned char* vp = Vt + (8 * part) * 272 + key * 2;
                *(LAS unsigned short*)(vp + 0 * 272) = (unsigned short)(v.x & 0xffffu); *(LAS unsigned short*)(vp + 1 * 272) = (unsigned short)(v.x >> 16);
                *(LAS unsigned short*)(vp + 2 * 272) = (unsigned short)(v.y & 0xffffu); *(LAS unsigned short*)(vp + 3 * 272) = (unsigned short)(v.y >> 16);
                *(LAS unsigned short*)(vp + 4 * 272) = (unsigned short)(v.z & 0xffffu); *(LAS unsigned short*)(vp + 5 * 272) = (unsigned short)(v.z >> 16);
                *(LAS unsigned short*)(vp + 6 * 272) = (unsigned short)(v.w & 0xffffu); *(LAS unsigned short*)(vp + 7 * 272) = (unsigned short)(v.w >> 16); }
            __syncthreads();
            f32x4 s[8];
#pragma unroll
            for (int kt = 0; kt < 8; ++kt) { s[kt] = (f32x4){0.f, 0.f, 0.f, 0.f};
#pragma unroll
                for (int ks = 0; ks < 4; ++ks) { const bf16x8 a = *(const LAS bf16x8*)(Ks + (kt * 16 + fr) * 272 + (32 * ks + 8 * fq) * 2); s[kt] = mfma16(a, qf[ks], s[kt]); } }
            float mx = -1e30f;
#pragma unroll
            for (int kt = 0; kt < 8; ++kt)
#pragma unroll
                for (int rg = 0; rg < 4; ++rg) { const int j = kt * 16 + 4 * fq + rg; const bool ok = (kb == 0) ? (j >= qi) : (j <= qi); const float sv = ok ? s[kt][rg] : -1e30f; s[kt][rg] = sv; mx = fmaxf(mx, sv); }
            mx = fmaxf(mx, __shfl_xor(mx, 16)); mx = fmaxf(mx, __shfl_xor(mx, 32));
            const float mnew = fmaxf(mrun, mx), alpha = exp2f(mrun - mnew); mrun = mnew;
            float ls = 0.f;
#pragma unroll
            for (int kt = 0; kt < 8; ++kt)
#pragma unroll
                for (int rg = 0; rg < 4; ++rg) { const float p = exp2f(s[kt][rg] - mnew); s[kt][rg] = p; ls += p; }
            lrun = lrun * alpha + ls;
#pragma unroll
            for (int dt = 0; dt < 8; ++dt) o[dt] = o[dt] * alpha;
#pragma unroll
            for (int pi = 0; pi < 4; ++pi) {
                const u32x4 bw = pack8(s[2 * pi], s[2 * pi + 1]); const bf16x8 bfrag = __builtin_bit_cast(bf16x8, bw);
#pragma unroll
                for (int dt = 0; dt < 8; ++dt) { const LAS unsigned char* vp = Vt + (dt * 16 + fr) * 272 + (2 * pi * 16 + 4 * fq) * 2;
                    const u32x2 lo = *(const LAS u32x2*)vp, hi = *(const LAS u32x2*)(vp + 32);
                    const u32x4 aw = {lo.x, lo.y, hi.x, hi.y}; o[dt] = mfma16(__builtin_bit_cast(bf16x8, aw), bfrag, o[dt]); } }
        }
        lrun += __shfl_xor(lrun, 16); lrun += __shfl_xor(lrun, 32);
        bf16* orow = P.ATTO + (mq * 12 + gh) * 128;
#pragma unroll
        for (int dt = 0; dt < 8; ++dt) { u32x2 w; w.x = pk2(o[dt][0], o[dt][1]); w.y = pk2(o[dt][2], o[dt][3]); *(GAS u32x2*)(orow + dt * 16 + 4 * fq) = w; }
        if (fq == 0) { P.ATTML[(mq * 12 + gh) * 2] = mrun; P.ATTML[(mq * 12 + gh) * 2 + 1] = lrun; }
    }
}

__device__ __forceinline__ u32x4 pack8s(const float* p) { u32x4 w; w.x = pk2(p[0], p[1]); w.y = pk2(p[2], p[3]); w.z = pk2(p[4], p[5]); w.w = pk2(p[6], p[7]); return w; }
__device__ __forceinline__ void p4a_chunk_prep(const Ptrs& P, unsigned char* ws, LAS unsigned char* lds, int tid, int wave, int lane) {
    LAS unsigned char* wl = lds + wave * 16384;
    LAS unsigned char* AH = wl, *BH = wl + 2048, *KH = wl + 4096, *RH = wl + 6144;
    LAS unsigned char* AT = wl + 8192, *RT = wl + 10240, *VTl = wl + 12288;
    LAS unsigned char* MX = wl + 14336;
    LAS unsigned char* WTl = wl, *U0Tl = wl + 2048, *PT = wl + 8192; LAS float* LmT = (LAS float*)(wl + 4096);
    const int fr = lane & 15, fq = lane >> 4, fq1 = fq & 1;
    const int gw = blockIdx.x * NWAVES + wave, NGW = gridDim.x * NWAVES;
    unsigned char* s1 = ws + WS_S1;
    for (int uidx = gw; uidx < NU16; uidx += NGW) {
        const int bh = uidx >> 8, c16 = uidx & 255, b = bh >> 4, h = bh & 15;
        const size_t gbase = ((size_t)b * SEQ + (size_t)c16 * 16) * RW + h * 64 + lane;
        float av[16], bv[16], kv[16], rv[16], vv[16];
        {   float wv[16];
#pragma unroll
            for (int t = 0; t < 16; ++t) { const size_t o = gbase + (size_t)t * RW; wv[t] = P.SC[SC_W * SC_STRIDE + o]; av[t] = P.SC[SC_KK * SC_STRIDE + o]; bv[t] = P.SC[SC_BB * SC_STRIDE + o];
                kv[t] = P.SC[SC_K * SC_STRIDE + o]; rv[t] = P.SC[SC_R * SC_STRIDE + o]; vv[t] = P.SC[SC_V * SC_STRIDE + o]; }
            float g = 1.0f;
#pragma unroll
            for (int t = 0; t < 16; ++t) { const float gp = g; g *= wv[t]; const float inv = 1.0f / g; av[t] *= gp; bv[t] *= inv; kv[t] *= inv; rv[t] *= g;
                *(LAS unsigned short*)(AH + t * 128 + lane * 2) = (unsigned short)f2bf(av[t]); *(LAS unsigned short*)(BH + t * 128 + lane * 2) = (unsigned short)f2bf(bv[t]);
                *(LAS unsigned short*)(KH + t * 128 + lane * 2) = (unsigned short)f2bf(kv[t]); *(LAS unsigned short*)(RH + t * 128 + lane * 2) = (unsigned short)f2bf(rv[t]); }
            *(LAS u32x4*)(AT + lane * 32) = pack8s(av); *(LAS u32x4*)(AT + lane * 32 + 16) = pack8s(av + 8);
            *(LAS u32x4*)(RT + lane * 32) = pack8s(rv); *(LAS u32x4*)(RT + lane * 32 + 16) = pack8s(rv + 8);
            const u32x4 v0 = pack8s(vv), v1 = pack8s(vv + 8);
            *(LAS u32x4*)(VTl + lane * 32) = v0; *(LAS u32x4*)(VTl + lane * 32 + 16) = v1;
            GAS u32x4* gv = (GAS u32x4*)(s1 + S1_VT + ((size_t)uidx * 64 + lane) * 32); gv[0] = v0; gv[1] = v1;
#pragma unroll
            for (int t = 0; t < 16; ++t) { bv[t] *= g; kv[t] *= g; }
            GAS u32x4* gb = (GAS u32x4*)(s1 + S1_BT + ((size_t)uidx * 64 + lane) * 32); gb[0] = pack8s(bv); gb[1] = pack8s(bv + 8);
            GAS u32x4* gk = (GAS u32x4*)(s1 + S1_KT + ((size_t)uidx * 64 + lane) * 32); gk[0] = pack8s(kv); gk[1] = pack8s(kv + 8);
            *(GAS float*)(s1 + S1_GAM + ((size_t)uidx * 64 + lane) * 4) = g; }
        LDS_WAIT(); asm volatile("" ::: "memory");
        f32x4 lab = {0.f, 0.f, 0.f, 0.f}, lak = lab, mrb = lab, mrk = lab;
#pragma unroll
        for (int ks = 0; ks < 2; ++ks) { const int off = fr * 128 + (32 * ks + 8 * fq) * 2;
            const bf16x8 a = *(const LAS bf16x8*)(AH + off), r_ = *(const LAS bf16x8*)(RH + off), b_ = *(const LAS bf16x8*)(BH + off), k_ = *(const LAS bf16x8*)(KH + off);
            lab = mfma16(a, b_, lab); lak = mfma16(a, k_, lak); mrb = mfma16(r_, b_, mrb); mrk = mfma16(r_, k_, mrk); }
#pragma unroll
        for (int rg = 0; rg < 4; ++rg) { const int t = 4 * fq + rg; const bool lo = fr < t, le = fr <= t; lab[rg] = lo ? lab[rg] : 0.f; lak[rg] = lo ? lak[rg] : 0.f; mrb[rg] = le ? mrb[rg] : 0.f; mrk[rg] = le ? mrk[rg] : 0.f; }
        asm volatile("" ::: "memory");
        *(LAS f32x4*)(LmT + fr * 16 + 4 * fq) = lab;
#pragma unroll
        for (int rg = 0; rg < 4; ++rg) { const int o = ((4 * fq + rg) * 16 + fr) * 2;
            *(LAS unsigned short*)(MX + o) = (unsigned short)f2bf(lak[rg]); *(LAS unsigned short*)(MX + 512 + o) = (unsigned short)f2bf(mrb[rg]); *(LAS unsigned short*)(MX + 1024 + o) = (unsigned short)f2bf(mrk[rg]); }
        LDS_WAIT(); asm volatile("" ::: "memory");
        float Tr[16];
#pragma unroll
        for (int m = 0; m < 16; ++m) Tr[m] = (m == fr) ? 1.0f : 0.0f;
#pragma unroll
        for (int j = 14; j >= 0; --j) { float acc = (j == fr) ? 1.0f : 0.0f;
#pragma unroll
            for (int q = 0; q < 4; ++q) { const f32x4 l4 = *(const LAS f32x4*)(LmT + j * 16 + 4 * q);
#pragma unroll
                for (int e = 0; e < 4; ++e) { const int m = 4 * q + e; if (m > j) acc += Tr[m] * l4[e]; } }
            Tr[j] = acc; }
        bf16x8 tfrag;
        { float sel[8];
#pragma unroll
          for (int j = 0; j < 8; ++j) sel[j] = (fq == 0) ? Tr[j] : ((fq == 1) ? Tr[8 + j] : 0.0f);
          tfrag = __builtin_bit_cast(bf16x8, pack8s(sel)); }
        f32x4 wacc[4];
#pragma unroll
        for (int nt = 0; nt < 4; ++nt) wacc[nt] = mfma16(tfrag, *(const LAS bf16x8*)(AT + (16 * nt + fr) * 32 + fq1 * 16), (f32x4){0.f, 0.f, 0.f, 0.f});
        asm volatile("" ::: "memory");
        { bf16* gwh = (bf16*)(s1 + S1_WH) + (size_t)uidx * 1024;
#pragma unroll
          for (int nt = 0; nt < 4; ++nt) { u32x2 w2; w2.x = pk2(wacc[nt][0], wacc[nt][1]); w2.y = pk2(wacc[nt][2], wacc[nt][3]); *(LAS u32x2*)(WTl + ((16 * nt + fr) * 16 + 4 * fq) * 2) = w2;
#pragma unroll
              for (int rg = 0; rg < 4; ++rg) gwh[(4 * fq + rg) * 64 + 16 * nt + fr] = (bf16)f2bf(wacc[nt][rg]); } }
        bf16x8 lkf, mbf, mkf, idf;
        { const u32x4 z4 = {0u, 0u, 0u, 0u};
          const u32x4 lk4 = *(const LAS u32x4*)(MX + (fr * 16 + 8 * fq1) * 2), mb4 = *(const LAS u32x4*)(MX + 512 + (fr * 16 + 8 * fq1) * 2), mk4 = *(const LAS u32x4*)(MX + 1024 + (fr * 16 + 8 * fq1) * 2);
          lkf = __builtin_bit_cast(bf16x8, (fq < 2) ? lk4 : z4);
          mbf = __builtin_bit_cast(bf16x8, mb4);
          mkf = __builtin_bit_cast(bf16x8, mk4);
          u32x4 id4; const int d = fr - 8 * fq1;
          id4.x = (d == 0 ? 0x3f80u : 0u) | (d == 1 ? 0x3f800000u : 0u); id4.y = (d == 2 ? 0x3f80u : 0u) | (d == 3 ? 0x3f800000u : 0u);
          id4.z = (d == 4 ? 0x3f80u : 0u) | (d == 5 ? 0x3f800000u : 0u); id4.w = (d == 6 ? 0x3f80u : 0u) | (d == 7 ? 0x3f800000u : 0u);
          idf = __builtin_bit_cast(bf16x8, id4); }
        LDS_WAIT(); asm volatile("" ::: "memory");
        f32x4 pacc[4];
#pragma unroll
        for (int nt = 0; nt < 4; ++nt) pacc[nt] = mfma16(lkf, *(const LAS bf16x8*)(VTl + (16 * nt + fr) * 32 + fq1 * 16), (f32x4){0.f, 0.f, 0.f, 0.f});
        asm volatile("" ::: "memory");
#pragma unroll
        for (int nt = 0; nt < 4; ++nt) { u32x2 w2; w2.x = pk2(pacc[nt][0], pacc[nt][1]); w2.y = pk2(pacc[nt][2], pacc[nt][3]); *(LAS u32x2*)(PT + ((16 * nt + fr) * 16 + 4 * fq) * 2) = w2; }
        LDS_WAIT(); asm volatile("" ::: "memory");
        f32x4 uacc[4];
#pragma unroll
        for (int nt = 0; nt < 4; ++nt) uacc[nt] = mfma16(tfrag, *(const LAS bf16x8*)(PT + (16 * nt + fr) * 32 + fq1 * 16), (f32x4){0.f, 0.f, 0.f, 0.f});
        asm volatile("" ::: "memory");
#pragma unroll
        for (int nt = 0; nt < 4; ++nt) { u32x2 w2; w2.x = pk2(uacc[nt][0], uacc[nt][1]); w2.y = pk2(uacc[nt][2], uacc[nt][3]); *(LAS u32x2*)(U0Tl + ((16 * nt + fr) * 16 + 4 * fq) * 2) = w2;
            *(GAS f32x4*)(s1 + S1_U0T + (((size_t)uidx * 64 + 16 * nt + fr) * 16 + 4 * fq) * 4) = uacc[nt]; }
        LDS_WAIT(); asm volatile("" ::: "memory");
        { const bf16x8 aq = (fq < 2) ? mbf : idf, ay = (fq < 2) ? mbf : mkf;
          bf16* gqh = (bf16*)(s1 + S1_QH) + (size_t)uidx * 1024;
#pragma unroll
          for (int nt = 0; nt < 4; ++nt) { const int row = 16 * nt + fr;
              const bf16x8 bq = *(const LAS bf16x8*)(((fq < 2) ? WTl : RT) + row * 32 + fq1 * 16), by = *(const LAS bf16x8*)(((fq < 2) ? U0Tl : VTl) + row * 32 + fq1 * 16);
              const f32x4 qa = mfma16(aq, bq, (f32x4){0.f, 0.f, 0.f, 0.f}), ya = mfma16(ay, by, (f32x4){0.f, 0.f, 0.f, 0.f});
#pragma unroll
              for (int rg = 0; rg < 4; ++rg) gqh[(4 * fq + rg) * 64 + row] = (bf16)f2bf(qa[rg]);
              *(GAS f32x4*)(s1 + S1_Y0T + (((size_t)uidx * 64 + row) * 16 + 4 * fq) * 4) = ya; } }
        LDS_WAIT(); asm volatile("" ::: "memory");
    }
}

__device__ __forceinline__ void p4b_scan(const Ptrs& P, unsigned char* ws, LAS unsigned char* lds, int tid, int wave, int lane) {
    constexpr int STEPB = 11776;
    constexpr int O_QH = 2304, O_BT = 4608, O_KT = 6656, O_U0 = 8704, O_Y0 = 9728, O_VT = 10752, O_GAM = 11264, NF4 = 688;
    const int fr = lane & 15, fq = lane >> 4;
    const unsigned char* s1 = ws + WS_S1;
    for (int unit = blockIdx.x; unit < 256; unit += gridDim.x) {
        const int bh = unit >> 2, vg = unit & 3, b = bh >> 4, h = bh & 15;
        const size_t u0idx = (size_t)bh * 256;
#define S2_LOAD(chunk4, bufsel) do { if (wave > 0) { for (int idx = tid - 64; idx < 4 * NF4; idx += NTHREADS - 64) { const int st = idx / NF4, q = idx - st * NF4; const size_t ui = u0idx + (size_t)(chunk4) * 4 + st; \
            const unsigned char* src; int dst; \
            if (q < 128) { src = s1 + S1_WH + ui * 2048 + q * 16; dst = (q >> 3) * 144 + (q & 7) * 16; } \
            else if (q < 256) { src = s1 + S1_QH + ui * 2048 + (q - 128) * 16; dst = O_QH + ((q - 128) >> 3) * 144 + (q & 7) * 16; } \
            else if (q < 384) { src = s1 + S1_BT + ui * 2048 + (q - 256) * 16; dst = O_BT + (q - 256) * 16; } \
            else if (q < 512) { src = s1 + S1_KT + ui * 2048 + (q - 384) * 16; dst = O_KT + (q - 384) * 16; } \
            else if (q < 576) { src = s1 + S1_U0T + (ui * 64 + vg * 16) * 64 + (q - 512) * 16; dst = O_U0 + (q - 512) * 16; } \
            else if (q < 640) { src = s1 + S1_Y0T + (ui * 64 + vg * 16) * 64 + (q - 576) * 16; dst = O_Y0 + (q - 576) * 16; } \
            else if (q < 672) { src = s1 + S1_VT + (ui * 64 + vg * 16) * 32 + (q - 640) * 16; dst = O_VT + (q - 640) * 16; } \
            else { src = s1 + S1_GAM + ui * 256 + (q - 672) * 16; dst = O_GAM + (q - 672) * 16; } \
            *(LAS u32x4*)(lds + ((bufsel) * 4 + st) * STEPB + dst) = *(const GAS u32x4*)src; } } } while (0)
        __syncthreads();
        S2_LOAD(0, 0);
        __syncthreads();
        f32x4 st4[4];
#pragma unroll
        for (int mt = 0; mt < 4; ++mt) st4[mt] = (f32x4){0.f, 0.f, 0.f, 0.f};
        float* yb = P.Y + ((size_t)b * SEQ) * RW + h * 64 + vg * 16 + fr;
#pragma unroll 1
        for (int c4 = 0; c4 < 64; ++c4) {
            if (c4 + 1 < 64) S2_LOAD(c4 + 1, (c4 + 1) & 1);
            if (wave == 0) {
#pragma unroll
                for (int s = 0; s < 4; ++s) { const LAS unsigned char* sb = lds + ((c4 & 1) * 4 + s) * STEPB;
                    bf16x8 sf[2];
#pragma unroll
                    for (int ks = 0; ks < 2; ++ks) sf[ks] = __builtin_bit_cast(bf16x8, pack8(st4[2 * ks], st4[2 * ks + 1]));
                    f32x4 sa = *(const LAS f32x4*)(sb + O_U0 + (fr * 16 + 4 * fq) * 4), y = *(const LAS f32x4*)(sb + O_Y0 + (fr * 16 + 4 * fq) * 4);
#pragma unroll
                    for (int ks = 0; ks < 2; ++ks) { const int o = fr * 144 + (32 * ks + 4 * fq) * 2;
                        const u32x2 w0 = *(const LAS u32x2*)(sb + o), w1 = *(const LAS u32x2*)(sb + o + 32), q0 = *(const LAS u32x2*)(sb + O_QH + o), q1 = *(const LAS u32x2*)(sb + O_QH + o + 32);
                        sa = mfma16(__builtin_bit_cast(bf16x8, (u32x4){w0.x, w0.y, w1.x, w1.y}), sf[ks], sa);
                        y = mfma16(__builtin_bit_cast(bf16x8, (u32x4){q0.x, q0.y, q1.x, q1.y}), sf[ks], y); }
                    const int tok = (c4 * 4 + s) * 16 + 4 * fq;
#pragma unroll
                    for (int rg = 0; rg < 4; ++rg) yb[(size_t)(tok + rg) * RW] = y[rg];
                    const u32x2 vt = *(const LAS u32x2*)(sb + O_VT + (fr * 16 + 4 * fq) * 2);
                    const bf16x8 ub = __builtin_bit_cast(bf16x8, (u32x4){pk2(sa[0], sa[1]), pk2(sa[2], sa[3]), vt.x, vt.y});
#pragma unroll
                    for (int mt = 0; mt < 4; ++mt) { const u32x2 b2 = *(const LAS u32x2*)(sb + O_BT + ((16 * mt + fr) * 16 + 4 * fq) * 2), k2 = *(const LAS u32x2*)(sb + O_KT + ((16 * mt + fr) * 16 + 4 * fq) * 2);
                        const f32x4 gm = *(const LAS f32x4*)(sb + O_GAM + (16 * mt + 4 * fq) * 4);
                        st4[mt] = mfma16(__builtin_bit_cast(bf16x8, (u32x4){b2.x, b2.y, k2.x, k2.y}), ub, st4[mt] * gm); } }
            }
            __syncthreads();
        }
#undef S2_LOAD
    }
}

__device__ __forceinline__ void p5_post(const Ptrs& P, int tid, int wave, int lane) {
    for (int m = blockIdx.x; m < T; m += gridDim.x) {
#pragma unroll
        for (int cc = 0; cc < 2; ++cc) { const int c = tid + 512 * cc, head = wave + 8 * cc; const size_t o = (size_t)m * RW + c;
            const float y = P.Y[o]; const float mean = wave_sum(y) * (1.0f / 64.0f); const float dv = y - mean; const float var = wave_sum(dv * dv) * (1.0f / 64.0f);
            float yn = dv * (1.0f / sqrtf(var + GN_EPS)) * P.ln_x_w[c] + P.ln_x_b[c];
            yn += P.BONUS[(size_t)m * NH + head] * P.SC[SC_V * SC_STRIDE + o];
            P.YAIN[o] = (bf16)f2bf(yn * bf2f(P.G[o])); }
        { const int hh = tid >> 7, dd = tid & 127; float mm[3], ll[3], ov[3]; float M = -1e30f;
#pragma unroll
          for (int g = 0; g < 3; ++g) { const size_t q = (size_t)m * 12 + g * 4 + hh; mm[g] = P.ATTML[q * 2]; ll[g] = P.ATTML[q * 2 + 1]; ov[g] = bf2f(P.ATTO[q * 128 + dd]); M = fmaxf(M, mm[g]); }
          float num = 0.f, den = 0.f;
#pragma unroll
          for (int g = 0; g < 3; ++g) { const float wg = exp2f(mm[g] - M); num += wg * ov[g]; den += wg * ll[g]; }
          P.OIN[(size_t)m * 512 + tid] = (bf16)f2bf(num / den); }
    }
}

__device__ __forceinline__ void p8_router(const Ptrs& P, LAS unsigned char* lds, int tid, int wave, int lane) {
    LAS float* Wl = (LAS float*)lds;
    const int e = lane & 31, kh = lane >> 5;
    for (int grp = blockIdx.x; grp < T / 64; grp += gridDim.x) {
        const int m0 = grp * 64 + wave * 8;
        float rs[8], acc[8];
#pragma unroll
        for (int tk = 0; tk < 8; ++tk) { const float* xr = P.X1 + (size_t)(m0 + tk) * D; f32x4 v[8]; float s = 0.f;
#pragma unroll
            for (int j = 0; j < 8; ++j) { v[j] = *(const GAS f32x4*)(xr + 4 * lane + 256 * j); s += (v[j].x * v[j].x + v[j].y * v[j].y) + (v[j].z * v[j].z + v[j].w * v[j].w); }
            const float r = 1.0f / sqrtf(wave_sum(s) * (1.0f / D) + NORM_EPS); rs[tk] = r; acc[tk] = 0.f;
            unsigned char* hr = (unsigned char*)P.H + (size_t)(m0 + tk) * D;
#pragma unroll
            for (int j = 0; j < 8; ++j) { const f32x4 gv = *(const GAS f32x4*)(P.norm_ffn + 4 * lane + 256 * j);
                *(GAS unsigned*)(hr + 4 * lane + 256 * j) = pk4_fp8(v[j].x * r * gv.x, v[j].y * r * gv.y, v[j].z * r * gv.z, v[j].w * r * gv.w); } }
#pragma unroll 1
        for (int hf = 0; hf < 2; ++hf) {
            __syncthreads();
            for (int idx = tid; idx < 8192; idx += NTHREADS) { const int k = idx >> 3, q = idx & 7; const float g = P.norm_ffn[hf * 1024 + k];
                *(LAS f32x4*)(Wl + k * 32 + 4 * q) = *(const GAS f32x4*)(P.w_router + (size_t)(hf * 1024 + k) * NE + 4 * q) * g; }
            __syncthreads();
            const float* xb = P.X1 + (size_t)m0 * D + hf * 1024 + kh * 512; const LAS float* wb = Wl + (kh * 512) * 32 + e;
#pragma unroll 2
            for (int i = 0; i < 512; i += 4) { const float w0 = wb[(i + 0) * 32], w1 = wb[(i + 1) * 32], w2 = wb[(i + 2) * 32], w3 = wb[(i + 3) * 32];
#pragma unroll
                for (int tk = 0; tk < 8; ++tk) { const f32x4 xv = *(const GAS f32x4*)(xb + (size_t)tk * D + i); acc[tk] += (xv.x * w0 + xv.y * w1) + (xv.z * w2 + xv.w * w3); } }
        }
        const float be = P.b_router[e];
#pragma unroll
        for (int tk = 0; tk < 8; ++tk) { float v = (acc[tk] + __shfl_xor(acc[tk], 32)) * rs[tk] + be;
            int sel[4]; float val[4];
#pragma unroll
            for (int k = 0; k < 4; ++k) { float mx = v;
#pragma unroll
                for (int o = 1; o < 32; o <<= 1) mx = fmaxf(mx, __shfl_xor(mx, o));
                const unsigned long long bal = __ballot(v == mx); const int s_ = __ffsll((unsigned long long)(bal & 0xffffffffull)) - 1;
                sel[k] = s_; val[k] = mx; v = (e == s_) ? -3.0e38f : v; }
            const float e1 = __expf(val[1] - val[0]), e2 = __expf(val[2] - val[0]), e3 = __expf(val[3] - val[0]); const float inv = 1.0f / (1.0f + e1 + e2 + e3);
            const float gate[4] = {inv, e1 * inv, e2 * inv, e3 * inv};
            if (lane == 0) { const int m = m0 + tk;
#pragma unroll
                for (int k = 0; k < 4; ++k) { const unsigned pos = __hip_atomic_fetch_add((unsigned*)(P.ctl + CW_CNT + 64 * sel[k]), 1u, RLX_AGENT);
                    P.TOPK_E[m * 4 + k] = sel[k]; P.TOPK_POS[m * 4 + k] = (int)pos; P.TOPK_GATE[m * 4 + k] = gate[k]; } }
        }
    }
}

__device__ __forceinline__ void moe_tables(const Ptrs& P, LAS int* tab, int tid) {
    if (tid == 0) { int acc = 0;
        for (int e = 0; e < NE; ++e) { tab[e] = acc; const int c = (int)__hip_atomic_load((unsigned*)(P.ctl + CW_CNT + 64 * e), RLX_AGENT); acc += (c + 255) >> 8; tab[64 + e] = c; }
        tab[32] = acc; }
    __syncthreads();
}

__device__ __forceinline__ void p9_gather(const Ptrs& P, LAS unsigned char* lds, int tid, int wave, int lane) {
    LAS int* tab = (LAS int*)(lds + TAB_OFF);
    moe_tables(P, tab, tid);
    const int gw = blockIdx.x * NWAVES + wave, NGW = gridDim.x * NWAVES;
    for (int p = gw; p < T * 4; p += NGW) { const int e = P.TOPK_E[p], pos = P.TOPK_POS[p]; const int row = tab[e] * 256 + pos;
        const GAS u32x4* src = (const GAS u32x4*)((const unsigned char*)P.H + (size_t)(p >> 2) * D); GAS u32x4* dst = (GAS u32x4*)((unsigned char*)P.XS + (size_t)row * D);
#pragma unroll
        for (int i = 0; i < 2; ++i) dst[lane + 64 * i] = src[lane + 64 * i];
        if (lane == 0) { P.ROWTOK[row] = p; P.ROWGATE[row] = P.TOPK_GATE[p]; } }
    for (int e = blockIdx.x; e < NE; e += gridDim.x) { const int cnt = tab[64 + e], r0 = tab[e] * 256, rend = tab[e + 1] * 256;
        for (int r = r0 + cnt + tid; r < rend; r += NTHREADS) { P.ROWTOK[r] = -1; P.ROWGATE[r] = 0.f; } }
}

__device__ __forceinline__ void p12_final(const Ptrs& P, int tid, int wave, int lane) {
    const int gw = blockIdx.x * NWAVES + wave, NGW = gridDim.x * NWAVES;
    for (int m = gw; m < T; m += NGW) {
        f32x4 v[8]; float s = 0.f;
#pragma unroll
        for (int j = 0; j < 8; ++j) { const int col = 4 * lane + 256 * j; v[j] = *(const GAS f32x4*)(P.X1 + (size_t)m * D + col);
#pragma unroll
            for (int k = 0; k < 4; ++k) { const u32x2 w = *(const GAS u32x2*)(P.OUTK + ((size_t)m * 4 + k) * D + col); v[j].x += bflo(w.x); v[j].y += bfhi(w.x); v[j].z += bflo(w.y); v[j].w += bfhi(w.y); }
            s += (v[j].x * v[j].x + v[j].y * v[j].y) + (v[j].z * v[j].z + v[j].w * v[j].w); }
        const float rs = 1.0f / sqrtf(wave_sum(s) * (1.0f / D) + NORM_EPS);
#pragma unroll
        for (int j = 0; j < 8; ++j) { const int col = 4 * lane + 256 * j; const f32x4 g = *(const GAS f32x4*)(P.norm_final + col); *(GAS f32x4*)(P.out + (size_t)m * D + col) = v[j] * rs * g; }
    }
}

struct Args { const void* in[26]; float* out; unsigned char* ws; int ph_lo, ph_hi; };
__global__ void __launch_bounds__(NTHREADS, 2) fwd(Args args) {
    extern __shared__ __attribute__((aligned(16))) unsigned char lds_raw[];
    LAS unsigned char* lds = (LAS unsigned char*)lds_raw;
    const int tid = threadIdx.x, lane = tid & 63, wave = __builtin_amdgcn_readfirstlane(tid >> 6);
    unsigned char* ws = args.ws;
    Ptrs P;
    P.x = (const float*)args.in[0]; P.positions = (const int*)args.in[1]; P.norm_mix = (const float*)args.in[2]; P.w_in = (const float*)args.in[3]; P.shift_mu = (const float*)args.in[4];
    P.w0 = (const float*)args.in[5]; P.w2_decay = (const float*)args.in[6]; P.a0 = (const float*)args.in[7]; P.a2_iclr = (const float*)args.in[8]; P.g2_gate = (const float*)args.in[9];
    P.k_k = (const float*)args.in[10]; P.k_a = (const float*)args.in[11]; P.r_k = (const float*)args.in[12]; P.ln_x_w = (const float*)args.in[13]; P.ln_x_b = (const float*)args.in[14];
    P.w_o_rwkv = (const float*)args.in[15]; P.w_o_attn = (const float*)args.in[16]; P.w_out = (const float*)args.in[17]; P.norm_ffn = (const float*)args.in[18]; P.w_router = (const float*)args.in[19];
    P.b_router = (const float*)args.in[20]; P.w1 = (const float*)args.in[21]; P.b1 = (const float*)args.in[22]; P.w2 = (const float*)args.in[23]; P.b2 = (const float*)args.in[24]; P.norm_final = (const float*)args.in[25];
    P.out = args.out; P.ctl = (gu32*)(ws + WS_CTL);
    P.WIN = (bf16*)(ws + WS_WIN); P.W1 = (bf16*)(ws + WS_W1); P.W2 = (bf16*)(ws + WS_W2); P.WOR = (bf16*)(ws + WS_WOR); P.WOA = (bf16*)(ws + WS_WOA); P.WOUT = (bf16*)(ws + WS_WOUT);
    P.H = (bf16*)(ws + WS_H); P.ZP = (bf16*)(ws + WS_ZP); P.QKV = (bf16*)(ws + WS_QKV); P.GATES = (bf16*)(ws + WS_GATES); P.ROT = (float*)(ws + WS_ROT); P.SC = (float*)(ws + WS_SC);
    P.G = (bf16*)(ws + WS_G); P.BONUS = (float*)(ws + WS_BONUS); P.Y = (float*)(ws + WS_Y); P.ATTO = (bf16*)(ws + WS_ATTO); P.ATTML = (float*)(ws + WS_ATTML); P.YAIN = (bf16*)(ws + WS_YAIN);
    P.OIN = (bf16*)(ws + WS_OIN); P.MERGED = (bf16*)(ws + WS_MERGED); P.X1 = (float*)(ws + WS_X1);
    P.TOPK_E = (int*)(ws + WS_TOPK); P.TOPK_POS = P.TOPK_E + T * 4; P.TOPK_GATE = (float*)(P.TOPK_POS + T * 4);
    P.ROWTOK = (int*)(ws + WS_ROWS); P.ROWGATE = (float*)(P.ROWTOK + XS_ROWS);
    P.LW = (bf16*)(ws + WS_LORA); P.LA = P.LW + 1024 * 64; P.LG = P.LA + 1024 * 64;
    P.XS = (bf16*)(ws + WS_XS); P.ACT = (bf16*)(ws + WS_ACT); P.OUTK = (bf16*)(ws + WS_OUTK);

    for (int u = tid; u < (LDS_BYTES - TAB_OFF) / 4; u += NTHREADS) ((LAS unsigned*)(lds + TAB_OFF))[u] = 0u;
    __syncthreads();
#if MK_ONE_LAUNCH
    XcdBarrier bar = xcd_barrier_post((unsigned*)(P.ctl + CW_BAR), (volatile LAS unsigned*)(lds + MISC_OFF));
#define GRID_BAR() xcd_barrier(bar)
#else
#define GRID_BAR() do { } while (0)
#endif
    const int lo = args.ph_lo, hi = args.ph_hi;
#ifndef PHASE_MASK
#define PHASE_MASK 0x3fff
#endif
#define IN(k) (((PHASE_MASK >> (k)) & 1) && lo <= (k) && (k) < hi)
#define SEAM(k) do { if (IN(k) && IN((k) + 1)) GRID_BAR(); } while (0)
    const int G = gridDim.x, c = blockIdx.x;

#ifndef REP_MASK
#define REP_MASK 0
#endif
#define REPS(k) (1 + ((REP_MASK >> (k)) & 1))
#define PHASE(k, ...) do { if (IN(k)) { { __VA_ARGS__ } if (REPS(k) == 2) { GRID_BAR(); { __VA_ARGS__ } } SEAM(k); } } while (0)
    PHASE(0, p0_prologue(P, lds, tid, wave, lane););
    PHASE(1, { pg8::Gemm g{P.H, P.WIN, T, NPROJ, D}; pg8::StaticOrder S; S.init(T, NPROJ, G, c); EpiProj E{P.ZP, P.QKV, P.GATES, P.ROT};
        pg8::gemm_phase<EpiProj, pg8::StaticOrder, true, true>(lds, g, S, E); });
    PHASE(2, p2_rwkv_prep(P, lds, tid, wave, lane););
    PHASE(3, p3_attention(P, lds, tid, wave, lane););
    PHASE(4, p4a_chunk_prep(P, ws, lds, tid, wave, lane););
    PHASE(5, p4b_scan(P, ws, lds, tid, wave, lane););
    PHASE(6, p5_post(P, tid, wave, lane););
    PHASE(7, {
        { pg8::Gemm g{P.YAIN, P.WOR, T, D, RW}; pg8::StaticOrder S; S.init(T, D, G, c); EpiMerge<0> E{P.MERGED, P.GATES}; pg8::gemm_phase<EpiMerge<0>, pg8::StaticOrder, true, true>(lds, g, S, E); }
        VM_WAIT(); __builtin_amdgcn_fence(__ATOMIC_ACQUIRE, "agent"); VM_WAIT(); __syncthreads();
        { pg8::Gemm g{P.OIN, P.WOA, T, D, 512}; pg8::StaticOrder S; S.init(T, D, G, c); EpiMerge<1> E{P.MERGED, P.GATES}; pg8::gemm_phase<EpiMerge<1>, pg8::StaticOrder, true, true>(lds, g, S, E); } });
    PHASE(8, { pg8::Gemm g{P.MERGED, P.WOUT, T, D, D}; pg8::StaticOrder S; S.init(T, D, G, c); EpiResid E{P.x, P.X1}; pg8::gemm_phase<EpiResid, pg8::StaticOrder, true, true>(lds, g, S, E); });
    PHASE(9, p8_router(P, lds, tid, wave, lane););
    PHASE(10, p9_gather(P, lds, tid, wave, lane););
    PHASE(11, { LAS int* tab = (LAS int*)(lds + TAB_OFF); moe_tables(P, tab, tid);
        pg8::Gemm g{P.XS, P.W1, XS_ROWS, NE * 4096, D / 2}; MoeOrder S{tab, 16, G, c}; EpiMoe1 E{P.ACT, P.b1};
        pg8::gemm_phase<EpiMoe1, MoeOrder, true, true, 122, 127>(lds, g, S, E); });
    PHASE(12, { LAS int* tab = (LAS int*)(lds + TAB_OFF); moe_tables(P, tab, tid);
        pg8::Gemm g{P.ACT, P.W2, XS_ROWS, NE * D, FF / 2}; MoeOrder S{tab, 8, G, c}; EpiMoe2 E{P.OUTK, P.b2, P.ROWTOK, P.ROWGATE};
        pg8::gemm_phase<EpiMoe2, MoeOrder, true, true, 122, 124>(lds, g, S, E); });
    PHASE(13, p12_final(P, tid, wave, lane););
#undef IN
#undef SEAM
}

extern "C" void kernel_launch(void* const* d_in, const int* in_sizes, int n_in, void* d_out, int out_size, void* d_ws, size_t ws_size, hipStream_t stream) {
    static int grid = 0;
    if (grid == 0) {
        if (n_in != 26 || out_size != T * D || ws_size < WS_END) { fprintf(stderr, "kernel_launch: unexpected shapes (n_in %d, out %d, ws %zu, need %zu); nothing launched\n", n_in, out_size, ws_size, (size_t)WS_END); grid = -1; return; }
        int dev = 0, cus = 0, per_cu = 0;
        if (hipGetDevice(&dev) != hipSuccess || hipDeviceGetAttribute(&cus, hipDeviceAttributeMultiprocessorCount, dev) != hipSuccess) { grid = -1; return; }
        if (hipFuncSetAttribute((const void*)fwd, hipFuncAttributeMaxDynamicSharedMemorySize, LDS_BYTES) != hipSuccess) { fprintf(stderr, "kernel_launch: hipFuncSetAttribute failed\n"); grid = -1; return; }
        if (hipOccupancyMaxActiveBlocksPerMultiprocessor(&per_cu, (const void*)fwd, NTHREADS, LDS_BYTES) != hipSuccess || per_cu < 1) fprintf(stderr, "kernel_launch: occupancy query says %d\n", per_cu);
        (void)hipGetLastError();
        grid = cus;
    }
    if (grid < 0) return;
    if (hipMemsetAsync((char*)d_ws + WS_CTL, 0, CTL_ZERO_BYTES, stream) != hipSuccess) return;
    Args a{};
    for (int i = 0; i < 26; ++i) a.in[i] = d_in[i];
    a.out = (float*)d_out; a.ws = (unsigned char*)d_ws;
#if MK_ONE_LAUNCH
    a.ph_lo = 0; a.ph_hi = NPHASES;
    hipLaunchKernelGGL(fwd, dim3(grid), dim3(NTHREADS), LDS_BYTES, stream, a);
#else
    for (int ph = 0; ph < NPHASES; ++ph) { a.ph_lo = ph; a.ph_hi = ph + 1; hipLaunchKernelGGL(fwd, dim3(grid), dim3(NTHREADS), LDS_BYTES, stream, a); }
#endif
}
```

```cpp
#include <hip/hip_runtime.h>
#include <cstdio>
#include <cstdint>
#include <cmath>
namespace pg8 {
#define PG8_LAS __attribute__((address_space(3)))
typedef unsigned short bf16_t;
typedef short bf16x8 __attribute__((ext_vector_type(8)));
typedef float f32x4 __attribute__((ext_vector_type(4)));
typedef unsigned u32x4 __attribute__((ext_vector_type(4)));
constexpr int BM = 256, BK = 64, HALF = 128, HTB = HALF * BK * 2  , STAGE_BYTES = 8 * HTB, NXCD = 8, WGM = 8;

__host__ __device__ __forceinline__ int lds_byte(int r, int c) { const int st = (r >> 4) * 2 + (c >> 5), rr = r & 15, cc = c & 31, ob = rr * 64 + cc * 2; return st * 1024 + (ob ^ (((ob >> 9) & 1) << 5)); }
__host__ __device__ __forceinline__ void stage_rc(int b, int& R, int& C) { const int st = b / 1024, sb = b % 1024, swz = sb ^ (((sb >> 9) & 1) << 5); R = (st >> 1) * 16 + swz / 64; C = (st & 1) * 32 + (swz % 64) / 2; }
__host__ __device__ __forceinline__ int perm32(int rho) { const int n = rho >> 4, i = rho & 15; return 8 * (i >> 2) + 4 * n + (i & 3); }

struct Unit { int pm, pn; };
struct Gemm { const bf16_t* A; const bf16_t* Bt; int M, N, K; };

struct StaticOrder {
    int nM, nN, nwg, G, c;
    __host__ __device__ void init(int M, int N, int G_, int c_) { nM = M / BM; nN = N / BM; nwg = nM * nN; G = G_; c = c_; }
    __host__ __device__ bool next(int i, Unit& u) const {
        const long L = (long)i * G + c; if (L >= nwg) return false;
        int wgid = (int)L; { const int q = nwg / NXCD, r = nwg % NXCD, xcd = wgid % NXCD, off = wgid / NXCD; wgid = (xcd < r ? xcd * (q + 1) : r * (q + 1) + (xcd - r) * q) + off; }
        const int nig = WGM * nN, gid = wgid / nig, fm = gid * WGM, gsz = (nM - fm) < WGM ? (nM - fm) : WGM;
        u.pm = fm + ((wgid % nig) % gsz); u.pn = (wgid % nig) / gsz; return true;
    }
    __device__ __forceinline__ void a_ready(const Unit&) const {}
    __device__ __forceinline__ void done(const Unit&) const {}
};

__device__ __forceinline__ unsigned cvt_pk_bf16(float lo, float hi) { unsigned r; asm volatile("v_cvt_pk_bf16_f32 %0, %1, %2" : "=v"(r) : "v"(lo), "v"(hi)); return r; }
typedef float f32x2 __attribute__((ext_vector_type(2)));

typedef int i32x4_t __attribute__((ext_vector_type(4)));
typedef int i32x8_t __attribute__((ext_vector_type(8)));
__device__ __forceinline__ f32x4 mfma_fp8(bf16x8 w0, bf16x8 w1, bf16x8 a0, bf16x8 a1, f32x4 c, int sw, int sa) {
    const i32x4_t x0 = __builtin_bit_cast(i32x4_t, w0), x1 = __builtin_bit_cast(i32x4_t, w1), y0 = __builtin_bit_cast(i32x4_t, a0), y1 = __builtin_bit_cast(i32x4_t, a1);
    const i32x8_t X = {x0.x, x0.y, x0.z, x0.w, x1.x, x1.y, x1.z, x1.w}, Y = {y0.x, y0.y, y0.z, y0.w, y1.x, y1.y, y1.z, y1.w};
    return __builtin_amdgcn_mfma_scale_f32_16x16x128_f8f6f4(X, Y, c, 0, 0, 0, sw, 0, sa);
}
template <class Epi, class Sched, bool ALIGN_EPI = false, bool SP2 = false, int FP8W = -1, int FP8A = -1>
__device__ __forceinline__ void gemm_phase(PG8_LAS unsigned char* lds, const Gemm g, const Sched& S, const Epi& E) {
    const int tid = threadIdx.x, wid = __builtin_amdgcn_readfirstlane(tid >> 6), lane = tid & 63, wr = wid >> 2, wc = wid & 3, fr = lane & 15, fq = lane >> 4;
    const int K = g.K, nt = K / BK;
    unsigned voffA[2], voffB[2];
#pragma unroll
    for (int i = 0; i < 2; ++i) { int R, C; stage_rc(tid * 16 + i * 8192, R, C); const int Rb = Epi::PERM ? ((R & ~31) + perm32(R & 31)) : R;
        voffA[i] = (unsigned)(R * K + C) * 2u; voffB[i] = (unsigned)(Rb * K + C) * 2u; }
    const size_t kstep = (size_t)(BK * 2);
    const size_t hstep = (size_t)HALF * K * 2;
    const size_t tstep = 2 * hstep;
    const unsigned ldsw = (unsigned)wid * 1024u;
    const int aoff = lds_byte(wr * 64 + fr, fq * 8), boff = lds_byte(wc * 32 + fr, fq * 8);
#define PG8_SA(b, h) (((b) * 2 + (h)) * HTB)
#define PG8_SB(b, h) ((4 + (b) * 2 + (h)) * HTB)
#define PG8_STAGE(bufoff, gbase, voff) do { _Pragma("unroll") for (int _i = 0; _i < 2; ++_i) \
        __builtin_amdgcn_global_load_lds((const unsigned*)((const char*)(gbase) + (voff)[_i]), (PG8_LAS unsigned*)(lds + (bufoff) + ldsw + _i * 8192), 16, 0, 0); } while (0)
#define PG8_LD8(p) __builtin_shufflevector(*(const PG8_LAS i32x4_t*)(p), *(const PG8_LAS i32x4_t*)((p) + 1024), 0, 1, 2, 3, 4, 5, 6, 7)
#define PG8_LDA(dst, b, h) do { if constexpr (FP8W >= 0) { _Pragma("unroll") for (int m = 0; m < 4; ++m) dst##8[m] = PG8_LD8(lds + PG8_SA(b, h) + aoff + m * 2048); } \
        else { _Pragma("unroll") for (int m = 0; m < 4; ++m) _Pragma("unroll") for (int k = 0; k < 2; ++k) dst[m][k] = *(const PG8_LAS bf16x8*)(lds + PG8_SA(b, h) + aoff + m * 2048 + k * 1024); } } while (0)
#define PG8_LDB(dst, b, h) do { if constexpr (FP8W >= 0) { _Pragma("unroll") for (int n = 0; n < 2; ++n) dst##8[n] = PG8_LD8(lds + PG8_SB(b, h) + boff + n * 2048); } \
        else { _Pragma("unroll") for (int n = 0; n < 2; ++n) _Pragma("unroll") for (int k = 0; k < 2; ++k) dst[n][k] = *(const PG8_LAS bf16x8*)(lds + PG8_SB(b, h) + boff + n * 2048 + k * 1024); } } while (0)
#define PG8_MMA(ai, bj, At, Bt) do { __builtin_amdgcn_s_setprio(1); _Pragma("unroll") for (int m = 0; m < 4; ++m) _Pragma("unroll") for (int n = 0; n < 2; ++n) { \
        if constexpr (FP8W >= 0) asm volatile("v_mfma_scale_f32_16x16x128_f8f6f4 %0, %1, %2, %0, %3, %4 op_sel_hi:[0,0,0]" : "+v"(acc[ai][bj][m][n]) : "v"(Bt##8[n]), "v"(At##8[m]), "v"(fp8sw), "v"(fp8sa)); \
        else { _Pragma("unroll") for (int k = 0; k < 2; ++k) acc[ai][bj][m][n] = __builtin_amdgcn_mfma_f32_16x16x32_bf16(Bt[n][k], At[m][k], acc[ai][bj][m][n], 0, 0, 0); } } \
        __builtin_amdgcn_s_setprio(0); } while (0)
#define PG8_WAIT_V(n) asm volatile("s_waitcnt vmcnt(" #n ")" ::: "memory")
#define PG8_WAIT_L(n) asm volatile("s_waitcnt lgkmcnt(" #n ")" ::: "memory")
#define PG8_BAR __builtin_amdgcn_s_barrier()
#define PG8_SCHED __builtin_amdgcn_sched_barrier(0)
    Unit cur, nxt; int ui = 0;
    if (!S.next(0, cur)) return;
    f32x4 acc[2][2][4][2];
#pragma unroll
    for (int a = 0; a < 2; ++a)
#pragma unroll
        for (int b = 0; b < 2; ++b)
#pragma unroll
            for (int m = 0; m < 4; ++m)
#pragma unroll
                for (int n = 0; n < 2; ++n) acc[a][b][m][n] = (f32x4){0.f, 0.f, 0.f, 0.f};
    const int fp8sw = FP8W, fp8sa = FP8A; (void)fp8sw; (void)fp8sa;
    bf16x8 At[4][2], B0[2][2], B1[2][2]; i32x8_t At8[4], B08[2], B18[2];
    const char* cA = (const char*)g.A + (size_t)cur.pm * tstep; const char* cB = (const char*)g.Bt + (size_t)cur.pn * tstep;
    S.a_ready(cur);
    if constexpr (SP2) {
        PG8_STAGE(PG8_SB(0, 0), cB, voffB); PG8_STAGE(PG8_SB(0, 1), cB + hstep, voffB); PG8_STAGE(PG8_SA(0, 0), cA, voffA); PG8_STAGE(PG8_SA(0, 1), cA + hstep, voffA);
        if (wr == 1) PG8_BAR;
        PG8_WAIT_V(2); PG8_BAR;
        PG8_STAGE(PG8_SB(1, 0), cB + kstep, voffB); PG8_STAGE(PG8_SA(1, 0), cA + kstep, voffA); PG8_STAGE(PG8_SB(1, 1), cB + hstep + kstep, voffB);
        PG8_WAIT_V(6); PG8_BAR;
    } else {
        PG8_STAGE(PG8_SB(0, 0), cB, voffB); PG8_STAGE(PG8_SA(0, 0), cA, voffA); PG8_STAGE(PG8_SB(0, 1), cB + hstep, voffB); PG8_STAGE(PG8_SA(0, 1), cA + hstep, voffA);
        if (wr == 1) PG8_BAR;
        PG8_WAIT_V(4); PG8_BAR;
        PG8_STAGE(PG8_SB(1, 0), cB + kstep, voffB); PG8_STAGE(PG8_SA(1, 0), cA + kstep, voffA); PG8_STAGE(PG8_SB(1, 1), cB + hstep + kstep, voffB);
        PG8_WAIT_V(6); PG8_BAR;
    }
    for (;;) {
        const bool has_next = S.next(ui + 1, nxt);
        const char* nA = has_next ? (const char*)g.A + (size_t)nxt.pm * tstep : cA; const char* nB = has_next ? (const char*)g.Bt + (size_t)nxt.pn * tstep : cB;
        for (int t = 0; t < nt; t += 2) {
            const bool last = (t == nt - 2);
            const char* a1 = cA + (size_t)(t + 1) * kstep;
            const char* a2 = last ? nA : cA + (size_t)(t + 2) * kstep; const char* b2 = last ? nB : cB + (size_t)(t + 2) * kstep;
            const char* a3 = a2 + kstep; const char* b3 = b2 + kstep;
            if (last && has_next) S.a_ready(nxt);
            if constexpr (SP2) {
            PG8_LDB(B0, 0, 0); PG8_LDB(B1, 0, 1); PG8_SCHED; PG8_LDA(At, 0, 0); PG8_STAGE(PG8_SA(1, 1), a1 + hstep, voffA);
            PG8_WAIT_V(8); PG8_WAIT_L(0); PG8_BAR; PG8_MMA(0, 0, At, B0); PG8_MMA(0, 1, At, B1); PG8_BAR; PG8_SCHED;
            PG8_LDA(At, 0, 1); PG8_STAGE(PG8_SB(0, 0), b2, voffB); PG8_STAGE(PG8_SB(0, 1), b2 + hstep, voffB); PG8_STAGE(PG8_SA(0, 0), a2, voffA);
            PG8_WAIT_V(8); PG8_WAIT_L(0); PG8_BAR; PG8_MMA(1, 0, At, B0); PG8_MMA(1, 1, At, B1); PG8_BAR; PG8_SCHED;
            PG8_LDB(B0, 1, 0); PG8_LDB(B1, 1, 1); PG8_SCHED; PG8_LDA(At, 1, 0); PG8_STAGE(PG8_SA(0, 1), a2 + hstep, voffA);
            PG8_WAIT_V(8); PG8_WAIT_L(0); PG8_BAR; PG8_MMA(0, 0, At, B0); PG8_MMA(0, 1, At, B1); PG8_BAR; PG8_SCHED;
            PG8_LDA(At, 1, 1); PG8_STAGE(PG8_SB(1, 0), b3, voffB); PG8_STAGE(PG8_SB(1, 1), b3 + hstep, voffB); PG8_STAGE(PG8_SA(1, 0), a3, voffA);
            PG8_WAIT_V(8); PG8_WAIT_L(0); PG8_BAR; PG8_MMA(1, 0, At, B0); PG8_MMA(1, 1, At, B1); PG8_BAR; PG8_SCHED;
            } else {
            PG8_LDB(B0, 0, 0); PG8_SCHED; PG8_LDA(At, 0, 0); PG8_STAGE(PG8_SA(1, 1), a1 + hstep, voffA);
            PG8_WAIT_L(8); PG8_BAR; PG8_WAIT_L(0); PG8_MMA(0, 0, At, B0); PG8_BAR; PG8_SCHED;
            PG8_LDB(B1, 0, 1); PG8_STAGE(PG8_SB(0, 0), b2, voffB);
            PG8_BAR; PG8_WAIT_L(0); PG8_MMA(0, 1, At, B1); PG8_BAR;
            PG8_LDA(At, 0, 1); PG8_STAGE(PG8_SA(0, 0), a2, voffA);
            PG8_BAR; PG8_WAIT_L(0); PG8_MMA(1, 0, At, B0); PG8_BAR; PG8_SCHED;
            PG8_STAGE(PG8_SB(0, 1), b2 + hstep, voffB);
            PG8_WAIT_V(6); PG8_BAR; PG8_MMA(1, 1, At, B1); PG8_BAR;
            PG8_LDB(B0, 1, 0); PG8_SCHED; PG8_LDA(At, 1, 0); PG8_STAGE(PG8_SA(0, 1), a2 + hstep, voffA);
            PG8_WAIT_L(8); PG8_BAR; PG8_WAIT_L(0); PG8_MMA(0, 0, At, B0); PG8_BAR; PG8_SCHED;
            PG8_LDB(B1, 1, 1); PG8_STAGE(PG8_SB(1, 0), b3, voffB);
            PG8_BAR; PG8_WAIT_L(0); PG8_MMA(0, 1, At, B1); PG8_BAR;
            PG8_LDA(At, 1, 1); PG8_STAGE(PG8_SA(1, 0), a3, voffA);
            PG8_BAR; PG8_WAIT_L(0); PG8_MMA(1, 0, At, B0); PG8_BAR; PG8_SCHED;
            PG8_STAGE(PG8_SB(1, 1), b3 + hstep, voffB);
            PG8_WAIT_V(6); PG8_BAR; PG8_MMA(1, 1, At, B1); PG8_BAR;
            }
        }
        if constexpr (FP8W >= 0) asm volatile("s_nop 15\n\ts_nop 15" ::: "memory");
        if constexpr (ALIGN_EPI) { if (wr == 0) PG8_BAR; }
        if constexpr (!Epi::AFTER_DRAIN) { E(acc, cur, wr, wc, fr, fq); S.done(cur); }
        if (!has_next) break;
#pragma unroll
        for (int a = 0; a < 2; ++a)
#pragma unroll
            for (int b = 0; b < 2; ++b)
#pragma unroll
                for (int m = 0; m < 4; ++m)
#pragma unroll
                    for (int n = 0; n < 2; ++n) acc[a][b][m][n] = (f32x4){0.f, 0.f, 0.f, 0.f};
        cur = nxt; cA = nA; cB = nB; ++ui;
        if constexpr (ALIGN_EPI) { if (wr == 1) PG8_BAR; }
    }
    PG8_WAIT_V(0);
    if constexpr (!ALIGN_EPI) { if (wr == 0) PG8_BAR; }
    PG8_BAR;
    if constexpr (Epi::AFTER_DRAIN) { E.fused(acc, cur, wr, wc, fr, fq, lds, wid, lane); S.done(cur); }
#undef PG8_SA
#undef PG8_SB
#undef PG8_STAGE
#undef PG8_LD8
#undef PG8_LDA
#undef PG8_LDB
#undef PG8_MMA
#undef PG8_WAIT_V
#undef PG8_WAIT_L
#undef PG8_BAR
#undef PG8_SCHED
}
}


constexpr int NB = 4, SEQ = 4096, T = NB * SEQ, D = 2048;
constexpr int RW = 1024, NH = 16, HD = 64;
constexpr int IN_W = 12064, SHIFT_W = 3360;
constexpr int ZPW = 3584, QKVW = 4608, GATEW = 4096, NPROJ = 12288;
constexpr int NE = 32, FF = 2048;
constexpr int XS_ROWS = T * 4 + NE * 256;
constexpr int NWAVES = 8, NTHREADS = 512;
constexpr float NORM_EPS = 1e-5f, GN_EPS = 64e-5f;
constexpr float QSCALE = 0.08838834764831845f * 1.4426950408889634f;

#ifndef MK_ONE_LAUNCH
#define MK_ONE_LAUNCH 1
#endif
constexpr int NPHASES = 14;

constexpr size_t MiB = 1ull << 20;
constexpr size_t WS_CTL = 0, CTL_ZERO_BYTES = 1 * MiB;
constexpr size_t WS_WIN = 1 * MiB;
constexpr size_t WS_W1 = WS_WIN + 48 * MiB;
constexpr size_t WS_W2 = WS_W1 + 512 * MiB;
constexpr size_t WS_WOR = WS_W2 + 256 * MiB;
constexpr size_t WS_WOA = WS_WOR + 4 * MiB;
constexpr size_t WS_WOUT = WS_WOA + 2 * MiB;
constexpr size_t WS_H = WS_WOUT + 8 * MiB;
constexpr size_t WS_ZP = WS_H + 64 * MiB;
constexpr size_t WS_QKV = WS_ZP + 112 * MiB;
constexpr size_t WS_GATES = WS_QKV + 144 * MiB;
constexpr size_t WS_ROT = WS_GATES + 128 * MiB;
constexpr size_t WS_SC = WS_ROT + 2 * MiB;
constexpr size_t WS_G = WS_SC + 384 * MiB;
constexpr size_t WS_BONUS = WS_G + 32 * MiB;
constexpr size_t WS_Y = WS_BONUS + 1 * MiB;
constexpr size_t WS_ATTO = WS_Y + 64 * MiB;
constexpr size_t WS_ATTML = WS_ATTO + 48 * MiB;
constexpr size_t WS_YAIN = WS_ATTML + 2 * MiB;
constexpr size_t WS_OIN = WS_YAIN + 32 * MiB;
constexpr size_t WS_MERGED = WS_OIN + 16 * MiB;
constexpr size_t WS_X1 = WS_MERGED + 64 * MiB;
constexpr size_t WS_TOPK = WS_X1 + 128 * MiB;
constexpr size_t WS_ROWS = WS_TOPK + 1 * MiB;
constexpr size_t WS_XS = WS_ROWS + 1 * MiB;
constexpr size_t WS_ACT = WS_XS + 288 * MiB;
constexpr size_t WS_OUTK = WS_ACT + 288 * MiB;
constexpr size_t WS_LORA = WS_OUTK + 256 * MiB;
constexpr size_t WS_END = WS_LORA + 1 * MiB;
constexpr size_t WS_S1 = WS_XS;
constexpr int NU16 = NB * NH * (SEQ / 16);
constexpr size_t S1_WH = 0, S1_QH = 32 * MiB, S1_BT = 64 * MiB, S1_KT = 96 * MiB, S1_VT = 128 * MiB, S1_U0T = 160 * MiB, S1_Y0T = 224 * MiB, S1_GAM = 288 * MiB;
constexpr size_t SC_STRIDE = (size_t)T * RW;
enum { SH_KK = 0, SH_BB = 1, SH_K = 2, SH_R = 3, SH_V = 4 };

constexpr int CW_TMO = 0, CW_CODE = 1, CW_BAR = 4096, CW_CNT = 8192;

constexpr int RING_BYTES = 131072;
constexpr int TAB_OFF = RING_BYTES;
constexpr int MISC_OFF = TAB_OFF + 512;
constexpr int LDS_BYTES = 147456;

#define GAS __attribute__((address_space(1)))
#define LAS __attribute__((address_space(3)))
typedef unsigned short bf16;
typedef unsigned u32x4 __attribute__((ext_vector_type(4)));
typedef unsigned u32x2 __attribute__((ext_vector_type(2)));
typedef float f32x4 __attribute__((ext_vector_type(4)));
typedef short bf16x8 __attribute__((ext_vector_type(8)));
typedef short bf16x4 __attribute__((ext_vector_type(4)));
typedef GAS unsigned gu32;
#define RLX_AGENT __ATOMIC_RELAXED, __HIP_MEMORY_SCOPE_AGENT
#define LDS_WAIT() asm volatile("s_waitcnt lgkmcnt(0)" ::: "memory")
#define VM_WAIT() asm volatile("s_waitcnt vmcnt(0)" ::: "memory")
__device__ __forceinline__ unsigned f2bf(float f) { unsigned u = __builtin_bit_cast(unsigned, f); return (u + 0x7fffu + ((u >> 16) & 1u)) >> 16; }
__device__ __forceinline__ unsigned pk2(float lo, float hi) { return f2bf(lo) | (f2bf(hi) << 16); }
__device__ __forceinline__ float bflo(unsigned w) { return __uint_as_float(w << 16); }
__device__ __forceinline__ float bfhi(unsigned w) { return __uint_as_float(w & 0xffff0000u); }
__device__ __forceinline__ float bf2f(bf16 h) { return __uint_as_float((unsigned)h << 16); }
__device__ __forceinline__ float sigmoidf_(float x) { return 1.0f / (1.0f + __expf(-x)); }
__device__ __forceinline__ float wave_sum(float v) {
#pragma unroll
    for (int o = 1; o < 64; o <<= 1) v += __shfl_xor(v, o);
    return v;
}
__device__ __forceinline__ unsigned pk4_fp8(float a, float b, float c, float d) { int r = __builtin_amdgcn_cvt_pk_fp8_f32(a, b, 0, false); r = __builtin_amdgcn_cvt_pk_fp8_f32(c, d, r, true); return (unsigned)r; }
__device__ __forceinline__ u32x4 pack8(const f32x4& a, const f32x4& b) { u32x4 w; w.x = pk2(a[0], a[1]); w.y = pk2(a[2], a[3]); w.z = pk2(b[0], b[1]); w.w = pk2(b[2], b[3]); return w; }
__device__ __forceinline__ void unpack8(const u32x4& w, f32x4& a, f32x4& b) { a = (f32x4){bflo(w.x), bfhi(w.x), bflo(w.y), bfhi(w.y)}; b = (f32x4){bflo(w.z), bfhi(w.z), bflo(w.w), bfhi(w.w)}; }

#define XB_TMO      128
#define XB_XCNT(j)  (256  + 64 * (j))
#define XB_XSUB(j)  (1280 + 64 * (j))
#define XB_XGEN(j)  (2304 + 64 * (j))
#define XB_TOP      3328
#define XB_TOPGEN   3392
#define XCD_BAR_WORDS 3456
#define XB_SPIN_CAP (1u << 18)

__device__ __forceinline__ unsigned xb_ld(unsigned* p)              { return __hip_atomic_load(p, __ATOMIC_RELAXED, __HIP_MEMORY_SCOPE_AGENT); }
__device__ __forceinline__ unsigned xb_add(unsigned* p, unsigned v) { return __hip_atomic_fetch_add(p, v, __ATOMIC_RELAXED, __HIP_MEMORY_SCOPE_AGENT); }
__device__ __forceinline__ unsigned xb_xcc_id() { return (unsigned)__builtin_amdgcn_s_getreg((3 << 11) | 20) & 0xFu; }
#define XB_SPIN(cond, bar) do { unsigned _sp = 0; while (cond) { __builtin_amdgcn_s_sleep(1); \
    if ((++_sp & 255u) == 0u) { if (xb_ld(&(bar)[XB_TMO])) break; if (_sp > XB_SPIN_CAP) { atomicAdd(&(bar)[XB_TMO], 1u); break; } } } } while (0)

struct XcdBarrier {
    unsigned* bar; unsigned x;
    volatile LAS unsigned* st;
};

__device__ __forceinline__ XcdBarrier xcd_barrier_post(unsigned* bar, volatile LAS unsigned* st) {
    XcdBarrier b; b.bar = bar; b.x = xb_xcc_id(); b.st = st;
    if (threadIdx.x == 0) (void)xb_add(&bar[XB_XCNT(b.x)], 1u);
    return b;
}
__device__ __forceinline__ void xcd_barrier_complete(unsigned* bar, unsigned x, unsigned& nloc, unsigned& nx) {
    const unsigned G = gridDim.x * gridDim.y * gridDim.z;
    unsigned sum, cnt, mine, sp = 0u;
    for (;;) {
        sum = 0u; cnt = 0u; mine = 0u;
#pragma unroll
        for (unsigned j = 0; j < 16; ++j) { const unsigned c = xb_ld(&bar[XB_XCNT(j)]); sum += c; cnt += (c > 0u) ? 1u : 0u; mine = (j == x) ? c : mine; }
        if (sum == G) break;
        __builtin_amdgcn_s_sleep(1);
        if ((++sp & 255u) == 0u) { if (xb_ld(&bar[XB_TMO])) break; if (sp > XB_SPIN_CAP) { atomicAdd(&bar[XB_TMO], 1u); break; } }
    }
    nloc = mine > 0u ? mine : 1u; nx = cnt > 0u ? cnt : 1u;
}

__device__ __forceinline__ void xcd_barrier(const XcdBarrier& b) {
    asm volatile("s_waitcnt vmcnt(0)" ::: "memory");
    __syncthreads();
    if (threadIdx.x == 0) {
        unsigned* bar = b.bar;
        __builtin_amdgcn_s_waitcnt(0);
        unsigned nloc = b.st[0], nx = b.st[1];
        if (nloc == 0u) { xcd_barrier_complete(bar, b.x, nloc, nx); b.st[0] = nloc; b.st[1] = nx; }
        const unsigned old = xb_add(&bar[XB_XSUB(b.x)], 1u);
        const unsigned gen = old / nloc;
        if (old + 1u == (gen + 1u) * nloc) {
            __builtin_amdgcn_fence(__ATOMIC_RELEASE, "agent");
            asm volatile("s_waitcnt vmcnt(0)" ::: "memory");
            const unsigned og = xb_add(&bar[XB_TOP], 1u);
            const unsigned tg = og / nx;
            if (og + 1u == (tg + 1u) * nx) xb_add(&bar[XB_TOPGEN], 1u);
            else XB_SPIN(xb_ld(&bar[XB_TOPGEN]) == tg, bar);
            __builtin_amdgcn_fence(__ATOMIC_ACQUIRE, "agent");
            xb_add(&bar[XB_XGEN(b.x)], 1u);
            asm volatile("s_waitcnt vmcnt(0)" ::: "memory");
        } else {
            XB_SPIN(xb_ld(&bar[XB_XGEN(b.x)]) == gen, bar);
            __builtin_amdgcn_fence(__ATOMIC_ACQUIRE, "agent");
            asm volatile("s_waitcnt vmcnt(0)" ::: "memory");
        }
    }
    __syncthreads();
}


struct Ptrs {
    const float *x, *norm_mix, *w_in, *shift_mu, *w0, *w2_decay, *a0, *a2_iclr, *g2_gate, *k_k, *k_a, *r_k, *ln_x_w, *ln_x_b, *w_o_rwkv, *w_o_attn, *w_out, *norm_ffn, *w_router, *b_router, *w1, *b1, *w2, *b2, *norm_final;
    const int* positions;
    float* out;
    bf16 *LW, *LA, *LG, *WIN, *W1, *W2, *WOR, *WOA, *WOUT, *H, *ZP, *QKV, *GATES, *G, *ATTO, *YAIN, *OIN, *MERGED, *XS, *ACT, *OUTK;
    bf16* SCH;
    float *ROT, *SC, *BONUS, *Y, *ATTML, *X1, *TOPK_GATE, *ROWGATE;
    int *TOPK_E, *TOPK_POS, *ROWTOK;
    gu32* ctl;
};

using pg8::Unit;
__device__ __forceinline__ void store8(bf16* p, const f32x4& a, const f32x4& b) { *(u32x4*)p = pack8(a, b); }

struct EpiProj {
    static constexpr bool PERM = true, AFTER_DRAIN = false;
    bf16* ZP; bf16* QKV; bf16* GATES; const float* ROT;
    __device__ __forceinline__ void operator()(const f32x4 (&acc)[2][2][4][2], const Unit& u, int wr, int wc, int fr, int fq) const {
        const int pn = u.pn, rbase = u.pm * 256 + wr * 64 + fr, cw = wc * 32 + 8 * fq;
        if (pn < 14) {
#pragma unroll
            for (int ai = 0; ai < 2; ++ai)
#pragma unroll
                for (int m = 0; m < 4; ++m) { bf16* rp = ZP + (size_t)(rbase + ai * 128 + m * 16) * ZPW + pn * 256 + cw;
#pragma unroll
                    for (int bj = 0; bj < 2; ++bj) store8(rp + bj * 128, acc[ai][bj][m][0], acc[ai][bj][m][1]); }
        } else if (pn < 32) {
            const int t = pn - 14; const bool rot = (t < 12) && (wc == 0); const float sc = (t < 6) ? QSCALE : 1.0f; const float sg = (fq < 2) ? -1.0f : 1.0f;
#pragma unroll
            for (int ai = 0; ai < 2; ++ai)
#pragma unroll
                for (int m = 0; m < 4; ++m) { const int row = rbase + ai * 128 + m * 16; bf16* rp = QKV + (size_t)row * QKVW + t * 256 + cw;
                    f32x4 c0 = {1.f, 1.f, 1.f, 1.f}, c1 = c0, s0 = {0.f, 0.f, 0.f, 0.f}, s1 = s0;
                    if (rot) { const float* rt = ROT + (size_t)row * 32 + 8 * (fq & 1); c0 = *(const f32x4*)rt; c1 = *(const f32x4*)(rt + 4); s0 = *(const f32x4*)(rt + 16); s1 = *(const f32x4*)(rt + 20); }
#pragma unroll
                    for (int bj = 0; bj < 2; ++bj) { f32x4 v0 = acc[ai][bj][m][0], v1 = acc[ai][bj][m][1];
                        if (rot) { f32x4 p0, p1;
#pragma unroll
                            for (int j = 0; j < 4; ++j) { p0[j] = __shfl_xor(v0[j], 32); p1[j] = __shfl_xor(v1[j], 32); }
                            v0 = v0 * c0 + (p0 * s0) * sg; v1 = v1 * c1 + (p1 * s1) * sg; }
                        v0 = v0 * sc; v1 = v1 * sc; store8(rp + bj * 128, v0, v1); } }
        } else {
            const int t = pn - 32;
#pragma unroll
            for (int ai = 0; ai < 2; ++ai)
#pragma unroll
                for (int m = 0; m < 4; ++m) { bf16* rp = GATES + (size_t)(rbase + ai * 128 + m * 16) * GATEW + t * 256 + cw;
#pragma unroll
                    for (int bj = 0; bj < 2; ++bj) { f32x4 v0 = acc[ai][bj][m][0], v1 = acc[ai][bj][m][1];
#pragma unroll
                        for (int j = 0; j < 4; ++j) { v0[j] = sigmoidf_(v0[j]); v1[j] = sigmoidf_(v1[j]); }
                        store8(rp + bj * 128, v0, v1); } }
        }
    }
};

template <int STAGE> struct EpiMerge {
    static constexpr bool PERM = true, AFTER_DRAIN = false;
    bf16* MERGED; const bf16* GATES;
    __device__ __forceinline__ void operator()(const f32x4 (&acc)[2][2][4][2], const Unit& u, int wr, int wc, int fr, int fq) const {
        const int rbase = u.pm * 256 + wr * 64 + fr, cb = u.pn * 256 + wc * 32 + 8 * fq;
#pragma unroll
        for (int ai = 0; ai < 2; ++ai)
#pragma unroll
            for (int m = 0; m < 4; ++m) { const int row = rbase + ai * 128 + m * 16;
#pragma unroll
                for (int bj = 0; bj < 2; ++bj) { const int col = cb + bj * 128;
                    const u32x4 gw = *(const u32x4*)(GATES + (size_t)row * GATEW + STAGE * 2048 + col); f32x4 g0, g1; unpack8(gw, g0, g1);
                    f32x4 v0 = acc[ai][bj][m][0] * g0, v1 = acc[ai][bj][m][1] * g1; bf16* dp = MERGED + (size_t)row * D + col;
                    if (STAGE == 1) { const u32x4 tw = *(const u32x4*)dp; f32x4 t0, t1; unpack8(tw, t0, t1); v0 = v0 + t0; v1 = v1 + t1; }
                    store8(dp, v0, v1); } }
    }
};

struct EpiResid {
    static constexpr bool PERM = false, AFTER_DRAIN = false;
    const float* X; float* X1;
    __device__ __forceinline__ void operator()(const f32x4 (&acc)[2][2][4][2], const Unit& u, int wr, int wc, int fr, int fq) const {
        const int rbase = u.pm * 256 + wr * 64 + fr, cb = u.pn * 256 + wc * 32 + 4 * fq;
#pragma unroll
        for (int ai = 0; ai < 2; ++ai)
#pragma unroll
            for (int m = 0; m < 4; ++m) { const size_t ro = (size_t)(rbase + ai * 128 + m * 16) * D;
#pragma unroll
                for (int bj = 0; bj < 2; ++bj)
#pragma unroll
                    for (int n = 0; n < 2; ++n) { const int col = cb + bj * 128 + n * 16; *(f32x4*)(X1 + ro + col) = *(const f32x4*)(X + ro + col) + acc[ai][bj][m][n]; } }
    }
};

struct EpiMoe1 {
    static constexpr bool PERM = true, AFTER_DRAIN = false;
    bf16* ACT; const float* b1;
    __device__ __forceinline__ void operator()(const f32x4 (&acc)[2][2][4][2], const Unit& u, int wr, int wc, int fr, int fq) const {
        const int e = u.pn >> 4, pnl = u.pn & 15, rbase = u.pm * 256 + wr * 64 + fr, col = pnl * 128 + wc * 32 + 8 * fq;
        const float* bg = b1 + (size_t)e * 4096 + col; const float* bl = bg + 2048;
        const f32x4 bg0 = *(const f32x4*)bg, bg1 = *(const f32x4*)(bg + 4), bl0 = *(const f32x4*)bl, bl1 = *(const f32x4*)(bl + 4);
#pragma unroll
        for (int ai = 0; ai < 2; ++ai)
#pragma unroll
            for (int m = 0; m < 4; ++m) { const int row = rbase + ai * 128 + m * 16;
                f32x4 g0 = acc[ai][0][m][0] + bg0, g1 = acc[ai][0][m][1] + bg1, l0 = acc[ai][1][m][0] + bl0, l1 = acc[ai][1][m][1] + bl1, o0, o1;
#pragma unroll
                for (int j = 0; j < 4; ++j) {
                    { const float xg = fminf(g0[j], 7.0f), xl = fminf(fmaxf(l0[j], -7.0f), 7.0f); o0[j] = xg * sigmoidf_(1.702f * xg) * (xl + 1.0f); }
                    { const float xg = fminf(g1[j], 7.0f), xl = fminf(fmaxf(l1[j], -7.0f), 7.0f); o1[j] = xg * sigmoidf_(1.702f * xg) * (xl + 1.0f); } }
                u32x2 w8; w8.x = pk4_fp8(o0[0] * 8.0f, o0[1] * 8.0f, o0[2] * 8.0f, o0[3] * 8.0f); w8.y = pk4_fp8(o1[0] * 8.0f, o1[1] * 8.0f, o1[2] * 8.0f, o1[3] * 8.0f);
                *(u32x2*)((unsigned char*)ACT + (size_t)row * FF + col) = w8; }
    }
};

struct EpiMoe2 {
    static constexpr bool PERM = true, AFTER_DRAIN = false;
    bf16* OUTK; const float* b2; const int* ROWTOK; const float* ROWGATE;
    __device__ __forceinline__ void operator()(const f32x4 (&acc)[2][2][4][2], const Unit& u, int wr, int wc, int fr, int fq) const {
        const int e = u.pn >> 3, pnl = u.pn & 7, rbase = u.pm * 256 + wr * 64 + fr, cb = pnl * 256 + wc * 32 + 8 * fq;
        f32x4 bv[2][2];
#pragma unroll
        for (int bj = 0; bj < 2; ++bj) { const float* bp = b2 + (size_t)e * D + cb + bj * 128; bv[bj][0] = *(const f32x4*)bp; bv[bj][1] = *(const f32x4*)(bp + 4); }
#pragma unroll
        for (int ai = 0; ai < 2; ++ai)
#pragma unroll
            for (int m = 0; m < 4; ++m) { const int row = rbase + ai * 128 + m * 16; const int p = ROWTOK[row];
                if (p >= 0) { const float gt = ROWGATE[row];
#pragma unroll
                    for (int bj = 0; bj < 2; ++bj) { const f32x4 v0 = (acc[ai][bj][m][0] + bv[bj][0]) * gt, v1 = (acc[ai][bj][m][1] + bv[bj][1]) * gt; store8(OUTK + (size_t)p * D + cb + bj * 128, v0, v1); } } }
    }
};

struct MoeOrder {
    const LAS int* toff; int npn, G, c;
    __device__ __forceinline__ bool next(int i, Unit& u) const {
        const int L = i * G + c, NT = toff[32];
        if (L >= NT * npn) return false;
        int e = 0;
#pragma unroll 1
        for (int j = 1; j < 32; ++j) e += (L >= toff[j] * npn) ? 1 : 0;
        const int t0 = toff[e], te = toff[e + 1] - t0, rem = L - t0 * npn;
        const int pnl = rem / te, pml = rem - pnl * te;
        u.pm = __builtin_amdgcn_readfirstlane(t0 + pml); u.pn = __builtin_amdgcn_readfirstlane(e * npn + pnl); return true;
    }
    __device__ __forceinline__ void a_ready(const Unit&) const {}
    __device__ __forceinline__ void done(const Unit&) const {}
};

__device__ __forceinline__ void tr_item(const float* src, int ldn, int k0, int c0, bf16* dst, size_t dstrow0, int K, LAS float* scr, int lane) {
    f32x4 v[8];
#pragma unroll
    for (int i = 0; i < 8; ++i) v[i] = *(const GAS f32x4*)(src + (size_t)(k0 + 8 * i + (lane >> 3)) * ldn + c0 + 4 * (lane & 7));
#pragma unroll
    for (int i = 0; i < 8; ++i) { LAS float* p = scr + (8 * i + (lane >> 3)) * 33 + 4 * (lane & 7); p[0] = v[i].x; p[1] = v[i].y; p[2] = v[i].z; p[3] = v[i].w; }
    LDS_WAIT(); asm volatile("" ::: "memory");
    const int c = lane & 7;
#pragma unroll
    for (int j = 0; j < 4; ++j) { const int n = (lane >> 3) + 8 * j; const LAS float* s = scr + (8 * c) * 33 + n;
        u32x4 o; o.x = pk2(s[0 * 33], s[1 * 33]); o.y = pk2(s[2 * 33], s[3 * 33]); o.z = pk2(s[4 * 33], s[5 * 33]); o.w = pk2(s[6 * 33], s[7 * 33]);
        *(GAS u32x4*)(dst + (dstrow0 + n) * (size_t)K + k0 + 8 * c) = o; }
    LDS_WAIT(); asm volatile("" ::: "memory");
}
__device__ __forceinline__ void tr8_tile(const float* src, int ldn, int k0, int c0, unsigned char* dst, size_t dstrow0, int K, float sc, LAS float* scr, int lane) {
    f32x4 v[16];
#pragma unroll
    for (int i = 0; i < 16; ++i) v[i] = *(const GAS f32x4*)(src + (size_t)(k0 + 8 * i + (lane >> 3)) * ldn + c0 + 4 * (lane & 7));
#pragma unroll
    for (int i = 0; i < 16; ++i) { LAS float* p = scr + (8 * i + (lane >> 3)) * 33 + 4 * (lane & 7); p[0] = v[i].x * sc; p[1] = v[i].y * sc; p[2] = v[i].z * sc; p[3] = v[i].w * sc; }
    LDS_WAIT(); asm volatile("" ::: "memory");
    const int n = lane & 31;
#pragma unroll
    for (int j = 0; j < 4; ++j) { const int kc = (lane >> 5) + 2 * j; const LAS float* s = scr + (16 * kc) * 33 + n;
        u32x4 o; o.x = pk4_fp8(s[0 * 33], s[1 * 33], s[2 * 33], s[3 * 33]); o.y = pk4_fp8(s[4 * 33], s[5 * 33], s[6 * 33], s[7 * 33]);
        o.z = pk4_fp8(s[8 * 33], s[9 * 33], s[10 * 33], s[11 * 33]); o.w = pk4_fp8(s[12 * 33], s[13 * 33], s[14 * 33], s[15 * 33]);
        *(GAS u32x4*)(dst + (dstrow0 + n) * (size_t)K + k0 + 16 * kc) = o; }
    LDS_WAIT(); asm volatile("" ::: "memory");
}
__device__ __forceinline__ void tr_item8(const float* src, int ldn, int k0, int c0, unsigned char* dst, size_t dstrow0, int K, float sc, LAS float* scr, int lane) {
    f32x4 v[8];
#pragma unroll
    for (int i = 0; i < 8; ++i) v[i] = *(const GAS f32x4*)(src + (size_t)(k0 + 8 * i + (lane >> 3)) * ldn + c0 + 4 * (lane & 7));
#pragma unroll
    for (int i = 0; i < 8; ++i) { LAS float* p = scr + (8 * i + (lane >> 3)) * 33 + 4 * (lane & 7); p[0] = v[i].x * sc; p[1] = v[i].y * sc; p[2] = v[i].z * sc; p[3] = v[i].w * sc; }
    LDS_WAIT(); asm volatile("" ::: "memory");
    const int c = lane & 7;
#pragma unroll
    for (int j = 0; j < 4; ++j) { const int n = (lane >> 3) + 8 * j; const LAS float* s = scr + (8 * c) * 33 + n;
        u32x2 o; o.x = pk4_fp8(s[0 * 33], s[1 * 33], s[2 * 33], s[3 * 33]); o.y = pk4_fp8(s[4 * 33], s[5 * 33], s[6 * 33], s[7 * 33]);
        *(GAS u32x2*)(dst + (dstrow0 + n) * (size_t)K + k0 + 8 * c) = o; }
    LDS_WAIT(); asm volatile("" ::: "memory");
}
__device__ __forceinline__ void rms_row_to_bf16(const float* xrow, const float* g, bf16* orow, int lane) {
    f32x4 v[8]; float s = 0.f;
#pragma unroll
    for (int j = 0; j < 8; ++j) { v[j] = *(const GAS f32x4*)(xrow + 4 * lane + 256 * j); s += (v[j].x * v[j].x + v[j].y * v[j].y) + (v[j].z * v[j].z + v[j].w * v[j].w); }
    const float rs = 1.0f / sqrtf(wave_sum(s) * (1.0f / D) + NORM_EPS);
#pragma unroll
    for (int j = 0; j < 8; ++j) { const f32x4 gv = *(const GAS f32x4*)(g + 4 * lane + 256 * j); u32x2 w; w.x = pk2(v[j].x * rs * gv.x, v[j].y * rs * gv.y); w.y = pk2(v[j].z * rs * gv.z, v[j].w * rs * gv.w);
        *(GAS u32x2*)(orow + 4 * lane + 256 * j) = w; }
}
__device__ __forceinline__ void p0_prologue(const Ptrs& P, LAS unsigned char* lds, int tid, int wave, int lane) {
    LAS float* scr = (LAS float*)(lds + wave * 8704);
    const int gw = blockIdx.x * NWAVES + wave, NGW = gridDim.x * NWAVES;
    constexpr int I_IN = 32 * 377, I_OR = 16 * 64, I_OA = 8 * 64, I_OUT = 32 * 64;
    constexpr int NITEMS = I_IN + I_OR + I_OA + I_OUT;
    for (int it = gw; it < NITEMS; it += NGW) {
        int r = it;
        if (r < I_IN) { const int kb = r / 377, nb = r % 377, c0 = 32 * nb; tr_item(P.w_in, IN_W, 64 * kb, c0, P.WIN, (size_t)(c0 < SHIFT_W ? c0 : c0 + 224), D, scr, lane); continue; }
        r -= I_IN;
        if (r < I_OR) { const int kb = r >> 6, nb = r & 63; tr_item(P.w_o_rwkv, D, 64 * kb, 32 * nb, P.WOR, (size_t)32 * nb, RW, scr, lane); continue; }
        r -= I_OR;
        if (r < I_OA) { const int kb = r >> 6, nb = r & 63; tr_item(P.w_o_attn, D, 64 * kb, 32 * nb, P.WOA, (size_t)32 * nb, 512, scr, lane); continue; }
        r -= I_OA;
        { const int kb = r >> 6, nb = r & 63; tr_item(P.w_out, D, 64 * kb, 32 * nb, P.WOUT, (size_t)32 * nb, D, scr, lane); }
    }
    { const int gt = blockIdx.x * NTHREADS + tid, NGT = gridDim.x * NTHREADS; GAS u32x4* z = (GAS u32x4*)(P.WIN + (size_t)SHIFT_W * D);
      for (int i = gt; i < 224 * D / 8; i += NGT) z[i] = (u32x4){0u, 0u, 0u, 0u}; }
    { const int gt = blockIdx.x * NTHREADS + tid, NGT = gridDim.x * NTHREADS;
      for (int i = gt; i < 1024 * 64; i += NGT) { const int n = i >> 6, k = i & 63; P.LW[i] = (bf16)f2bf(P.w2_decay[k * RW + n]); P.LA[i] = (bf16)f2bf(P.a2_iclr[k * RW + n]); }
      for (int i = gt; i < 1024 * 160; i += NGT) { const int n = i / 160, k = i - n * 160; P.LG[i] = (bf16)f2bf(P.g2_gate[k * RW + n]); } }
    for (int m = gw; m < T; m += NGW) rms_row_to_bf16(P.x + (size_t)m * D, P.norm_mix, P.H + (size_t)m * D, lane);
    { const int gt = blockIdx.x * NTHREADS + tid, NGT = gridDim.x * NTHREADS;
      for (int i = gt; i < T * 16; i += NGT) { const int m = i >> 4, f = i & 15; const float inv = exp2f(-(float)f * (18.931568569324174f / 16.0f));
          const float ang = (float)P.positions[m] * inv; double rev = (double)ang * 0.15915494309189535; rev -= floor(rev); const float rv = (float)rev; const float sn = __builtin_amdgcn_sinf(rv), cs = __builtin_amdgcn_cosf(rv); P.ROT[(size_t)m * 32 + f] = cs; P.ROT[(size_t)m * 32 + 16 + f] = sn; } }
}

template <int CTRL> __device__ __forceinline__ float dppf(float x) { return __builtin_bit_cast(float, __builtin_amdgcn_mov_dpp(__builtin_bit_cast(int, x), CTRL, 0xf, 0xf, true)); }
__device__ __forceinline__ float sum8(float x) { x += dppf<0xB1>(x); x += dppf<0x4E>(x); x += dppf<0x141>(x); return x; }
__device__ __forceinline__ f32x4 mfma16(bf16x8 a, bf16x8 b, f32x4 c) { return __builtin_amdgcn_mfma_f32_16x16x32_bf16(a, b, c, 0, 0, 0); }
__device__ __forceinline__ void p2_rwkv_prep(const Ptrs& P, LAS unsigned char* lds, int tid, int wave, int lane) {
    constexpr int AWP = 144, AGP = 336, SLP = 196;
    LAS unsigned char* AW = lds; LAS unsigned char* AA = lds + 9216; LAS unsigned char* AG = lds + 18432; LAS float* slab = (LAS float*)(lds + 40960);
    const int fr = lane & 15, fq = lane >> 4;
    for (int u = blockIdx.x; u < T / 64; u += gridDim.x) {
        const int m0 = u * 64;
        __syncthreads();
        for (int item = tid; item < 64 * 36; item += NTHREADS) { const int tk = item / 36, c8 = item - tk * 36, m = m0 + tk, col0 = 3072 + 8 * c8;
            const u32x4 pw = *(const GAS u32x4*)(P.ZP + (size_t)m * ZPW + col0); u32x4 qw = {0u, 0u, 0u, 0u}; if (m % SEQ) qw = *(const GAS u32x4*)(P.ZP + (size_t)(m - 1) * ZPW + col0);
            f32x4 p0, p1, q0, q1; unpack8(pw, p0, p1); unpack8(qw, q0, q1);
            const f32x4 mu0 = *(const GAS f32x4*)(P.shift_mu + col0), mu1 = *(const GAS f32x4*)(P.shift_mu + col0 + 4);
            f32x4 z0 = p0 + (q0 - p0) * mu0, z1 = p1 + (q1 - p1) * mu1;
            if (c8 < 8) {
#pragma unroll
                for (int j = 0; j < 4; ++j) { z0[j] = tanhf(z0[j]); z1[j] = tanhf(z1[j]); }
                *(LAS u32x4*)(AW + tk * AWP + c8 * 16) = pack8(z0, z1);
            } else if (c8 < 16) { *(LAS u32x4*)(AA + tk * AWP + (c8 - 8) * 16) = pack8(z0, z1);
            } else {
#pragma unroll
                for (int j = 0; j < 4; ++j) { z0[j] = sigmoidf_(z0[j]); z1[j] = sigmoidf_(z1[j]); }
                *(LAS u32x4*)(AG + tk * AGP + (c8 - 16) * 16) = pack8(z0, z1); } }
        __syncthreads();
        const int ct = wave & 3, tt0 = (wave >> 2) * 2;
        const int etk = tid >> 3, ec8 = tid & 7, em = m0 + etk; const bool ehasp = (em % SEQ) != 0;
#pragma unroll 1
        for (int h = 0; h < NH; ++h) {
            { const int chrow = h * 64 + ct * 16 + fr;
              f32x4 acc[2][3];
#pragma unroll
              for (int t = 0; t < 2; ++t)
#pragma unroll
                  for (int kd = 0; kd < 3; ++kd) acc[t][kd] = (f32x4){0.f, 0.f, 0.f, 0.f};
#pragma unroll
              for (int ks = 0; ks < 2; ++ks) { const bf16x8 wf = *(const GAS bf16x8*)(P.LW + (size_t)chrow * 64 + ks * 32 + 8 * fq), af = *(const GAS bf16x8*)(P.LA + (size_t)chrow * 64 + ks * 32 + 8 * fq);
#pragma unroll
                  for (int t = 0; t < 2; ++t) { const int tok = (tt0 + t) * 16 + fr;
                      acc[t][0] = mfma16(wf, *(const LAS bf16x8*)(AW + tok * AWP + (ks * 32 + 8 * fq) * 2), acc[t][0]);
                      acc[t][1] = mfma16(af, *(const LAS bf16x8*)(AA + tok * AWP + (ks * 32 + 8 * fq) * 2), acc[t][1]); } }
#pragma unroll
              for (int ks = 0; ks < 5; ++ks) { const bf16x8 gf = *(const GAS bf16x8*)(P.LG + (size_t)chrow * 160 + ks * 32 + 8 * fq);
#pragma unroll
                  for (int t = 0; t < 2; ++t) { const int tok = (tt0 + t) * 16 + fr; acc[t][2] = mfma16(gf, *(const LAS bf16x8*)(AG + tok * AGP + (ks * 32 + 8 * fq) * 2), acc[t][2]); } }
#pragma unroll
              for (int t = 0; t < 2; ++t)
#pragma unroll
                  for (int kd = 0; kd < 3; ++kd) *(LAS f32x4*)(slab + ((tt0 + t) * 16 + fr) * SLP + kd * 64 + ct * 16 + 4 * fq) = acc[t][kd]; }
            __syncthreads();
            { const int ch0 = h * 64 + 8 * ec8; const LAS float* sl = slab + etk * SLP + 8 * ec8;
              const bf16* zp = P.ZP + (size_t)em * ZPW + ch0;
              float rr[8], kv[8], vv[8];
#pragma unroll
              for (int sg = 0; sg < 3; ++sg) { const u32x4 pw = *(const GAS u32x4*)(zp + sg * 1024); u32x4 qw = {0u, 0u, 0u, 0u}; if (ehasp) qw = *(const GAS u32x4*)(zp - ZPW + sg * 1024);
                  f32x4 p0, p1, q0, q1; unpack8(pw, p0, p1); unpack8(qw, q0, q1);
                  const f32x4 mu0 = *(const GAS f32x4*)(P.shift_mu + sg * 1024 + ch0), mu1 = *(const GAS f32x4*)(P.shift_mu + sg * 1024 + ch0 + 4);
                  const f32x4 z0 = p0 + (q0 - p0) * mu0, z1 = p1 + (q1 - p1) * mu1;
#pragma unroll
                  for (int j = 0; j < 4; ++j) { if (sg == 0) { rr[j] = z0[j]; rr[4 + j] = z1[j]; } else if (sg == 1) { kv[j] = z0[j]; kv[4 + j] = z1[j]; } else { vv[j] = z0[j]; vv[4 + j] = z1[j]; } } }
              float dec[8], av[8], gv[8], kkp[8], kn[8]; float ss = 0.f, bon = 0.f;
#pragma unroll
              for (int q = 0; q < 2; ++q) { const f32x4 wr_ = *(const LAS f32x4*)(sl + 4 * q), ap = *(const LAS f32x4*)(sl + 64 + 4 * q), gg = *(const LAS f32x4*)(sl + 128 + 4 * q);
                  const f32x4 w0v = *(const GAS f32x4*)(P.w0 + ch0 + 4 * q), a0v = *(const GAS f32x4*)(P.a0 + ch0 + 4 * q), kkv = *(const GAS f32x4*)(P.k_k + ch0 + 4 * q), kav = *(const GAS f32x4*)(P.k_a + ch0 + 4 * q), rkv = *(const GAS f32x4*)(P.r_k + ch0 + 4 * q);
#pragma unroll
                  for (int j = 0; j < 4; ++j) { const int i = 4 * q + j;
                      dec[i] = __expf(-0.6065306597126334f * sigmoidf_(w0v[j] + wr_[j])); av[i] = sigmoidf_(a0v[j] + ap[j]); gv[i] = gg[j];
                      kkp[i] = kv[i] * kkv[j]; ss += kkp[i] * kkp[i]; kn[i] = kv[i] * (1.0f + (av[i] - 1.0f) * kav[j]); bon += rr[i] * kn[i] * rkv[j]; } }
              ss = sum8(ss); bon = sum8(bon);
              const float rn = 1.0f / fmaxf(sqrtf(ss), 1e-12f);
              const size_t o = (size_t)em * RW + ch0;
              f32x4 t0, t1;
#pragma unroll
              for (int j = 0; j < 4; ++j) { t0[j] = -kkp[j] * rn; t1[j] = -kkp[4 + j] * rn; }
              *(GAS u32x4*)(P.SCH + SH_KK * SC_STRIDE + o) = pack8(t0, t1);
#pragma unroll
              for (int j = 0; j < 4; ++j) { t0[j] = -t0[j] * av[j]; t1[j] = -t1[j] * av[4 + j]; }
              *(GAS u32x4*)(P.SCH + SH_BB * SC_STRIDE + o) = pack8(t0, t1);
              *(GAS f32x4*)(P.SC + o) = (f32x4){dec[0], dec[1], dec[2], dec[3]}; *(GAS f32x4*)(P.SC + o + 4) = (f32x4){dec[4], dec[5], dec[6], dec[7]};
              *(GAS u32x4*)(P.SCH + SH_K * SC_STRIDE + o) = pack8((f32x4){kn[0], kn[1], kn[2], kn[3]}, (f32x4){kn[4], kn[5], kn[6], kn[7]});
              *(GAS u32x4*)(P.SCH + SH_R * SC_STRIDE + o) = pack8((f32x4){rr[0], rr[1], rr[2], rr[3]}, (f32x4){rr[4], rr[5], rr[6], rr[7]});
              *(GAS u32x4*)(P.SCH + SH_V * SC_STRIDE + o) = pack8((f32x4){vv[0], vv[1], vv[2], vv[3]}, (f32x4){vv[4], vv[5], vv[6], vv[7]});
              *(GAS u32x4*)(P.G + o) = pack8((f32x4){gv[0], gv[1], gv[2], gv[3]}, (f32x4){gv[4], gv[5], gv[6], gv[7]});
              if (ec8 == 0) P.BONUS[(size_t)em * NH + h] = bon; }
            __syncthreads();
        }
    }
}

__device__ __forceinline__ void p3_attention(const Ptrs& P, LAS unsigned char* lds, int tid, int wave, int lane) {
    const int fr = lane & 15, fq = lane >> 4;
    LAS unsigned char* Ks = lds; LAS unsigned char* Vt = lds + 34816;
    for (int u = blockIdx.x; u < NB * 12 * 32; u += gridDim.x) {
        const int b = u / 384, r = u - b * 384, gh = r >> 5, idx = r & 31, g = gh >> 2;
        const int d = (g == 0) ? 1 : ((g == 1) ? 4 : 16), nb = 32 / d, c = idx / nb, n = idx - c * nb;
        const int qi = wave * 16 + fr; const size_t mq = (size_t)b * SEQ + (size_t)(n * 128 + qi) * d + c;
        const bf16* qrow = P.QKV + mq * QKVW + gh * 128;
        bf16x8 qf[4];
#pragma unroll
        for (int ks = 0; ks < 4; ++ks) qf[ks] = *(const GAS bf16x8*)(qrow + 32 * ks + 8 * fq);
        f32x4 o[8];
#pragma unroll
        for (int dt = 0; dt < 8; ++dt) o[dt] = (f32x4){0.f, 0.f, 0.f, 0.f};
        float mrun = -1e30f, lrun = 0.f;
        for (int kb = (n == 0) ? 1 : 0; kb < 2; ++kb) {
            const int kblk = n - 1 + kb;
            __syncthreads();
#pragma unroll
            for (int i = 0; i < 4; ++i) { const int p = tid + 512 * i, key = p >> 4, part = p & 15; const size_t mk = (size_t)b * SEQ + (size_t)(kblk * 128 + key) * d + c;
                *(LAS u32x4*)(Ks + key * 272 + part * 16) = *(const GAS u32x4*)(P.QKV + mk * QKVW + 1536 + gh * 128 + part * 8); }
#pragma unroll
            for (int i = 0; i < 4; ++i) { const int key = tid & 127, part = (tid >> 7) + 4 * i; const size_t mk = (size_t)b * SEQ + (size_t)(kblk * 128 + key) * d + c;
                const u32x4 v = *(const GAS u32x4*)(P.QKV + mk * QKVW + 3072 + gh * 128 + part * 8);
                LAS unsigned char* vp = Vt + (8 * part) * 272 + key * 2;
                *(LAS unsigned short*)(vp + 0 * 272) = (unsigned short)(v.x & 0xffffu); *(LAS unsigned short*)(vp + 1 * 272) = (unsigned short)(v.x >> 16);
                *(LAS unsigned short*)(vp + 2 * 272) = (unsigned short)(v.y & 0xffffu); *(LAS unsigned short*)(vp + 3 * 272) = (unsigned short)(v.y >> 16);
                *(LAS unsigned short*)(vp + 4 * 272) = (unsigned short)(v.z & 0xffffu); *(LAS unsigned short*)(vp + 5 * 272) = (unsigned short)(v.z >> 16);
                *(LAS unsigned short*)(vp + 6 * 272) = (unsigned short)(v.w & 0xffffu); *(LAS unsigned short*)(vp + 7 * 272) = (unsigned short)(v.w >> 16); }
            __syncthreads();
            f32x4 s[8];
#pragma unroll
            for (int kt = 0; kt < 8; ++kt) { s[kt] = (f32x4){0.f, 0.f, 0.f, 0.f};
#pragma unroll
                for (int ks = 0; ks < 4; ++ks) { const bf16x8 a = *(const LAS bf16x8*)(Ks + (kt * 16 + fr) * 272 + (32 * ks + 8 * fq) * 2); s[kt] = mfma16(a, qf[ks], s[kt]); } }
            float mx = -1e30f;
#pragma unroll
            for (int kt = 0; kt < 8; ++kt)
#pragma unroll
                for (int rg = 0; rg < 4; ++rg) { const int j = kt * 16 + 4 * fq + rg; const bool ok = (kb == 0) ? (j >= qi) : (j <= qi); const float sv = ok ? s[kt][rg] : -1e30f; s[kt][rg] = sv; mx = fmaxf(mx, sv); }
            mx = fmaxf(mx, __shfl_xor(mx, 16)); mx = fmaxf(mx, __shfl_xor(mx, 32));
            const float mnew = fmaxf(mrun, mx), alpha = exp2f(mrun - mnew); mrun = mnew;
            float ls = 0.f;
#pragma unroll
            for (int kt = 0; kt < 8; ++kt)
#pragma unroll
                for (int rg = 0; rg < 4; ++rg) { const float p = exp2f(s[kt][rg] - mnew); s[kt][rg] = p; ls += p; }
            lrun = lrun * alpha + ls;
#pragma unroll
            for (int dt = 0; dt < 8; ++dt) o[dt] = o[dt] * alpha;
#pragma unroll
            for (int pi = 0; pi < 4; ++pi) {
                const u32x4 bw = pack8(s[2 * pi], s[2 * pi + 1]); const bf16x8 bfrag = __builtin_bit_cast(bf16x8, bw);
#pragma unroll
                for (int dt = 0; dt < 8; ++dt) { const LAS unsigned char* vp = Vt + (dt * 16 + fr) * 272 + (2 * pi * 16 + 4 * fq) * 2;
                    const u32x2 lo = *(const LAS u32x2*)vp, hi = *(const LAS u32x2*)(vp + 32);
                    const u32x4 aw = {lo.x, lo.y, hi.x, hi.y}; o[dt] = mfma16(__builtin_bit_cast(bf16x8, aw), bfrag, o[dt]); } }
        }
        lrun += __shfl_xor(lrun, 16); lrun += __shfl_xor(lrun, 32);
        bf16* orow = P.ATTO + (mq * 12 + gh) * 128;
#pragma unroll
        for (int dt = 0; dt < 8; ++dt) { u32x2 w; w.x = pk2(o[dt][0], o[dt][1]); w.y = pk2(o[dt][2], o[dt][3]); *(GAS u32x2*)(orow + dt * 16 + 4 * fq) = w; }
        if (fq == 0) { P.ATTML[(mq * 12 + gh) * 2] = mrun; P.ATTML[(mq * 12 + gh) * 2 + 1] = lrun; }
    }
}

__device__ __forceinline__ u32x4 pack8s(const float* p) { u32x4 w; w.x = pk2(p[0], p[1]); w.y = pk2(p[2], p[3]); w.z = pk2(p[4], p[5]); w.w = pk2(p[6], p[7]); return w; }
__device__ __forceinline__ void p4a_chunk_prep(const Ptrs& P, unsigned char* ws, LAS unsigned char* lds, int tid, int wave, int lane) {
    LAS unsigned char* wl = lds + wave * 16384;
    LAS unsigned char* AH = wl, *BH = wl + 2048, *KH = wl + 4096, *RH = wl + 6144;
    LAS unsigned char* AT = wl + 8192, *RT = wl + 10240, *VTl = wl + 12288;
    LAS unsigned char* MX = wl + 14336;
    LAS unsigned char* WTl = wl, *U0Tl = wl + 2048, *PT = wl + 8192; LAS float* LmT = (LAS float*)(wl + 4096);
    const int fr = lane & 15, fq = lane >> 4, fq1 = fq & 1;
    const int gw = blockIdx.x * NWAVES + wave, NGW = gridDim.x * NWAVES;
    unsigned char* s1 = ws + WS_S1;
    for (int uidx = gw; uidx < NU16; uidx += NGW) {
        const int bh = uidx >> 8, c16 = uidx & 255, b = bh >> 4, h = bh & 15;
        const size_t gbase = ((size_t)b * SEQ + (size_t)c16 * 16) * RW + h * 64 + lane;
        float av[16], bv[16], kv[16], rv[16], vv[16];
        {   float wv[16];
#pragma unroll
            for (int t = 0; t < 16; ++t) { const size_t o = gbase + (size_t)t * RW; wv[t] = P.SC[o]; av[t] = bf2f(P.SCH[SH_KK * SC_STRIDE + o]); bv[t] = bf2f(P.SCH[SH_BB * SC_STRIDE + o]);
                kv[t] = bf2f(P.SCH[SH_K * SC_STRIDE + o]); rv[t] = bf2f(P.SCH[SH_R * SC_STRIDE + o]); vv[t] = bf2f(P.SCH[SH_V * SC_STRIDE + o]); }
            float g = 1.0f;
#pragma unroll
            for (int t = 0; t < 16; ++t) { const float gp = g; g *= wv[t]; const float inv = 1.0f / g; av[t] *= gp; bv[t] *= inv; kv[t] *= inv; rv[t] *= g;
                *(LAS unsigned short*)(AH + t * 128 + lane * 2) = (unsigned short)f2bf(av[t]); *(LAS unsigned short*)(BH + t * 128 + lane * 2) = (unsigned short)f2bf(bv[t]);
                *(LAS unsigned short*)(KH + t * 128 + lane * 2) = (unsigned short)f2bf(kv[t]); *(LAS unsigned short*)(RH + t * 128 + lane * 2) = (unsigned short)f2bf(rv[t]); }
            *(LAS u32x4*)(AT + lane * 32) = pack8s(av); *(LAS u32x4*)(AT + lane * 32 + 16) = pack8s(av + 8);
            *(LAS u32x4*)(RT + lane * 32) = pack8s(rv); *(LAS u32x4*)(RT + lane * 32 + 16) = pack8s(rv + 8);
            const u32x4 v0 = pack8s(vv), v1 = pack8s(vv + 8);
            *(LAS u32x4*)(VTl + lane * 32) = v0; *(LAS u32x4*)(VTl + lane * 32 + 16) = v1;
            GAS u32x4* gv = (GAS u32x4*)(s1 + S1_VT + ((size_t)uidx * 64 + lane) * 32); gv[0] = v0; gv[1] = v1;
#pragma unroll
            for (int t = 0; t < 16; ++t) { bv[t] *= g; kv[t] *= g; }
            GAS u32x4* gb = (GAS u32x4*)(s1 + S1_BT + ((size_t)uidx * 64 + lane) * 32); gb[0] = pack8s(bv); gb[1] = pack8s(bv + 8);
            GAS u32x4* gk = (GAS u32x4*)(s1 + S1_KT + ((size_t)uidx * 64 + lane) * 32); gk[0] = pack8s(kv); gk[1] = pack8s(kv + 8);
            *(GAS float*)(s1 + S1_GAM + ((size_t)uidx * 64 + lane) * 4) = g; }
        LDS_WAIT(); asm volatile("" ::: "memory");
        f32x4 lab = {0.f, 0.f, 0.f, 0.f}, lak = lab, mrb = lab, mrk = lab;
#pragma unroll
        for (int ks = 0; ks < 2; ++ks) { const int off = fr * 128 + (32 * ks + 8 * fq) * 2;
            const bf16x8 a = *(const LAS bf16x8*)(AH + off), r_ = *(const LAS bf16x8*)(RH + off), b_ = *(const LAS bf16x8*)(BH + off), k_ = *(const LAS bf16x8*)(KH + off);
            lab = mfma16(a, b_, lab); lak = mfma16(a, k_, lak); mrb = mfma16(r_, b_, mrb); mrk = mfma16(r_, k_, mrk); }
#pragma unroll
        for (int rg = 0; rg < 4; ++rg) { const int t = 4 * fq + rg; const bool lo = fr < t, le = fr <= t; lab[rg] = lo ? lab[rg] : 0.f; lak[rg] = lo ? lak[rg] : 0.f; mrb[rg] = le ? mrb[rg] : 0.f; mrk[rg] = le ? mrk[rg] : 0.f; }
        asm volatile("" ::: "memory");
        *(LAS f32x4*)(LmT + fr * 16 + 4 * fq) = lab;
#pragma unroll
        for (int rg = 0; rg < 4; ++rg) { const int o = ((4 * fq + rg) * 16 + fr) * 2;
            *(LAS unsigned short*)(MX + o) = (unsigned short)f2bf(lak[rg]); *(LAS unsigned short*)(MX + 512 + o) = (unsigned short)f2bf(mrb[rg]); *(LAS unsigned short*)(MX + 1024 + o) = (unsigned short)f2bf(mrk[rg]); }
        LDS_WAIT(); asm volatile("" ::: "memory");
        float Tr[16];
#pragma unroll
        for (int m = 0; m < 16; ++m) Tr[m] = (m == fr) ? 1.0f : 0.0f;
#pragma unroll
        for (int j = 14; j >= 0; --j) { float acc = (j == fr) ? 1.0f : 0.0f;
#pragma unroll
            for (int q = 0; q < 4; ++q) { const f32x4 l4 = *(const LAS f32x4*)(LmT + j * 16 + 4 * q);
#pragma unroll
                for (int e = 0; e < 4; ++e) { const int m = 4 * q + e; if (m > j) acc += Tr[m] * l4[e]; } }
            Tr[j] = acc; }
        bf16x8 tfrag;
        { float sel[8];
#pragma unroll
          for (int j = 0; j < 8; ++j) sel[j] = (fq == 0) ? Tr[j] : ((fq == 1) ? Tr[8 + j] : 0.0f);
          tfrag = __builtin_bit_cast(bf16x8, pack8s(sel)); }
        f32x4 wacc[4];
#pragma unroll
        for (int nt = 0; nt < 4; ++nt) wacc[nt] = mfma16(tfrag, *(const LAS bf16x8*)(AT + (16 * nt + fr) * 32 + fq1 * 16), (f32x4){0.f, 0.f, 0.f, 0.f});
        asm volatile("" ::: "memory");
        { bf16* gwh = (bf16*)(s1 + S1_WH) + (size_t)uidx * 1024;
#pragma unroll
          for (int nt = 0; nt < 4; ++nt) { u32x2 w2; w2.x = pk2(wacc[nt][0], wacc[nt][1]); w2.y = pk2(wacc[nt][2], wacc[nt][3]); *(LAS u32x2*)(WTl + ((16 * nt + fr) * 16 + 4 * fq) * 2) = w2;
#pragma unroll
              for (int rg = 0; rg < 4; ++rg) gwh[(4 * fq + rg) * 64 + 16 * nt + fr] = (bf16)f2bf(wacc[nt][rg]); } }
        bf16x8 lkf, mbf, mkf, idf;
        { const u32x4 z4 = {0u, 0u, 0u, 0u};
          const u32x4 lk4 = *(const LAS u32x4*)(MX + (fr * 16 + 8 * fq1) * 2), mb4 = *(const LAS u32x4*)(MX + 512 + (fr * 16 + 8 * fq1) * 2), mk4 = *(const LAS u32x4*)(MX + 1024 + (fr * 16 + 8 * fq1) * 2);
          lkf = __builtin_bit_cast(bf16x8, (fq < 2) ? lk4 : z4);
          mbf = __builtin_bit_cast(bf16x8, mb4);
          mkf = __builtin_bit_cast(bf16x8, mk4);
          u32x4 id4; const int d = fr - 8 * fq1;
          id4.x = (d == 0 ? 0x3f80u : 0u) | (d == 1 ? 0x3f800000u : 0u); id4.y = (d == 2 ? 0x3f80u : 0u) | (d == 3 ? 0x3f800000u : 0u);
          id4.z = (d == 4 ? 0x3f80u : 0u) | (d == 5 ? 0x3f800000u : 0u); id4.w = (d == 6 ? 0x3f80u : 0u) | (d == 7 ? 0x3f800000u : 0u);
          idf = __builtin_bit_cast(bf16x8, id4); }
        LDS_WAIT(); asm volatile("" ::: "memory");
        f32x4 pacc[4];
#pragma unroll
        for (int nt = 0; nt < 4; ++nt) pacc[nt] = mfma16(lkf, *(const LAS bf16x8*)(VTl + (16 * nt + fr) * 32 + fq1 * 16), (f32x4){0.f, 0.f, 0.f, 0.f});
        asm volatile("" ::: "memory");
#pragma unroll
        for (int nt = 0; nt < 4; ++nt) { u32x2 w2; w2.x = pk2(pacc[nt][0], pacc[nt][1]); w2.y = pk2(pacc[nt][2], pacc[nt][3]); *(LAS u32x2*)(PT + ((16 * nt + fr) * 16 + 4 * fq) * 2) = w2; }
        LDS_WAIT(); asm volatile("" ::: "memory");
        f32x4 uacc[4];
#pragma unroll
        for (int nt = 0; nt < 4; ++nt) uacc[nt] = mfma16(tfrag, *(const LAS bf16x8*)(PT + (16 * nt + fr) * 32 + fq1 * 16), (f32x4){0.f, 0.f, 0.f, 0.f});
        asm volatile("" ::: "memory");
#pragma unroll
        for (int nt = 0; nt < 4; ++nt) { u32x2 w2; w2.x = pk2(uacc[nt][0], uacc[nt][1]); w2.y = pk2(uacc[nt][2], uacc[nt][3]); *(LAS u32x2*)(U0Tl + ((16 * nt + fr) * 16 + 4 * fq) * 2) = w2;
            *(GAS f32x4*)(s1 + S1_U0T + (((size_t)uidx * 64 + 16 * nt + fr) * 16 + 4 * fq) * 4) = uacc[nt]; }
        LDS_WAIT(); asm volatile("" ::: "memory");
        { const bf16x8 aq = (fq < 2) ? mbf : idf, ay = (fq < 2) ? mbf : mkf;
          bf16* gqh = (bf16*)(s1 + S1_QH) + (size_t)uidx * 1024;
#pragma unroll
          for (int nt = 0; nt < 4; ++nt) { const int row = 16 * nt + fr;
              const bf16x8 bq = *(const LAS bf16x8*)(((fq < 2) ? WTl : RT) + row * 32 + fq1 * 16), by = *(const LAS bf16x8*)(((fq < 2) ? U0Tl : VTl) + row * 32 + fq1 * 16);
              const f32x4 qa = mfma16(aq, bq, (f32x4){0.f, 0.f, 0.f, 0.f}), ya = mfma16(ay, by, (f32x4){0.f, 0.f, 0.f, 0.f});
#pragma unroll
              for (int rg = 0; rg < 4; ++rg) gqh[(4 * fq + rg) * 64 + row] = (bf16)f2bf(qa[rg]);
              *(GAS f32x4*)(s1 + S1_Y0T + (((size_t)uidx * 64 + row) * 16 + 4 * fq) * 4) = ya; } }
        LDS_WAIT(); asm volatile("" ::: "memory");
    }
}

struct S2Regs { u32x2 wf[4], qf[4], bt[4], kt[4], vt; f32x4 u0, y0, gm[4]; };
__device__ __forceinline__ void s2_load(S2Regs& R, const unsigned char* s1, size_t ui, int vg, int fr, int fq) {
    const unsigned char* wh = s1 + S1_WH + ui * 2048 + (fr * 64 + 4 * fq) * 2; const unsigned char* qh = s1 + S1_QH + ui * 2048 + (fr * 64 + 4 * fq) * 2;
#pragma unroll
    for (int ks = 0; ks < 2; ++ks) { R.wf[2 * ks] = *(const GAS u32x2*)(wh + ks * 64); R.wf[2 * ks + 1] = *(const GAS u32x2*)(wh + ks * 64 + 32); R.qf[2 * ks] = *(const GAS u32x2*)(qh + ks * 64); R.qf[2 * ks + 1] = *(const GAS u32x2*)(qh + ks * 64 + 32); }
#pragma unroll
    for (int mt = 0; mt < 4; ++mt) { R.bt[mt] = *(const GAS u32x2*)(s1 + S1_BT + ui * 2048 + ((16 * mt + fr) * 16 + 4 * fq) * 2); R.kt[mt] = *(const GAS u32x2*)(s1 + S1_KT + ui * 2048 + ((16 * mt + fr) * 16 + 4 * fq) * 2);
        R.gm[mt] = *(const GAS f32x4*)(s1 + S1_GAM + ui * 256 + (16 * mt + 4 * fq) * 4); }
    const size_t vr = ui * 64 + vg * 16 + fr;
    R.vt = *(const GAS u32x2*)(s1 + S1_VT + (vr * 16 + 4 * fq) * 2); R.u0 = *(const GAS f32x4*)(s1 + S1_U0T + (vr * 16 + 4 * fq) * 4); R.y0 = *(const GAS f32x4*)(s1 + S1_Y0T + (vr * 16 + 4 * fq) * 4);
}
__device__ __forceinline__ void s2_step(const S2Regs& R, f32x4 (&st4)[4], float* yp) {
    bf16x8 sf[2];
#pragma unroll
    for (int ks = 0; ks < 2; ++ks) sf[ks] = __builtin_bit_cast(bf16x8, pack8(st4[2 * ks], st4[2 * ks + 1]));
    f32x4 sa = R.u0, y = R.y0;
#pragma unroll
    for (int ks = 0; ks < 2; ++ks) { sa = mfma16(__builtin_bit_cast(bf16x8, (u32x4){R.wf[2 * ks].x, R.wf[2 * ks].y, R.wf[2 * ks + 1].x, R.wf[2 * ks + 1].y}), sf[ks], sa);
        y = mfma16(__builtin_bit_cast(bf16x8, (u32x4){R.qf[2 * ks].x, R.qf[2 * ks].y, R.qf[2 * ks + 1].x, R.qf[2 * ks + 1].y}), sf[ks], y); }
#pragma unroll
    for (int rg = 0; rg < 4; ++rg) yp[(size_t)rg * RW] = y[rg];
    const bf16x8 ub = __builtin_bit_cast(bf16x8, (u32x4){pk2(sa[0], sa[1]), pk2(sa[2], sa[3]), R.vt.x, R.vt.y});
#pragma unroll
    for (int mt = 0; mt < 4; ++mt) st4[mt] = mfma16(__builtin_bit_cast(bf16x8, (u32x4){R.bt[mt].x, R.bt[mt].y, R.kt[mt].x, R.kt[mt].y}), ub, st4[mt] * R.gm[mt]);
}
__device__ __forceinline__ void p4b_scan(const Ptrs& P, unsigned char* ws, LAS unsigned char* lds, int tid, int wave, int lane) {
    if (wave == 0) {
        const int fr = lane & 15, fq = lane >> 4;
        const unsigned char* s1 = ws + WS_S1;
        for (int unit = blockIdx.x; unit < 256; unit += gridDim.x) {
            const int bh = unit >> 2, vg = unit & 3, b = bh >> 4, h = bh & 15;
            const size_t u0idx = (size_t)bh * 256;
            f32x4 st4[4];
#pragma unroll
            for (int mt = 0; mt < 4; ++mt) st4[mt] = (f32x4){0.f, 0.f, 0.f, 0.f};
            float* yb = P.Y + ((size_t)b * SEQ + 4 * fq) * RW + h * 64 + vg * 16 + fr;
            S2Regs RA, RB;
            s2_load(RA, s1, u0idx, vg, fr, fq);
#pragma unroll 1
            for (int c = 0; c < 256; c += 2) {
                s2_load(RB, s1, u0idx + c + 1, vg, fr, fq);
                s2_step(RA, st4, yb + (size_t)(c * 16) * RW);
                s2_load(RA, s1, u0idx + ((c + 2 < 256) ? c + 2 : c), vg, fr, fq);
                s2_step(RB, st4, yb + (size_t)((c + 1) * 16) * RW);
            }
        }
    } else {
        LAS float* scr = (LAS float*)(lds + (wave - 1) * 16896);
        const int gw = blockIdx.x * (NWAVES - 1) + (wave - 1), NGW = gridDim.x * (NWAVES - 1);
        constexpr int I_W1 = NE * 16 * 128, I_W2 = NE * 16 * 64;
        for (int it = gw; it < I_W1 + I_W2; it += NGW) {
            int r = it;
            if (r < I_W1) { const int e = r >> 11, q = r & 2047, kb = q >> 7, nb = q & 127, c0 = 32 * nb;
                tr8_tile(P.w1 + (size_t)e * D * 4096, 4096, 128 * kb, c0, (unsigned char*)P.W1, (size_t)e * 4096 + ((c0 & 2047) >> 7) * 256 + (c0 >> 11) * 128 + (c0 & 127), D, 32.0f, scr, lane); continue; }
            r -= I_W1;
            { const int e = r >> 10, q = r & 1023, kb = q >> 6, nb = q & 63; tr8_tile(P.w2 + (size_t)e * FF * D, D, 128 * kb, 32 * nb, (unsigned char*)P.W2, (size_t)e * D + 32 * nb, FF, 32.0f, scr, lane); }
        }
    }
}

__device__ __forceinline__ float sum4q(float x) { x += dppf<0xB1>(x); x += dppf<0x4E>(x); return x; }
__device__ __forceinline__ void p5_post(const Ptrs& P, int tid, int wave, int lane) {
    const int gw = blockIdx.x * NWAVES + wave, NGW = gridDim.x * NWAVES;
    const int c0 = 16 * lane, head = lane >> 2;
    for (int m = gw; m < T; m += NGW) {
        const size_t o = (size_t)m * RW + c0;
        f32x4 y[4], v[4];
#pragma unroll
        for (int q = 0; q < 4; ++q) y[q] = *(const GAS f32x4*)(P.Y + o + 4 * q);
        { const u32x4 v0 = *(const GAS u32x4*)(P.SCH + SH_V * SC_STRIDE + o), v1 = *(const GAS u32x4*)(P.SCH + SH_V * SC_STRIDE + o + 8); unpack8(v0, v[0], v[1]); unpack8(v1, v[2], v[3]); }
        const u32x4 g0 = *(const GAS u32x4*)(P.G + o), g1 = *(const GAS u32x4*)(P.G + o + 8);
        const float bon = P.BONUS[(size_t)m * NH + head];
        const int hh = lane >> 4, d0 = (lane & 15) * 8; float mm[3], ll[3]; u32x4 ow[3];
#pragma unroll
        for (int g = 0; g < 3; ++g) { const size_t q = (size_t)m * 12 + g * 4 + hh; mm[g] = P.ATTML[q * 2]; ll[g] = P.ATTML[q * 2 + 1]; ow[g] = *(const GAS u32x4*)(P.ATTO + q * 128 + d0); }
        float s = 0.f;
#pragma unroll
        for (int q = 0; q < 4; ++q) s += (y[q].x + y[q].y) + (y[q].z + y[q].w);
        const float mean = sum4q(s) * (1.0f / 64.0f); float s2 = 0.f;
#pragma unroll
        for (int q = 0; q < 4; ++q) { y[q] = y[q] - mean; s2 += (y[q].x * y[q].x + y[q].y * y[q].y) + (y[q].z * y[q].z + y[q].w * y[q].w); }
        const float rstd = 1.0f / sqrtf(sum4q(s2) * (1.0f / 64.0f) + GN_EPS);
        f32x4 gq[4]; unpack8(g0, gq[0], gq[1]); unpack8(g1, gq[2], gq[3]);
#pragma unroll
        for (int q = 0; q < 4; ++q) { const f32x4 lw = *(const GAS f32x4*)(P.ln_x_w + c0 + 4 * q), lb = *(const GAS f32x4*)(P.ln_x_b + c0 + 4 * q); y[q] = ((y[q] * rstd) * lw + lb + v[q] * bon) * gq[q]; }
        *(GAS u32x4*)(P.YAIN + o) = pack8(y[0], y[1]); *(GAS u32x4*)(P.YAIN + o + 8) = pack8(y[2], y[3]);
        const float M = fmaxf(mm[0], fmaxf(mm[1], mm[2])); float den = 0.f; f32x4 n0 = {0.f, 0.f, 0.f, 0.f}, n1 = n0;
#pragma unroll
        for (int g = 0; g < 3; ++g) { const float wg = exp2f(mm[g] - M); den += wg * ll[g]; f32x4 a, b; unpack8(ow[g], a, b); n0 = n0 + a * wg; n1 = n1 + b * wg; }
        const float inv = 1.0f / den;
        *(GAS u32x4*)(P.OIN + (size_t)m * 512 + 8 * lane) = pack8(n0 * inv, n1 * inv);
    }
}

__device__ __forceinline__ void p8_router(const Ptrs& P, LAS unsigned char* lds, int tid, int wave, int lane, int cnt_base = CW_CNT) {
    LAS float* Wl = (LAS float*)lds;
    const int e = lane & 31, kh = lane >> 5;
    LAS int* picks = (LAS int*)(lds + TAB_OFF + 512 + 256); LAS int* pbase = picks + 256;
    for (int grp = blockIdx.x; grp < T / 64; grp += gridDim.x) {
        const int m0 = grp * 64 + wave * 8;
        float rs[8], acc[8];
#pragma unroll
        for (int tk = 0; tk < 8; ++tk) { const float* xr = P.X1 + (size_t)(m0 + tk) * D; f32x4 v[8]; float s = 0.f;
#pragma unroll
            for (int j = 0; j < 8; ++j) { v[j] = *(const GAS f32x4*)(xr + 4 * lane + 256 * j); s += (v[j].x * v[j].x + v[j].y * v[j].y) + (v[j].z * v[j].z + v[j].w * v[j].w); }
            const float r = 1.0f / sqrtf(wave_sum(s) * (1.0f / D) + NORM_EPS); rs[tk] = r; acc[tk] = 0.f;
            unsigned char* hr = (unsigned char*)P.H + (size_t)(m0 + tk) * D;
#pragma unroll
            for (int j = 0; j < 8; ++j) { const f32x4 gv = *(const GAS f32x4*)(P.norm_ffn + 4 * lane + 256 * j);
                *(GAS unsigned*)(hr + 4 * lane + 256 * j) = pk4_fp8(v[j].x * r * gv.x, v[j].y * r * gv.y, v[j].z * r * gv.z, v[j].w * r * gv.w); } }
#pragma unroll 1
        for (int hf = 0; hf < 2; ++hf) {
            __syncthreads();
            for (int idx = tid; idx < 8192; idx += NTHREADS) { const int k = idx >> 3, q = idx & 7; const float g = P.norm_ffn[hf * 1024 + k];
                *(LAS f32x4*)(Wl + k * 32 + 4 * q) = *(const GAS f32x4*)(P.w_router + (size_t)(hf * 1024 + k) * NE + 4 * q) * g; }
            __syncthreads();
            const float* xb = P.X1 + (size_t)m0 * D + hf * 1024 + kh * 512; const LAS float* wb = Wl + (kh * 512) * 32 + e;
#pragma unroll 3
            for (int i = 0; i < 512; i += 4) { const float w0 = wb[(i + 0) * 32], w1 = wb[(i + 1) * 32], w2 = wb[(i + 2) * 32], w3 = wb[(i + 3) * 32];
#pragma unroll
                for (int tk = 0; tk < 8; ++tk) { const f32x4 xv = *(const GAS f32x4*)(xb + (size_t)tk * D + i); acc[tk] += (xv.x * w0 + xv.y * w1) + (xv.z * w2 + xv.w * w3); } }
        }
        const float be = P.b_router[e];
#pragma unroll
        for (int tk = 0; tk < 8; ++tk) { float v = (acc[tk] + __shfl_xor(acc[tk], 32)) * rs[tk] + be;
            int sel[4]; float val[4];
#pragma unroll
            for (int k = 0; k < 4; ++k) { float mx = v;
#pragma unroll
                for (int o = 1; o < 32; o <<= 1) mx = fmaxf(mx, __shfl_xor(mx, o));
                const unsigned long long bal = __ballot(v == mx); const int s_ = __ffsll((unsigned long long)(bal & 0xffffffffull)) - 1;
                sel[k] = s_; val[k] = mx; v = (e == s_) ? -3.0e38f : v; }
            const float e1 = __expf(val[1] - val[0]), e2 = __expf(val[2] - val[0]), e3 = __expf(val[3] - val[0]); const float inv = 1.0f / (1.0f + e1 + e2 + e3);
            const float gate[4] = {inv, e1 * inv, e2 * inv, e3 * inv};
            if (lane == 0) { const int m = m0 + tk;
#pragma unroll
                for (int k = 0; k < 4; ++k) { picks[wave * 32 + tk * 4 + k] = sel[k]; P.TOPK_E[m * 4 + k] = sel[k]; P.TOPK_GATE[m * 4 + k] = gate[k]; } }
        }
        __syncthreads();
        if (tid < 32) { int cnt = 0;
            for (int j = 0; j < 256; ++j) cnt += (picks[j] == tid) ? 1 : 0;
            pbase[tid] = (int)__hip_atomic_fetch_add((unsigned*)(P.ctl + cnt_base + 64 * tid), (unsigned)cnt, RLX_AGENT); }
        __syncthreads();
        if (tid < 256) { const int mine = picks[tid]; int rank = 0;
            for (int j = 0; j < tid; ++j) rank += (picks[j] == mine) ? 1 : 0;
            P.TOPK_POS[(grp * 64 + (tid >> 5) * 8) * 4 + (tid & 31)] = pbase[mine] + rank; }
    }
}

__device__ __forceinline__ void moe_tables(const Ptrs& P, LAS int* tab, int tid) {
    if (tid == 0) { int acc = 0;
        for (int e = 0; e < NE; ++e) { tab[e] = acc; const int c = (int)__hip_atomic_load((unsigned*)(P.ctl + CW_CNT + 64 * e), RLX_AGENT); acc += (c + 255) >> 8; tab[64 + e] = c; }
        tab[32] = acc; }
    __syncthreads();
}

__device__ __forceinline__ void p9_gather(const Ptrs& P, LAS unsigned char* lds, int tid, int wave, int lane) {
    LAS int* tab = (LAS int*)(lds + TAB_OFF);
    moe_tables(P, tab, tid);
    const int gw = blockIdx.x * NWAVES + wave, NGW = gridDim.x * NWAVES;
    for (int p = gw; p < T * 4; p += NGW) { const int e = P.TOPK_E[p], pos = P.TOPK_POS[p]; const int row = tab[e] * 256 + pos;
        const GAS u32x4* src = (const GAS u32x4*)((const unsigned char*)P.H + (size_t)(p >> 2) * D); GAS u32x4* dst = (GAS u32x4*)((unsigned char*)P.XS + (size_t)row * D);
#pragma unroll
        for (int i = 0; i < 2; ++i) dst[lane + 64 * i] = src[lane + 64 * i];
        if (lane == 0) { P.ROWTOK[row] = p; P.ROWGATE[row] = P.TOPK_GATE[p]; } }
    for (int e = blockIdx.x; e < NE; e += gridDim.x) { const int cnt = tab[64 + e], r0 = tab[e] * 256, rend = tab[e + 1] * 256;
        for (int r = r0 + cnt + tid; r < rend; r += NTHREADS) { P.ROWTOK[r] = -1; P.ROWGATE[r] = 0.f; } }
}

__device__ __forceinline__ void p12_final(const Ptrs& P, int tid, int wave, int lane) {
    const int gw = blockIdx.x * NWAVES + wave, NGW = gridDim.x * NWAVES;
    for (int m = gw; m < T; m += NGW) {
        f32x4 v[8]; float s = 0.f;
#pragma unroll
        for (int j = 0; j < 8; ++j) { const int col = 4 * lane + 256 * j; v[j] = *(const GAS f32x4*)(P.X1 + (size_t)m * D + col);
#pragma unroll
            for (int k = 0; k < 4; ++k) { const u32x2 w = *(const GAS u32x2*)(P.OUTK + ((size_t)m * 4 + k) * D + col); v[j].x += bflo(w.x); v[j].y += bfhi(w.x); v[j].z += bflo(w.y); v[j].w += bfhi(w.y); }
            s += (v[j].x * v[j].x + v[j].y * v[j].y) + (v[j].z * v[j].z + v[j].w * v[j].w); }
        const float rs = 1.0f / sqrtf(wave_sum(s) * (1.0f / D) + NORM_EPS);
#pragma unroll
        for (int j = 0; j < 8; ++j) { const int col = 4 * lane + 256 * j; const f32x4 g = *(const GAS f32x4*)(P.norm_final + col); *(GAS f32x4*)(P.out + (size_t)m * D + col) = v[j] * rs * g; }
    }
}

struct Args { const void* in[26]; float* out; unsigned char* ws; int ph_lo, ph_hi; };
__global__ void __launch_bounds__(NTHREADS, 2) fwd(Args args) {
    extern __shared__ __attribute__((aligned(16))) unsigned char lds_raw[];
    LAS unsigned char* lds = (LAS unsigned char*)lds_raw;
    const int tid = threadIdx.x, lane = tid & 63, wave = __builtin_amdgcn_readfirstlane(tid >> 6);
    unsigned char* ws = args.ws;
    Ptrs P;
    P.x = (const float*)args.in[0]; P.positions = (const int*)args.in[1]; P.norm_mix = (const float*)args.in[2]; P.w_in = (const float*)args.in[3]; P.shift_mu = (const float*)args.in[4];
    P.w0 = (const float*)args.in[5]; P.w2_decay = (const float*)args.in[6]; P.a0 = (const float*)args.in[7]; P.a2_iclr = (const float*)args.in[8]; P.g2_gate = (const float*)args.in[9];
    P.k_k = (const float*)args.in[10]; P.k_a = (const float*)args.in[11]; P.r_k = (const float*)args.in[12]; P.ln_x_w = (const float*)args.in[13]; P.ln_x_b = (const float*)args.in[14];
    P.w_o_rwkv = (const float*)args.in[15]; P.w_o_attn = (const float*)args.in[16]; P.w_out = (const float*)args.in[17]; P.norm_ffn = (const float*)args.in[18]; P.w_router = (const float*)args.in[19];
    P.b_router = (const float*)args.in[20]; P.w1 = (const float*)args.in[21]; P.b1 = (const float*)args.in[22]; P.w2 = (const float*)args.in[23]; P.b2 = (const float*)args.in[24]; P.norm_final = (const float*)args.in[25];
    P.out = args.out; P.ctl = (gu32*)(ws + WS_CTL);
    P.WIN = (bf16*)(ws + WS_WIN); P.W1 = (bf16*)(ws + WS_W1); P.W2 = (bf16*)(ws + WS_W2); P.WOR = (bf16*)(ws + WS_WOR); P.WOA = (bf16*)(ws + WS_WOA); P.WOUT = (bf16*)(ws + WS_WOUT);
    P.H = (bf16*)(ws + WS_H); P.ZP = (bf16*)(ws + WS_ZP); P.QKV = (bf16*)(ws + WS_QKV); P.GATES = (bf16*)(ws + WS_GATES); P.ROT = (float*)(ws + WS_ROT); P.SC = (float*)(ws + WS_SC); P.SCH = (bf16*)(ws + WS_SC + 64 * MiB);
    P.G = (bf16*)(ws + WS_G); P.BONUS = (float*)(ws + WS_BONUS); P.Y = (float*)(ws + WS_Y); P.ATTO = (bf16*)(ws + WS_ATTO); P.ATTML = (float*)(ws + WS_ATTML); P.YAIN = (bf16*)(ws + WS_YAIN);
    P.OIN = (bf16*)(ws + WS_OIN); P.MERGED = (bf16*)(ws + WS_MERGED); P.X1 = (float*)(ws + WS_X1);
    P.TOPK_E = (int*)(ws + WS_TOPK); P.TOPK_POS = P.TOPK_E + T * 4; P.TOPK_GATE = (float*)(P.TOPK_POS + T * 4);
    P.ROWTOK = (int*)(ws + WS_ROWS); P.ROWGATE = (float*)(P.ROWTOK + XS_ROWS);
    P.LW = (bf16*)(ws + WS_LORA); P.LA = P.LW + 1024 * 64; P.LG = P.LA + 1024 * 64;
    P.XS = (bf16*)(ws + WS_XS); P.ACT = (bf16*)(ws + WS_ACT); P.OUTK = (bf16*)(ws + WS_OUTK);

    for (int u = tid; u < (LDS_BYTES - TAB_OFF) / 4; u += NTHREADS) ((LAS unsigned*)(lds + TAB_OFF))[u] = 0u;
    __syncthreads();
#if MK_ONE_LAUNCH
    XcdBarrier bar = xcd_barrier_post((unsigned*)(P.ctl + CW_BAR), (volatile LAS unsigned*)(lds + MISC_OFF));
#define GRID_BAR() xcd_barrier(bar)
#else
#define GRID_BAR() do { } while (0)
#endif
    const int lo = args.ph_lo, hi = args.ph_hi;
#ifndef PHASE_MASK
#define PHASE_MASK 0x3fff
#endif
#define IN(k) (((PHASE_MASK >> (k)) & 1) && lo <= (k) && (k) < hi)
#define SEAM(k) do { if (IN(k) && IN((k) + 1)) GRID_BAR(); } while (0)
    const int G = gridDim.x, c = blockIdx.x;

#ifndef REP_MASK
#define REP_MASK 0
#endif
#define REPS(k) (1 + ((REP_MASK >> (k)) & 1))
#define PHASE(k, ...) do { if (IN(k)) { { __VA_ARGS__ } if (REPS(k) == 2) { GRID_BAR(); { __VA_ARGS__ } } SEAM(k); } } while (0)
    PHASE(0, p0_prologue(P, lds, tid, wave, lane););
    PHASE(1, { pg8::Gemm g{P.H, P.WIN, T, NPROJ, D}; pg8::StaticOrder S; S.init(T, NPROJ, G, c); EpiProj E{P.ZP, P.QKV, P.GATES, P.ROT};
        pg8::gemm_phase<EpiProj, pg8::StaticOrder, true, true>(lds, g, S, E); });
    PHASE(2, p2_rwkv_prep(P, lds, tid, wave, lane););
    PHASE(3, p3_attention(P, lds, tid, wave, lane););
    PHASE(4, p4a_chunk_prep(P, ws, lds, tid, wave, lane););
    PHASE(5, p4b_scan(P, ws, lds, tid, wave, lane););
    PHASE(6, p5_post(P, tid, wave, lane););
    PHASE(7, {
        { pg8::Gemm g{P.YAIN, P.WOR, T, D, RW}; pg8::StaticOrder S; S.init(T, D, G, c); EpiMerge<0> E{P.MERGED, P.GATES}; pg8::gemm_phase<EpiMerge<0>, pg8::StaticOrder, true, true>(lds, g, S, E); }
        VM_WAIT(); __builtin_amdgcn_fence(__ATOMIC_ACQUIRE, "agent"); VM_WAIT(); __syncthreads();
        { pg8::Gemm g{P.OIN, P.WOA, T, D, 512}; pg8::StaticOrder S; S.init(T, D, G, c); EpiMerge<1> E{P.MERGED, P.GATES}; pg8::gemm_phase<EpiMerge<1>, pg8::StaticOrder, true, true>(lds, g, S, E); } });
    PHASE(8, { pg8::Gemm g{P.MERGED, P.WOUT, T, D, D}; pg8::StaticOrder S; S.init(T, D, G, c); EpiResid E{P.x, P.X1}; pg8::gemm_phase<EpiResid, pg8::StaticOrder, true, true>(lds, g, S, E); });
#ifdef ROUTER_TWICE
    if (IN(9)) { p8_router(P, lds, tid, wave, lane, CW_CNT + 4096); GRID_BAR(); }
#endif
    PHASE(9, p8_router(P, lds, tid, wave, lane););
    PHASE(10, p9_gather(P, lds, tid, wave, lane););
    PHASE(11, { LAS int* tab = (LAS int*)(lds + TAB_OFF); moe_tables(P, tab, tid);
        pg8::Gemm g{P.XS, P.W1, XS_ROWS, NE * 4096, D / 2}; MoeOrder S{tab, 16, G, c}; EpiMoe1 E{P.ACT, P.b1};
        pg8::gemm_phase<EpiMoe1, MoeOrder, true, true, 122, 127>(lds, g, S, E); });
    PHASE(12, { LAS int* tab = (LAS int*)(lds + TAB_OFF); moe_tables(P, tab, tid);
        pg8::Gemm g{P.ACT, P.W2, XS_ROWS, NE * D, FF / 2}; MoeOrder S{tab, 8, G, c}; EpiMoe2 E{P.OUTK, P.b2, P.ROWTOK, P.ROWGATE};
        pg8::gemm_phase<EpiMoe2, MoeOrder, true, true, 122, 124>(lds, g, S, E); });
    PHASE(13, p12_final(P, tid, wave, lane););
#undef IN
#undef SEAM
}

extern "C" void kernel_launch(void* const* d_in, const int* in_sizes, int n_in, void* d_out, int out_size, void* d_ws, size_t ws_size, hipStream_t stream) {
    static int grid = 0;
    if (grid == 0) {
        if (n_in != 26 || out_size != T * D || ws_size < WS_END) { fprintf(stderr, "kernel_launch: unexpected shapes (n_in %d, out %d, ws %zu, need %zu); nothing launched\n", n_in, out_size, ws_size, (size_t)WS_END); grid = -1; return; }
        int dev = 0, cus = 0, per_cu = 0;
        if (hipGetDevice(&dev) != hipSuccess || hipDeviceGetAttribute(&cus, hipDeviceAttributeMultiprocessorCount, dev) != hipSuccess) { grid = -1; return; }
        if (hipFuncSetAttribute((const void*)fwd, hipFuncAttributeMaxDynamicSharedMemorySize, LDS_BYTES) != hipSuccess) { fprintf(stderr, "kernel_launch: hipFuncSetAttribute failed\n"); grid = -1; return; }
        if (hipOccupancyMaxActiveBlocksPerMultiprocessor(&per_cu, (const void*)fwd, NTHREADS, LDS_BYTES) != hipSuccess || per_cu < 1) fprintf(stderr, "kernel_launch: occupancy query says %d\n", per_cu);
        (void)hipGetLastError();
        grid = cus;
    }
    if (grid < 0) return;
    if (hipMemsetAsync((char*)d_ws + WS_CTL, 0, CTL_ZERO_BYTES, stream) != hipSuccess) return;
    Args a{};
    for (int i = 0; i < 26; ++i) a.in[i] = d_in[i];
    a.out = (float*)d_out; a.ws = (unsigned char*)d_ws;
#if MK_ONE_LAUNCH
    a.ph_lo = 0; a.ph_hi = NPHASES;
    hipLaunchKernelGGL(fwd, dim3(grid), dim3(NTHREADS), LDS_BYTES, stream, a);
#else
    for (int ph = 0; ph < NPHASES; ++ph) { a.ph_lo = ph; a.ph_hi = ph + 1; hipLaunchKernelGGL(fwd, dim3(grid), dim3(NTHREADS), LDS_BYTES, stream, a); }
#endif
}
```

```cpp
#include <hip/hip_runtime.h>
#include <cstdio>
#include <cstdint>
#include <cmath>
namespace pg8 {
#define PG8_LAS __attribute__((address_space(3)))
typedef unsigned short bf16_t;
typedef short bf16x8 __attribute__((ext_vector_type(8)));
typedef float f32x4 __attribute__((ext_vector_type(4)));
typedef unsigned u32x4 __attribute__((ext_vector_type(4)));
constexpr int BM = 256, BK = 64, HALF = 128, HTB = HALF * BK * 2  , STAGE_BYTES = 8 * HTB, NXCD = 8, WGM = 8;

__host__ __device__ __forceinline__ int lds_byte(int r, int c) { const int st = (r >> 4) * 2 + (c >> 5), rr = r & 15, cc = c & 31, ob = rr * 64 + cc * 2; return st * 1024 + (ob ^ (((ob >> 9) & 1) << 5)); }
__host__ __device__ __forceinline__ void stage_rc(int b, int& R, int& C) { const int st = b / 1024, sb = b % 1024, swz = sb ^ (((sb >> 9) & 1) << 5); R = (st >> 1) * 16 + swz / 64; C = (st & 1) * 32 + (swz % 64) / 2; }
__host__ __device__ __forceinline__ int perm32(int rho) { const int n = rho >> 4, i = rho & 15; return 8 * (i >> 2) + 4 * n + (i & 3); }

struct Unit { int pm, pn; };
struct Gemm { const bf16_t* A; const bf16_t* Bt; int M, N, K; };

struct StaticOrder {
    int nM, nN, nwg, G, c;
    __host__ __device__ void init(int M, int N, int G_, int c_) { nM = M / BM; nN = N / BM; nwg = nM * nN; G = G_; c = c_; }
    __host__ __device__ bool next(int i, Unit& u) const {
        const long L = (long)i * G + c; if (L >= nwg) return false;
        int wgid = (int)L; { const int q = nwg / NXCD, r = nwg % NXCD, xcd = wgid % NXCD, off = wgid / NXCD; wgid = (xcd < r ? xcd * (q + 1) : r * (q + 1) + (xcd - r) * q) + off; }
        const int nig = WGM * nN, gid = wgid / nig, fm = gid * WGM, gsz = (nM - fm) < WGM ? (nM - fm) : WGM;
        u.pm = fm + ((wgid % nig) % gsz); u.pn = (wgid % nig) / gsz; return true;
    }
    __device__ __forceinline__ void a_ready(const Unit&) const {}
    __device__ __forceinline__ void done(const Unit&) const {}
};

__device__ __forceinline__ unsigned cvt_pk_bf16(float lo, float hi) { unsigned r; asm volatile("v_cvt_pk_bf16_f32 %0, %1, %2" : "=v"(r) : "v"(lo), "v"(hi)); return r; }
typedef float f32x2 __attribute__((ext_vector_type(2)));

typedef int i32x4_t __attribute__((ext_vector_type(4)));
typedef int i32x8_t __attribute__((ext_vector_type(8)));
__device__ __forceinline__ f32x4 mfma_fp8(bf16x8 w0, bf16x8 w1, bf16x8 a0, bf16x8 a1, f32x4 c, int sw, int sa) {
    const i32x4_t x0 = __builtin_bit_cast(i32x4_t, w0), x1 = __builtin_bit_cast(i32x4_t, w1), y0 = __builtin_bit_cast(i32x4_t, a0), y1 = __builtin_bit_cast(i32x4_t, a1);
    const i32x8_t X = {x0.x, x0.y, x0.z, x0.w, x1.x, x1.y, x1.z, x1.w}, Y = {y0.x, y0.y, y0.z, y0.w, y1.x, y1.y, y1.z, y1.w};
    return __builtin_amdgcn_mfma_scale_f32_16x16x128_f8f6f4(X, Y, c, 0, 0, 0, sw, 0, sa);
}
template <class Epi, class Sched, bool ALIGN_EPI = false, bool SP2 = false, int FP8W = -1, int FP8A = -1>
__device__ __forceinline__ void gemm_phase(PG8_LAS unsigned char* lds, const Gemm g, const Sched& S, const Epi& E) {
    const int tid = threadIdx.x, wid = __builtin_amdgcn_readfirstlane(tid >> 6), lane = tid & 63, wr = wid >> 2, wc = wid & 3, fr = lane & 15, fq = lane >> 4;
    const int K = g.K, nt = K / BK;
    unsigned voffA[2], voffB[2];
#pragma unroll
    for (int i = 0; i < 2; ++i) { int R, C; stage_rc(tid * 16 + i * 8192, R, C); const int Rb = Epi::PERM ? ((R & ~31) + perm32(R & 31)) : R;
        voffA[i] = (unsigned)(R * K + C) * 2u; voffB[i] = (unsigned)(Rb * K + C) * 2u; }
    const size_t kstep = (size_t)(BK * 2);
    const size_t hstep = (size_t)HALF * K * 2;
    const size_t tstep = 2 * hstep;
    const unsigned ldsw = (unsigned)wid * 1024u;
    const int aoff = lds_byte(wr * 64 + fr, fq * 8), boff = lds_byte(wc * 32 + fr, fq * 8);
#define PG8_SA(b, h) (((b) * 2 + (h)) * HTB)
#define PG8_SB(b, h) ((4 + (b) * 2 + (h)) * HTB)
#define PG8_STAGE(bufoff, gbase, voff) do { _Pragma("unroll") for (int _i = 0; _i < 2; ++_i) \
        __builtin_amdgcn_global_load_lds((const unsigned*)((const char*)(gbase) + (voff)[_i]), (PG8_LAS unsigned*)(lds + (bufoff) + ldsw + _i * 8192), 16, 0, 0); } while (0)
#define PG8_LD8(p) __builtin_shufflevector(*(const PG8_LAS i32x4_t*)(p), *(const PG8_LAS i32x4_t*)((p) + 1024), 0, 1, 2, 3, 4, 5, 6, 7)
#define PG8_LDA(dst, b, h) do { if constexpr (FP8W >= 0) { _Pragma("unroll") for (int m = 0; m < 4; ++m) dst##8[m] = PG8_LD8(lds + PG8_SA(b, h) + aoff + m * 2048); } \
        else { _Pragma("unroll") for (int m = 0; m < 4; ++m) _Pragma("unroll") for (int k = 0; k < 2; ++k) dst[m][k] = *(const PG8_LAS bf16x8*)(lds + PG8_SA(b, h) + aoff + m * 2048 + k * 1024); } } while (0)
#define PG8_LDB(dst, b, h) do { if constexpr (FP8W >= 0) { _Pragma("unroll") for (int n = 0; n < 2; ++n) dst##8[n] = PG8_LD8(lds + PG8_SB(b, h) + boff + n * 2048); } \
        else { _Pragma("unroll") for (int n = 0; n < 2; ++n) _Pragma("unroll") for (int k = 0; k < 2; ++k) dst[n][k] = *(const PG8_LAS bf16x8*)(lds + PG8_SB(b, h) + boff + n * 2048 + k * 1024); } } while (0)
#define PG8_MMA(ai, bj, At, Bt) do { __builtin_amdgcn_s_setprio(1); _Pragma("unroll") for (int m = 0; m < 4; ++m) _Pragma("unroll") for (int n = 0; n < 2; ++n) { \
        if constexpr (FP8W >= 0) asm volatile("v_mfma_scale_f32_16x16x128_f8f6f4 %0, %1, %2, %0, %3, %4 op_sel_hi:[0,0,0]" : "+v"(acc[ai][bj][m][n]) : "v"(Bt##8[n]), "v"(At##8[m]), "v"(fp8sw), "v"(fp8sa)); \
        else { _Pragma("unroll") for (int k = 0; k < 2; ++k) acc[ai][bj][m][n] = __builtin_amdgcn_mfma_f32_16x16x32_bf16(Bt[n][k], At[m][k], acc[ai][bj][m][n], 0, 0, 0); } } \
        __builtin_amdgcn_s_setprio(0); } while (0)
#define PG8_WAIT_V(n) asm volatile("s_waitcnt vmcnt(" #n ")" ::: "memory")
#define PG8_WAIT_L(n) asm volatile("s_waitcnt lgkmcnt(" #n ")" ::: "memory")
#define PG8_BAR __builtin_amdgcn_s_barrier()
#define PG8_SCHED __builtin_amdgcn_sched_barrier(0)
    Unit cur, nxt; int ui = 0;
    if (!S.next(0, cur)) return;
    f32x4 acc[2][2][4][2];
#pragma unroll
    for (int a = 0; a < 2; ++a)
#pragma unroll
        for (int b = 0; b < 2; ++b)
#pragma unroll
            for (int m = 0; m < 4; ++m)
#pragma unroll
                for (int n = 0; n < 2; ++n) acc[a][b][m][n] = (f32x4){0.f, 0.f, 0.f, 0.f};
    const int fp8sw = FP8W, fp8sa = FP8A; (void)fp8sw; (void)fp8sa;
    bf16x8 At[4][2], B0[2][2], B1[2][2]; i32x8_t At8[4], B08[2], B18[2];
    const char* cA = (const char*)g.A + (size_t)cur.pm * tstep; const char* cB = (const char*)g.Bt + (size_t)cur.pn * tstep;
    S.a_ready(cur);
    if constexpr (SP2) {
        PG8_STAGE(PG8_SB(0, 0), cB, voffB); PG8_STAGE(PG8_SB(0, 1), cB + hstep, voffB); PG8_STAGE(PG8_SA(0, 0), cA, voffA); PG8_STAGE(PG8_SA(0, 1), cA + hstep, voffA);
        if (wr == 1) PG8_BAR;
        PG8_WAIT_V(2); PG8_BAR;
        PG8_STAGE(PG8_SB(1, 0), cB + kstep, voffB); PG8_STAGE(PG8_SA(1, 0), cA + kstep, voffA); PG8_STAGE(PG8_SB(1, 1), cB + hstep + kstep, voffB);
        PG8_WAIT_V(6); PG8_BAR;
    } else {
        PG8_STAGE(PG8_SB(0, 0), cB, voffB); PG8_STAGE(PG8_SA(0, 0), cA, voffA); PG8_STAGE(PG8_SB(0, 1), cB + hstep, voffB); PG8_STAGE(PG8_SA(0, 1), cA + hstep, voffA);
        if (wr == 1) PG8_BAR;
        PG8_WAIT_V(4); PG8_BAR;
        PG8_STAGE(PG8_SB(1, 0), cB + kstep, voffB); PG8_STAGE(PG8_SA(1, 0), cA + kstep, voffA); PG8_STAGE(PG8_SB(1, 1), cB + hstep + kstep, voffB);
        PG8_WAIT_V(6); PG8_BAR;
    }
    for (;;) {
        const bool has_next = S.next(ui + 1, nxt);
        const char* nA = has_next ? (const char*)g.A + (size_t)nxt.pm * tstep : cA; const char* nB = has_next ? (const char*)g.Bt + (size_t)nxt.pn * tstep : cB;
        for (int t = 0; t < nt; t += 2) {
            const bool last = (t == nt - 2);
            const char* a1 = cA + (size_t)(t + 1) * kstep;
            const char* a2 = last ? nA : cA + (size_t)(t + 2) * kstep; const char* b2 = last ? nB : cB + (size_t)(t + 2) * kstep;
            const char* a3 = a2 + kstep; const char* b3 = b2 + kstep;
            if (last && has_next) S.a_ready(nxt);
            if constexpr (SP2) {
            PG8_LDB(B0, 0, 0); PG8_LDB(B1, 0, 1); PG8_SCHED; PG8_LDA(At, 0, 0); PG8_STAGE(PG8_SA(1, 1), a1 + hstep, voffA);
            PG8_WAIT_V(8); PG8_WAIT_L(0); PG8_BAR; PG8_MMA(0, 0, At, B0); PG8_MMA(0, 1, At, B1); PG8_BAR; PG8_SCHED;
            PG8_LDA(At, 0, 1); PG8_STAGE(PG8_SB(0, 0), b2, voffB); PG8_STAGE(PG8_SB(0, 1), b2 + hstep, voffB); PG8_STAGE(PG8_SA(0, 0), a2, voffA);
            PG8_WAIT_V(8); PG8_WAIT_L(0); PG8_BAR; PG8_MMA(1, 0, At, B0); PG8_MMA(1, 1, At, B1); PG8_BAR; PG8_SCHED;
            PG8_LDB(B0, 1, 0); PG8_LDB(B1, 1, 1); PG8_SCHED; PG8_LDA(At, 1, 0); PG8_STAGE(PG8_SA(0, 1), a2 + hstep, voffA);
            PG8_WAIT_V(8); PG8_WAIT_L(0); PG8_BAR; PG8_MMA(0, 0, At, B0); PG8_MMA(0, 1, At, B1); PG8_BAR; PG8_SCHED;
            PG8_LDA(At, 1, 1); PG8_STAGE(PG8_SB(1, 0), b3, voffB); PG8_STAGE(PG8_SB(1, 1), b3 + hstep, voffB); PG8_STAGE(PG8_SA(1, 0), a3, voffA);
            PG8_WAIT_V(8); PG8_WAIT_L(0); PG8_BAR; PG8_MMA(1, 0, At, B0); PG8_MMA(1, 1, At, B1); PG8_BAR; PG8_SCHED;
            } else {
            PG8_LDB(B0, 0, 0); PG8_SCHED; PG8_LDA(At, 0, 0); PG8_STAGE(PG8_SA(1, 1), a1 + hstep, voffA);
            PG8_WAIT_L(8); PG8_BAR; PG8_WAIT_L(0); PG8_MMA(0, 0, At, B0); PG8_BAR; PG8_SCHED;
            PG8_LDB(B1, 0, 1); PG8_STAGE(PG8_SB(0, 0), b2, voffB);
            PG8_BAR; PG8_WAIT_L(0); PG8_MMA(0, 1, At, B1); PG8_BAR;
            PG8_LDA(At, 0, 1); PG8_STAGE(PG8_SA(0, 0), a2, voffA);
            PG8_BAR; PG8_WAIT_L(0); PG8_MMA(1, 0, At, B0); PG8_BAR; PG8_SCHED;
            PG8_STAGE(PG8_SB(0, 1), b2 + hstep, voffB);
            PG8_WAIT_V(6); PG8_BAR; PG8_MMA(1, 1, At, B1); PG8_BAR;
            PG8_LDB(B0, 1, 0); PG8_SCHED; PG8_LDA(At, 1, 0); PG8_STAGE(PG8_SA(0, 1), a2 + hstep, voffA);
            PG8_WAIT_L(8); PG8_BAR; PG8_WAIT_L(0); PG8_MMA(0, 0, At, B0); PG8_BAR; PG8_SCHED;
            PG8_LDB(B1, 1, 1); PG8_STAGE(PG8_SB(1, 0), b3, voffB);
            PG8_BAR; PG8_WAIT_L(0); PG8_MMA(0, 1, At, B1); PG8_BAR;
            PG8_LDA(At, 1, 1); PG8_STAGE(PG8_SA(1, 0), a3, voffA);
            PG8_BAR; PG8_WAIT_L(0); PG8_MMA(1, 0, At, B0); PG8_BAR; PG8_SCHED;
            PG8_STAGE(PG8_SB(1, 1), b3 + hstep, voffB);
            PG8_WAIT_V(6); PG8_BAR; PG8_MMA(1, 1, At, B1); PG8_BAR;
            }
        }
        if constexpr (FP8W >= 0) asm volatile("s_nop 15\n\ts_nop 15" ::: "memory");
        if constexpr (ALIGN_EPI) { if (wr == 0) PG8_BAR; }
        if constexpr (!Epi::AFTER_DRAIN) { E(acc, cur, wr, wc, fr, fq); S.done(cur); }
        if (!has_next) break;
#pragma unroll
        for (int a = 0; a < 2; ++a)
#pragma unroll
            for (int b = 0; b < 2; ++b)
#pragma unroll
                for (int m = 0; m < 4; ++m)
#pragma unroll
                    for (int n = 0; n < 2; ++n) acc[a][b][m][n] = (f32x4){0.f, 0.f, 0.f, 0.f};
        cur = nxt; cA = nA; cB = nB; ++ui;
        if constexpr (ALIGN_EPI) { if (wr == 1) PG8_BAR; }
    }
    PG8_WAIT_V(0);
    if constexpr (!ALIGN_EPI) { if (wr == 0) PG8_BAR; }
    PG8_BAR;
    if constexpr (Epi::AFTER_DRAIN) { E.fused(acc, cur, wr, wc, fr, fq, lds, wid, lane); S.done(cur); }
#undef PG8_SA
#undef PG8_SB
#undef PG8_STAGE
#undef PG8_LD8
#undef PG8_LDA
#undef PG8_LDB
#undef PG8_MMA
#undef PG8_WAIT_V
#undef PG8_WAIT_L
#undef PG8_BAR
#undef PG8_SCHED
}
}


constexpr int NB = 4, SEQ = 4096, T = NB * SEQ, D = 2048;
constexpr int RW = 1024, NH = 16, HD = 64;
constexpr int IN_W = 12064, SHIFT_W = 3360;
constexpr int ZPW = 3584, QKVW = 4608, GATEW = 4096, NPROJ = 12288;
constexpr int NE = 32, FF = 2048;
constexpr int XS_ROWS = T * 4 + NE * 256;
constexpr int NWAVES = 8, NTHREADS = 512;
constexpr float NORM_EPS = 1e-5f, GN_EPS = 64e-5f;
constexpr float QSCALE = 0.08838834764831845f * 1.4426950408889634f;

#ifndef MK_ONE_LAUNCH
#define MK_ONE_LAUNCH 1
#endif
constexpr int NPHASES = 14;

constexpr size_t MiB = 1ull << 20;
constexpr size_t WS_CTL = 0, CTL_ZERO_BYTES = 1 * MiB;
constexpr size_t WS_WIN = 1 * MiB;
constexpr size_t WS_W1 = WS_WIN + 48 * MiB;
constexpr size_t WS_W2 = WS_W1 + 512 * MiB;
constexpr size_t WS_WOR = WS_W2 + 256 * MiB;
constexpr size_t WS_WOA = WS_WOR + 4 * MiB;
constexpr size_t WS_WOUT = WS_WOA + 2 * MiB;
constexpr size_t WS_H = WS_WOUT + 8 * MiB;
constexpr size_t WS_ZP = WS_H + 64 * MiB;
constexpr size_t WS_QKV = WS_ZP + 112 * MiB;
constexpr size_t WS_GATES = WS_QKV + 144 * MiB;
constexpr size_t WS_ROT = WS_GATES + 128 * MiB;
constexpr size_t WS_SC = WS_ROT + 2 * MiB;
constexpr size_t WS_G = WS_SC + 384 * MiB;
constexpr size_t WS_BONUS = WS_G + 32 * MiB;
constexpr size_t WS_Y = WS_BONUS + 1 * MiB;
constexpr size_t WS_ATTO = WS_Y + 64 * MiB;
constexpr size_t WS_ATTML = WS_ATTO + 48 * MiB;
constexpr size_t WS_YAIN = WS_ATTML + 2 * MiB;
constexpr size_t WS_OIN = WS_YAIN + 32 * MiB;
constexpr size_t WS_MERGED = WS_OIN + 16 * MiB;
constexpr size_t WS_X1 = WS_MERGED + 64 * MiB;
constexpr size_t WS_TOPK = WS_X1 + 128 * MiB;
constexpr size_t WS_ROWS = WS_TOPK + 1 * MiB;
constexpr size_t WS_XS = WS_ROWS + 1 * MiB;
constexpr size_t WS_ACT = WS_XS + 288 * MiB;
constexpr size_t WS_OUTK = WS_ACT + 288 * MiB;
constexpr size_t WS_LORA = WS_OUTK + 256 * MiB;
constexpr size_t WS_END = WS_LORA + 1 * MiB;
constexpr size_t WS_S1 = WS_XS;
constexpr int NU16 = NB * NH * (SEQ / 16);
constexpr size_t S1_WH = 0, S1_QH = 32 * MiB, S1_BT = 64 * MiB, S1_KT = 96 * MiB, S1_VT = 128 * MiB, S1_U0T = 160 * MiB, S1_Y0T = 224 * MiB, S1_GAM = 288 * MiB;
constexpr size_t SC_STRIDE = (size_t)T * RW;
enum { SH_KK = 0, SH_BB = 1, SH_K = 2, SH_R = 3, SH_V = 4 };

constexpr int CW_TMO = 0, CW_CODE = 1, CW_BAR = 4096, CW_CNT = 8192;

constexpr int RING_BYTES = 131072;
constexpr int TAB_OFF = 147456;
constexpr int MISC_OFF = TAB_OFF + 512;
constexpr int LDS_BYTES = 151552;

#define GAS __attribute__((address_space(1)))
#define LAS __attribute__((address_space(3)))
typedef unsigned short bf16;
typedef unsigned u32x4 __attribute__((ext_vector_type(4)));
typedef unsigned u32x2 __attribute__((ext_vector_type(2)));
typedef float f32x4 __attribute__((ext_vector_type(4)));
typedef short bf16x8 __attribute__((ext_vector_type(8)));
typedef short bf16x4 __attribute__((ext_vector_type(4)));
typedef GAS unsigned gu32;
#define RLX_AGENT __ATOMIC_RELAXED, __HIP_MEMORY_SCOPE_AGENT
#define LDS_WAIT() asm volatile("s_waitcnt lgkmcnt(0)" ::: "memory")
#define VM_WAIT() asm volatile("s_waitcnt vmcnt(0)" ::: "memory")
__device__ __forceinline__ unsigned f2bf(float f) { unsigned u = __builtin_bit_cast(unsigned, f); return (u + 0x7fffu + ((u >> 16) & 1u)) >> 16; }
__device__ __forceinline__ unsigned pk2(float lo, float hi) { return f2bf(lo) | (f2bf(hi) << 16); }
__device__ __forceinline__ float bflo(unsigned w) { return __uint_as_float(w << 16); }
__device__ __forceinline__ float bfhi(unsigned w) { return __uint_as_float(w & 0xffff0000u); }
__device__ __forceinline__ float bf2f(bf16 h) { return __uint_as_float((unsigned)h << 16); }
__device__ __forceinline__ float sigmoidf_(float x) { return 1.0f / (1.0f + __expf(-x)); }
__device__ __forceinline__ float wave_sum(float v) {
#pragma unroll
    for (int o = 1; o < 64; o <<= 1) v += __shfl_xor(v, o);
    return v;
}
__device__ __forceinline__ unsigned pk4_fp8(float a, float b, float c, float d) { int r = __builtin_amdgcn_cvt_pk_fp8_f32(a, b, 0, false); r = __builtin_amdgcn_cvt_pk_fp8_f32(c, d, r, true); return (unsigned)r; }
__device__ __forceinline__ u32x4 pack8(const f32x4& a, const f32x4& b) { u32x4 w; w.x = pk2(a[0], a[1]); w.y = pk2(a[2], a[3]); w.z = pk2(b[0], b[1]); w.w = pk2(b[2], b[3]); return w; }
__device__ __forceinline__ void unpack8(const u32x4& w, f32x4& a, f32x4& b) { a = (f32x4){bflo(w.x), bfhi(w.x), bflo(w.y), bfhi(w.y)}; b = (f32x4){bflo(w.z), bfhi(w.z), bflo(w.w), bfhi(w.w)}; }

#define XB_TMO      128
#define XB_XCNT(j)  (256  + 64 * (j))
#define XB_XSUB(j)  (1280 + 64 * (j))
#define XB_XGEN(j)  (2304 + 64 * (j))
#define XB_TOP      3328
#define XB_TOPGEN   3392
#define XCD_BAR_WORDS 3456
#define XB_SPIN_CAP (1u << 18)

__device__ __forceinline__ unsigned xb_ld(unsigned* p)              { return __hip_atomic_load(p, __ATOMIC_RELAXED, __HIP_MEMORY_SCOPE_AGENT); }
__device__ __forceinline__ unsigned xb_add(unsigned* p, unsigned v) { return __hip_atomic_fetch_add(p, v, __ATOMIC_RELAXED, __HIP_MEMORY_SCOPE_AGENT); }
__device__ __forceinline__ unsigned xb_xcc_id() { return (unsigned)__builtin_amdgcn_s_getreg((3 << 11) | 20) & 0xFu; }
#define XB_SPIN(cond, bar) do { unsigned _sp = 0; while (cond) { __builtin_amdgcn_s_sleep(1); \
    if ((++_sp & 255u) == 0u) { if (xb_ld(&(bar)[XB_TMO])) break; if (_sp > XB_SPIN_CAP) { atomicAdd(&(bar)[XB_TMO], 1u); break; } } } } while (0)

struct XcdBarrier {
    unsigned* bar; unsigned x;
    volatile LAS unsigned* st;
};

__device__ __forceinline__ XcdBarrier xcd_barrier_post(unsigned* bar, volatile LAS unsigned* st) {
    XcdBarrier b; b.bar = bar; b.x = xb_xcc_id(); b.st = st;
    if (threadIdx.x == 0) (void)xb_add(&bar[XB_XCNT(b.x)], 1u);
    return b;
}
__device__ __forceinline__ void xcd_barrier_complete(unsigned* bar, unsigned x, unsigned& nloc, unsigned& nx) {
    const unsigned G = gridDim.x * gridDim.y * gridDim.z;
    unsigned sum, cnt, mine, sp = 0u;
    for (;;) {
        sum = 0u; cnt = 0u; mine = 0u;
#pragma unroll
        for (unsigned j = 0; j < 16; ++j) { const unsigned c = xb_ld(&bar[XB_XCNT(j)]); sum += c; cnt += (c > 0u) ? 1u : 0u; mine = (j == x) ? c : mine; }
        if (sum == G) break;
        __builtin_amdgcn_s_sleep(1);
        if ((++sp & 255u) == 0u) { if (xb_ld(&bar[XB_TMO])) break; if (sp > XB_SPIN_CAP) { atomicAdd(&bar[XB_TMO], 1u); break; } }
    }
    nloc = mine > 0u ? mine : 1u; nx = cnt > 0u ? cnt : 1u;
}

__device__ __forceinline__ void xcd_barrier(const XcdBarrier& b) {
    asm volatile("s_waitcnt vmcnt(0)" ::: "memory");
    __syncthreads();
    if (threadIdx.x == 0) {
        unsigned* bar = b.bar;
        __builtin_amdgcn_s_waitcnt(0);
        unsigned nloc = b.st[0], nx = b.st[1];
        if (nloc == 0u) { xcd_barrier_complete(bar, b.x, nloc, nx); b.st[0] = nloc; b.st[1] = nx; }
        const unsigned old = xb_add(&bar[XB_XSUB(b.x)], 1u);
        const unsigned gen = old / nloc;
        if (old + 1u == (gen + 1u) * nloc) {
            __builtin_amdgcn_fence(__ATOMIC_RELEASE, "agent");
            asm volatile("s_waitcnt vmcnt(0)" ::: "memory");
            const unsigned og = xb_add(&bar[XB_TOP], 1u);
            const unsigned tg = og / nx;
            if (og + 1u == (tg + 1u) * nx) xb_add(&bar[XB_TOPGEN], 1u);
            else XB_SPIN(xb_ld(&bar[XB_TOPGEN]) == tg, bar);
            __builtin_amdgcn_fence(__ATOMIC_ACQUIRE, "agent");
            xb_add(&bar[XB_XGEN(b.x)], 1u);
            asm volatile("s_waitcnt vmcnt(0)" ::: "memory");
        } else {
            XB_SPIN(xb_ld(&bar[XB_XGEN(b.x)]) == gen, bar);
            __builtin_amdgcn_fence(__ATOMIC_ACQUIRE, "agent");
            asm volatile("s_waitcnt vmcnt(0)" ::: "memory");
        }
    }
    __syncthreads();
}


struct Ptrs {
    const float *x, *norm_mix, *w_in, *shift_mu, *w0, *w2_decay, *a0, *a2_iclr, *g2_gate, *k_k, *k_a, *r_k, *ln_x_w, *ln_x_b, *w_o_rwkv, *w_o_attn, *w_out, *norm_ffn, *w_router, *b_router, *w1, *b1, *w2, *b2, *norm_final;
    const int* positions;
    float* out;
    bf16 *LW, *LA, *LG, *WRH, *WRL, *WIN, *W1, *W2, *WOR, *WOA, *WOUT, *H, *ZP, *QKV, *GATES, *G, *ATTO, *YAIN, *OIN, *MERGED, *XS, *ACT, *OUTK;
    bf16* SCH;
    float *ROT, *SC, *BONUS, *Y, *ATTML, *X1, *TOPK_GATE, *ROWGATE;
    int *TOPK_E, *TOPK_POS, *ROWTOK;
    gu32* ctl;
};

using pg8::Unit;
__device__ __forceinline__ void store8(bf16* p, const f32x4& a, const f32x4& b) { *(u32x4*)p = pack8(a, b); }

struct EpiProj {
    static constexpr bool PERM = true, AFTER_DRAIN = false;
    bf16* ZP; bf16* QKV; bf16* GATES; const float* ROT;
    __device__ __forceinline__ void operator()(const f32x4 (&acc)[2][2][4][2], const Unit& u, int wr, int wc, int fr, int fq) const {
        const int pn = u.pn, rbase = u.pm * 256 + wr * 64 + fr, cw = wc * 32 + 8 * fq;
        if (pn < 14) {
#pragma unroll
            for (int ai = 0; ai < 2; ++ai)
#pragma unroll
                for (int m = 0; m < 4; ++m) { bf16* rp = ZP + (size_t)(rbase + ai * 128 + m * 16) * ZPW + pn * 256 + cw;
#pragma unroll
                    for (int bj = 0; bj < 2; ++bj) store8(rp + bj * 128, acc[ai][bj][m][0], acc[ai][bj][m][1]); }
        } else if (pn < 32) {
            const int t = pn - 14; const bool rot = (t < 12) && (wc == 0); const float sc = (t < 6) ? QSCALE : 1.0f; const float sg = (fq < 2) ? -1.0f : 1.0f;
#pragma unroll
            for (int ai = 0; ai < 2; ++ai)
#pragma unroll
                for (int m = 0; m < 4; ++m) { const int row = rbase + ai * 128 + m * 16; bf16* rp = QKV + (size_t)row * QKVW + t * 256 + cw;
                    f32x4 c0 = {1.f, 1.f, 1.f, 1.f}, c1 = c0, s0 = {0.f, 0.f, 0.f, 0.f}, s1 = s0;
                    if (rot) { const float* rt = ROT + (size_t)row * 32 + 8 * (fq & 1); c0 = *(const f32x4*)rt; c1 = *(const f32x4*)(rt + 4); s0 = *(const f32x4*)(rt + 16); s1 = *(const f32x4*)(rt + 20); }
#pragma unroll
                    for (int bj = 0; bj < 2; ++bj) { f32x4 v0 = acc[ai][bj][m][0], v1 = acc[ai][bj][m][1];
                        if (rot) { f32x4 p0, p1;
#pragma unroll
                            for (int j = 0; j < 4; ++j) { p0[j] = __shfl_xor(v0[j], 32); p1[j] = __shfl_xor(v1[j], 32); }
                            v0 = v0 * c0 + (p0 * s0) * sg; v1 = v1 * c1 + (p1 * s1) * sg; }
                        v0 = v0 * sc; v1 = v1 * sc; store8(rp + bj * 128, v0, v1); } }
        } else {
            const int t = pn - 32;
#pragma unroll
            for (int ai = 0; ai < 2; ++ai)
#pragma unroll
                for (int m = 0; m < 4; ++m) { bf16* rp = GATES + (size_t)(rbase + ai * 128 + m * 16) * GATEW + t * 256 + cw;
#pragma unroll
                    for (int bj = 0; bj < 2; ++bj) { f32x4 v0 = acc[ai][bj][m][0], v1 = acc[ai][bj][m][1];
#pragma unroll
                        for (int j = 0; j < 4; ++j) { v0[j] = sigmoidf_(v0[j]); v1[j] = sigmoidf_(v1[j]); }
                        store8(rp + bj * 128, v0, v1); } }
        }
    }
};

template <int STAGE> struct EpiMerge {
    static constexpr bool PERM = true, AFTER_DRAIN = false;
    bf16* MERGED; const bf16* GATES;
    __device__ __forceinline__ void operator()(const f32x4 (&acc)[2][2][4][2], const Unit& u, int wr, int wc, int fr, int fq) const {
        const int rbase = u.pm * 256 + wr * 64 + fr, cb = u.pn * 256 + wc * 32 + 8 * fq;
#pragma unroll
        for (int ai = 0; ai < 2; ++ai)
#pragma unroll
            for (int m = 0; m < 4; ++m) { const int row = rbase + ai * 128 + m * 16;
#pragma unroll
                for (int bj = 0; bj < 2; ++bj) { const int col = cb + bj * 128;
                    const u32x4 gw = *(const u32x4*)(GATES + (size_t)row * GATEW + STAGE * 2048 + col); f32x4 g0, g1; unpack8(gw, g0, g1);
                    f32x4 v0 = acc[ai][bj][m][0] * g0, v1 = acc[ai][bj][m][1] * g1; bf16* dp = MERGED + (size_t)row * D + col;
                    if (STAGE == 1) { const u32x4 tw = *(const u32x4*)dp; f32x4 t0, t1; unpack8(tw, t0, t1); v0 = v0 + t0; v1 = v1 + t1; }
                    store8(dp, v0, v1); } }
    }
};

struct EpiResid {
    static constexpr bool PERM = false, AFTER_DRAIN = false;
    const float* X; float* X1;
    __device__ __forceinline__ void operator()(const f32x4 (&acc)[2][2][4][2], const Unit& u, int wr, int wc, int fr, int fq) const {
        const int rbase = u.pm * 256 + wr * 64 + fr, cb = u.pn * 256 + wc * 32 + 4 * fq;
#pragma unroll
        for (int ai = 0; ai < 2; ++ai)
#pragma unroll
            for (int m = 0; m < 4; ++m) { const size_t ro = (size_t)(rbase + ai * 128 + m * 16) * D;
#pragma unroll
                for (int bj = 0; bj < 2; ++bj)
#pragma unroll
                    for (int n = 0; n < 2; ++n) { const int col = cb + bj * 128 + n * 16; *(f32x4*)(X1 + ro + col) = *(const f32x4*)(X + ro + col) + acc[ai][bj][m][n]; } }
    }
};

struct EpiMoe1 {
    static constexpr bool PERM = true, AFTER_DRAIN = false;
    bf16* ACT; const float* b1;
    __device__ __forceinline__ void operator()(const f32x4 (&acc)[2][2][4][2], const Unit& u, int wr, int wc, int fr, int fq) const {
        const int e = u.pn >> 4, pnl = u.pn & 15, rbase = u.pm * 256 + wr * 64 + fr, col = pnl * 128 + wc * 32 + 8 * fq;
        const float* bg = b1 + (size_t)e * 4096 + col; const float* bl = bg + 2048;
        const f32x4 bg0 = *(const f32x4*)bg, bg1 = *(const f32x4*)(bg + 4), bl0 = *(const f32x4*)bl, bl1 = *(const f32x4*)(bl + 4);
#pragma unroll
        for (int ai = 0; ai < 2; ++ai)
#pragma unroll
            for (int m = 0; m < 4; ++m) { const int row = rbase + ai * 128 + m * 16;
                f32x4 g0 = acc[ai][0][m][0] + bg0, g1 = acc[ai][0][m][1] + bg1, l0 = acc[ai][1][m][0] + bl0, l1 = acc[ai][1][m][1] + bl1, o0, o1;
#pragma unroll
                for (int j = 0; j < 4; ++j) {
                    { const float xg = fminf(g0[j], 7.0f), xl = fminf(fmaxf(l0[j], -7.0f), 7.0f); o0[j] = xg * sigmoidf_(1.702f * xg) * (xl + 1.0f); }
                    { const float xg = fminf(g1[j], 7.0f), xl = fminf(fmaxf(l1[j], -7.0f), 7.0f); o1[j] = xg * sigmoidf_(1.702f * xg) * (xl + 1.0f); } }
                u32x2 w8; w8.x = pk4_fp8(o0[0] * 8.0f, o0[1] * 8.0f, o0[2] * 8.0f, o0[3] * 8.0f); w8.y = pk4_fp8(o1[0] * 8.0f, o1[1] * 8.0f, o1[2] * 8.0f, o1[3] * 8.0f);
                *(u32x2*)((unsigned char*)ACT + (size_t)row * FF + col) = w8; }
    }
};

struct EpiMoe2 {
    static constexpr bool PERM = true, AFTER_DRAIN = false;
    bf16* OUTK; const float* b2; const int* ROWTOK; const float* ROWGATE;
    __device__ __forceinline__ void operator()(const f32x4 (&acc)[2][2][4][2], const Unit& u, int wr, int wc, int fr, int fq) const {
        const int e = u.pn >> 3, pnl = u.pn & 7, rbase = u.pm * 256 + wr * 64 + fr, cb = pnl * 256 + wc * 32 + 8 * fq;
        f32x4 bv[2][2];
#pragma unroll
        for (int bj = 0; bj < 2; ++bj) { const float* bp = b2 + (size_t)e * D + cb + bj * 128; bv[bj][0] = *(const f32x4*)bp; bv[bj][1] = *(const f32x4*)(bp + 4); }
#pragma unroll
        for (int ai = 0; ai < 2; ++ai)
#pragma unroll
            for (int m = 0; m < 4; ++m) { const int row = rbase + ai * 128 + m * 16; const int p = ROWTOK[row];
                if (p >= 0) { const float gt = ROWGATE[row];
#pragma unroll
                    for (int bj = 0; bj < 2; ++bj) { const f32x4 v0 = (acc[ai][bj][m][0] + bv[bj][0]) * gt, v1 = (acc[ai][bj][m][1] + bv[bj][1]) * gt; store8(OUTK + (size_t)p * D + cb + bj * 128, v0, v1); } } }
    }
};

struct MoeOrder {
    const LAS int* toff; int npn, G, c;
    __device__ __forceinline__ bool next(int i, Unit& u) const {
        const int L0 = i * G + c, NT = toff[32], NU = NT * npn;
        if (L0 >= NU) return false;
        const int q8 = NU >> 3, r8 = NU & 7, xcd = L0 & 7, off = L0 >> 3;
        const int L = (xcd < r8 ? xcd * (q8 + 1) : r8 * (q8 + 1) + (xcd - r8) * q8) + off;
        int e = 0;
#pragma unroll 1
        for (int j = 1; j < 32; ++j) e += (L >= toff[j] * npn) ? 1 : 0;
        const int t0 = toff[e], te = toff[e + 1] - t0, rem = L - t0 * npn;
        const int pnl = rem / te, pml = rem - pnl * te;
        u.pm = __builtin_amdgcn_readfirstlane(t0 + pml); u.pn = __builtin_amdgcn_readfirstlane(e * npn + pnl); return true;
    }
    __device__ __forceinline__ void a_ready(const Unit&) const {}
    __device__ __forceinline__ void done(const Unit&) const {}
};

__device__ __forceinline__ void tr_item(const float* src, int ldn, int k0, int c0, bf16* dst, size_t dstrow0, int K, LAS float* scr, int lane) {
    f32x4 v[8];
#pragma unroll
    for (int i = 0; i < 8; ++i) v[i] = *(const GAS f32x4*)(src + (size_t)(k0 + 8 * i + (lane >> 3)) * ldn + c0 + 4 * (lane & 7));
#pragma unroll
    for (int i = 0; i < 8; ++i) { LAS float* p = scr + (8 * i + (lane >> 3)) * 33 + 4 * (lane & 7); p[0] = v[i].x; p[1] = v[i].y; p[2] = v[i].z; p[3] = v[i].w; }
    LDS_WAIT(); asm volatile("" ::: "memory");
    const int c = lane & 7;
#pragma unroll
    for (int j = 0; j < 4; ++j) { const int n = (lane >> 3) + 8 * j; const LAS float* s = scr + (8 * c) * 33 + n;
        u32x4 o; o.x = pk2(s[0 * 33], s[1 * 33]); o.y = pk2(s[2 * 33], s[3 * 33]); o.z = pk2(s[4 * 33], s[5 * 33]); o.w = pk2(s[6 * 33], s[7 * 33]);
        *(GAS u32x4*)(dst + (dstrow0 + n) * (size_t)K + k0 + 8 * c) = o; }
    LDS_WAIT(); asm volatile("" ::: "memory");
}
__device__ __forceinline__ void tr8_tile(const float* src, int ldn, int k0, int c0, unsigned char* dst, size_t dstrow0, int K, float sc, LAS float* scr, int lane) {
    f32x4 v[16];
#pragma unroll
    for (int i = 0; i < 16; ++i) v[i] = *(const GAS f32x4*)(src + (size_t)(k0 + 8 * i + (lane >> 3)) * ldn + c0 + 4 * (lane & 7));
#pragma unroll
    for (int i = 0; i < 16; ++i) { LAS float* p = scr + (8 * i + (lane >> 3)) * 33 + 4 * (lane & 7); p[0] = v[i].x * sc; p[1] = v[i].y * sc; p[2] = v[i].z * sc; p[3] = v[i].w * sc; }
    LDS_WAIT(); asm volatile("" ::: "memory");
    const int n = lane & 31;
#pragma unroll
    for (int j = 0; j < 4; ++j) { const int kc = (lane >> 5) + 2 * j; const LAS float* s = scr + (16 * kc) * 33 + n;
        u32x4 o; o.x = pk4_fp8(s[0 * 33], s[1 * 33], s[2 * 33], s[3 * 33]); o.y = pk4_fp8(s[4 * 33], s[5 * 33], s[6 * 33], s[7 * 33]);
        o.z = pk4_fp8(s[8 * 33], s[9 * 33], s[10 * 33], s[11 * 33]); o.w = pk4_fp8(s[12 * 33], s[13 * 33], s[14 * 33], s[15 * 33]);
        *(GAS u32x4*)(dst + (dstrow0 + n) * (size_t)K + k0 + 16 * kc) = o; }
    LDS_WAIT(); asm volatile("" ::: "memory");
}
__device__ __forceinline__ void tr_item8(const float* src, int ldn, int k0, int c0, unsigned char* dst, size_t dstrow0, int K, float sc, LAS float* scr, int lane) {
    f32x4 v[8];
#pragma unroll
    for (int i = 0; i < 8; ++i) v[i] = *(const GAS f32x4*)(src + (size_t)(k0 + 8 * i + (lane >> 3)) * ldn + c0 + 4 * (lane & 7));
#pragma unroll
    for (int i = 0; i < 8; ++i) { LAS float* p = scr + (8 * i + (lane >> 3)) * 33 + 4 * (lane & 7); p[0] = v[i].x * sc; p[1] = v[i].y * sc; p[2] = v[i].z * sc; p[3] = v[i].w * sc; }
    LDS_WAIT(); asm volatile("" ::: "memory");
    const int c = lane & 7;
#pragma unroll
    for (int j = 0; j < 4; ++j) { const int n = (lane >> 3) + 8 * j; const LAS float* s = scr + (8 * c) * 33 + n;
        u32x2 o; o.x = pk4_fp8(s[0 * 33], s[1 * 33], s[2 * 33], s[3 * 33]); o.y = pk4_fp8(s[4 * 33], s[5 * 33], s[6 * 33], s[7 * 33]);
        *(GAS u32x2*)(dst + (dstrow0 + n) * (size_t)K + k0 + 8 * c) = o; }
    LDS_WAIT(); asm volatile("" ::: "memory");
}
__device__ __forceinline__ void rms_row_to_bf16(const float* xrow, const float* g, bf16* orow, int lane) {
    f32x4 v[8]; float s = 0.f;
#pragma unroll
    for (int j = 0; j < 8; ++j) { v[j] = *(const GAS f32x4*)(xrow + 4 * lane + 256 * j); s += (v[j].x * v[j].x + v[j].y * v[j].y) + (v[j].z * v[j].z + v[j].w * v[j].w); }
    const float rs = 1.0f / sqrtf(wave_sum(s) * (1.0f / D) + NORM_EPS);
#pragma unroll
    for (int j = 0; j < 8; ++j) { const f32x4 gv = *(const GAS f32x4*)(g + 4 * lane + 256 * j); u32x2 w; w.x = pk2(v[j].x * rs * gv.x, v[j].y * rs * gv.y); w.y = pk2(v[j].z * rs * gv.z, v[j].w * rs * gv.w);
        *(GAS u32x2*)(orow + 4 * lane + 256 * j) = w; }
}
__device__ __forceinline__ void p0_prologue(const Ptrs& P, LAS unsigned char* lds, int tid, int wave, int lane) {
    LAS float* scr = (LAS float*)(lds + wave * 8704);
    const int gw = blockIdx.x * NWAVES + wave, NGW = gridDim.x * NWAVES;
    constexpr int I_IN = 32 * 377, I_OR = 16 * 64, I_OA = 8 * 64, I_OUT = 32 * 64;
    constexpr int NITEMS = I_IN + I_OR + I_OA + I_OUT;
    for (int it = gw; it < NITEMS; it += NGW) {
        int r = it;
        if (r < I_IN) { const int kb = r / 377, nb = r % 377, c0 = 32 * nb; tr_item(P.w_in, IN_W, 64 * kb, c0, P.WIN, (size_t)(c0 < SHIFT_W ? c0 : c0 + 224), D, scr, lane); continue; }
        r -= I_IN;
        if (r < I_OR) { const int kb = r >> 6, nb = r & 63; tr_item(P.w_o_rwkv, D, 64 * kb, 32 * nb, P.WOR, (size_t)32 * nb, RW, scr, lane); continue; }
        r -= I_OR;
        if (r < I_OA) { const int kb = r >> 6, nb = r & 63; tr_item(P.w_o_attn, D, 64 * kb, 32 * nb, P.WOA, (size_t)32 * nb, 512, scr, lane); continue; }
        r -= I_OA;
        { const int kb = r >> 6, nb = r & 63; tr_item(P.w_out, D, 64 * kb, 32 * nb, P.WOUT, (size_t)32 * nb, D, scr, lane); }
    }
    { const int gt = blockIdx.x * NTHREADS + tid, NGT = gridDim.x * NTHREADS; GAS u32x4* z = (GAS u32x4*)(P.WIN + (size_t)SHIFT_W * D);
      for (int i = gt; i < 224 * D / 8; i += NGT) z[i] = (u32x4){0u, 0u, 0u, 0u}; }
    { const int gt = blockIdx.x * NTHREADS + tid, NGT = gridDim.x * NTHREADS;
      for (int i = gt; i < 1024 * 64; i += NGT) { const int n = i >> 6, k = i & 63; P.LW[i] = (bf16)f2bf(P.w2_decay[k * RW + n]); P.LA[i] = (bf16)f2bf(P.a2_iclr[k * RW + n]); }
      for (int i = gt; i < 1024 * 160; i += NGT) { const int n = i / 160, k = i - n * 160; P.LG[i] = (bf16)f2bf(P.g2_gate[k * RW + n]); } }
    { const int gt = blockIdx.x * NTHREADS + tid, NGT = gridDim.x * NTHREADS;
      for (int i = gt; i < NE * D; i += NGT) { const int e = i >> 11, k = i & 2047; const float v = P.w_router[(size_t)k * NE + e] * P.norm_ffn[k]; const unsigned h = f2bf(v); P.WRH[i] = (bf16)h; P.WRL[i] = (bf16)f2bf(v - bf2f((bf16)h)); } }
    for (int m = gw; m < T; m += NGW) rms_row_to_bf16(P.x + (size_t)m * D, P.norm_mix, P.H + (size_t)m * D, lane);
    { const int gt = blockIdx.x * NTHREADS + tid, NGT = gridDim.x * NTHREADS;
      for (int i = gt; i < T * 16; i += NGT) { const int m = i >> 4, f = i & 15; const float inv = exp2f(-(float)f * (18.931568569324174f / 16.0f));
          const float ang = (float)P.positions[m] * inv; double rev = (double)ang * 0.15915494309189535; rev -= floor(rev); const float rv = (float)rev; const float sn = __builtin_amdgcn_sinf(rv), cs = __builtin_amdgcn_cosf(rv); P.ROT[(size_t)m * 32 + f] = cs; P.ROT[(size_t)m * 32 + 16 + f] = sn; } }
}

template <int CTRL> __device__ __forceinline__ float dppf(float x) { return __builtin_bit_cast(float, __builtin_amdgcn_mov_dpp(__builtin_bit_cast(int, x), CTRL, 0xf, 0xf, true)); }
__device__ __forceinline__ float sum8(float x) { x += dppf<0xB1>(x); x += dppf<0x4E>(x); x += dppf<0x141>(x); return x; }
__device__ __forceinline__ f32x4 mfma16(bf16x8 a, bf16x8 b, f32x4 c) { return __builtin_amdgcn_mfma_f32_16x16x32_bf16(a, b, c, 0, 0, 0); }
__device__ __forceinline__ u32x4 pack8s(const float* p) { u32x4 w; w.x = pk2(p[0], p[1]); w.y = pk2(p[2], p[3]); w.z = pk2(p[4], p[5]); w.w = pk2(p[6], p[7]); return w; }
__device__ __forceinline__ void p4a_chunk_prep(const Ptrs& P, unsigned char* ws, LAS unsigned char* lds, int tid, int wave, int lane, int u64) {
    LAS unsigned char* wl = lds + wave * 16384;
    LAS unsigned char* AH = wl, *BH = wl + 2048, *KH = wl + 4096, *RH = wl + 6144;
    LAS unsigned char* AT = wl + 8192, *RT = wl + 10240, *VTl = wl + 12288;
    LAS unsigned char* MX = wl + 14336;
    LAS unsigned char* WTl = wl, *U0Tl = wl + 2048, *PT = wl + 8192; LAS float* LmT = (LAS float*)(wl + 4096);
    const int fr = lane & 15, fq = lane >> 4, fq1 = fq & 1;
    unsigned char* s1 = ws + WS_S1;
    for (int jj = 0; jj < 8; ++jj) {
        const int j = wave * 8 + jj, h = j & 15, b = u64 >> 6, c16 = (u64 & 63) * 4 + (j >> 4), bh = b * 16 + h, uidx = (bh << 8) + c16;
        const size_t gbase = ((size_t)b * SEQ + (size_t)c16 * 16) * RW + h * 64 + lane;
        float av[16], bv[16], kv[16], rv[16], vv[16];
        {   float wv[16];
#pragma unroll
            for (int t = 0; t < 16; ++t) { const size_t o = gbase + (size_t)t * RW; wv[t] = P.SC[o]; av[t] = bf2f(P.SCH[SH_KK * SC_STRIDE + o]); bv[t] = bf2f(P.SCH[SH_BB * SC_STRIDE + o]);
                kv[t] = bf2f(P.SCH[SH_K * SC_STRIDE + o]); rv[t] = bf2f(P.SCH[SH_R * SC_STRIDE + o]); vv[t] = bf2f(P.SCH[SH_V * SC_STRIDE + o]); }
            float g = 1.0f;
#pragma unroll
            for (int t = 0; t < 16; ++t) { const float gp = g; g *= wv[t]; const float inv = 1.0f / g; av[t] *= gp; bv[t] *= inv; kv[t] *= inv; rv[t] *= g;
                *(LAS unsigned short*)(AH + t * 128 + lane * 2) = (unsigned short)f2bf(av[t]); *(LAS unsigned short*)(BH + t * 128 + lane * 2) = (unsigned short)f2bf(bv[t]);
                *(LAS unsigned short*)(KH + t * 128 + lane * 2) = (unsigned short)f2bf(kv[t]); *(LAS unsigned short*)(RH + t * 128 + lane * 2) = (unsigned short)f2bf(rv[t]); }
            *(LAS u32x4*)(AT + lane * 32) = pack8s(av); *(LAS u32x4*)(AT + lane * 32 + 16) = pack8s(av + 8);
            *(LAS u32x4*)(RT + lane * 32) = pack8s(rv); *(LAS u32x4*)(RT + lane * 32 + 16) = pack8s(rv + 8);
            const u32x4 v0 = pack8s(vv), v1 = pack8s(vv + 8);
            *(LAS u32x4*)(VTl + lane * 32) = v0; *(LAS u32x4*)(VTl + lane * 32 + 16) = v1;
            GAS u32x4* gv = (GAS u32x4*)(s1 + S1_VT + ((size_t)uidx * 64 + lane) * 32); gv[0] = v0; gv[1] = v1;
#pragma unroll
            for (int t = 0; t < 16; ++t) { bv[t] *= g; kv[t] *= g; }
            GAS u32x4* gb = (GAS u32x4*)(s1 + S1_BT + ((size_t)uidx * 64 + lane) * 32); gb[0] = pack8s(bv); gb[1] = pack8s(bv + 8);
            GAS u32x4* gk = (GAS u32x4*)(s1 + S1_KT + ((size_t)uidx * 64 + lane) * 32); gk[0] = pack8s(kv); gk[1] = pack8s(kv + 8);
            *(GAS float*)(s1 + S1_GAM + ((size_t)uidx * 64 + lane) * 4) = g; }
        LDS_WAIT(); asm volatile("" ::: "memory");
        f32x4 lab = {0.f, 0.f, 0.f, 0.f}, lak = lab, mrb = lab, mrk = lab;
#pragma unroll
        for (int ks = 0; ks < 2; ++ks) { const int off = fr * 128 + (32 * ks + 8 * fq) * 2;
            const bf16x8 a = *(const LAS bf16x8*)(AH + off), r_ = *(const LAS bf16x8*)(RH + off), b_ = *(const LAS bf16x8*)(BH + off), k_ = *(const LAS bf16x8*)(KH + off);
            lab = mfma16(a, b_, lab); lak = mfma16(a, k_, lak); mrb = mfma16(r_, b_, mrb); mrk = mfma16(r_, k_, mrk); }
#pragma unroll
        for (int rg = 0; rg < 4; ++rg) { const int t = 4 * fq + rg; const bool lo = fr < t, le = fr <= t; lab[rg] = lo ? lab[rg] : 0.f; lak[rg] = lo ? lak[rg] : 0.f; mrb[rg] = le ? mrb[rg] : 0.f; mrk[rg] = le ? mrk[rg] : 0.f; }
        asm volatile("" ::: "memory");
        *(LAS f32x4*)(LmT + fr * 16 + 4 * fq) = lab;
#pragma unroll
        for (int rg = 0; rg < 4; ++rg) { const int o = ((4 * fq + rg) * 16 + fr) * 2;
            *(LAS unsigned short*)(MX + o) = (unsigned short)f2bf(lak[rg]); *(LAS unsigned short*)(MX + 512 + o) = (unsigned short)f2bf(mrb[rg]); *(LAS unsigned short*)(MX + 1024 + o) = (unsigned short)f2bf(mrk[rg]); }
        LDS_WAIT(); asm volatile("" ::: "memory");
        float Tr[16];
#pragma unroll
        for (int m = 0; m < 16; ++m) Tr[m] = (m == fr) ? 1.0f : 0.0f;
#pragma unroll
        for (int j = 14; j >= 0; --j) { float acc = (j == fr) ? 1.0f : 0.0f;
#pragma unroll
            for (int q = 0; q < 4; ++q) { const f32x4 l4 = *(const LAS f32x4*)(LmT + j * 16 + 4 * q);
#pragma unroll
                for (int e = 0; e < 4; ++e) { const int m = 4 * q + e; if (m > j) acc += Tr[m] * l4[e]; } }
            Tr[j] = acc; }
        bf16x8 tfrag;
        { float sel[8];
#pragma unroll
          for (int j = 0; j < 8; ++j) sel[j] = (fq == 0) ? Tr[j] : ((fq == 1) ? Tr[8 + j] : 0.0f);
          tfrag = __builtin_bit_cast(bf16x8, pack8s(sel)); }
        f32x4 wacc[4];
#pragma unroll
        for (int nt = 0; nt < 4; ++nt) wacc[nt] = mfma16(tfrag, *(const LAS bf16x8*)(AT + (16 * nt + fr) * 32 + fq1 * 16), (f32x4){0.f, 0.f, 0.f, 0.f});
        asm volatile("" ::: "memory");
        { bf16* gwh = (bf16*)(s1 + S1_WH) + (size_t)uidx * 1024;
#pragma unroll
          for (int nt = 0; nt < 4; ++nt) { u32x2 w2; w2.x = pk2(wacc[nt][0], wacc[nt][1]); w2.y = pk2(wacc[nt][2], wacc[nt][3]); *(LAS u32x2*)(WTl + ((16 * nt + fr) * 16 + 4 * fq) * 2) = w2;
#pragma unroll
              for (int rg = 0; rg < 4; ++rg) gwh[(4 * fq + rg) * 64 + 16 * nt + fr] = (bf16)f2bf(wacc[nt][rg]); } }
        bf16x8 lkf, mbf, mkf, idf;
        { const u32x4 z4 = {0u, 0u, 0u, 0u};
          const u32x4 lk4 = *(const LAS u32x4*)(MX + (fr * 16 + 8 * fq1) * 2), mb4 = *(const LAS u32x4*)(MX + 512 + (fr * 16 + 8 * fq1) * 2), mk4 = *(const LAS u32x4*)(MX + 1024 + (fr * 16 + 8 * fq1) * 2);
          lkf = __builtin_bit_cast(bf16x8, (fq < 2) ? lk4 : z4);
          mbf = __builtin_bit_cast(bf16x8, mb4);
          mkf = __builtin_bit_cast(bf16x8, mk4);
          u32x4 id4; const int d = fr - 8 * fq1;
          id4.x = (d == 0 ? 0x3f80u : 0u) | (d == 1 ? 0x3f800000u : 0u); id4.y = (d == 2 ? 0x3f80u : 0u) | (d == 3 ? 0x3f800000u : 0u);
          id4.z = (d == 4 ? 0x3f80u : 0u) | (d == 5 ? 0x3f800000u : 0u); id4.w = (d == 6 ? 0x3f80u : 0u) | (d == 7 ? 0x3f800000u : 0u);
          idf = __builtin_bit_cast(bf16x8, id4); }
        LDS_WAIT(); asm volatile("" ::: "memory");
        f32x4 pacc[4];
#pragma unroll
        for (int nt = 0; nt < 4; ++nt) pacc[nt] = mfma16(lkf, *(const LAS bf16x8*)(VTl + (16 * nt + fr) * 32 + fq1 * 16), (f32x4){0.f, 0.f, 0.f, 0.f});
        asm volatile("" ::: "memory");
#pragma unroll
        for (int nt = 0; nt < 4; ++nt) { u32x2 w2; w2.x = pk2(pacc[nt][0], pacc[nt][1]); w2.y = pk2(pacc[nt][2], pacc[nt][3]); *(LAS u32x2*)(PT + ((16 * nt + fr) * 16 + 4 * fq) * 2) = w2; }
        LDS_WAIT(); asm volatile("" ::: "memory");
        f32x4 uacc[4];
#pragma unroll
        for (int nt = 0; nt < 4; ++nt) uacc[nt] = mfma16(tfrag, *(const LAS bf16x8*)(PT + (16 * nt + fr) * 32 + fq1 * 16), (f32x4){0.f, 0.f, 0.f, 0.f});
        asm volatile("" ::: "memory");
#pragma unroll
        for (int nt = 0; nt < 4; ++nt) { u32x2 w2; w2.x = pk2(uacc[nt][0], uacc[nt][1]); w2.y = pk2(uacc[nt][2], uacc[nt][3]); *(LAS u32x2*)(U0Tl + ((16 * nt + fr) * 16 + 4 * fq) * 2) = w2;
            *(GAS f32x4*)(s1 + S1_U0T + (((size_t)uidx * 64 + 16 * nt + fr) * 16 + 4 * fq) * 4) = uacc[nt]; }
        LDS_WAIT(); asm volatile("" ::: "memory");
        { const bf16x8 aq = (fq < 2) ? mbf : idf, ay = (fq < 2) ? mbf : mkf;
          bf16* gqh = (bf16*)(s1 + S1_QH) + (size_t)uidx * 1024;
#pragma unroll
          for (int nt = 0; nt < 4; ++nt) { const int row = 16 * nt + fr;
              const bf16x8 bq = *(const LAS bf16x8*)(((fq < 2) ? WTl : RT) + row * 32 + fq1 * 16), by = *(const LAS bf16x8*)(((fq < 2) ? U0Tl : VTl) + row * 32 + fq1 * 16);
              const f32x4 qa = mfma16(aq, bq, (f32x4){0.f, 0.f, 0.f, 0.f}), ya = mfma16(ay, by, (f32x4){0.f, 0.f, 0.f, 0.f});
#pragma unroll
              for (int rg = 0; rg < 4; ++rg) gqh[(4 * fq + rg) * 64 + row] = (bf16)f2bf(qa[rg]);
              *(GAS f32x4*)(s1 + S1_Y0T + (((size_t)uidx * 64 + row) * 16 + 4 * fq) * 4) = ya; } }
        LDS_WAIT(); asm volatile("" ::: "memory");
    }
}

__device__ __forceinline__ void p2_rwkv_prep(const Ptrs& P, unsigned char* ws, LAS unsigned char* lds, int tid, int wave, int lane) {
    constexpr int AWP = 144, AGP = 336, SLP = 196;
    LAS unsigned char* AW = lds; LAS unsigned char* AA = lds + 9216; LAS unsigned char* AG = lds + 18432; LAS float* slab = (LAS float*)(lds + 40960);
    const int fr = lane & 15, fq = lane >> 4;
    for (int u = blockIdx.x; u < T / 64; u += gridDim.x) {
        const int m0 = u * 64;
        __syncthreads();
        for (int item = tid; item < 64 * 36; item += NTHREADS) { const int tk = item / 36, c8 = item - tk * 36, m = m0 + tk, col0 = 3072 + 8 * c8;
            const u32x4 pw = *(const GAS u32x4*)(P.ZP + (size_t)m * ZPW + col0); u32x4 qw = {0u, 0u, 0u, 0u}; if (m % SEQ) qw = *(const GAS u32x4*)(P.ZP + (size_t)(m - 1) * ZPW + col0);
            f32x4 p0, p1, q0, q1; unpack8(pw, p0, p1); unpack8(qw, q0, q1);
            const f32x4 mu0 = *(const GAS f32x4*)(P.shift_mu + col0), mu1 = *(const GAS f32x4*)(P.shift_mu + col0 + 4);
            f32x4 z0 = p0 + (q0 - p0) * mu0, z1 = p1 + (q1 - p1) * mu1;
            if (c8 < 8) {
#pragma unroll
                for (int j = 0; j < 4; ++j) { z0[j] = tanhf(z0[j]); z1[j] = tanhf(z1[j]); }
                *(LAS u32x4*)(AW + tk * AWP + c8 * 16) = pack8(z0, z1);
            } else if (c8 < 16) { *(LAS u32x4*)(AA + tk * AWP + (c8 - 8) * 16) = pack8(z0, z1);
            } else {
#pragma unroll
                for (int j = 0; j < 4; ++j) { z0[j] = sigmoidf_(z0[j]); z1[j] = sigmoidf_(z1[j]); }
                *(LAS u32x4*)(AG + tk * AGP + (c8 - 16) * 16) = pack8(z0, z1); } }
        __syncthreads();
        const int ct = wave & 3, tt0 = (wave >> 2) * 2;
        const int etk = tid >> 3, ec8 = tid & 7, em = m0 + etk; const bool ehasp = (em % SEQ) != 0;
        u32x4 zc[3], zq[3]; bf16x8 fw[2], fa[2], fg[5];
#define P2_PREF_M(h_) do { const int chrow_ = (h_) * 64 + ct * 16 + fr; \
            _Pragma("unroll") for (int ks = 0; ks < 2; ++ks) { fw[ks] = *(const GAS bf16x8*)(P.LW + (size_t)chrow_ * 64 + ks * 32 + 8 * fq); fa[ks] = *(const GAS bf16x8*)(P.LA + (size_t)chrow_ * 64 + ks * 32 + 8 * fq); } \
            _Pragma("unroll") for (int ks = 0; ks < 5; ++ks) fg[ks] = *(const GAS bf16x8*)(P.LG + (size_t)chrow_ * 160 + ks * 32 + 8 * fq); } while (0)
#define P2_PREF_E(h_) do { const int ch0_ = (h_) * 64 + 8 * ec8; const bf16* zp_ = P.ZP + (size_t)em * ZPW + ch0_; \
            _Pragma("unroll") for (int sg = 0; sg < 3; ++sg) { zc[sg] = *(const GAS u32x4*)(zp_ + sg * 1024); zq[sg] = (u32x4){0u, 0u, 0u, 0u}; if (ehasp) zq[sg] = *(const GAS u32x4*)(zp_ - ZPW + sg * 1024); \
                } } while (0)
        P2_PREF_E(0);
#pragma unroll 1
        for (int h = 0; h < NH; ++h) {
            { f32x4 acc[2][3]; P2_PREF_M(h);
#pragma unroll
              for (int t = 0; t < 2; ++t)
#pragma unroll
                  for (int kd = 0; kd < 3; ++kd) acc[t][kd] = (f32x4){0.f, 0.f, 0.f, 0.f};
#pragma unroll
              for (int ks = 0; ks < 2; ++ks)
#pragma unroll
                  for (int t = 0; t < 2; ++t) { const int tok = (tt0 + t) * 16 + fr;
                      acc[t][0] = mfma16(fw[ks], *(const LAS bf16x8*)(AW + tok * AWP + (ks * 32 + 8 * fq) * 2), acc[t][0]);
                      acc[t][1] = mfma16(fa[ks], *(const LAS bf16x8*)(AA + tok * AWP + (ks * 32 + 8 * fq) * 2), acc[t][1]); }
#pragma unroll
              for (int ks = 0; ks < 5; ++ks)
#pragma unroll
                  for (int t = 0; t < 2; ++t) { const int tok = (tt0 + t) * 16 + fr; acc[t][2] = mfma16(fg[ks], *(const LAS bf16x8*)(AG + tok * AGP + (ks * 32 + 8 * fq) * 2), acc[t][2]); }
#pragma unroll
              for (int t = 0; t < 2; ++t)
#pragma unroll
                  for (int kd = 0; kd < 3; ++kd) *(LAS f32x4*)(slab + ((tt0 + t) * 16 + fr) * SLP + kd * 64 + ct * 16 + 4 * fq) = acc[t][kd]; }
            __syncthreads();
            { const int ch0 = h * 64 + 8 * ec8; const LAS float* sl = slab + etk * SLP + 8 * ec8;
              float rr[8], kv[8], vv[8];
#pragma unroll
              for (int sg = 0; sg < 3; ++sg) { f32x4 p0, p1, q0, q1; unpack8(zc[sg], p0, p1); unpack8(zq[sg], q0, q1);
                  const f32x4 mu0 = *(const GAS f32x4*)(P.shift_mu + sg * 1024 + ch0), mu1 = *(const GAS f32x4*)(P.shift_mu + sg * 1024 + ch0 + 4);
                  const f32x4 z0 = p0 + (q0 - p0) * mu0, z1 = p1 + (q1 - p1) * mu1;
#pragma unroll
                  for (int j = 0; j < 4; ++j) { if (sg == 0) { rr[j] = z0[j]; rr[4 + j] = z1[j]; } else if (sg == 1) { kv[j] = z0[j]; kv[4 + j] = z1[j]; } else { vv[j] = z0[j]; vv[4 + j] = z1[j]; } } }
              float dec[8], av[8], gv[8], kkp[8], kn[8]; float ss = 0.f, bon = 0.f;
#pragma unroll
              for (int q = 0; q < 2; ++q) { const f32x4 wr_ = *(const LAS f32x4*)(sl + 4 * q), ap = *(const LAS f32x4*)(sl + 64 + 4 * q), gg = *(const LAS f32x4*)(sl + 128 + 4 * q);
                  const f32x4 w0v = *(const GAS f32x4*)(P.w0 + ch0 + 4 * q), a0v = *(const GAS f32x4*)(P.a0 + ch0 + 4 * q), kkv = *(const GAS f32x4*)(P.k_k + ch0 + 4 * q), kav = *(const GAS f32x4*)(P.k_a + ch0 + 4 * q), rkv = *(const GAS f32x4*)(P.r_k + ch0 + 4 * q);
#pragma unroll
                  for (int j = 0; j < 4; ++j) { const int i = 4 * q + j;
                      dec[i] = __expf(-0.6065306597126334f * sigmoidf_(w0v[j] + wr_[j])); av[i] = sigmoidf_(a0v[j] + ap[j]); gv[i] = gg[j];
                      kkp[i] = kv[i] * kkv[j]; ss += kkp[i] * kkp[i]; kn[i] = kv[i] * (1.0f + (av[i] - 1.0f) * kav[j]); bon += rr[i] * kn[i] * rkv[j]; } }
              if (h + 1 < NH) P2_PREF_E(h + 1);
              ss = sum8(ss); bon = sum8(bon);
              const float rn = 1.0f / fmaxf(sqrtf(ss), 1e-12f);
              const size_t o = (size_t)em * RW + ch0;
              f32x4 t0, t1;
#pragma unroll
              for (int j = 0; j < 4; ++j) { t0[j] = -kkp[j] * rn; t1[j] = -kkp[4 + j] * rn; }
              *(GAS u32x4*)(P.SCH + SH_KK * SC_STRIDE + o) = pack8(t0, t1);
#pragma unroll
              for (int j = 0; j < 4; ++j) { t0[j] = -t0[j] * av[j]; t1[j] = -t1[j] * av[4 + j]; }
              *(GAS u32x4*)(P.SCH + SH_BB * SC_STRIDE + o) = pack8(t0, t1);
              *(GAS f32x4*)(P.SC + o) = (f32x4){dec[0], dec[1], dec[2], dec[3]}; *(GAS f32x4*)(P.SC + o + 4) = (f32x4){dec[4], dec[5], dec[6], dec[7]};
              *(GAS u32x4*)(P.SCH + SH_K * SC_STRIDE + o) = pack8((f32x4){kn[0], kn[1], kn[2], kn[3]}, (f32x4){kn[4], kn[5], kn[6], kn[7]});
              *(GAS u32x4*)(P.SCH + SH_R * SC_STRIDE + o) = pack8((f32x4){rr[0], rr[1], rr[2], rr[3]}, (f32x4){rr[4], rr[5], rr[6], rr[7]});
              *(GAS u32x4*)(P.SCH + SH_V * SC_STRIDE + o) = pack8((f32x4){vv[0], vv[1], vv[2], vv[3]}, (f32x4){vv[4], vv[5], vv[6], vv[7]});
              *(GAS u32x4*)(P.G + o) = pack8((f32x4){gv[0], gv[1], gv[2], gv[3]}, (f32x4){gv[4], gv[5], gv[6], gv[7]});
              if (ec8 == 0) P.BONUS[(size_t)em * NH + h] = bon; }
            __syncthreads();
        }
#undef P2_PREF_M
#undef P2_PREF_E
        VM_WAIT(); __builtin_amdgcn_fence(__ATOMIC_ACQUIRE, "agent"); VM_WAIT(); __syncthreads();
        p4a_chunk_prep(P, ws, lds, tid, wave, lane, u);
    }
}

template <int N> __device__ __forceinline__ float dpp_shr1(float x) { return __builtin_bit_cast(float, __builtin_amdgcn_update_dpp(0x3f800000, __builtin_bit_cast(int, x), 0x110 + N, 0xf, 0xf, false)); }
__device__ __forceinline__ float sum_fq(float x) {
    auto s = __builtin_amdgcn_permlane16_swap(__float_as_uint(x), __float_as_uint(x), false, false); x = __uint_as_float(s[0]) + __uint_as_float(s[1]);
    auto t = __builtin_amdgcn_permlane32_swap(__float_as_uint(x), __float_as_uint(x), false, false); return __uint_as_float(t[0]) + __uint_as_float(t[1]);
}
__device__ __forceinline__ u32x2 pack4(float a, float b, float c, float d) { u32x2 w; w.x = pk2(a, b); w.y = pk2(c, d); return w; }
__device__ __forceinline__ void p2_fused(const Ptrs& P, unsigned char* ws, LAS unsigned char* lds, int tid, int wave, int lane) {
    constexpr int AWP = 144, AGP = 336;
    LAS unsigned char* AW = lds; LAS unsigned char* AA = lds + 4608; LAS unsigned char* AG = lds + 9216;
    LAS unsigned char* wl = lds + 20480 + wave * 15872;
    LAS unsigned char* AH = wl, *BH = wl + 2048, *KH = wl + 4096, *RH = wl + 6144;
    LAS unsigned char* AT = wl + 8192, *RT = wl + 10240, *VTl = wl + 12288;
    LAS unsigned char* MX = wl + 14336;
    LAS unsigned char* WTl = wl, *U0Tl = wl + 2048, *PT = wl + 8192; LAS float* LmT = (LAS float*)(wl + 4096);
    const int lane0 = lane, fr0 = lane & 15, fq0 = lane >> 4;
    unsigned char* s1 = ws + WS_S1;
    for (int u = blockIdx.x; u < T / 64; u += gridDim.x) {
#pragma unroll 1
      for (int half = 0; half < 2; ++half) {
        const int m0 = u * 64 + half * 32;
        __syncthreads();
        for (int item = tid; item < 32 * 36; item += NTHREADS) { const int tk = item / 36, c8 = item - tk * 36, m = m0 + tk, col0 = 3072 + 8 * c8;
            const u32x4 pw = *(const GAS u32x4*)(P.ZP + (size_t)m * ZPW + col0); u32x4 qw = {0u, 0u, 0u, 0u}; if (m % SEQ) qw = *(const GAS u32x4*)(P.ZP + (size_t)(m - 1) * ZPW + col0);
            f32x4 p0, p1, q0, q1; unpack8(pw, p0, p1); unpack8(qw, q0, q1);
            const f32x4 mu0 = *(const GAS f32x4*)(P.shift_mu + col0), mu1 = *(const GAS f32x4*)(P.shift_mu + col0 + 4);
            f32x4 z0 = p0 + (q0 - p0) * mu0, z1 = p1 + (q1 - p1) * mu1;
            if (c8 < 8) {
#pragma unroll
                for (int j = 0; j < 4; ++j) { z0[j] = tanhf(z0[j]); z1[j] = tanhf(z1[j]); }
                *(LAS u32x4*)(AW + tk * AWP + c8 * 16) = pack8(z0, z1);
            } else if (c8 < 16) { *(LAS u32x4*)(AA + tk * AWP + (c8 - 8) * 16) = pack8(z0, z1);
            } else {
#pragma unroll
                for (int j = 0; j < 4; ++j) { z0[j] = sigmoidf_(z0[j]); z1[j] = sigmoidf_(z1[j]); }
                *(LAS u32x4*)(AG + tk * AGP + (c8 - 16) * 16) = pack8(z0, z1); } }
        __syncthreads();
        const int tloc = wave >> 2;
        const int mbase = m0 + tloc * 16, bb_ = mbase / SEQ, c16 = (mbase % SEQ) >> 4;
#pragma unroll 1
        for (int hh = 0; hh < 4; ++hh) {
            int fr = fr0, fq = fq0, lane = lane0; asm volatile("" : "+v"(fr), "+v"(fq), "+v"(lane));
            const int fq1 = fq & 1, m = mbase + fr; const bool hasp = (m % SEQ) != 0;
            const int h = (wave & 3) * 4 + hh, uidx = ((bb_ * 16 + h) << 8) + c16;
            f32x4 accw[4], acca[4], accg[4];
#pragma unroll
            for (int ct = 0; ct < 4; ++ct) { accw[ct] = (f32x4){0.f, 0.f, 0.f, 0.f}; acca[ct] = accw[ct]; accg[ct] = accw[ct]; const int chrow = h * 64 + ct * 16 + fr;
#pragma unroll
                for (int ks = 0; ks < 2; ++ks) { const bf16x8 wf = *(const GAS bf16x8*)(P.LW + (size_t)chrow * 64 + ks * 32 + 8 * fq), af = *(const GAS bf16x8*)(P.LA + (size_t)chrow * 64 + ks * 32 + 8 * fq);
                    accw[ct] = mfma16(wf, *(const LAS bf16x8*)(AW + (tloc * 16 + fr) * AWP + (ks * 32 + 8 * fq) * 2), accw[ct]);
                    acca[ct] = mfma16(af, *(const LAS bf16x8*)(AA + (tloc * 16 + fr) * AWP + (ks * 32 + 8 * fq) * 2), acca[ct]); }
#pragma unroll
                for (int ks = 0; ks < 5; ++ks) { const bf16x8 gf = *(const GAS bf16x8*)(P.LG + (size_t)chrow * 160 + ks * 32 + 8 * fq);
                    accg[ct] = mfma16(gf, *(const LAS bf16x8*)(AG + (tloc * 16 + fr) * AGP + (ks * 32 + 8 * fq) * 2), accg[ct]); } }
            float dec[16], aa[16], kkp[16], kn[16], rr[16]; float ss = 0.f, bon = 0.f;
#pragma unroll
            for (int ct = 0; ct < 4; ++ct) { const int c0 = h * 64 + 16 * ct + 4 * fq; const bf16* zp = P.ZP + (size_t)m * ZPW + c0;
                float cur[3][4], prv[3][4], v4[4];
#pragma unroll
                for (int sg = 0; sg < 3; ++sg) { const u32x2 pw = *(const GAS u32x2*)(zp + sg * 1024); u32x2 qw = {0u, 0u}; if (hasp) qw = *(const GAS u32x2*)(zp - ZPW + sg * 1024);
                    cur[sg][0] = bflo(pw.x); cur[sg][1] = bfhi(pw.x); cur[sg][2] = bflo(pw.y); cur[sg][3] = bfhi(pw.y); prv[sg][0] = bflo(qw.x); prv[sg][1] = bfhi(qw.x); prv[sg][2] = bflo(qw.y); prv[sg][3] = bfhi(qw.y); }
                const f32x4 mur = *(const GAS f32x4*)(P.shift_mu + c0), muk = *(const GAS f32x4*)(P.shift_mu + 1024 + c0), muv = *(const GAS f32x4*)(P.shift_mu + 2048 + c0);
                const f32x4 w0v = *(const GAS f32x4*)(P.w0 + c0), a0v = *(const GAS f32x4*)(P.a0 + c0), kkv = *(const GAS f32x4*)(P.k_k + c0), kav = *(const GAS f32x4*)(P.k_a + c0), rkv = *(const GAS f32x4*)(P.r_k + c0);
#pragma unroll
                for (int rg = 0; rg < 4; ++rg) { const int i = ct * 4 + rg;
                    const float r = cur[0][rg] + (prv[0][rg] - cur[0][rg]) * mur[rg], k = cur[1][rg] + (prv[1][rg] - cur[1][rg]) * muk[rg], v = cur[2][rg] + (prv[2][rg] - cur[2][rg]) * muv[rg];
                    dec[i] = __expf(-0.6065306597126334f * sigmoidf_(w0v[rg] + accw[ct][rg])); aa[i] = sigmoidf_(a0v[rg] + acca[ct][rg]);
                    kkp[i] = k * kkv[rg]; ss += kkp[i] * kkp[i]; kn[i] = k * (1.0f + (aa[i] - 1.0f) * kav[rg]); bon += r * kn[i] * rkv[rg]; rr[i] = r; v4[rg] = v;
                    *(LAS unsigned short*)(VTl + (16 * ct + 4 * fq + rg) * 32 + fr * 2) = (unsigned short)f2bf(v); }
                *(GAS u32x2*)(P.G + (size_t)m * RW + c0) = pack4(accg[ct][0], accg[ct][1], accg[ct][2], accg[ct][3]);
                *(GAS u32x2*)(P.SCH + SH_V * SC_STRIDE + (size_t)m * RW + c0) = pack4(v4[0], v4[1], v4[2], v4[3]); }
            ss = sum_fq(ss); bon = sum_fq(bon);
            const float rn = 1.0f / fmaxf(sqrtf(ss), 1e-12f);
            if (fq == 0) P.BONUS[(size_t)m * NH + h] = bon;
            asm volatile("" : "+v"(fr), "+v"(fq), "+v"(lane));
            bf16* gbt = (bf16*)(s1 + S1_BT) + (size_t)uidx * 1024 + fr; bf16* gkt = (bf16*)(s1 + S1_KT) + (size_t)uidx * 1024 + fr;
#pragma unroll
            for (int ct = 0; ct < 4; ++ct) { float a4[4], b4[4], k4[4], r4[4], g15[4];
#pragma unroll
                for (int rg = 0; rg < 4; ++rg) { const int i = ct * 4 + rg;
                    float g = dec[i]; g *= dpp_shr1<1>(g); g *= dpp_shr1<2>(g); g *= dpp_shr1<4>(g); g *= dpp_shr1<8>(g);
                    const float gp = dpp_shr1<1>(g), gl = __shfl(g, (lane & 48) | 15), inv = 1.0f / g;
                    const float kkn = -kkp[i] * rn, bbv = -kkn * aa[i];
                    a4[rg] = kkn * gp; b4[rg] = bbv * inv; k4[rg] = kn[i] * inv; r4[rg] = rr[i] * g; g15[rg] = gl;
                    const int kx = 16 * ct + 4 * fq + rg;
                    gbt[kx * 16] = (bf16)f2bf(b4[rg] * gl); gkt[kx * 16] = (bf16)f2bf(k4[rg] * gl);
                    *(LAS unsigned short*)(AT + kx * 32 + fr * 2) = (unsigned short)f2bf(a4[rg]); *(LAS unsigned short*)(RT + kx * 32 + fr * 2) = (unsigned short)f2bf(r4[rg]); }
                const int o = fr * 128 + (16 * ct + 4 * fq) * 2;
                *(LAS u32x2*)(AH + o) = pack4(a4[0], a4[1], a4[2], a4[3]); *(LAS u32x2*)(BH + o) = pack4(b4[0], b4[1], b4[2], b4[3]);
                *(LAS u32x2*)(KH + o) = pack4(k4[0], k4[1], k4[2], k4[3]); *(LAS u32x2*)(RH + o) = pack4(r4[0], r4[1], r4[2], r4[3]);
                if (fr == 0) *(GAS f32x4*)(s1 + S1_GAM + ((size_t)uidx * 64 + 16 * ct + 4 * fq) * 4) = (f32x4){g15[0], g15[1], g15[2], g15[3]}; }
            LDS_WAIT(); asm volatile("" ::: "memory");
            { GAS u32x4* gv = (GAS u32x4*)(s1 + S1_VT + ((size_t)uidx * 64 + lane) * 32); gv[0] = *(const LAS u32x4*)(VTl + lane * 32); gv[1] = *(const LAS u32x4*)(VTl + lane * 32 + 16); }
        asm volatile("" : "+v"(fr), "+v"(fq), "+v"(lane));
        f32x4 lab = {0.f, 0.f, 0.f, 0.f}, lak = lab, mrb = lab, mrk = lab;
#pragma unroll
        for (int ks = 0; ks < 2; ++ks) { const int off = fr * 128 + (32 * ks + 8 * fq) * 2;
            const bf16x8 a = *(const LAS bf16x8*)(AH + off), r_ = *(const LAS bf16x8*)(RH + off), b_ = *(const LAS bf16x8*)(BH + off), k_ = *(const LAS bf16x8*)(KH + off);
            lab = mfma16(a, b_, lab); lak = mfma16(a, k_, lak); mrb = mfma16(r_, b_, mrb); mrk = mfma16(r_, k_, mrk); }
#pragma unroll
        for (int rg = 0; rg < 4; ++rg) { const int t = 4 * fq + rg; const bool lo = fr < t, le = fr <= t; lab[rg] = lo ? lab[rg] : 0.f; lak[rg] = lo ? lak[rg] : 0.f; mrb[rg] = le ? mrb[rg] : 0.f; mrk[rg] = le ? mrk[rg] : 0.f; }
        asm volatile("" ::: "memory");
        *(LAS f32x4*)(LmT + fr * 16 + 4 * fq) = lab;
#pragma unroll
        for (int rg = 0; rg < 4; ++rg) { const int o = ((4 * fq + rg) * 16 + fr) * 2;
            *(LAS unsigned short*)(MX + o) = (unsigned short)f2bf(lak[rg]); *(LAS unsigned short*)(MX + 512 + o) = (unsigned short)f2bf(mrb[rg]); *(LAS unsigned short*)(MX + 1024 + o) = (unsigned short)f2bf(mrk[rg]); }
        LDS_WAIT(); asm volatile("" ::: "memory");
        float Tr[16];
#pragma unroll
        for (int m = 0; m < 16; ++m) Tr[m] = (m == fr) ? 1.0f : 0.0f;
#pragma unroll
        for (int j = 14; j >= 0; --j) { float acc = (j == fr) ? 1.0f : 0.0f;
#pragma unroll
            for (int q = 0; q < 4; ++q) { const f32x4 l4 = *(const LAS f32x4*)(LmT + j * 16 + 4 * q);
#pragma unroll
                for (int e = 0; e < 4; ++e) { const int m = 4 * q + e; if (m > j) acc += Tr[m] * l4[e]; } }
            Tr[j] = acc; }
        bf16x8 tfrag;
        { float sel[8];
#pragma unroll
          for (int j = 0; j < 8; ++j) sel[j] = (fq == 0) ? Tr[j] : ((fq == 1) ? Tr[8 + j] : 0.0f);
          tfrag = __builtin_bit_cast(bf16x8, pack8s(sel)); }
        f32x4 wacc[4];
#pragma unroll
        for (int nt = 0; nt < 4; ++nt) wacc[nt] = mfma16(tfrag, *(const LAS bf16x8*)(AT + (16 * nt + fr) * 32 + fq1 * 16), (f32x4){0.f, 0.f, 0.f, 0.f});
        asm volatile("" ::: "memory");
        { bf16* gwh = (bf16*)(s1 + S1_WH) + (size_t)uidx * 1024;
#pragma unroll
          for (int nt = 0; nt < 4; ++nt) { u32x2 w2; w2.x = pk2(wacc[nt][0], wacc[nt][1]); w2.y = pk2(wacc[nt][2], wacc[nt][3]); *(LAS u32x2*)(WTl + ((16 * nt + fr) * 16 + 4 * fq) * 2) = w2;
#pragma unroll
              for (int rg = 0; rg < 4; ++rg) gwh[(4 * fq + rg) * 64 + 16 * nt + fr] = (bf16)f2bf(wacc[nt][rg]); } }
        asm volatile("" : "+v"(fr), "+v"(fq), "+v"(lane));
        bf16x8 lkf, mbf, mkf, idf;
        { const u32x4 z4 = {0u, 0u, 0u, 0u};
          const u32x4 lk4 = *(const LAS u32x4*)(MX + (fr * 16 + 8 * fq1) * 2), mb4 = *(const LAS u32x4*)(MX + 512 + (fr * 16 + 8 * fq1) * 2), mk4 = *(const LAS u32x4*)(MX + 1024 + (fr * 16 + 8 * fq1) * 2);
          lkf = __builtin_bit_cast(bf16x8, (fq < 2) ? lk4 : z4);
          mbf = __builtin_bit_cast(bf16x8, mb4);
          mkf = __builtin_bit_cast(bf16x8, mk4);
          u32x4 id4; const int d = fr - 8 * fq1;
          id4.x = (d == 0 ? 0x3f80u : 0u) | (d == 1 ? 0x3f800000u : 0u); id4.y = (d == 2 ? 0x3f80u : 0u) | (d == 3 ? 0x3f800000u : 0u);
          id4.z = (d == 4 ? 0x3f80u : 0u) | (d == 5 ? 0x3f800000u : 0u); id4.w = (d == 6 ? 0x3f80u : 0u) | (d == 7 ? 0x3f800000u : 0u);
          idf = __builtin_bit_cast(bf16x8, id4); }
        LDS_WAIT(); asm volatile("" ::: "memory");
        f32x4 pacc[4];
#pragma unroll
        for (int nt = 0; nt < 4; ++nt) pacc[nt] = mfma16(lkf, *(const LAS bf16x8*)(VTl + (16 * nt + fr) * 32 + fq1 * 16), (f32x4){0.f, 0.f, 0.f, 0.f});
        asm volatile("" ::: "memory");
#pragma unroll
        for (int nt = 0; nt < 4; ++nt) { u32x2 w2; w2.x = pk2(pacc[nt][0], pacc[nt][1]); w2.y = pk2(pacc[nt][2], pacc[nt][3]); *(LAS u32x2*)(PT + ((16 * nt + fr) * 16 + 4 * fq) * 2) = w2; }
        LDS_WAIT(); asm volatile("" ::: "memory");
        f32x4 uacc[4];
#pragma unroll
        for (int nt = 0; nt < 4; ++nt) uacc[nt] = mfma16(tfrag, *(const LAS bf16x8*)(PT + (16 * nt + fr) * 32 + fq1 * 16), (f32x4){0.f, 0.f, 0.f, 0.f});
        asm volatile("" ::: "memory");
#pragma unroll
        for (int nt = 0; nt < 4; ++nt) { u32x2 w2; w2.x = pk2(uacc[nt][0], uacc[nt][1]); w2.y = pk2(uacc[nt][2], uacc[nt][3]); *(LAS u32x2*)(U0Tl + ((16 * nt + fr) * 16 + 4 * fq) * 2) = w2;
            *(GAS f32x4*)(s1 + S1_U0T + (((size_t)uidx * 64 + 16 * nt + fr) * 16 + 4 * fq) * 4) = uacc[nt]; }
        LDS_WAIT(); asm volatile("" ::: "memory");
        { const bf16x8 aq = (fq < 2) ? mbf : idf, ay = (fq < 2) ? mbf : mkf;
          bf16* gqh = (bf16*)(s1 + S1_QH) + (size_t)uidx * 1024;
#pragma unroll
          for (int nt = 0; nt < 4; ++nt) { const int row = 16 * nt + fr;
              const bf16x8 bq = *(const LAS bf16x8*)(((fq < 2) ? WTl : RT) + row * 32 + fq1 * 16), by = *(const LAS bf16x8*)(((fq < 2) ? U0Tl : VTl) + row * 32 + fq1 * 16);
              const f32x4 qa = mfma16(aq, bq, (f32x4){0.f, 0.f, 0.f, 0.f}), ya = mfma16(ay, by, (f32x4){0.f, 0.f, 0.f, 0.f});
#pragma unroll
              for (int rg = 0; rg < 4; ++rg) gqh[(4 * fq + rg) * 64 + row] = (bf16)f2bf(qa[rg]);
              *(GAS f32x4*)(s1 + S1_Y0T + (((size_t)uidx * 64 + row) * 16 + 4 * fq) * 4) = ya; } }
        LDS_WAIT(); asm volatile("" ::: "memory");
        }
      }
    }
}

__device__ __forceinline__ void p3_attention(const Ptrs& P, LAS unsigned char* lds, int tid, int wave, int lane) {
    const int fr = lane & 15, fq = lane >> 4;
    LAS unsigned char* Ks = lds; LAS unsigned char* Vt = lds + 34816;
    for (int u = blockIdx.x; u < NB * 12 * 32; u += gridDim.x) {
        const int b = u / 384, r = u - b * 384, gh = r >> 5, idx = r & 31, g = gh >> 2;
        const int d = (g == 0) ? 1 : ((g == 1) ? 4 : 16), nb = 32 / d, c = idx / nb, n = idx - c * nb;
        const int qi = wave * 16 + fr; const size_t mq = (size_t)b * SEQ + (size_t)(n * 128 + qi) * d + c;
        const bf16* qrow = P.QKV + mq * QKVW + gh * 128;
        bf16x8 qf[4];
#pragma unroll
        for (int ks = 0; ks < 4; ++ks) qf[ks] = *(const GAS bf16x8*)(qrow + 32 * ks + 8 * fq);
        f32x4 o[8];
#pragma unroll
        for (int dt = 0; dt < 8; ++dt) o[dt] = (f32x4){0.f, 0.f, 0.f, 0.f};
        float mrun = -1e30f, lrun = 0.f;
        for (int kb = (n == 0) ? 1 : 0; kb < 2; ++kb) {
            const int kblk = n - 1 + kb;
            __syncthreads();
#pragma unroll
            for (int i = 0; i < 4; ++i) { const int p = tid + 512 * i, key = p >> 4, part = p & 15; const size_t mk = (size_t)b * SEQ + (size_t)(kblk * 128 + key) * d + c;
                *(LAS u32x4*)(Ks + key * 272 + part * 16) = *(const GAS u32x4*)(P.QKV + mk * QKVW + 1536 + gh * 128 + part * 8); }
#pragma unroll
            for (int i = 0; i < 4; ++i) { const int key = tid & 127, part = (tid >> 7) + 4 * i; const size_t mk = (size_t)b * SEQ + (size_t)(kblk * 128 + key) * d + c;
                const u32x4 v = *(const GAS u32x4*)(P.QKV + mk * QKVW + 3072 + gh * 128 + part * 8);
                LAS unsigned char* vp = Vt + (8 * part) * 272 + key * 2;
                *(LAS unsigned short*)(vp + 0 * 272) = (unsigned short)(v.x & 0xffffu); *(LAS unsigned short*)(vp + 1 * 272) = (unsigned short)(v.x >> 16);
                *(LAS unsigned short*)(vp + 2 * 272) = (unsigned short)(v.y & 0xffffu); *(LAS unsigned short*)(vp + 3 * 272) = (unsigned short)(v.y >> 16);
                *(LAS unsigned short*)(vp + 4 * 272) = (unsigned short)(v.z & 0xffffu); *(LAS unsigned short*)(vp + 5 * 272) = (unsigned short)(v.z >> 16);
                *(LAS unsigned short*)(vp + 6 * 272) = (unsigned short)(v.w & 0xffffu); *(LAS unsigned short*)(vp + 7 * 272) = (unsigned short)(v.w >> 16); }
            __syncthreads();
            f32x4 s[8];
#pragma unroll
            for (int kt = 0; kt < 8; ++kt) { s[kt] = (f32x4){0.f, 0.f, 0.f, 0.f};
#pragma unroll
                for (int ks = 0; ks < 4; ++ks) { const bf16x8 a = *(const LAS bf16x8*)(Ks + (kt * 16 + fr) * 272 + (32 * ks + 8 * fq) * 2); s[kt] = mfma16(a, qf[ks], s[kt]); } }
            float mx = -1e30f;
#pragma unroll
            for (int kt = 0; kt < 8; ++kt)
#pragma unroll
                for (int rg = 0; rg < 4; ++rg) { const int j = kt * 16 + 4 * fq + rg; const bool ok = (kb == 0) ? (j >= qi) : (j <= qi); const float sv = ok ? s[kt][rg] : -1e30f; s[kt][rg] = sv; mx = fmaxf(mx, sv); }
            mx = fmaxf(mx, __shfl_xor(mx, 16)); mx = fmaxf(mx, __shfl_xor(mx, 32));
            const float mnew = fmaxf(mrun, mx), alpha = exp2f(mrun - mnew); mrun = mnew;
            float ls = 0.f;
#pragma unroll
            for (int kt = 0; kt < 8; ++kt)
#pragma unroll
                for (int rg = 0; rg < 4; ++rg) { const float p = exp2f(s[kt][rg] - mnew); s[kt][rg] = p; ls += p; }
            lrun = lrun * alpha + ls;
#pragma unroll
            for (int dt = 0; dt < 8; ++dt) o[dt] = o[dt] * alpha;
#pragma unroll
            for (int pi = 0; pi < 4; ++pi) {
                const u32x4 bw = pack8(s[2 * pi], s[2 * pi + 1]); const bf16x8 bfrag = __builtin_bit_cast(bf16x8, bw);
#pragma unroll
                for (int dt = 0; dt < 8; ++dt) { const LAS unsigned char* vp = Vt + (dt * 16 + fr) * 272 + (2 * pi * 16 + 4 * fq) * 2;
                    const u32x2 lo = *(const LAS u32x2*)vp, hi = *(const LAS u32x2*)(vp + 32);
                    const u32x4 aw = {lo.x, lo.y, hi.x, hi.y}; o[dt] = mfma16(__builtin_bit_cast(bf16x8, aw), bfrag, o[dt]); } }
        }
        lrun += __shfl_xor(lrun, 16); lrun += __shfl_xor(lrun, 32);
        bf16* orow = P.ATTO + (mq * 12 + gh) * 128;
#pragma unroll
        for (int dt = 0; dt < 8; ++dt) { u32x2 w; w.x = pk2(o[dt][0], o[dt][1]); w.y = pk2(o[dt][2], o[dt][3]); *(GAS u32x2*)(orow + dt * 16 + 4 * fq) = w; }
        if (fq == 0) { P.ATTML[(mq * 12 + gh) * 2] = mrun; P.ATTML[(mq * 12 + gh) * 2 + 1] = lrun; }
    }
}

struct S2Regs { u32x2 wf[4], qf[4], bt[4], kt[4], vt; f32x4 u0, y0, gm[4]; };
__device__ __forceinline__ void s2_load(S2Regs& R, const unsigned char* s1, size_t ui, int vg, int fr, int fq) {
    const unsigned char* wh = s1 + S1_WH + ui * 2048 + (fr * 64 + 4 * fq) * 2; const unsigned char* qh = s1 + S1_QH + ui * 2048 + (fr * 64 + 4 * fq) * 2;
#pragma unroll
    for (int ks = 0; ks < 2; ++ks) { R.wf[2 * ks] = *(const GAS u32x2*)(wh + ks * 64); R.wf[2 * ks + 1] = *(const GAS u32x2*)(wh + ks * 64 + 32); R.qf[2 * ks] = *(const GAS u32x2*)(qh + ks * 64); R.qf[2 * ks + 1] = *(const GAS u32x2*)(qh + ks * 64 + 32); }
#pragma unroll
    for (int mt = 0; mt < 4; ++mt) { R.bt[mt] = *(const GAS u32x2*)(s1 + S1_BT + ui * 2048 + ((16 * mt + fr) * 16 + 4 * fq) * 2); R.kt[mt] = *(const GAS u32x2*)(s1 + S1_KT + ui * 2048 + ((16 * mt + fr) * 16 + 4 * fq) * 2);
        R.gm[mt] = *(const GAS f32x4*)(s1 + S1_GAM + ui * 256 + (16 * mt + 4 * fq) * 4); }
    const size_t vr = ui * 64 + vg * 16 + fr;
    R.vt = *(const GAS u32x2*)(s1 + S1_VT + (vr * 16 + 4 * fq) * 2); R.u0 = *(const GAS f32x4*)(s1 + S1_U0T + (vr * 16 + 4 * fq) * 4); R.y0 = *(const GAS f32x4*)(s1 + S1_Y0T + (vr * 16 + 4 * fq) * 4);
}
__device__ __forceinline__ void s2_step(const S2Regs& R, f32x4 (&st4)[4], float* yp) {
    bf16x8 sf[2];
#pragma unroll
    for (int ks = 0; ks < 2; ++ks) sf[ks] = __builtin_bit_cast(bf16x8, pack8(st4[2 * ks], st4[2 * ks + 1]));
    f32x4 sa = R.u0, y = R.y0;
#pragma unroll
    for (int ks = 0; ks < 2; ++ks) { sa = mfma16(__builtin_bit_cast(bf16x8, (u32x4){R.wf[2 * ks].x, R.wf[2 * ks].y, R.wf[2 * ks + 1].x, R.wf[2 * ks + 1].y}), sf[ks], sa);
        y = mfma16(__builtin_bit_cast(bf16x8, (u32x4){R.qf[2 * ks].x, R.qf[2 * ks].y, R.qf[2 * ks + 1].x, R.qf[2 * ks + 1].y}), sf[ks], y); }
#pragma unroll
    for (int rg = 0; rg < 4; ++rg) yp[(size_t)rg * RW] = y[rg];
    const bf16x8 ub = __builtin_bit_cast(bf16x8, (u32x4){pk2(sa[0], sa[1]), pk2(sa[2], sa[3]), R.vt.x, R.vt.y});
#pragma unroll
    for (int mt = 0; mt < 4; ++mt) st4[mt] = mfma16(__builtin_bit_cast(bf16x8, (u32x4){R.bt[mt].x, R.bt[mt].y, R.kt[mt].x, R.kt[mt].y}), ub, st4[mt] * R.gm[mt]);
}
__device__ __forceinline__ void p4b_scan(const Ptrs& P, unsigned char* ws, LAS unsigned char* lds, int tid, int wave, int lane) {
    if (wave == 0) {
        const int fr = lane & 15, fq = lane >> 4;
        const unsigned char* s1 = ws + WS_S1;
        for (int unit = blockIdx.x; unit < 256; unit += gridDim.x) {
            const int bh = unit >> 2, vg = unit & 3, b = bh >> 4, h = bh & 15;
            const size_t u0idx = (size_t)bh * 256;
            f32x4 st4[4];
#pragma unroll
            for (int mt = 0; mt < 4; ++mt) st4[mt] = (f32x4){0.f, 0.f, 0.f, 0.f};
            float* yb = P.Y + ((size_t)b * SEQ + 4 * fq) * RW + h * 64 + vg * 16 + fr;
            S2Regs RA, RB;
            s2_load(RA, s1, u0idx, vg, fr, fq);
#pragma unroll 1
            for (int c = 0; c < 256; c += 2) {
                s2_load(RB, s1, u0idx + c + 1, vg, fr, fq);
                s2_step(RA, st4, yb + (size_t)(c * 16) * RW);
                s2_load(RA, s1, u0idx + ((c + 2 < 256) ? c + 2 : c), vg, fr, fq);
                s2_step(RB, st4, yb + (size_t)((c + 1) * 16) * RW);
            }
        }
    } else {
        LAS float* scr = (LAS float*)(lds + (wave - 1) * 16896);
        const int gw = blockIdx.x * (NWAVES - 1) + (wave - 1), NGW = gridDim.x * (NWAVES - 1);
        constexpr int I_W1 = NE * 16 * 128, I_W2 = NE * 16 * 64;
        for (int it = gw; it < I_W1 + I_W2; it += NGW) {
            int r = it;
            if (r < I_W1) { const int e = r >> 11, q = r & 2047, kb = q >> 7, nb = q & 127, c0 = 32 * nb;
                tr8_tile(P.w1 + (size_t)e * D * 4096, 4096, 128 * kb, c0, (unsigned char*)P.W1, (size_t)e * 4096 + ((c0 & 2047) >> 7) * 256 + (c0 >> 11) * 128 + (c0 & 127), D, 32.0f, scr, lane); continue; }
            r -= I_W1;
            { const int e = r >> 10, q = r & 1023, kb = q >> 6, nb = q & 63; tr8_tile(P.w2 + (size_t)e * FF * D, D, 128 * kb, 32 * nb, (unsigned char*)P.W2, (size_t)e * D + 32 * nb, FF, 32.0f, scr, lane); }
        }
    }
}

__device__ __forceinline__ float sum4q(float x) { x += dppf<0xB1>(x); x += dppf<0x4E>(x); return x; }
__device__ __forceinline__ void p5_post(const Ptrs& P, int tid, int wave, int lane) {
    const int gw = blockIdx.x * NWAVES + wave, NGW = gridDim.x * NWAVES;
    const int c0 = 16 * lane, head = lane >> 2;
    for (int m = gw; m < T; m += NGW) {
        const size_t o = (size_t)m * RW + c0;
        f32x4 y[4], v[4];
#pragma unroll
        for (int q = 0; q < 4; ++q) y[q] = *(const GAS f32x4*)(P.Y + o + 4 * q);
        { const u32x4 v0 = *(const GAS u32x4*)(P.SCH + SH_V * SC_STRIDE + o), v1 = *(const GAS u32x4*)(P.SCH + SH_V * SC_STRIDE + o + 8); unpack8(v0, v[0], v[1]); unpack8(v1, v[2], v[3]); }
        const u32x4 g0 = *(const GAS u32x4*)(P.G + o), g1 = *(const GAS u32x4*)(P.G + o + 8);
        const float bon = P.BONUS[(size_t)m * NH + head];
        const int hh = lane >> 4, d0 = (lane & 15) * 8; float mm[3], ll[3]; u32x4 ow[3];
#pragma unroll
        for (int g = 0; g < 3; ++g) { const size_t q = (size_t)m * 12 + g * 4 + hh; mm[g] = P.ATTML[q * 2]; ll[g] = P.ATTML[q * 2 + 1]; ow[g] = *(const GAS u32x4*)(P.ATTO + q * 128 + d0); }
        float s = 0.f;
#pragma unroll
        for (int q = 0; q < 4; ++q) s += (y[q].x + y[q].y) + (y[q].z + y[q].w);
        const float mean = sum4q(s) * (1.0f / 64.0f); float s2 = 0.f;
#pragma unroll
        for (int q = 0; q < 4; ++q) { y[q] = y[q] - mean; s2 += (y[q].x * y[q].x + y[q].y * y[q].y) + (y[q].z * y[q].z + y[q].w * y[q].w); }
        const float rstd = 1.0f / sqrtf(sum4q(s2) * (1.0f / 64.0f) + GN_EPS);
        f32x4 gq[4]; unpack8(g0, gq[0], gq[1]); unpack8(g1, gq[2], gq[3]);
#pragma unroll
        for (int q = 0; q < 4; ++q) { const f32x4 lw = *(const GAS f32x4*)(P.ln_x_w + c0 + 4 * q), lb = *(const GAS f32x4*)(P.ln_x_b + c0 + 4 * q); y[q] = ((y[q] * rstd) * lw + lb + v[q] * bon) * gq[q]; }
        *(GAS u32x4*)(P.YAIN + o) = pack8(y[0], y[1]); *(GAS u32x4*)(P.YAIN + o + 8) = pack8(y[2], y[3]);
        const float M = fmaxf(mm[0], fmaxf(mm[1], mm[2])); float den = 0.f; f32x4 n0 = {0.f, 0.f, 0.f, 0.f}, n1 = n0;
#pragma unroll
        for (int g = 0; g < 3; ++g) { const float wg = exp2f(mm[g] - M); den += wg * ll[g]; f32x4 a, b; unpack8(ow[g], a, b); n0 = n0 + a * wg; n1 = n1 + b * wg; }
        const float inv = 1.0f / den;
        *(GAS u32x4*)(P.OIN + (size_t)m * 512 + 8 * lane) = pack8(n0 * inv, n1 * inv);
    }
}

template <int CTRL> __device__ __forceinline__ int dppi(int x) { return __builtin_amdgcn_mov_dpp(x, CTRL, 0xf, 0xf, true); }
__device__ __forceinline__ float row16_max(float x) { x = fmaxf(x, dppf<0xB1>(x)); x = fmaxf(x, dppf<0x4E>(x)); x = fmaxf(x, dppf<0x141>(x)); x = fmaxf(x, dppf<0x140>(x)); return x; }
__device__ __forceinline__ int row16_min(int x) { x = min(x, dppi<0xB1>(x)); x = min(x, dppi<0x4E>(x)); x = min(x, dppi<0x141>(x)); x = min(x, dppi<0x140>(x)); return x; }
__device__ __forceinline__ void p8_router(const Ptrs& P, LAS unsigned char* lds, int tid, int wave, int lane, int cnt_base = CW_CNT) {
    LAS float* rsv = (LAS float*)lds;
    LAS float* part = (LAS float*)(lds + 1024);
    LAS int* picks = (LAS int*)(lds + 1024 + 8192); LAS int* pbase = picks + 256;
    const int fr = lane & 15, fq = lane >> 4;
    for (int grp = blockIdx.x; grp < T / 64; grp += gridDim.x) {
        const int mb = grp * 64;
        __syncthreads();
#pragma unroll 2
        for (int tk = 0; tk < 8; ++tk) { const int m = mb + wave * 8 + tk; const float* xr = P.X1 + (size_t)m * D; f32x4 v[8]; float s = 0.f;
#pragma unroll
            for (int j = 0; j < 8; ++j) { v[j] = *(const GAS f32x4*)(xr + 4 * lane + 256 * j); s += (v[j].x * v[j].x + v[j].y * v[j].y) + (v[j].z * v[j].z + v[j].w * v[j].w); }
            const float r = 1.0f / sqrtf(wave_sum(s) * (1.0f / D) + NORM_EPS); if (lane == 0) rsv[wave * 8 + tk] = r;
            unsigned char* hr = (unsigned char*)P.H + (size_t)m * D;
#pragma unroll
            for (int j = 0; j < 8; ++j) { const f32x4 gv = *(const GAS f32x4*)(P.norm_ffn + 4 * lane + 256 * j);
                *(GAS unsigned*)(hr + 4 * lane + 256 * j) = pk4_fp8(v[j].x * r * gv.x, v[j].y * r * gv.y, v[j].z * r * gv.z, v[j].w * r * gv.w); } }
        const int tt = wave & 3, kh = wave >> 2;
        f32x4 acc[2] = {{0.f, 0.f, 0.f, 0.f}, {0.f, 0.f, 0.f, 0.f}};
        { const float* xa = P.X1 + (size_t)(mb + tt * 16 + fr) * D + kh * 1024 + 8 * fq; const bf16* wh = P.WRH + (size_t)fr * D + kh * 1024 + 8 * fq; const bf16* wl = P.WRL + (size_t)fr * D + kh * 1024 + 8 * fq;
#pragma unroll 4
          for (int ks = 0; ks < 32; ++ks) { const f32x4 x0 = *(const GAS f32x4*)(xa + 32 * ks), x1 = *(const GAS f32x4*)(xa + 32 * ks + 4);
              float hi[8], lo[8];
#pragma unroll
              for (int j = 0; j < 4; ++j) { hi[j] = bf2f((bf16)f2bf(x0[j])); lo[j] = x0[j] - hi[j]; hi[4 + j] = bf2f((bf16)f2bf(x1[j])); lo[4 + j] = x1[j] - hi[4 + j]; }
              const bf16x8 ah = __builtin_bit_cast(bf16x8, pack8s(hi)), al = __builtin_bit_cast(bf16x8, pack8s(lo));
#pragma unroll
              for (int nt = 0; nt < 2; ++nt) { const bf16x8 bh = *(const GAS bf16x8*)(wh + (size_t)nt * 16 * D + 32 * ks), bl = *(const GAS bf16x8*)(wl + (size_t)nt * 16 * D + 32 * ks);
                  acc[nt] = mfma16(ah, bh, acc[nt]); acc[nt] = mfma16(al, bh, acc[nt]); acc[nt] = mfma16(ah, bl, acc[nt]); } } }
        if (kh == 1) { *(LAS f32x4*)(part + ((tt * 2 + 0) * 64 + lane) * 4) = acc[0]; *(LAS f32x4*)(part + ((tt * 2 + 1) * 64 + lane) * 4) = acc[1]; }
        __syncthreads();
        if (kh == 0) {
            acc[0] = acc[0] + *(const LAS f32x4*)(part + ((tt * 2 + 0) * 64 + lane) * 4); acc[1] = acc[1] + *(const LAS f32x4*)(part + ((tt * 2 + 1) * 64 + lane) * 4);
            const float b0 = P.b_router[fr], b1 = P.b_router[16 + fr];
#pragma unroll
            for (int rg = 0; rg < 4; ++rg) { const int tl = tt * 16 + 4 * fq + rg; const float r = rsv[tl];
                float v0 = acc[0][rg] * r + b0, v1 = acc[1][rg] * r + b1; int sel[4]; float val[4];
#pragma unroll
                for (int k = 0; k < 4; ++k) { const float mx = row16_max(fmaxf(v0, v1)); const int cand = (v0 == mx) ? fr : ((v1 == mx) ? 16 + fr : 99); const int s_ = row16_min(cand);
                    sel[k] = s_; val[k] = mx; v0 = (s_ == fr) ? -3.0e38f : v0; v1 = (s_ == 16 + fr) ? -3.0e38f : v1; }
                const float e1 = __expf(val[1] - val[0]), e2 = __expf(val[2] - val[0]), e3 = __expf(val[3] - val[0]); const float inv = 1.0f / (1.0f + e1 + e2 + e3);
                const float gate[4] = {inv, e1 * inv, e2 * inv, e3 * inv};
                if (fr == 0) { const int m = mb + tl;
#pragma unroll
                    for (int k = 0; k < 4; ++k) { picks[tl * 4 + k] = sel[k]; P.TOPK_E[m * 4 + k] = sel[k]; P.TOPK_GATE[m * 4 + k] = gate[k]; } } }
        }
        __syncthreads();
        if (tid < 32) { int cnt = 0;
            for (int j = 0; j < 256; ++j) cnt += (picks[j] == tid) ? 1 : 0;
            pbase[tid] = (int)__hip_atomic_fetch_add((unsigned*)(P.ctl + cnt_base + 64 * tid), (unsigned)cnt, RLX_AGENT); }
        __syncthreads();
        if (tid < 256) { const int mine = picks[tid]; int rank = 0;
            for (int j = 0; j < tid; ++j) rank += (picks[j] == mine) ? 1 : 0;
            P.TOPK_POS[mb * 4 + tid] = pbase[mine] + rank; }
    }
}

__device__ __forceinline__ void moe_tables(const Ptrs& P, LAS int* tab, int tid) {
    if (tid == 0) { int acc = 0;
        for (int e = 0; e < NE; ++e) { tab[e] = acc; const int c = (int)__hip_atomic_load((unsigned*)(P.ctl + CW_CNT + 64 * e), RLX_AGENT); acc += (c + 255) >> 8; tab[64 + e] = c; }
        tab[32] = acc; }
    __syncthreads();
}

__device__ __forceinline__ void p9_gather(const Ptrs& P, LAS unsigned char* lds, int tid, int wave, int lane) {
    LAS int* tab = (LAS int*)(lds + TAB_OFF);
    moe_tables(P, tab, tid);
    const int gw = blockIdx.x * NWAVES + wave, NGW = gridDim.x * NWAVES;
    for (int p = gw; p < T * 4; p += NGW) { const int e = P.TOPK_E[p], pos = P.TOPK_POS[p]; const int row = tab[e] * 256 + pos;
        const GAS u32x4* src = (const GAS u32x4*)((const unsigned char*)P.H + (size_t)(p >> 2) * D); GAS u32x4* dst = (GAS u32x4*)((unsigned char*)P.XS + (size_t)row * D);
#pragma unroll
        for (int i = 0; i < 2; ++i) dst[lane + 64 * i] = src[lane + 64 * i];
        if (lane == 0) { P.ROWTOK[row] = p; P.ROWGATE[row] = P.TOPK_GATE[p]; } }
    for (int e = blockIdx.x; e < NE; e += gridDim.x) { const int cnt = tab[64 + e], r0 = tab[e] * 256, rend = tab[e + 1] * 256;
        for (int r = r0 + cnt + tid; r < rend; r += NTHREADS) { P.ROWTOK[r] = -1; P.ROWGATE[r] = 0.f; } }
}

__device__ __forceinline__ void p12_final(const Ptrs& P, int tid, int wave, int lane) {
    const int gw = blockIdx.x * NWAVES + wave, NGW = gridDim.x * NWAVES;
    for (int m = gw; m < T; m += NGW) {
        f32x4 v[8]; float s = 0.f;
#pragma unroll
        for (int j = 0; j < 8; ++j) { const int col = 4 * lane + 256 * j; v[j] = *(const GAS f32x4*)(P.X1 + (size_t)m * D + col);
#pragma unroll
            for (int k = 0; k < 4; ++k) { const u32x2 w = *(const GAS u32x2*)(P.OUTK + ((size_t)m * 4 + k) * D + col); v[j].x += bflo(w.x); v[j].y += bfhi(w.x); v[j].z += bflo(w.y); v[j].w += bfhi(w.y); }
            s += (v[j].x * v[j].x + v[j].y * v[j].y) + (v[j].z * v[j].z + v[j].w * v[j].w); }
        const float rs = 1.0f / sqrtf(wave_sum(s) * (1.0f / D) + NORM_EPS);
#pragma unroll
        for (int j = 0; j < 8; ++j) { const int col = 4 * lane + 256 * j; const f32x4 g = *(const GAS f32x4*)(P.norm_final + col); *(GAS f32x4*)(P.out + (size_t)m * D + col) = v[j] * rs * g; }
    }
}

struct Args { const void* in[26]; float* out; unsigned char* ws; int ph_lo, ph_hi; };
__global__ void __launch_bounds__(NTHREADS, 2) fwd(Args args) {
    extern __shared__ __attribute__((aligned(16))) unsigned char lds_raw[];
    LAS unsigned char* lds = (LAS unsigned char*)lds_raw;
    const int tid = threadIdx.x, lane = tid & 63, wave = __builtin_amdgcn_readfirstlane(tid >> 6);
    unsigned char* ws = args.ws;
    Ptrs P;
    P.x = (const float*)args.in[0]; P.positions = (const int*)args.in[1]; P.norm_mix = (const float*)args.in[2]; P.w_in = (const float*)args.in[3]; P.shift_mu = (const float*)args.in[4];
    P.w0 = (const float*)args.in[5]; P.w2_decay = (const float*)args.in[6]; P.a0 = (const float*)args.in[7]; P.a2_iclr = (const float*)args.in[8]; P.g2_gate = (const float*)args.in[9];
    P.k_k = (const float*)args.in[10]; P.k_a = (const float*)args.in[11]; P.r_k = (const float*)args.in[12]; P.ln_x_w = (const float*)args.in[13]; P.ln_x_b = (const float*)args.in[14];
    P.w_o_rwkv = (const float*)args.in[15]; P.w_o_attn = (const float*)args.in[16]; P.w_out = (const float*)args.in[17]; P.norm_ffn = (const float*)args.in[18]; P.w_router = (const float*)args.in[19];
    P.b_router = (const float*)args.in[20]; P.w1 = (const float*)args.in[21]; P.b1 = (const float*)args.in[22]; P.w2 = (const float*)args.in[23]; P.b2 = (const float*)args.in[24]; P.norm_final = (const float*)args.in[25];
    P.out = args.out; P.ctl = (gu32*)(ws + WS_CTL);
    P.WIN = (bf16*)(ws + WS_WIN); P.W1 = (bf16*)(ws + WS_W1); P.W2 = (bf16*)(ws + WS_W2); P.WOR = (bf16*)(ws + WS_WOR); P.WOA = (bf16*)(ws + WS_WOA); P.WOUT = (bf16*)(ws + WS_WOUT);
    P.H = (bf16*)(ws + WS_H); P.ZP = (bf16*)(ws + WS_ZP); P.QKV = (bf16*)(ws + WS_QKV); P.GATES = (bf16*)(ws + WS_GATES); P.ROT = (float*)(ws + WS_ROT); P.SC = (float*)(ws + WS_SC); P.SCH = (bf16*)(ws + WS_SC + 64 * MiB);
    P.G = (bf16*)(ws + WS_G); P.BONUS = (float*)(ws + WS_BONUS); P.Y = (float*)(ws + WS_Y); P.ATTO = (bf16*)(ws + WS_ATTO); P.ATTML = (float*)(ws + WS_ATTML); P.YAIN = (bf16*)(ws + WS_YAIN);
    P.OIN = (bf16*)(ws + WS_OIN); P.MERGED = (bf16*)(ws + WS_MERGED); P.X1 = (float*)(ws + WS_X1);
    P.TOPK_E = (int*)(ws + WS_TOPK); P.TOPK_POS = P.TOPK_E + T * 4; P.TOPK_GATE = (float*)(P.TOPK_POS + T * 4);
    P.ROWTOK = (int*)(ws + WS_ROWS); P.ROWGATE = (float*)(P.ROWTOK + XS_ROWS);
    P.LW = (bf16*)(ws + WS_LORA); P.LA = P.LW + 1024 * 64; P.LG = P.LA + 1024 * 64; P.WRH = P.LG + 1024 * 160; P.WRL = P.WRH + NE * D;
    P.XS = (bf16*)(ws + WS_XS); P.ACT = (bf16*)(ws + WS_ACT); P.OUTK = (bf16*)(ws + WS_OUTK);

    for (int u = tid; u < (LDS_BYTES - TAB_OFF) / 4; u += NTHREADS) ((LAS unsigned*)(lds + TAB_OFF))[u] = 0u;
    __syncthreads();
#if MK_ONE_LAUNCH
    XcdBarrier bar = xcd_barrier_post((unsigned*)(P.ctl + CW_BAR), (volatile LAS unsigned*)(lds + MISC_OFF));
#define GRID_BAR() xcd_barrier(bar)
#else
#define GRID_BAR() do { } while (0)
#endif
    const int lo = args.ph_lo, hi = args.ph_hi;
#ifndef PHASE_MASK
#define PHASE_MASK 0x3fff
#endif
#define IN(k) (((PHASE_MASK >> (k)) & 1) && lo <= (k) && (k) < hi)
#define SEAM(k) do { if (IN(k) && IN((k) + 1)) GRID_BAR(); } while (0)
    const int G = gridDim.x, c = blockIdx.x;

#ifndef REP_MASK
#define REP_MASK 0
#endif
#define REPS(k) (1 + ((REP_MASK >> (k)) & 1))
#define PHASE(k, ...) do { if (IN(k)) { { __VA_ARGS__ } if (REPS(k) == 2) { GRID_BAR(); { __VA_ARGS__ } } SEAM(k); } } while (0)
    PHASE(0, p0_prologue(P, lds, tid, wave, lane););
    PHASE(1, { pg8::Gemm g{P.H, P.WIN, T, NPROJ, D}; pg8::StaticOrder S; S.init(T, NPROJ, G, c); EpiProj E{P.ZP, P.QKV, P.GATES, P.ROT};
        pg8::gemm_phase<EpiProj, pg8::StaticOrder, true, true>(lds, g, S, E); });
#ifndef PROBE_SUB
#define PROBE_SUB 0
#endif
    PHASE(2, { p2_fused(P, ws, lds, tid, wave, lane); __syncthreads(); if (PROBE_SUB == 1) { p2_fused(P, ws, lds, tid, wave, lane); __syncthreads(); }
        p3_attention(P, lds, tid, wave, lane); if (PROBE_SUB == 2) { __syncthreads(); p3_attention(P, lds, tid, wave, lane); } });
    PHASE(5, p4b_scan(P, ws, lds, tid, wave, lane););
    PHASE(6, p5_post(P, tid, wave, lane););
    PHASE(7, {
        { pg8::Gemm g{P.YAIN, P.WOR, T, D, RW}; pg8::StaticOrder S; S.init(T, D, G, c); EpiMerge<0> E{P.MERGED, P.GATES}; pg8::gemm_phase<EpiMerge<0>, pg8::StaticOrder, true, true>(lds, g, S, E); }
        VM_WAIT(); __builtin_amdgcn_fence(__ATOMIC_ACQUIRE, "agent"); VM_WAIT(); __syncthreads();
        { pg8::Gemm g{P.OIN, P.WOA, T, D, 512}; pg8::StaticOrder S; S.init(T, D, G, c); EpiMerge<1> E{P.MERGED, P.GATES}; pg8::gemm_phase<EpiMerge<1>, pg8::StaticOrder, true, true>(lds, g, S, E); } });
    PHASE(8, { pg8::Gemm g{P.MERGED, P.WOUT, T, D, D}; pg8::StaticOrder S; S.init(T, D, G, c); EpiResid E{P.x, P.X1}; pg8::gemm_phase<EpiResid, pg8::StaticOrder, true, true>(lds, g, S, E); });
#ifdef ROUTER_TWICE
    if (IN(9)) { p8_router(P, lds, tid, wave, lane, CW_CNT + 4096); GRID_BAR(); }
#endif
    PHASE(9, p8_router(P, lds, tid, wave, lane););
    PHASE(10, p9_gather(P, lds, tid, wave, lane););
    PHASE(11, { LAS int* tab = (LAS int*)(lds + TAB_OFF); moe_tables(P, tab, tid);
        pg8::Gemm g{P.XS, P.W1, XS_ROWS, NE * 4096, D / 2}; MoeOrder S{tab, 16, G, c}; EpiMoe1 E{P.ACT, P.b1};
        pg8::gemm_phase<EpiMoe1, MoeOrder, true, true, 122, 127>(lds, g, S, E); });
    PHASE(12, { LAS int* tab = (LAS int*)(lds + TAB_OFF); moe_tables(P, tab, tid);
        pg8::Gemm g{P.ACT, P.W2, XS_ROWS, NE * D, FF / 2}; MoeOrder S{tab, 8, G, c}; EpiMoe2 E{P.OUTK, P.b2, P.ROWTOK, P.ROWGATE};
        pg8::gemm_phase<EpiMoe2, MoeOrder, true, true, 122, 124>(lds, g, S, E); });
    PHASE(13, p12_final(P, tid, wave, lane););
#undef IN
#undef SEAM
}

extern "C" void kernel_launch(void* const* d_in, const int* in_sizes, int n_in, void* d_out, int out_size, void* d_ws, size_t ws_size, hipStream_t stream) {
    static int grid = 0;
    if (grid == 0) {
        if (n_in != 26 || out_size != T * D || ws_size < WS_END) { fprintf(stderr, "kernel_launch: unexpected shapes (n_in %d, out %d, ws %zu, need %zu); nothing launched\n", n_in, out_size, ws_size, (size_t)WS_END); grid = -1; return; }
        int dev = 0, cus = 0, per_cu = 0;
        if (hipGetDevice(&dev) != hipSuccess || hipDeviceGetAttribute(&cus, hipDeviceAttributeMultiprocessorCount, dev) != hipSuccess) { grid = -1; return; }
        if (hipFuncSetAttribute((const void*)fwd, hipFuncAttributeMaxDynamicSharedMemorySize, LDS_BYTES) != hipSuccess) { fprintf(stderr, "kernel_launch: hipFuncSetAttribute failed\n"); grid = -1; return; }
        if (hipOccupancyMaxActiveBlocksPerMultiprocessor(&per_cu, (const void*)fwd, NTHREADS, LDS_BYTES) != hipSuccess || per_cu < 1) fprintf(stderr, "kernel_launch: occupancy query says %d\n", per_cu);
        (void)hipGetLastError();
        grid = cus;
    }
    if (grid < 0) return;
    if (hipMemsetAsync((char*)d_ws + WS_CTL, 0, CTL_ZERO_BYTES, stream) != hipSuccess) return;
    Args a{};
    for (int i = 0; i < 26; ++i) a.in[i] = d_in[i];
    a.out = (float*)d_out; a.ws = (unsigned char*)d_ws;
#if MK_ONE_LAUNCH
    a.ph_lo = 0; a.ph_hi = NPHASES;
    hipLaunchKernelGGL(fwd, dim3(grid), dim3(NTHREADS), LDS_BYTES, stream, a);
#else
    for (int ph = 0; ph < NPHASES; ++ph) { a.ph_lo = ph; a.ph_hi = ph + 1; hipLaunchKernelGGL(fwd, dim3(grid), dim3(NTHREADS), LDS_BYTES, stream, a); }
#endif
}
```

```cpp
#include <hip/hip_runtime.h>
#include <cstdio>
#include <cstdint>
#include <cmath>
#ifndef PG8_KROT
#define PG8_KROT 1
#endif
namespace pg8 {
#define PG8_LAS __attribute__((address_space(3)))
typedef unsigned short bf16_t;
typedef short bf16x8 __attribute__((ext_vector_type(8)));
typedef float f32x4 __attribute__((ext_vector_type(4)));
typedef unsigned u32x4 __attribute__((ext_vector_type(4)));
constexpr int BM = 256, BK = 64, HALF = 128, HTB = HALF * BK * 2  , STAGE_BYTES = 8 * HTB, NXCD = 8, WGM = 8;

__host__ __device__ __forceinline__ int lds_byte(int r, int c) { const int st = (r >> 4) * 2 + (c >> 5), rr = r & 15, cc = c & 31, ob = rr * 64 + cc * 2; return st * 1024 + (ob ^ (((ob >> 9) & 1) << 5)); }
__host__ __device__ __forceinline__ void stage_rc(int b, int& R, int& C) { const int st = b / 1024, sb = b % 1024, swz = sb ^ (((sb >> 9) & 1) << 5); R = (st >> 1) * 16 + swz / 64; C = (st & 1) * 32 + (swz % 64) / 2; }
__host__ __device__ __forceinline__ int perm32(int rho) { const int n = rho >> 4, i = rho & 15; return 8 * (i >> 2) + 4 * n + (i & 3); }

struct Unit { int pm, pn; };
struct Gemm { const bf16_t* A; const bf16_t* Bt; int M, N, K; };

struct StaticOrder {
    int nM, nN, nwg, G, c;
    __host__ __device__ void init(int M, int N, int G_, int c_) { nM = M / BM; nN = N / BM; nwg = nM * nN; G = G_; c = c_; }
    __host__ __device__ bool next(int i, Unit& u) const {
        const long L = (long)i * G + c; if (L >= nwg) return false;
        int wgid = (int)L; { const int q = nwg / NXCD, r = nwg % NXCD, xcd = wgid % NXCD, off = wgid / NXCD; wgid = (xcd < r ? xcd * (q + 1) : r * (q + 1) + (xcd - r) * q) + off; }
        const int nig = WGM * nN, gid = wgid / nig, fm = gid * WGM, gsz = (nM - fm) < WGM ? (nM - fm) : WGM;
        u.pm = fm + ((wgid % nig) % gsz); u.pn = (wgid % nig) / gsz; return true;
    }
    __device__ __forceinline__ void a_ready(const Unit&) const {}
    __device__ __forceinline__ void done(const Unit&) const {}
};

__device__ __forceinline__ unsigned cvt_pk_bf16(float lo, float hi) { unsigned r; asm volatile("v_cvt_pk_bf16_f32 %0, %1, %2" : "=v"(r) : "v"(lo), "v"(hi)); return r; }
typedef float f32x2 __attribute__((ext_vector_type(2)));

typedef int i32x4_t __attribute__((ext_vector_type(4)));
typedef int i32x8_t __attribute__((ext_vector_type(8)));
__device__ __forceinline__ f32x4 mfma_fp8(bf16x8 w0, bf16x8 w1, bf16x8 a0, bf16x8 a1, f32x4 c, int sw, int sa) {
    const i32x4_t x0 = __builtin_bit_cast(i32x4_t, w0), x1 = __builtin_bit_cast(i32x4_t, w1), y0 = __builtin_bit_cast(i32x4_t, a0), y1 = __builtin_bit_cast(i32x4_t, a1);
    const i32x8_t X = {x0.x, x0.y, x0.z, x0.w, x1.x, x1.y, x1.z, x1.w}, Y = {y0.x, y0.y, y0.z, y0.w, y1.x, y1.y, y1.z, y1.w};
    return __builtin_amdgcn_mfma_scale_f32_16x16x128_f8f6f4(X, Y, c, 0, 0, 0, sw, 0, sa);
}
template <class Epi, class Sched, bool ALIGN_EPI = false, bool SP2 = false, int FP8W = -1, int FP8A = -1, bool PRE = false, bool KROT = true, bool MID = false, bool GATH = false>
__device__ __forceinline__ void gemm_phase(PG8_LAS unsigned char* lds, const Gemm g, const Sched& S, const Epi& E) {
    const int tid = threadIdx.x, wid = __builtin_amdgcn_readfirstlane(tid >> 6), lane = tid & 63, wr = wid >> 2, wc = wid & 3, fr = lane & 15, fq = lane >> 4;
    const int K = g.K, nt = K / BK;
    int kpre = 0; if constexpr (PRE) kpre = E.npre(wid);
    constexpr int PRE_OFF = 131072, PRE_SLOT = 4096;
    unsigned voffA[2], voffB[2]; int arow[2]; unsigned acol[2];
#pragma unroll
    for (int i = 0; i < 2; ++i) { int R, C; stage_rc(tid * 16 + i * 8192, R, C); const int Rb = 64 * (R >> 5) + (Epi::PERM ? perm32(R & 31) : (R & 31));
        voffA[i] = (unsigned)(R * K + C) * 2u; voffB[i] = (unsigned)(Rb * K + C) * 2u; arow[i] = R; acol[i] = (unsigned)C * 2u; }
    const size_t kstep = (size_t)(BK * 2);
    const int krot = (PG8_KROT && KROT) ? (int)(blockIdx.x & 7) * (nt >> 3) : 0;
#define PG8_KP(x) ((size_t)(((x) + krot) >= nt ? ((x) + krot - nt) : ((x) + krot)) * kstep)
    const size_t kp0 = PG8_KP(0), kp1 = PG8_KP(1);
    const size_t hstep = (size_t)HALF * K * 2;
    const size_t tstep = 2 * hstep;
    const size_t bh1 = (size_t)32 * K * 2;
    const unsigned ldsw = (unsigned)wid * 1024u;
    const int aoff = lds_byte(wr * 64 + fr, fq * 8), boff = lds_byte(wc * 32 + fr, fq * 8);
#define PG8_SA(b, h) (((b) * 2 + (h)) * HTB)
#define PG8_SB(b, h) ((4 + (b) * 2 + (h)) * HTB)
#define PG8_STAGE(bufoff, gbase, voff) do { _Pragma("unroll") for (int _i = 0; _i < 2; ++_i) \
        __builtin_amdgcn_global_load_lds((const unsigned*)((const char*)(gbase) + (voff)[_i]), (PG8_LAS unsigned*)(lds + (bufoff) + ldsw + _i * 8192), 16, 0, 0); } while (0)
#define PG8_LD8(p) __builtin_shufflevector(*(const PG8_LAS i32x4_t*)(p), *(const PG8_LAS i32x4_t*)((p) + 1024), 0, 1, 2, 3, 4, 5, 6, 7)
#define PG8_LDA(dst, b, h) do { if constexpr (FP8W >= 0) { _Pragma("unroll") for (int m = 0; m < 4; ++m) dst##8[m] = PG8_LD8(lds + PG8_SA(b, h) + aoff + m * 2048); } \
        else { _Pragma("unroll") for (int m = 0; m < 4; ++m) _Pragma("unroll") for (int k = 0; k < 2; ++k) dst[m][k] = *(const PG8_LAS bf16x8*)(lds + PG8_SA(b, h) + aoff + m * 2048 + k * 1024); } } while (0)
#define PG8_LDB(dst, b, h) do { if constexpr (FP8W >= 0) { _Pragma("unroll") for (int n = 0; n < 2; ++n) dst##8[n] = PG8_LD8(lds + PG8_SB(b, h) + boff + n * 2048); } \
        else { _Pragma("unroll") for (int n = 0; n < 2; ++n) _Pragma("unroll") for (int k = 0; k < 2; ++k) dst[n][k] = *(const PG8_LAS bf16x8*)(lds + PG8_SB(b, h) + boff + n * 2048 + k * 1024); } } while (0)
#define PG8_MMA(ai, bj, At, Bt) do { __builtin_amdgcn_s_setprio(1); _Pragma("unroll") for (int m = 0; m < 4; ++m) _Pragma("unroll") for (int n = 0; n < 2; ++n) { \
        if constexpr (FP8W >= 0) { if constexpr (FP8A == 4) { const i32x4_t b4_ = __builtin_shufflevector(Bt##8[n], Bt##8[n], 0, 1, 2, 3), a4_ = __builtin_shufflevector(At##8[m], At##8[m], 0, 1, 2, 3); asm volatile("v_mfma_f32_16x16x128_f8f6f4 %0, %1, %2, %0 cbsz:4 blgp:4" : "+v"(acc[ai][bj][m][n]) : "v"(b4_), "v"(a4_)); } else asm volatile("v_mfma_f32_16x16x128_f8f6f4 %0, %1, %2, %0" : "+v"(acc[ai][bj][m][n]) : "v"(Bt##8[n]), "v"(At##8[m])); } \
        else { _Pragma("unroll") for (int k = 0; k < 2; ++k) acc[ai][bj][m][n] = __builtin_amdgcn_mfma_f32_16x16x32_bf16(Bt[n][k], At[m][k], acc[ai][bj][m][n], 0, 0, 0); } } \
        __builtin_amdgcn_s_setprio(0); } while (0)
#define PG8_WAIT_V(n) asm volatile("s_waitcnt vmcnt(" #n ")" ::: "memory")
#define PG8_WAIT_L(n) asm volatile("s_waitcnt lgkmcnt(" #n ")" ::: "memory")
#define PG8_BAR __builtin_amdgcn_s_barrier()
#define PG8_SCHED __builtin_amdgcn_sched_barrier(0)
    Unit cur, nxt; int ui = 0;
    if (!S.next(0, cur)) return;
    f32x4 acc[2][2][4][2];
#pragma unroll
    for (int a = 0; a < 2; ++a)
#pragma unroll
        for (int b = 0; b < 2; ++b)
#pragma unroll
            for (int m = 0; m < 4; ++m)
#pragma unroll
                for (int n = 0; n < 2; ++n) acc[a][b][m][n] = (f32x4){0.f, 0.f, 0.f, 0.f};
    const int fp8sw = FP8W, fp8sa = FP8A; (void)fp8sw; (void)fp8sa;
    bf16x8 At[4][2], B0[2][2], B1[2][2]; i32x8_t At8[4], B08[2], B18[2];
    const char* cA = (const char*)g.A + (size_t)cur.pm * tstep; const char* cB = (const char*)g.Bt + (size_t)cur.pn * tstep;
    S.a_ready(cur);
    const char* gA = (const char*)g.A; unsigned oc[2][2] = {{0u, 0u}, {0u, 0u}}, on[2][2] = {{0u, 0u}, {0u, 0u}};
    if constexpr (GATH) { static_assert(!GATH || (SP2 && PRE), "gathered A rows: SP2 + PRE form only"); int sb_, nv_; E.arows(cur, sb_, nv_);
#pragma unroll
        for (int h = 0; h < 2; ++h)
#pragma unroll
            for (int i = 0; i < 2; ++i) { const int row = arow[i] + 128 * h; const int p_ = E.RT2[sb_ + row]; oc[h][i] = ((row < nv_) ? (unsigned)(p_ >> 2) : 0u) * (unsigned)(K * 2) + acol[i]; } }
#define PG8_STA(bufslot, h, kbytes, origptr) do { if constexpr (GATH) PG8_STAGE(bufslot, gA + (kbytes), oc[h]); else PG8_STAGE(bufslot, origptr, voffA); } while (0)
    if constexpr (SP2) {
        PG8_STAGE(PG8_SB(0, 0), cB + kp0, voffB); PG8_STAGE(PG8_SB(0, 1), cB + bh1 + kp0, voffB); PG8_STA(PG8_SA(0, 0), 0, kp0, cA + kp0); PG8_STA(PG8_SA(0, 1), 1, kp0, cA + hstep + kp0);
        if (wr == 1) PG8_BAR;
        PG8_WAIT_V(2); PG8_BAR;
        PG8_STAGE(PG8_SB(1, 0), cB + kp1, voffB); PG8_STA(PG8_SA(1, 0), 0, kp1, cA + kp1); PG8_STAGE(PG8_SB(1, 1), cB + bh1 + kp1, voffB);
        PG8_WAIT_V(6); PG8_BAR;
    } else {
        PG8_STAGE(PG8_SB(0, 0), cB + kp0, voffB); PG8_STAGE(PG8_SA(0, 0), cA + kp0, voffA); PG8_STAGE(PG8_SB(0, 1), cB + bh1 + kp0, voffB); PG8_STAGE(PG8_SA(0, 1), cA + hstep + kp0, voffA);
        if (wr == 1) PG8_BAR;
        PG8_WAIT_V(4); PG8_BAR;
        PG8_STAGE(PG8_SB(1, 0), cB + kp1, voffB); PG8_STAGE(PG8_SA(1, 0), cA + kp1, voffA); PG8_STAGE(PG8_SB(1, 1), cB + bh1 + kp1, voffB);
        PG8_WAIT_V(6); PG8_BAR;
    }
    for (;;) {
        const bool has_next = S.next(ui + 1, nxt);
        const char* nA = has_next ? (const char*)g.A + (size_t)nxt.pm * tstep : cA; const char* nB = has_next ? (const char*)g.Bt + (size_t)nxt.pn * tstep : cB;
        for (int t = 0; t < nt; t += 2) {
            if constexpr (MID) { if (t == Epi::MID_T) E.mid(acc, cur, wr, wc, fr, fq); }
            const bool last = (t == nt - 2);
            const char* a1 = cA + PG8_KP(t + 1);
            const size_t k2 = last ? kp0 : PG8_KP(t + 2), k3 = last ? kp1 : PG8_KP(t + 3);
            const char* a2 = (last ? nA : cA) + k2; const char* b2 = (last ? nB : cB) + k2;
            const char* a3 = (last ? nA : cA) + k3; const char* b3 = (last ? nB : cB) + k3;
            if (last && has_next) S.a_ready(nxt);
            if constexpr (SP2) {
            if constexpr (PRE) { if (t == 0) E.prefetch(cur, lds + PRE_OFF + (ui & 1) * PRE_SLOT, wid, lane); }
            if constexpr (GATH) {
                if (t == 0 && has_next && wid < 4) { int sb_, nv_; E.arows(nxt, sb_, nv_);
                    __builtin_amdgcn_global_load_lds((const unsigned*)(E.RT2 + sb_ + wid * 64 + lane), (PG8_LAS unsigned*)(lds + PRE_OFF + ((ui + 1) & 1) * PRE_SLOT + 2048 + wid * 256), 4, 0, 0); }
                if (last) {
                    if (has_next) { int sb_, nv_; E.arows(nxt, sb_, nv_); const PG8_LAS int* rt_ = (const PG8_LAS int*)(lds + PRE_OFF + ((ui + 1) & 1) * PRE_SLOT + 2048);
#pragma unroll
                        for (int h = 0; h < 2; ++h)
#pragma unroll
                            for (int i = 0; i < 2; ++i) { const int row = arow[i] + 128 * h; const int p_ = rt_[row]; on[h][i] = ((row < nv_) ? (unsigned)(p_ >> 2) : 0u) * (unsigned)(K * 2) + acol[i]; } }
                    else { on[0][0] = oc[0][0]; on[0][1] = oc[0][1]; on[1][0] = oc[1][0]; on[1][1] = oc[1][1]; } } }
            PG8_LDB(B0, 0, 0); PG8_LDB(B1, 0, 1); PG8_SCHED; PG8_LDA(At, 0, 0); PG8_STA(PG8_SA(1, 1), 1, PG8_KP(t + 1), a1 + hstep);
            if constexpr (GATH) { if (last) { oc[0][0] = on[0][0]; oc[0][1] = on[0][1]; oc[1][0] = on[1][0]; oc[1][1] = on[1][1]; } }
            if (PRE && t == 0 && kpre == 1) PG8_WAIT_V(9); else if (PRE && t == 0 && kpre == 2) PG8_WAIT_V(10); else PG8_WAIT_V(8);
            PG8_WAIT_L(0); PG8_BAR; PG8_MMA(0, 0, At, B0); PG8_MMA(0, 1, At, B1); PG8_BAR; PG8_SCHED;
            PG8_LDA(At, 0, 1); PG8_STAGE(PG8_SB(0, 0), b2, voffB); PG8_STAGE(PG8_SB(0, 1), b2 + bh1, voffB); PG8_STA(PG8_SA(0, 0), 0, k2, a2);
            if (PRE && t == 0 && kpre == 1) PG8_WAIT_V(9); else if (PRE && t == 0 && kpre == 2) PG8_WAIT_V(10); else PG8_WAIT_V(8);
            PG8_WAIT_L(0); PG8_BAR; PG8_MMA(1, 0, At, B0); PG8_MMA(1, 1, At, B1); PG8_BAR; PG8_SCHED;
            PG8_LDB(B0, 1, 0); PG8_LDB(B1, 1, 1); PG8_SCHED; PG8_LDA(At, 1, 0); PG8_STA(PG8_SA(0, 1), 1, k2, a2 + hstep);
            PG8_WAIT_V(8); PG8_WAIT_L(0); PG8_BAR; PG8_MMA(0, 0, At, B0); PG8_MMA(0, 1, At, B1); PG8_BAR; PG8_SCHED;
            PG8_LDA(At, 1, 1); PG8_STAGE(PG8_SB(1, 0), b3, voffB); PG8_STAGE(PG8_SB(1, 1), b3 + bh1, voffB); PG8_STA(PG8_SA(1, 0), 0, k3, a3);
            PG8_WAIT_V(8); PG8_WAIT_L(0); PG8_BAR; PG8_MMA(1, 0, At, B0); PG8_MMA(1, 1, At, B1); PG8_BAR; PG8_SCHED;
            } else {
            PG8_LDB(B0, 0, 0); PG8_SCHED; PG8_LDA(At, 0, 0); PG8_STAGE(PG8_SA(1, 1), a1 + hstep, voffA);
            PG8_WAIT_L(8); PG8_BAR; PG8_WAIT_L(0); PG8_MMA(0, 0, At, B0); PG8_BAR; PG8_SCHED;
            PG8_LDB(B1, 0, 1); PG8_STAGE(PG8_SB(0, 0), b2, voffB);
            PG8_BAR; PG8_WAIT_L(0); PG8_MMA(0, 1, At, B1); PG8_BAR;
            PG8_LDA(At, 0, 1); PG8_STAGE(PG8_SA(0, 0), a2, voffA);
            PG8_BAR; PG8_WAIT_L(0); PG8_MMA(1, 0, At, B0); PG8_BAR; PG8_SCHED;
            PG8_STAGE(PG8_SB(0, 1), b2 + bh1, voffB);
            PG8_WAIT_V(6); PG8_BAR; PG8_MMA(1, 1, At, B1); PG8_BAR;
            PG8_LDB(B0, 1, 0); PG8_SCHED; PG8_LDA(At, 1, 0); PG8_STAGE(PG8_SA(0, 1), a2 + hstep, voffA);
            PG8_WAIT_L(8); PG8_BAR; PG8_WAIT_L(0); PG8_MMA(0, 0, At, B0); PG8_BAR; PG8_SCHED;
            PG8_LDB(B1, 1, 1); PG8_STAGE(PG8_SB(1, 0), b3, voffB);
            PG8_BAR; PG8_WAIT_L(0); PG8_MMA(0, 1, At, B1); PG8_BAR;
            PG8_LDA(At, 1, 1); PG8_STAGE(PG8_SA(1, 0), a3, voffA);
            PG8_BAR; PG8_WAIT_L(0); PG8_MMA(1, 0, At, B0); PG8_BAR; PG8_SCHED;
            PG8_STAGE(PG8_SB(1, 1), b3 + bh1, voffB);
            PG8_WAIT_V(6); PG8_BAR; PG8_MMA(1, 1, At, B1); PG8_BAR;
            }
        }
        {
#pragma unroll
            for (int a_ = 0; a_ < 2; ++a_)
#pragma unroll
                for (int b_ = 0; b_ < 2; ++b_)
                    asm volatile("s_nop 15\n\ts_nop 15" : "+v"(acc[a_][b_][0][0]), "+v"(acc[a_][b_][0][1]), "+v"(acc[a_][b_][1][0]), "+v"(acc[a_][b_][1][1]), "+v"(acc[a_][b_][2][0]), "+v"(acc[a_][b_][2][1]), "+v"(acc[a_][b_][3][0]), "+v"(acc[a_][b_][3][1]));
        }
        if constexpr (ALIGN_EPI) { if (wr == 0) PG8_BAR; }
        if constexpr (!Epi::AFTER_DRAIN) { if constexpr (PRE) E(acc, cur, wr, wc, fr, fq, lds + PRE_OFF + (ui & 1) * PRE_SLOT); else E(acc, cur, wr, wc, fr, fq); S.done(cur); }
        if (!has_next) break;
#pragma unroll
        for (int a = 0; a < 2; ++a)
#pragma unroll
            for (int b = 0; b < 2; ++b)
#pragma unroll
                for (int m = 0; m < 4; ++m)
#pragma unroll
                    for (int n = 0; n < 2; ++n) acc[a][b][m][n] = (f32x4){0.f, 0.f, 0.f, 0.f};
        cur = nxt; cA = nA; cB = nB; ++ui;
        if constexpr (ALIGN_EPI) { if (wr == 1) PG8_BAR; }
    }
    PG8_WAIT_V(0);
    if constexpr (!ALIGN_EPI) { if (wr == 0) PG8_BAR; }
    PG8_BAR;
    if constexpr (Epi::AFTER_DRAIN) { E.fused(acc, cur, wr, wc, fr, fq, lds, wid, lane); S.done(cur); }
#undef PG8_KP
#undef PG8_STA
#undef PG8_SA
#undef PG8_SB
#undef PG8_STAGE
#undef PG8_LD8
#undef PG8_LDA
#undef PG8_LDB
#undef PG8_MMA
#undef PG8_WAIT_V
#undef PG8_WAIT_L
#undef PG8_BAR
#undef PG8_SCHED
}
}


constexpr int NB = 4, SEQ = 4096, T = NB * SEQ, D = 2048;
constexpr int RW = 1024, NH = 16, HD = 64;
constexpr int IN_W = 12064, SHIFT_W = 3360;
constexpr int ZPW = 3584, QKVW = 4608, GATEW = 4096, NPROJ = 12288;
constexpr int NE = 32, FF = 2048;
constexpr int XS_ROWS = T * 4 + NE * 256;
constexpr int NWAVES = 8, NTHREADS = 512;
constexpr float NORM_EPS = 1e-5f, GN_EPS = 64e-5f;
constexpr float QSCALE = 0.08838834764831845f * 1.4426950408889634f;

#ifndef MK_ONE_LAUNCH
#define MK_ONE_LAUNCH 1
#endif
constexpr int NPHASES = 14;

constexpr size_t MiB = 1ull << 20;
constexpr size_t WS_CTL = 0, CTL_ZERO_BYTES = 1 * MiB;
constexpr size_t WS_WIN = 1 * MiB;
constexpr size_t WS_W1 = WS_WIN + 48 * MiB;
constexpr size_t WS_W2 = WS_W1 + 512 * MiB;
constexpr size_t WS_WOR = WS_W2 + 256 * MiB;
constexpr size_t WS_WOA = WS_WOR + 4 * MiB;
constexpr size_t WS_WOUT = WS_WOA + 2 * MiB;
constexpr size_t WS_H = WS_WOUT + 8 * MiB;
constexpr size_t WS_ZP = WS_H + 64 * MiB;
constexpr size_t WS_QKV = WS_ZP + 112 * MiB;
constexpr size_t WS_GATES = WS_QKV + 144 * MiB;
constexpr size_t WS_ROT = WS_GATES + 128 * MiB;
constexpr size_t WS_SC = WS_ROT + 2 * MiB;
constexpr size_t WS_G = WS_SC + 384 * MiB;
constexpr size_t WS_BONUS = WS_G + 32 * MiB;
constexpr size_t WS_Y = WS_BONUS + 1 * MiB;
constexpr size_t WS_ATTO = WS_Y + 64 * MiB;
constexpr size_t WS_ATTML = WS_ATTO + 48 * MiB;
constexpr size_t WS_YAIN = WS_ATTML + 2 * MiB;
constexpr size_t WS_OIN = WS_YAIN + 32 * MiB;
constexpr size_t WS_MERGED = WS_OIN + 16 * MiB;
constexpr size_t WS_X1 = WS_MERGED + 64 * MiB;
constexpr size_t WS_TOPK = WS_X1 + 128 * MiB;
constexpr size_t WS_ROWS = WS_TOPK + 1 * MiB;
constexpr size_t WS_XS = WS_ROWS + 1 * MiB;
constexpr size_t WS_ACT = WS_XS + 288 * MiB;
constexpr size_t WS_OUTK = WS_ACT + 288 * MiB;
constexpr size_t WS_LORA = WS_OUTK + 256 * MiB;
constexpr size_t WS_H8 = WS_LORA + 1 * MiB;
constexpr size_t WS_WG8 = WS_H8 + 32 * MiB;
constexpr size_t WS_MERGED8 = WS_WG8 + 16 * MiB;
constexpr size_t WS_ROWS2 = WS_MERGED8 + 32 * MiB;
constexpr size_t WS_WG8B = WS_ROWS2 + 4 * MiB;
constexpr size_t WS_END = WS_WG8B + 20 * MiB;
constexpr size_t WS_S1 = WS_XS;
constexpr int NU16 = NB * NH * (SEQ / 16);
constexpr size_t S1_WH = 0, S1_QH = 32 * MiB, S1_BT = 64 * MiB, S1_KT = 96 * MiB, S1_VT = 128 * MiB, S1_U0T = 160 * MiB, S1_Y0T = 224 * MiB, S1_GAM = 288 * MiB;
constexpr size_t SC_STRIDE = (size_t)T * RW;
enum { SH_KK = 0, SH_BB = 1, SH_K = 2, SH_R = 3, SH_V = 4 };

constexpr int CW_TMO = 0, CW_CODE = 1, CW_BAR = 4096, CW_CNT = 8192;

constexpr int RING_BYTES = 131072;
constexpr int TAB_OFF = 147456;
constexpr int MISC_OFF = TAB_OFF + 512;
constexpr int LDS_BYTES = 151552;

#define GAS __attribute__((address_space(1)))
#define LAS __attribute__((address_space(3)))
typedef unsigned short bf16;
typedef unsigned u32x4 __attribute__((ext_vector_type(4)));
typedef unsigned u32x2 __attribute__((ext_vector_type(2)));
typedef float f32x2 __attribute__((ext_vector_type(2)));
typedef float f32x4 __attribute__((ext_vector_type(4)));
typedef short bf16x8 __attribute__((ext_vector_type(8)));
typedef short bf16x4 __attribute__((ext_vector_type(4)));
typedef GAS unsigned gu32;
#define RLX_AGENT __ATOMIC_RELAXED, __HIP_MEMORY_SCOPE_AGENT
#define LDS_WAIT() asm volatile("s_waitcnt lgkmcnt(0)" ::: "memory")
#define VM_WAIT() asm volatile("s_waitcnt vmcnt(0)" ::: "memory")
__device__ __forceinline__ unsigned f2bf(float f) { unsigned u = __builtin_bit_cast(unsigned, f); return (u + 0x7fffu + ((u >> 16) & 1u)) >> 16; }
__device__ __forceinline__ unsigned pk2(float lo, float hi) { return f2bf(lo) | (f2bf(hi) << 16); }
__device__ __forceinline__ unsigned pk2h(float lo, float hi) { unsigned r; asm("s_nop 1\n\tv_cvt_pk_bf16_f32 %0, %1, %2" : "=v"(r) : "v"(lo), "v"(hi)); return r; }
__device__ __forceinline__ u32x4 pack8h(const f32x4& a, const f32x4& b) { u32x4 w; w.x = pk2h(a[0], a[1]); w.y = pk2h(a[2], a[3]); w.z = pk2h(b[0], b[1]); w.w = pk2h(b[2], b[3]); return w; }
__device__ __forceinline__ float bflo(unsigned w) { return __uint_as_float(w << 16); }
__device__ __forceinline__ float bfhi(unsigned w) { return __uint_as_float(w & 0xffff0000u); }
__device__ __forceinline__ float bf2f(bf16 h) { return __uint_as_float((unsigned)h << 16); }
__device__ __forceinline__ float sigmoidf_(float x) { return __builtin_amdgcn_rcpf(1.0f + __builtin_amdgcn_exp2f(-1.4426950408889634f * x)); }
__device__ __forceinline__ float tanhf_(float x) { return 1.0f - 2.0f * __builtin_amdgcn_rcpf(1.0f + __builtin_amdgcn_exp2f(2.8853900817779268f * x)); }
__device__ __forceinline__ unsigned pk2v(float lo, float hi) { unsigned r; asm("s_nop 1\n\tv_cvt_pk_bf16_f32 %0, %1, %2" : "=v"(r) : "v"(lo), "v"(hi)); return r; }
__device__ __forceinline__ float wave_sum(float v) {
#pragma unroll
    for (int o = 1; o < 64; o <<= 1) v += __shfl_xor(v, o);
    return v;
}
__device__ __forceinline__ unsigned pk4_fp8(float a, float b, float c, float d) { int r = __builtin_amdgcn_cvt_pk_fp8_f32(a, b, 0, false); r = __builtin_amdgcn_cvt_pk_fp8_f32(c, d, r, true); return (unsigned)r; }
__device__ __forceinline__ u32x4 pack8(const f32x4& a, const f32x4& b) { u32x4 w; w.x = pk2(a[0], a[1]); w.y = pk2(a[2], a[3]); w.z = pk2(b[0], b[1]); w.w = pk2(b[2], b[3]); return w; }
__device__ __forceinline__ void unpack8(const u32x4& w, f32x4& a, f32x4& b) { a = (f32x4){bflo(w.x), bfhi(w.x), bflo(w.y), bfhi(w.y)}; b = (f32x4){bflo(w.z), bfhi(w.z), bflo(w.w), bfhi(w.w)}; }

#define XB_TMO      128
#define XB_XCNT(j)  (256  + 64 * (j))
#define XB_XSUB(j)  (1280 + 64 * (j))
#define XB_XGEN(j)  (2304 + 64 * (j))
#define XB_TOP      3328
#define XB_TOPGEN   3392
#define XCD_BAR_WORDS 3456
#define XB_SPIN_CAP (1u << 18)

__device__ __forceinline__ unsigned xb_ld(unsigned* p)              { return __hip_atomic_load(p, __ATOMIC_RELAXED, __HIP_MEMORY_SCOPE_AGENT); }
__device__ __forceinline__ unsigned xb_add(unsigned* p, unsigned v) { return __hip_atomic_fetch_add(p, v, __ATOMIC_RELAXED, __HIP_MEMORY_SCOPE_AGENT); }
__device__ __forceinline__ unsigned xb_xcc_id() { return (unsigned)__builtin_amdgcn_s_getreg((3 << 11) | 20) & 0xFu; }
#define XB_SPIN(cond, bar) do { unsigned _sp = 0; while (cond) { __builtin_amdgcn_s_sleep(1); \
    if ((++_sp & 255u) == 0u) { if (xb_ld(&(bar)[XB_TMO])) break; if (_sp > XB_SPIN_CAP) { atomicAdd(&(bar)[XB_TMO], 1u); break; } } } } while (0)

struct XcdBarrier {
    unsigned* bar; unsigned x;
    volatile LAS unsigned* st;
};

__device__ __forceinline__ XcdBarrier xcd_barrier_post(unsigned* bar, volatile LAS unsigned* st) {
    XcdBarrier b; b.bar = bar; b.x = xb_xcc_id(); b.st = st;
    if (threadIdx.x == 0) (void)xb_add(&bar[XB_XCNT(b.x)], 1u);
    return b;
}
__device__ __forceinline__ void xcd_barrier_complete(unsigned* bar, unsigned x, unsigned& nloc, unsigned& nx) {
    const unsigned G = gridDim.x * gridDim.y * gridDim.z;
    unsigned sum, cnt, mine, sp = 0u;
    for (;;) {
        sum = 0u; cnt = 0u; mine = 0u;
#pragma unroll
        for (unsigned j = 0; j < 16; ++j) { const unsigned c = xb_ld(&bar[XB_XCNT(j)]); sum += c; cnt += (c > 0u) ? 1u : 0u; mine = (j == x) ? c : mine; }
        if (sum == G) break;
        __builtin_amdgcn_s_sleep(1);
        if ((++sp & 255u) == 0u) { if (xb_ld(&bar[XB_TMO])) break; if (sp > XB_SPIN_CAP) { atomicAdd(&bar[XB_TMO], 1u); break; } }
    }
    nloc = mine > 0u ? mine : 1u; nx = cnt > 0u ? cnt : 1u;
}

__device__ __forceinline__ void xcd_barrier(const XcdBarrier& b) {
    asm volatile("s_waitcnt vmcnt(0)" ::: "memory");
    __syncthreads();
    if (threadIdx.x == 0) {
        unsigned* bar = b.bar;
        __builtin_amdgcn_s_waitcnt(0);
        unsigned nloc = b.st[0], nx = b.st[1];
        if (nloc == 0u) { xcd_barrier_complete(bar, b.x, nloc, nx); b.st[0] = nloc; b.st[1] = nx; }
        const unsigned old = xb_add(&bar[XB_XSUB(b.x)], 1u);
        const unsigned gen = old / nloc;
        if (old + 1u == (gen + 1u) * nloc) {
            __builtin_amdgcn_fence(__ATOMIC_RELEASE, "agent");
            asm volatile("s_waitcnt vmcnt(0)" ::: "memory");
            const unsigned og = xb_add(&bar[XB_TOP], 1u);
            const unsigned tg = og / nx;
            if (og + 1u == (tg + 1u) * nx) xb_add(&bar[XB_TOPGEN], 1u);
            else XB_SPIN(xb_ld(&bar[XB_TOPGEN]) == tg, bar);
            __builtin_amdgcn_fence(__ATOMIC_ACQUIRE, "agent");
            xb_add(&bar[XB_XGEN(b.x)], 1u);
            asm volatile("s_waitcnt vmcnt(0)" ::: "memory");
        } else {
            XB_SPIN(xb_ld(&bar[XB_XGEN(b.x)]) == gen, bar);
            __builtin_amdgcn_fence(__ATOMIC_ACQUIRE, "agent");
            asm volatile("s_waitcnt vmcnt(0)" ::: "memory");
        }
    }
    __syncthreads();
}


struct Ptrs {
    const float *x, *norm_mix, *w_in, *shift_mu, *w0, *w2_decay, *a0, *a2_iclr, *g2_gate, *k_k, *k_a, *r_k, *ln_x_w, *ln_x_b, *w_o_rwkv, *w_o_attn, *w_out, *norm_ffn, *w_router, *b_router, *w1, *b1, *w2, *b2, *norm_final;
    const int* positions;
    float* out;
    bf16 *LW, *LA, *LG, *WRH, *WRL, *WIN, *W1, *W2, *WOR, *WOA, *WOUT, *H, *ZP, *QKV, *GATES, *G, *ATTO, *YAIN, *OIN, *MERGED, *XS, *ACT, *OUTK;
    bf16* SCH;
    float *ROT, *SC, *BONUS, *Y, *ATTML, *TOPK_GATE, *ROWGATE, *RG2; bf16* X1; int* RT2;
    int *TOPK_E, *TOPK_POS, *ROWTOK;
    gu32* ctl;
};

using pg8::Unit;
__device__ __forceinline__ void store8(bf16* p, const f32x4& a, const f32x4& b) { *(u32x4*)p = pack8h(a, b); }

struct EpiProj {
    static constexpr bool PERM = true, AFTER_DRAIN = false;
    bf16* ZP; bf16* QKV; bf16* GATES; const float* ROT; int dry; int pn_off; float descale;
    __device__ __forceinline__ void operator()(const f32x4 (&accq)[2][2][4][2], const Unit& u, int wr, int wc, int fr, int fq) const {
        if (dry == 1) return;
        f32x4 acc[2][2][4][2];
#pragma unroll
        for (int a_ = 0; a_ < 2; ++a_)
#pragma unroll
            for (int b_ = 0; b_ < 2; ++b_)
#pragma unroll
                for (int m_ = 0; m_ < 4; ++m_)
#pragma unroll
                    for (int n_ = 0; n_ < 2; ++n_) acc[a_][b_][m_][n_] = accq[a_][b_][m_][n_] * descale;
        const int pn = u.pn + pn_off, rbase = u.pm * 256 + wr * 64 + fr, cw = wc * 64 + 8 * fq;
        if (pn < 14) {
#pragma unroll
            for (int ai = 0; ai < 2; ++ai)
#pragma unroll
                for (int m = 0; m < 4; ++m) { bf16* rp = ZP + (size_t)(rbase + ai * 128 + m * 16) * ZPW + pn * 256 + cw;
#pragma unroll
                    for (int bj = 0; bj < 2; ++bj) if ((dry != 3 || bj == 0) && (dry != 4 || (bj == 0 && ai == 0 && m == 0))) store8(rp + bj * 32, acc[ai][bj][m][0], acc[ai][bj][m][1]); }
        } else if (pn < 32) {
            const int t = pn - 14; const bool rotw = (t < 12) && ((wc & 1) == 0);   const float sc = (t < 6) ? QSCALE : 1.0f; const float sg = (fq < 2) ? -1.0f : 1.0f;
#pragma unroll
            for (int ai = 0; ai < 2; ++ai)
#pragma unroll
                for (int m = 0; m < 4; ++m) { const int row = rbase + ai * 128 + m * 16; bf16* rp = QKV + (size_t)row * QKVW + t * 256 + cw;
                    f32x4 c0 = {1.f, 1.f, 1.f, 1.f}, c1 = c0, s0 = {0.f, 0.f, 0.f, 0.f}, s1 = s0;
                    if (rotw) { const float* rt = ROT + (size_t)row * 32 + 8 * (fq & 1); c0 = *(const f32x4*)rt; c1 = *(const f32x4*)(rt + 4); s0 = *(const f32x4*)(rt + 16); s1 = *(const f32x4*)(rt + 20); }
#pragma unroll
                    for (int bj = 0; bj < 2; ++bj) { f32x4 v0 = acc[ai][bj][m][0], v1 = acc[ai][bj][m][1];
                        if (rotw && bj == 0) { f32x4 p0, p1;
#pragma unroll
                            for (int j = 0; j < 4; ++j) { p0[j] = __shfl_xor(v0[j], 32); p1[j] = __shfl_xor(v1[j], 32); }
                            v0 = v0 * c0 + (p0 * s0) * sg; v1 = v1 * c1 + (p1 * s1) * sg; }
                        v0 = v0 * sc; v1 = v1 * sc; store8(rp + bj * 32, v0, v1); } }
        } else {
            const int t = pn - 32;
#pragma unroll
            for (int ai = 0; ai < 2; ++ai)
#pragma unroll
                for (int m = 0; m < 4; ++m) { unsigned char* rp = (unsigned char*)GATES + (size_t)(rbase + ai * 128 + m * 16) * GATEW + t * 256 + cw;
#pragma unroll
                    for (int bj = 0; bj < 2; ++bj) { f32x4 v0 = acc[ai][bj][m][0], v1 = acc[ai][bj][m][1]; unsigned q0[4], q1[4];
#pragma unroll
                        for (int j = 0; j < 4; ++j) { q0[j] = (unsigned)(sigmoidf_(v0[j]) * 255.0f + 0.5f); q1[j] = (unsigned)(sigmoidf_(v1[j]) * 255.0f + 0.5f); }
                        u32x2 w; w.x = q0[0] | (q0[1] << 8) | (q0[2] << 16) | (q0[3] << 24); w.y = q1[0] | (q1[1] << 8) | (q1[2] << 16) | (q1[3] << 24);
                        *(u32x2*)(rp + bj * 32) = w; } }
        }
    }
};

template <int STAGE> struct EpiMerge {
    static constexpr bool PERM = true, AFTER_DRAIN = false;
    bf16* MERGED; const bf16* GATES; unsigned char* M8;
    __device__ __forceinline__ void operator()(const f32x4 (&acc)[2][2][4][2], const Unit& u, int wr, int wc, int fr, int fq) const {
        const int rbase = u.pm * 256 + wr * 64 + fr, cb = u.pn * 256 + wc * 64 + 8 * fq;
#pragma unroll
        for (int ai = 0; ai < 2; ++ai)
#pragma unroll
            for (int m = 0; m < 4; ++m) { const int row = rbase + ai * 128 + m * 16;
#pragma unroll
                for (int bj = 0; bj < 2; ++bj) { const int col = cb + bj * 32;
                    const u32x2 gw = *(const u32x2*)((const unsigned char*)GATES + (size_t)row * GATEW + STAGE * 2048 + col);
                    const f32x4 g0 = (f32x4){(float)(gw.x & 255u), (float)((gw.x >> 8) & 255u), (float)((gw.x >> 16) & 255u), (float)(gw.x >> 24)} * (1.0f / 255.0f);
                    const f32x4 g1 = (f32x4){(float)(gw.y & 255u), (float)((gw.y >> 8) & 255u), (float)((gw.y >> 16) & 255u), (float)(gw.y >> 24)} * (1.0f / 255.0f);
                    f32x4 v0 = acc[ai][bj][m][0] * g0, v1 = acc[ai][bj][m][1] * g1; bf16* dp = MERGED + (size_t)row * D + col;
                    if (STAGE == 1) { const u32x4 tw = *(const u32x4*)dp; f32x4 t0, t1; unpack8(tw, t0, t1); v0 = v0 + t0; v1 = v1 + t1; }
                    if (STAGE == 1) { u32x2 w8; w8.x = pk4_fp8(v0[0] * 16.0f, v0[1] * 16.0f, v0[2] * 16.0f, v0[3] * 16.0f); w8.y = pk4_fp8(v1[0] * 16.0f, v1[1] * 16.0f, v1[2] * 16.0f, v1[3] * 16.0f); *(u32x2*)(M8 + (size_t)row * D + col) = w8; }
                    else store8(dp, v0, v1); } }
    }
};

struct EpiMerge2 {
    static constexpr bool PERM = true, AFTER_DRAIN = false; static constexpr int MID_T = 16;
    const bf16* GATES; unsigned char* M8;
    __device__ __forceinline__ void gates8(const unsigned char* gp, f32x4& a, f32x4& b) const { const u32x2 w = *(const u32x2*)gp;
        a = (f32x4){(float)(w.x & 255u), (float)((w.x >> 8) & 255u), (float)((w.x >> 16) & 255u), (float)(w.x >> 24)}; b = (f32x4){(float)(w.y & 255u), (float)((w.y >> 8) & 255u), (float)((w.y >> 16) & 255u), (float)(w.y >> 24)}; }
    __device__ __forceinline__ void mid(f32x4 (&acc)[2][2][4][2], const Unit& u, int wr, int wc, int fr, int fq) const {
        int rbase = u.pm * 256 + wr * 64 + fr, cb = u.pn * 256 + wc * 64 + 8 * fq; asm volatile("" : "+v"(rbase), "+v"(cb));
#pragma unroll
        for (int ai = 0; ai < 2; ++ai)
#pragma unroll
            for (int m = 0; m < 4; ++m) { const int row = rbase + ai * 128 + m * 16;
#pragma unroll
                for (int bj = 0; bj < 2; ++bj) { const unsigned char* gp = (const unsigned char*)GATES + (size_t)row * GATEW + cb + bj * 32;
                    f32x4 r0, r1, a0, a1; gates8(gp, r0, r1); gates8(gp + 2048, a0, a1);
#pragma unroll
                    for (int j = 0; j < 4; ++j) { acc[ai][bj][m][0][j] *= r0[j] * __builtin_amdgcn_rcpf(fmaxf(a0[j], 1.0f)); acc[ai][bj][m][1][j] *= r1[j] * __builtin_amdgcn_rcpf(fmaxf(a1[j], 1.0f)); }
                    __builtin_amdgcn_sched_barrier(0); } }
    }
    __device__ __forceinline__ void operator()(const f32x4 (&acc)[2][2][4][2], const Unit& u, int wr, int wc, int fr, int fq) const {
        const int rbase = u.pm * 256 + wr * 64 + fr, cb = u.pn * 256 + wc * 64 + 8 * fq;
#pragma unroll
        for (int ai = 0; ai < 2; ++ai)
#pragma unroll
            for (int m = 0; m < 4; ++m) { const int row = rbase + ai * 128 + m * 16;
#pragma unroll
                for (int bj = 0; bj < 2; ++bj) { const int col = cb + bj * 32; f32x4 a0, a1; gates8((const unsigned char*)GATES + (size_t)row * GATEW + 2048 + col, a0, a1);
                    f32x4 v0, v1;
#pragma unroll
                    for (int j = 0; j < 4; ++j) { v0[j] = acc[ai][bj][m][0][j] * (fmaxf(a0[j], 1.0f) * (16.0f / 255.0f)); v1[j] = acc[ai][bj][m][1][j] * (fmaxf(a1[j], 1.0f) * (16.0f / 255.0f)); }
                    u32x2 w8; w8.x = pk4_fp8(v0[0], v0[1], v0[2], v0[3]); w8.y = pk4_fp8(v1[0], v1[1], v1[2], v1[3]); *(u32x2*)(M8 + (size_t)row * D + col) = w8; } }
    }
};

struct EpiResid {
    static constexpr bool PERM = true, AFTER_DRAIN = false;
    const float* X; bf16* X1; float descale;
    __device__ __forceinline__ void operator()(const f32x4 (&acc)[2][2][4][2], const Unit& u, int wr, int wc, int fr, int fq) const {
        const int rbase = u.pm * 256 + wr * 64 + fr, cb = u.pn * 256 + wc * 64 + 8 * fq;
#pragma unroll
        for (int ai = 0; ai < 2; ++ai)
#pragma unroll
            for (int m = 0; m < 4; ++m) { const size_t ro = (size_t)(rbase + ai * 128 + m * 16) * D;
#pragma unroll
                for (int bj = 0; bj < 2; ++bj) { const int col = cb + bj * 32;
                    const f32x4 v0 = *(const f32x4*)(X + ro + col) + acc[ai][bj][m][0] * descale, v1 = *(const f32x4*)(X + ro + col + 4) + acc[ai][bj][m][1] * descale;
                    store8(X1 + ro + col, v0, v1); } }
    }
};

struct EpiMoe1 {
    static constexpr bool PERM = true, AFTER_DRAIN = false;
    bf16* ACT; const float* b1; int dry; const int* RT2; const LAS int* tab;
    __device__ __forceinline__ void arows(const Unit& u, int& sbase, int& nvalid) const { const int e = u.pn >> 4, pml = u.pm - tab[e]; sbase = e * 16384 + pml * 256; nvalid = tab[64 + e] - pml * 256; }
    __device__ __forceinline__ int npre(int wid) const { return wid < 4 ? 2 : 0; }
    __device__ __forceinline__ void prefetch(const Unit& u, LAS unsigned char* slot, int wid, int lane) const {
        if (wid < 4) { const int e = u.pn >> 4, pnl = u.pn & 15, i = wid * 64 + lane;
            __builtin_amdgcn_global_load_lds((const unsigned*)(b1 + (size_t)e * 4096 + (i >> 7) * 2048 + pnl * 128 + (i & 127)), (LAS unsigned*)(slot + wid * 256), 4, 0, 0); }
    }
    __device__ __forceinline__ void operator()(const f32x4 (&acc)[2][2][4][2], const Unit& u, int wr, int wc, int fr, int fq, const LAS unsigned char* slot) const {
        if (dry) return;
        const int pnl = u.pn & 15, rbase = u.pm * 256 + wr * 64 + fr, col = pnl * 128 + wc * 32 + 8 * fq;
        const LAS float* bg = (const LAS float*)slot + wc * 32 + 8 * fq; const LAS float* bl = bg + 128;
        const f32x4 bg0 = *(const LAS f32x4*)bg, bg1 = *(const LAS f32x4*)(bg + 4), bl0 = *(const LAS f32x4*)bl, bl1 = *(const LAS f32x4*)(bl + 4);
        const f32x2 S1 = {0.03125f, 0.03125f}, S8 = {0.25f, 0.25f}, CE = {-2.4554669595930156f, -2.4554669595930156f}, ONE = {1.0f, 1.0f};
        f32x2 bgp[4], blp[4];
        bgp[0] = (f32x2){bg0[0], bg0[1]}; bgp[1] = (f32x2){bg0[2], bg0[3]}; bgp[2] = (f32x2){bg1[0], bg1[1]}; bgp[3] = (f32x2){bg1[2], bg1[3]};
        blp[0] = (f32x2){bl0[0], bl0[1]} * 8.0f + 8.0f; blp[1] = (f32x2){bl0[2], bl0[3]} * 8.0f + 8.0f; blp[2] = (f32x2){bl1[0], bl1[1]} * 8.0f + 8.0f; blp[3] = (f32x2){bl1[2], bl1[3]} * 8.0f + 8.0f;
#pragma unroll
        for (int ai = 0; ai < 2; ++ai)
#pragma unroll
            for (int m = 0; m < 4; ++m) { const int row = rbase + ai * 128 + m * 16;
                f32x2 o[4];
#pragma unroll
                for (int q = 0; q < 4; ++q) { const f32x4 ag = acc[ai][0][m][q >> 1], al = acc[ai][1][m][q >> 1];
                    const f32x2 agp = (q & 1) ? (f32x2){ag[2], ag[3]} : (f32x2){ag[0], ag[1]}, alp = (q & 1) ? (f32x2){al[2], al[3]} : (f32x2){al[0], al[1]};
                    const f32x2 G = __builtin_elementwise_fma(agp, S1, bgp[q]), L = __builtin_elementwise_fma(alp, S8, blp[q]);
                    const f32x2 xg = {fminf(G[0], 7.0f), fminf(G[1], 7.0f)};
                    const f32x2 xl = {fminf(fmaxf(L[0], -48.0f), 64.0f), fminf(fmaxf(L[1], -48.0f), 64.0f)};
                    const f32x2 ea = xg * CE;
                    const f32x2 en = (f32x2){__builtin_amdgcn_exp2f(ea[0]), __builtin_amdgcn_exp2f(ea[1])} + ONE;
                    const f32x2 rc = {__builtin_amdgcn_rcpf(en[0]), __builtin_amdgcn_rcpf(en[1])};
                    o[q] = (xg * rc) * xl; }
                u32x2 w8; w8.x = pk4_fp8(o[0][0], o[0][1], o[1][0], o[1][1]); w8.y = pk4_fp8(o[2][0], o[2][1], o[3][0], o[3][1]);
                *(u32x2*)((unsigned char*)ACT + (size_t)row * FF + col) = w8; }
    }
};

struct EpiMoe2 {
    static constexpr bool PERM = true, AFTER_DRAIN = false;
    bf16* OUTK; const float* b2; const int* ROWTOK; const float* ROWGATE; int dry; const LAS int* tab;
    __device__ __forceinline__ int npre(int wid) const { return wid < 4 ? 2 : 1; }
    __device__ __forceinline__ void prefetch(const Unit& u, LAS unsigned char* slot, int wid, int lane) const {
        const int e = u.pn >> 3, pnl = u.pn & 7, i = (wid & 3) * 64 + lane; const size_t sb = (size_t)e * 16384 + (size_t)(u.pm - tab[e]) * 256;
        if (wid < 4) { __builtin_amdgcn_global_load_lds((const unsigned*)(b2 + (size_t)e * D + pnl * 256 + i), (LAS unsigned*)(slot + wid * 256), 4, 0, 0);
                       __builtin_amdgcn_global_load_lds((const unsigned*)(ROWGATE + sb + i), (LAS unsigned*)(slot + 2048 + wid * 256), 4, 0, 0); }
        else __builtin_amdgcn_global_load_lds((const unsigned*)(ROWTOK + sb + i), (LAS unsigned*)(slot + 1024 + (wid & 3) * 256), 4, 0, 0);
    }
    __device__ __forceinline__ void operator()(const f32x4 (&acc)[2][2][4][2], const Unit& u, int wr, int wc, int fr, int fq, const LAS unsigned char* slot) const {
        if (dry) return;
        const int pnl = u.pn & 7, cb = pnl * 256 + wc * 64 + 8 * fq, e_ = u.pn >> 3, nvalid = tab[64 + e_] - (u.pm - tab[e_]) * 256;
        f32x4 bv[2][2];
#pragma unroll
        for (int bj = 0; bj < 2; ++bj) { const LAS float* bp = (const LAS float*)slot + wc * 64 + 8 * fq + bj * 32; bv[bj][0] = *(const LAS f32x4*)bp; bv[bj][1] = *(const LAS f32x4*)(bp + 4); }
        int pr[8]; float gr[8];
#pragma unroll
        for (int i = 0; i < 8; ++i) { const int rl = wr * 64 + fr + (i >> 2) * 128 + (i & 3) * 16; pr[i] = ((const LAS int*)(slot + 1024))[rl]; gr[i] = ((const LAS float*)(slot + 2048))[rl]; }
#pragma unroll
        for (int ai = 0; ai < 2; ++ai)
#pragma unroll
            for (int m = 0; m < 4; ++m) { const int p = pr[ai * 4 + m];
                if (wr * 64 + fr + ai * 128 + m * 16 < nvalid) { const float gt = gr[ai * 4 + m] * 32.0f;
#pragma unroll
                    for (int bj = 0; bj < 2; ++bj) { const f32x4 v0 = (acc[ai][bj][m][0] * 0.00390625f + bv[bj][0]) * gt, v1 = (acc[ai][bj][m][1] * 0.00390625f + bv[bj][1]) * gt;   { u32x2 w8; w8.x = pk4_fp8(v0[0], v0[1], v0[2], v0[3]); w8.y = pk4_fp8(v1[0], v1[1], v1[2], v1[3]); *(u32x2*)((unsigned char*)OUTK + (size_t)p * D + cb + bj * 32) = w8; } } } }
    }
};

struct MoeOrder {
    const LAS int* toff; int npn, G, c;
    __device__ __forceinline__ bool next(int i, Unit& u) const {
        const int L0 = i * G + c, NT = toff[32], NU = NT * npn;
        if (L0 >= NU) return false;
        const int q8 = NU >> 3, r8 = NU & 7, xcd = L0 & 7, off = L0 >> 3;
        const int L = (xcd < r8 ? xcd * (q8 + 1) : r8 * (q8 + 1) + (xcd - r8) * q8) + off;
        int e = 0;
#pragma unroll 1
        for (int j = 1; j < 32; ++j) e += (L >= toff[j] * npn) ? 1 : 0;
        const int t0 = toff[e], te = toff[e + 1] - t0, rem = L - t0 * npn;
        const int pnl = rem / te, pml = rem - pnl * te;
        u.pm = __builtin_amdgcn_readfirstlane(t0 + pml); u.pn = __builtin_amdgcn_readfirstlane(e * npn + pnl); return true;
    }
    __device__ __forceinline__ void a_ready(const Unit&) const {}
    __device__ __forceinline__ void done(const Unit&) const {}
};

__device__ __forceinline__ void tr_item(const float* src, int ldn, int k0, int c0, bf16* dst, size_t dstrow0, int K, LAS float* scr, int lane) {
    f32x4 v[8];
#pragma unroll
    for (int i = 0; i < 8; ++i) v[i] = *(const GAS f32x4*)(src + (size_t)(k0 + 8 * i + (lane >> 3)) * ldn + c0 + 4 * (lane & 7));
#pragma unroll
    for (int i = 0; i < 8; ++i) { LAS float* p = scr + (8 * i + (lane >> 3)) * 33 + 4 * (lane & 7); p[0] = v[i].x; p[1] = v[i].y; p[2] = v[i].z; p[3] = v[i].w; }
    LDS_WAIT(); asm volatile("" ::: "memory");
    const int c = lane & 7;
#pragma unroll
    for (int j = 0; j < 4; ++j) { const int n = (lane >> 3) + 8 * j; const LAS float* s = scr + (8 * c) * 33 + n;
        u32x4 o; o.x = pk2(s[0 * 33], s[1 * 33]); o.y = pk2(s[2 * 33], s[3 * 33]); o.z = pk2(s[4 * 33], s[5 * 33]); o.w = pk2(s[6 * 33], s[7 * 33]);
        *(GAS u32x4*)(dst + (dstrow0 + n) * (size_t)K + k0 + 8 * c) = o; }
    LDS_WAIT(); asm volatile("" ::: "memory");
}
__device__ __forceinline__ void tr8_tile(const float* src, int ldn, int k0, int c0, unsigned char* dst, size_t dstrow0, int K, float sc, LAS float* scr, int lane) {
    f32x4 v[16];
#pragma unroll
    for (int i = 0; i < 16; ++i) v[i] = *(const GAS f32x4*)(src + (size_t)(k0 + 8 * i + (lane >> 3)) * ldn + c0 + 4 * (lane & 7));
#pragma unroll
    for (int i = 0; i < 16; ++i) { LAS float* p = scr + (8 * i + (lane >> 3)) * 33 + 4 * (lane & 7); p[0] = v[i].x * sc; p[1] = v[i].y * sc; p[2] = v[i].z * sc; p[3] = v[i].w * sc; }
    LDS_WAIT(); asm volatile("" ::: "memory");
    const int n = lane & 31;
#pragma unroll
    for (int j = 0; j < 4; ++j) { const int kc = (lane >> 5) + 2 * j; const LAS float* s = scr + (16 * kc) * 33 + n;
        u32x4 o; o.x = pk4_fp8(s[0 * 33], s[1 * 33], s[2 * 33], s[3 * 33]); o.y = pk4_fp8(s[4 * 33], s[5 * 33], s[6 * 33], s[7 * 33]);
        o.z = pk4_fp8(s[8 * 33], s[9 * 33], s[10 * 33], s[11 * 33]); o.w = pk4_fp8(s[12 * 33], s[13 * 33], s[14 * 33], s[15 * 33]);
        *(GAS u32x4*)(dst + (dstrow0 + n) * (size_t)K + k0 + 16 * kc) = o; }
    LDS_WAIT(); asm volatile("" ::: "memory");
}
__device__ __forceinline__ void tr_item8(const float* src, int ldn, int k0, int c0, unsigned char* dst, size_t dstrow0, int K, float sc, LAS float* scr, int lane) {
    f32x4 v[8];
#pragma unroll
    for (int i = 0; i < 8; ++i) v[i] = *(const GAS f32x4*)(src + (size_t)(k0 + 8 * i + (lane >> 3)) * ldn + c0 + 4 * (lane & 7));
#pragma unroll
    for (int i = 0; i < 8; ++i) { LAS float* p = scr + (8 * i + (lane >> 3)) * 33 + 4 * (lane & 7); p[0] = v[i].x * sc; p[1] = v[i].y * sc; p[2] = v[i].z * sc; p[3] = v[i].w * sc; }
    LDS_WAIT(); asm volatile("" ::: "memory");
    const int c = lane & 7;
#pragma unroll
    for (int j = 0; j < 4; ++j) { const int n = (lane >> 3) + 8 * j; const LAS float* s = scr + (8 * c) * 33 + n;
        u32x2 o; o.x = pk4_fp8(s[0 * 33], s[1 * 33], s[2 * 33], s[3 * 33]); o.y = pk4_fp8(s[4 * 33], s[5 * 33], s[6 * 33], s[7 * 33]);
        *(GAS u32x2*)(dst + (dstrow0 + n) * (size_t)K + k0 + 8 * c) = o; }
    LDS_WAIT(); asm volatile("" ::: "memory");
}
__device__ __forceinline__ void rms_row_to_bf16(const float* xrow, const float* g, bf16* orow, int lane) {
    f32x4 v[8]; float s = 0.f;
#pragma unroll
    for (int j = 0; j < 8; ++j) { v[j] = *(const GAS f32x4*)(xrow + 4 * lane + 256 * j); s += (v[j].x * v[j].x + v[j].y * v[j].y) + (v[j].z * v[j].z + v[j].w * v[j].w); }
    const float rs = 1.0f / sqrtf(wave_sum(s) * (1.0f / D) + NORM_EPS);
#pragma unroll
    for (int j = 0; j < 8; ++j) { const f32x4 gv = *(const GAS f32x4*)(g + 4 * lane + 256 * j); u32x2 w; w.x = pk2(v[j].x * rs * gv.x, v[j].y * rs * gv.y); w.y = pk2(v[j].z * rs * gv.z, v[j].w * rs * gv.w);
        *(GAS u32x2*)(orow + 4 * lane + 256 * j) = w; }
}
__device__ __forceinline__ void p0_prologue(const Ptrs& P, unsigned char* ws, LAS unsigned char* lds, int tid, int wave, int lane) {
    LAS float* scr = (LAS float*)(lds + wave * 8704);
    const int gw = blockIdx.x * NWAVES + wave, NGW = gridDim.x * NWAVES;
    constexpr int I_IN = 32 * 377, I_OR = 16 * 64, I_OA = 8 * 64, I_OUT = 32 * 64;
    constexpr int NITEMS = I_IN + I_OR + I_OA + I_OUT;
    for (int it = gw; it < NITEMS; it += NGW) {
        int r = it;
        if (r < I_IN) { const int kb = r / 377, nb = r % 377, c0 = 32 * nb;
            if (c0 >= 3072) tr_item8(P.w_in, IN_W, 64 * kb, c0, ws + WS_WG8B, (size_t)((c0 < SHIFT_W ? c0 : c0 + 224) - 3072), D, 32.0f, scr, lane);
            else tr_item(P.w_in, IN_W, 64 * kb, c0, P.WIN, (size_t)(c0 < SHIFT_W ? c0 : c0 + 224), D, scr, lane);
            continue; }
        r -= I_IN;
        if (r < I_OR) { const int kb = r >> 6, nb = r & 63; tr_item(P.w_o_rwkv, D, 64 * kb, 32 * nb, P.WOR, (size_t)32 * nb, 1536, scr, lane); continue; }
        r -= I_OR;
        if (r < I_OA) { const int kb = r >> 6, nb = r & 63; tr_item(P.w_o_attn, D, 64 * kb, 32 * nb, P.WOR + 1024, (size_t)32 * nb, 1536, scr, lane); continue; }
        r -= I_OA;
        { const int kb = r >> 6, nb = r & 63; tr_item8(P.w_out, D, 64 * kb, 32 * nb, (unsigned char*)P.WOUT, (size_t)32 * nb, D, 32.0f, scr, lane); }
    }
    { const int gt = blockIdx.x * NTHREADS + tid, NGT = gridDim.x * NTHREADS; GAS u32x4* z = (GAS u32x4*)(ws + WS_WG8B + (size_t)(SHIFT_W - 3072) * D);
      for (int i = gt; i < 224 * D / 16; i += NGT) z[i] = (u32x4){0u, 0u, 0u, 0u}; }
    { const int gt = blockIdx.x * NTHREADS + tid, NGT = gridDim.x * NTHREADS;
      for (int i = gt; i < 1024 * 64; i += NGT) { const int n = i >> 6, k = i & 63; P.LW[i] = (bf16)f2bf(P.w2_decay[k * RW + n]); P.LA[i] = (bf16)f2bf(P.a2_iclr[k * RW + n]); }
      for (int i = gt; i < 1024 * 160; i += NGT) { const int n = i / 160, k = i - n * 160; P.LG[i] = (bf16)f2bf(P.g2_gate[k * RW + n]); } }
    { const int gt = blockIdx.x * NTHREADS + tid, NGT = gridDim.x * NTHREADS;
      for (int i = gt; i < NE * D; i += NGT) { const int e = i >> 11, k = i & 2047; const float v = P.w_router[(size_t)k * NE + e] * P.norm_ffn[k]; const unsigned h = f2bf(v); P.WRH[i] = (bf16)h; P.WRL[i] = (bf16)f2bf(v - bf2f((bf16)h)); } }
    for (int m = gw; m < T; m += NGW) { const float* xrow = P.x + (size_t)m * D; f32x4 v[8]; float sq = 0.f;
#pragma unroll
        for (int j = 0; j < 8; ++j) { v[j] = *(const GAS f32x4*)(xrow + 4 * lane + 256 * j); sq += (v[j].x * v[j].x + v[j].y * v[j].y) + (v[j].z * v[j].z + v[j].w * v[j].w); }
        const float rs = 1.0f / sqrtf(wave_sum(sq) * (1.0f / D) + NORM_EPS); unsigned char* h8 = ws + WS_H8 + (size_t)m * D; bf16* hb = P.H + (size_t)m * D;
#pragma unroll
        for (int j = 0; j < 8; ++j) { const f32x4 gv = *(const GAS f32x4*)(P.norm_mix + 4 * lane + 256 * j); const float a0 = v[j].x * rs * gv.x, a1 = v[j].y * rs * gv.y, a2 = v[j].z * rs * gv.z, a3 = v[j].w * rs * gv.w;
            *(GAS unsigned*)(h8 + 4 * lane + 256 * j) = pk4_fp8(a0, a1, a2, a3); u32x2 w; w.x = pk2(a0, a1); w.y = pk2(a2, a3); *(GAS u32x2*)(hb + 4 * lane + 256 * j) = w; } }
    { const int gt = blockIdx.x * NTHREADS + tid, NGT = gridDim.x * NTHREADS;
      for (int i = gt; i < T * 16; i += NGT) { const int m = i >> 4, f = i & 15; const float inv = exp2f(-(float)f * (18.931568569324174f / 16.0f));
          const float ang = (float)P.positions[m] * inv; double rev = (double)ang * 0.15915494309189535; rev -= floor(rev); const float rv = (float)rev; const float sn = __builtin_amdgcn_sinf(rv), cs = __builtin_amdgcn_cosf(rv); P.ROT[(size_t)m * 32 + f] = cs; P.ROT[(size_t)m * 32 + 16 + f] = sn; } }
}

template <int CTRL> __device__ __forceinline__ float dppf(float x) { return __builtin_bit_cast(float, __builtin_amdgcn_mov_dpp(__builtin_bit_cast(int, x), CTRL, 0xf, 0xf, true)); }
__device__ __forceinline__ float sum8(float x) { x += dppf<0xB1>(x); x += dppf<0x4E>(x); x += dppf<0x141>(x); return x; }
__device__ __forceinline__ f32x4 mfma16(bf16x8 a, bf16x8 b, f32x4 c) { return __builtin_amdgcn_mfma_f32_16x16x32_bf16(a, b, c, 0, 0, 0); }
__device__ __forceinline__ u32x4 pack8s(const float* p) { u32x4 w; w.x = pk2(p[0], p[1]); w.y = pk2(p[2], p[3]); w.z = pk2(p[4], p[5]); w.w = pk2(p[6], p[7]); return w; }
__device__ __forceinline__ void p4a_chunk_prep(const Ptrs& P, unsigned char* ws, LAS unsigned char* lds, int tid, int wave, int lane, int u64) {
    LAS unsigned char* wl = lds + wave * 16384;
    LAS unsigned char* AH = wl, *BH = wl + 2048, *KH = wl + 4096, *RH = wl + 6144;
    LAS unsigned char* AT = wl + 8192, *RT = wl + 10240, *VTl = wl + 12288;
    LAS unsigned char* MX = wl + 14336;
    LAS unsigned char* WTl = wl, *U0Tl = wl + 2048, *PT = wl + 8192; LAS float* LmT = (LAS float*)(wl + 4096);
    const int fr = lane & 15, fq = lane >> 4, fq1 = fq & 1;
    unsigned char* s1 = ws + WS_S1;
    for (int jj = 0; jj < 8; ++jj) {
        const int j = wave * 8 + jj, h = j & 15, b = u64 >> 6, c16 = (u64 & 63) * 4 + (j >> 4), bh = b * 16 + h, uidx = (bh << 8) + c16;
        const size_t gbase = ((size_t)b * SEQ + (size_t)c16 * 16) * RW + h * 64 + lane;
        float av[16], bv[16], kv[16], rv[16], vv[16];
        {   float wv[16];
#pragma unroll
            for (int t = 0; t < 16; ++t) { const size_t o = gbase + (size_t)t * RW; wv[t] = P.SC[o]; av[t] = bf2f(P.SCH[SH_KK * SC_STRIDE + o]); bv[t] = bf2f(P.SCH[SH_BB * SC_STRIDE + o]);
                kv[t] = bf2f(P.SCH[SH_K * SC_STRIDE + o]); rv[t] = bf2f(P.SCH[SH_R * SC_STRIDE + o]); vv[t] = bf2f(P.SCH[SH_V * SC_STRIDE + o]); }
            float g = 1.0f;
#pragma unroll
            for (int t = 0; t < 16; ++t) { const float gp = g; g *= wv[t]; const float inv = 1.0f / g; av[t] *= gp; bv[t] *= inv; kv[t] *= inv; rv[t] *= g;
                *(LAS unsigned short*)(AH + t * 128 + lane * 2) = (unsigned short)f2bf(av[t]); *(LAS unsigned short*)(BH + t * 128 + lane * 2) = (unsigned short)f2bf(bv[t]);
                *(LAS unsigned short*)(KH + t * 128 + lane * 2) = (unsigned short)f2bf(kv[t]); *(LAS unsigned short*)(RH + t * 128 + lane * 2) = (unsigned short)f2bf(rv[t]); }
            *(LAS u32x4*)(AT + lane * 32) = pack8s(av); *(LAS u32x4*)(AT + lane * 32 + 16) = pack8s(av + 8);
            *(LAS u32x4*)(RT + lane * 32) = pack8s(rv); *(LAS u32x4*)(RT + lane * 32 + 16) = pack8s(rv + 8);
            const u32x4 v0 = pack8s(vv), v1 = pack8s(vv + 8);
            *(LAS u32x4*)(VTl + lane * 32) = v0; *(LAS u32x4*)(VTl + lane * 32 + 16) = v1;
            GAS u32x4* gv = (GAS u32x4*)(s1 + S1_VT + ((size_t)uidx * 64 + lane) * 32); gv[0] = v0; gv[1] = v1;
#pragma unroll
            for (int t = 0; t < 16; ++t) { bv[t] *= g; kv[t] *= g; }
            GAS u32x4* gb = (GAS u32x4*)(s1 + S1_BT + ((size_t)uidx * 64 + lane) * 32); gb[0] = pack8s(bv); gb[1] = pack8s(bv + 8);
            GAS u32x4* gk = (GAS u32x4*)(s1 + S1_KT + ((size_t)uidx * 64 + lane) * 32); gk[0] = pack8s(kv); gk[1] = pack8s(kv + 8);
            *(GAS float*)(s1 + S1_GAM + ((size_t)uidx * 64 + lane) * 4) = g; }
        LDS_WAIT(); asm volatile("" ::: "memory");
        f32x4 lab = {0.f, 0.f, 0.f, 0.f}, lak = lab, mrb = lab, mrk = lab;
#pragma unroll
        for (int ks = 0; ks < 2; ++ks) { const int off = fr * 128 + (32 * ks + 8 * fq) * 2;
            const bf16x8 a = *(const LAS bf16x8*)(AH + off), r_ = *(const LAS bf16x8*)(RH + off), b_ = *(const LAS bf16x8*)(BH + off), k_ = *(const LAS bf16x8*)(KH + off);
            lab = mfma16(a, b_, lab); lak = mfma16(a, k_, lak); mrb = mfma16(r_, b_, mrb); mrk = mfma16(r_, k_, mrk); }
#pragma unroll
        for (int rg = 0; rg < 4; ++rg) { const int t = 4 * fq + rg; const bool lo = fr < t, le = fr <= t; lab[rg] = lo ? lab[rg] : 0.f; lak[rg] = lo ? lak[rg] : 0.f; mrb[rg] = le ? mrb[rg] : 0.f; mrk[rg] = le ? mrk[rg] : 0.f; }
        asm volatile("" ::: "memory");
        *(LAS f32x4*)(LmT + fr * 16 + 4 * fq) = lab;
#pragma unroll
        for (int rg = 0; rg < 4; ++rg) { const int o = ((4 * fq + rg) * 16 + fr) * 2;
            *(LAS unsigned short*)(MX + o) = (unsigned short)f2bf(lak[rg]); *(LAS unsigned short*)(MX + 512 + o) = (unsigned short)f2bf(mrb[rg]); *(LAS unsigned short*)(MX + 1024 + o) = (unsigned short)f2bf(mrk[rg]); }
        LDS_WAIT(); asm volatile("" ::: "memory");
        float Tr[16];
#pragma unroll
        for (int m = 0; m < 16; ++m) Tr[m] = (m == fr) ? 1.0f : 0.0f;
#pragma unroll
        for (int j = 14; j >= 0; --j) { float acc = (j == fr) ? 1.0f : 0.0f;
#pragma unroll
            for (int q = 0; q < 4; ++q) { const f32x4 l4 = *(const LAS f32x4*)(LmT + j * 16 + 4 * q);
#pragma unroll
                for (int e = 0; e < 4; ++e) { const int m = 4 * q + e; if (m > j) acc += Tr[m] * l4[e]; } }
            Tr[j] = acc; }
        bf16x8 tfrag;
        { float sel[8];
#pragma unroll
          for (int j = 0; j < 8; ++j) sel[j] = (fq == 0) ? Tr[j] : ((fq == 1) ? Tr[8 + j] : 0.0f);
          tfrag = __builtin_bit_cast(bf16x8, pack8s(sel)); }
        f32x4 wacc[4];
#pragma unroll
        for (int nt = 0; nt < 4; ++nt) wacc[nt] = mfma16(tfrag, *(const LAS bf16x8*)(AT + (16 * nt + fr) * 32 + fq1 * 16), (f32x4){0.f, 0.f, 0.f, 0.f});
        asm volatile("" ::: "memory");
        { bf16* gwh = (bf16*)(s1 + S1_WH) + (size_t)uidx * 1024;
#pragma unroll
          for (int nt = 0; nt < 4; ++nt) { u32x2 w2; w2.x = pk2(wacc[nt][0], wacc[nt][1]); w2.y = pk2(wacc[nt][2], wacc[nt][3]); *(LAS u32x2*)(WTl + ((16 * nt + fr) * 16 + 4 * fq) * 2) = w2;
#pragma unroll
              for (int rg = 0; rg < 4; ++rg) gwh[(4 * fq + rg) * 64 + 16 * nt + fr] = (bf16)f2bf(wacc[nt][rg]); } }
        bf16x8 lkf, mbf, mkf, idf;
        { const u32x4 z4 = {0u, 0u, 0u, 0u};
          const u32x4 lk4 = *(const LAS u32x4*)(MX + (fr * 16 + 8 * fq1) * 2), mb4 = *(const LAS u32x4*)(MX + 512 + (fr * 16 + 8 * fq1) * 2), mk4 = *(const LAS u32x4*)(MX + 1024 + (fr * 16 + 8 * fq1) * 2);
          lkf = __builtin_bit_cast(bf16x8, (fq < 2) ? lk4 : z4);
          mbf = __builtin_bit_cast(bf16x8, mb4);
          mkf = __builtin_bit_cast(bf16x8, mk4);
          u32x4 id4; const int d = fr - 8 * fq1;
          id4.x = (d == 0 ? 0x3f80u : 0u) | (d == 1 ? 0x3f800000u : 0u); id4.y = (d == 2 ? 0x3f80u : 0u) | (d == 3 ? 0x3f800000u : 0u);
          id4.z = (d == 4 ? 0x3f80u : 0u) | (d == 5 ? 0x3f800000u : 0u); id4.w = (d == 6 ? 0x3f80u : 0u) | (d == 7 ? 0x3f800000u : 0u);
          idf = __builtin_bit_cast(bf16x8, id4); }
        LDS_WAIT(); asm volatile("" ::: "memory");
        f32x4 pacc[4];
#pragma unroll
        for (int nt = 0; nt < 4; ++nt) pacc[nt] = mfma16(lkf, *(const LAS bf16x8*)(VTl + (16 * nt + fr) * 32 + fq1 * 16), (f32x4){0.f, 0.f, 0.f, 0.f});
        asm volatile("" ::: "memory");
#pragma unroll
        for (int nt = 0; nt < 4; ++nt) { u32x2 w2; w2.x = pk2(pacc[nt][0], pacc[nt][1]); w2.y = pk2(pacc[nt][2], pacc[nt][3]); *(LAS u32x2*)(PT + ((16 * nt + fr) * 16 + 4 * fq) * 2) = w2; }
        LDS_WAIT(); asm volatile("" ::: "memory");
        f32x4 uacc[4];
#pragma unroll
        for (int nt = 0; nt < 4; ++nt) uacc[nt] = mfma16(tfrag, *(const LAS bf16x8*)(PT + (16 * nt + fr) * 32 + fq1 * 16), (f32x4){0.f, 0.f, 0.f, 0.f});
        asm volatile("" ::: "memory");
#pragma unroll
        for (int nt = 0; nt < 4; ++nt) { u32x2 w2; w2.x = pk2(uacc[nt][0], uacc[nt][1]); w2.y = pk2(uacc[nt][2], uacc[nt][3]); *(LAS u32x2*)(U0Tl + ((16 * nt + fr) * 16 + 4 * fq) * 2) = w2;
            { u32x2 w; w.x = pk2(uacc[nt][0], uacc[nt][1]); w.y = pk2(uacc[nt][2], uacc[nt][3]); *(GAS u32x2*)(s1 + S1_U0T + (((size_t)uidx * 64 + 16 * nt + fr) * 16 + 4 * fq) * 2) = w; } }
        LDS_WAIT(); asm volatile("" ::: "memory");
        { const bf16x8 aq = (fq < 2) ? mbf : idf, ay = (fq < 2) ? mbf : mkf;
          bf16* gqh = (bf16*)(s1 + S1_QH) + (size_t)uidx * 1024;
#pragma unroll
          for (int nt = 0; nt < 4; ++nt) { const int row = 16 * nt + fr;
              const bf16x8 bq = *(const LAS bf16x8*)(((fq < 2) ? WTl : RT) + row * 32 + fq1 * 16), by = *(const LAS bf16x8*)(((fq < 2) ? U0Tl : VTl) + row * 32 + fq1 * 16);
              const f32x4 qa = mfma16(aq, bq, (f32x4){0.f, 0.f, 0.f, 0.f}), ya = mfma16(ay, by, (f32x4){0.f, 0.f, 0.f, 0.f});
#pragma unroll
              for (int rg = 0; rg < 4; ++rg) gqh[(4 * fq + rg) * 64 + row] = (bf16)f2bf(qa[rg]);
              { u32x2 w; w.x = pk2(ya[0], ya[1]); w.y = pk2(ya[2], ya[3]); *(GAS u32x2*)(s1 + S1_Y0T + (((size_t)uidx * 64 + row) * 16 + 4 * fq) * 2) = w; } } }
        LDS_WAIT(); asm volatile("" ::: "memory");
    }
}

__device__ __forceinline__ void p2_rwkv_prep(const Ptrs& P, unsigned char* ws, LAS unsigned char* lds, int tid, int wave, int lane) {
    constexpr int AWP = 144, AGP = 336, SLP = 196;
    LAS unsigned char* AW = lds; LAS unsigned char* AA = lds + 9216; LAS unsigned char* AG = lds + 18432; LAS float* slab = (LAS float*)(lds + 40960);
    const int fr = lane & 15, fq = lane >> 4;
    for (int u = blockIdx.x; u < T / 64; u += gridDim.x) {
        const int m0 = u * 64;
        __syncthreads();
        for (int item = tid; item < 64 * 36; item += NTHREADS) { const int tk = item / 36, c8 = item - tk * 36, m = m0 + tk, col0 = 3072 + 8 * c8;
            const u32x4 pw = *(const GAS u32x4*)(P.ZP + (size_t)m * ZPW + col0); u32x4 qw = {0u, 0u, 0u, 0u}; if (m % SEQ) qw = *(const GAS u32x4*)(P.ZP + (size_t)(m - 1) * ZPW + col0);
            f32x4 p0, p1, q0, q1; unpack8(pw, p0, p1); unpack8(qw, q0, q1);
            const f32x4 mu0 = *(const GAS f32x4*)(P.shift_mu + col0), mu1 = *(const GAS f32x4*)(P.shift_mu + col0 + 4);
            f32x4 z0 = p0 + (q0 - p0) * mu0, z1 = p1 + (q1 - p1) * mu1;
            if (c8 < 8) {
#pragma unroll
                for (int j = 0; j < 4; ++j) { z0[j] = tanhf(z0[j]); z1[j] = tanhf(z1[j]); }
                *(LAS u32x4*)(AW + tk * AWP + c8 * 16) = pack8(z0, z1);
            } else if (c8 < 16) { *(LAS u32x4*)(AA + tk * AWP + (c8 - 8) * 16) = pack8(z0, z1);
            } else {
#pragma unroll
                for (int j = 0; j < 4; ++j) { z0[j] = sigmoidf_(z0[j]); z1[j] = sigmoidf_(z1[j]); }
                *(LAS u32x4*)(AG + tk * AGP + (c8 - 16) * 16) = pack8(z0, z1); } }
        __syncthreads();
        const int ct = wave & 3, tt0 = (wave >> 2) * 2;
        const int etk = tid >> 3, ec8 = tid & 7, em = m0 + etk; const bool ehasp = (em % SEQ) != 0;
        u32x4 zc[3], zq[3]; bf16x8 fw[2], fa[2], fg[5];
#define P2_PREF_M(h_) do { const int chrow_ = (h_) * 64 + ct * 16 + fr; \
            _Pragma("unroll") for (int ks = 0; ks < 2; ++ks) { fw[ks] = *(const GAS bf16x8*)(P.LW + (size_t)chrow_ * 64 + ks * 32 + 8 * fq); fa[ks] = *(const GAS bf16x8*)(P.LA + (size_t)chrow_ * 64 + ks * 32 + 8 * fq); } \
            _Pragma("unroll") for (int ks = 0; ks < 5; ++ks) fg[ks] = *(const GAS bf16x8*)(P.LG + (size_t)chrow_ * 160 + ks * 32 + 8 * fq); } while (0)
#define P2_PREF_E(h_) do { const int ch0_ = (h_) * 64 + 8 * ec8; const bf16* zp_ = P.ZP + (size_t)em * ZPW + ch0_; \
            _Pragma("unroll") for (int sg = 0; sg < 3; ++sg) { zc[sg] = *(const GAS u32x4*)(zp_ + sg * 1024); zq[sg] = (u32x4){0u, 0u, 0u, 0u}; if (ehasp) zq[sg] = *(const GAS u32x4*)(zp_ - ZPW + sg * 1024); \
                } } while (0)
        P2_PREF_E(0);
#pragma unroll 1
        for (int h = 0; h < NH; ++h) {
            { f32x4 acc[2][3]; P2_PREF_M(h);
#pragma unroll
              for (int t = 0; t < 2; ++t)
#pragma unroll
                  for (int kd = 0; kd < 3; ++kd) acc[t][kd] = (f32x4){0.f, 0.f, 0.f, 0.f};
#pragma unroll
              for (int ks = 0; ks < 2; ++ks)
#pragma unroll
                  for (int t = 0; t < 2; ++t) { const int tok = (tt0 + t) * 16 + fr;
                      acc[t][0] = mfma16(fw[ks], *(const LAS bf16x8*)(AW + tok * AWP + (ks * 32 + 8 * fq) * 2), acc[t][0]);
                      acc[t][1] = mfma16(fa[ks], *(const LAS bf16x8*)(AA + tok * AWP + (ks * 32 + 8 * fq) * 2), acc[t][1]); }
#pragma unroll
              for (int ks = 0; ks < 5; ++ks)
#pragma unroll
                  for (int t = 0; t < 2; ++t) { const int tok = (tt0 + t) * 16 + fr; acc[t][2] = mfma16(fg[ks], *(const LAS bf16x8*)(AG + tok * AGP + (ks * 32 + 8 * fq) * 2), acc[t][2]); }
#pragma unroll
              for (int t = 0; t < 2; ++t)
#pragma unroll
                  for (int kd = 0; kd < 3; ++kd) *(LAS f32x4*)(slab + ((tt0 + t) * 16 + fr) * SLP + kd * 64 + ct * 16 + 4 * fq) = acc[t][kd]; }
            __syncthreads();
            { const int ch0 = h * 64 + 8 * ec8; const LAS float* sl = slab + etk * SLP + 8 * ec8;
              float rr[8], kv[8], vv[8];
#pragma unroll
              for (int sg = 0; sg < 3; ++sg) { f32x4 p0, p1, q0, q1; unpack8(zc[sg], p0, p1); unpack8(zq[sg], q0, q1);
                  const f32x4 mu0 = *(const GAS f32x4*)(P.shift_mu + sg * 1024 + ch0), mu1 = *(const GAS f32x4*)(P.shift_mu + sg * 1024 + ch0 + 4);
                  const f32x4 z0 = p0 + (q0 - p0) * mu0, z1 = p1 + (q1 - p1) * mu1;
#pragma unroll
                  for (int j = 0; j < 4; ++j) { if (sg == 0) { rr[j] = z0[j]; rr[4 + j] = z1[j]; } else if (sg == 1) { kv[j] = z0[j]; kv[4 + j] = z1[j]; } else { vv[j] = z0[j]; vv[4 + j] = z1[j]; } } }
              float dec[8], av[8], gv[8], kkp[8], kn[8]; float ss = 0.f, bon = 0.f;
#pragma unroll
              for (int q = 0; q < 2; ++q) { const f32x4 wr_ = *(const LAS f32x4*)(sl + 4 * q), ap = *(const LAS f32x4*)(sl + 64 + 4 * q), gg = *(const LAS f32x4*)(sl + 128 + 4 * q);
                  const f32x4 w0v = *(const GAS f32x4*)(P.w0 + ch0 + 4 * q), a0v = *(const GAS f32x4*)(P.a0 + ch0 + 4 * q), kkv = *(const GAS f32x4*)(P.k_k + ch0 + 4 * q), kav = *(const GAS f32x4*)(P.k_a + ch0 + 4 * q), rkv = *(const GAS f32x4*)(P.r_k + ch0 + 4 * q);
#pragma unroll
                  for (int j = 0; j < 4; ++j) { const int i = 4 * q + j;
                      dec[i] = __expf(-0.6065306597126334f * sigmoidf_(w0v[j] + wr_[j])); av[i] = sigmoidf_(a0v[j] + ap[j]); gv[i] = gg[j];
                      kkp[i] = kv[i] * kkv[j]; ss += kkp[i] * kkp[i]; kn[i] = kv[i] * (1.0f + (av[i] - 1.0f) * kav[j]); bon += rr[i] * kn[i] * rkv[j]; } }
              if (h + 1 < NH) P2_PREF_E(h + 1);
              ss = sum8(ss); bon = sum8(bon);
              const float rn = 1.0f / fmaxf(sqrtf(ss), 1e-12f);
              const size_t o = (size_t)em * RW + ch0;
              f32x4 t0, t1;
#pragma unroll
              for (int j = 0; j < 4; ++j) { t0[j] = -kkp[j] * rn; t1[j] = -kkp[4 + j] * rn; }
              *(GAS u32x4*)(P.SCH + SH_KK * SC_STRIDE + o) = pack8(t0, t1);
#pragma unroll
              for (int j = 0; j < 4; ++j) { t0[j] = -t0[j] * av[j]; t1[j] = -t1[j] * av[4 + j]; }
              *(GAS u32x4*)(P.SCH + SH_BB * SC_STRIDE + o) = pack8(t0, t1);
              *(GAS f32x4*)(P.SC + o) = (f32x4){dec[0], dec[1], dec[2], dec[3]}; *(GAS f32x4*)(P.SC + o + 4) = (f32x4){dec[4], dec[5], dec[6], dec[7]};
              *(GAS u32x4*)(P.SCH + SH_K * SC_STRIDE + o) = pack8((f32x4){kn[0], kn[1], kn[2], kn[3]}, (f32x4){kn[4], kn[5], kn[6], kn[7]});
              *(GAS u32x4*)(P.SCH + SH_R * SC_STRIDE + o) = pack8((f32x4){rr[0], rr[1], rr[2], rr[3]}, (f32x4){rr[4], rr[5], rr[6], rr[7]});
              *(GAS u32x4*)(P.SCH + SH_V * SC_STRIDE + o) = pack8((f32x4){vv[0], vv[1], vv[2], vv[3]}, (f32x4){vv[4], vv[5], vv[6], vv[7]});
              *(GAS u32x4*)(P.G + o) = pack8((f32x4){gv[0], gv[1], gv[2], gv[3]}, (f32x4){gv[4], gv[5], gv[6], gv[7]});
              if (ec8 == 0) P.BONUS[(size_t)em * NH + h] = bon; }
            __syncthreads();
        }
#undef P2_PREF_M
#undef P2_PREF_E
        VM_WAIT(); __builtin_amdgcn_fence(__ATOMIC_ACQUIRE, "agent"); VM_WAIT(); __syncthreads();
        p4a_chunk_prep(P, ws, lds, tid, wave, lane, u);
    }
}

template <int N> __device__ __forceinline__ float dpp_shr1(float x) { return __builtin_bit_cast(float, __builtin_amdgcn_update_dpp(0x3f800000, __builtin_bit_cast(int, x), 0x110 + N, 0xf, 0xf, false)); }
__device__ __forceinline__ float sum_fq(float x) {
    auto s = __builtin_amdgcn_permlane16_swap(__float_as_uint(x), __float_as_uint(x), false, false); x = __uint_as_float(s[0]) + __uint_as_float(s[1]);
    auto t = __builtin_amdgcn_permlane32_swap(__float_as_uint(x), __float_as_uint(x), false, false); return __uint_as_float(t[0]) + __uint_as_float(t[1]);
}
__device__ __forceinline__ u32x2 pack4(float a, float b, float c, float d) { u32x2 w; w.x = pk2(a, b); w.y = pk2(c, d); return w; }
__device__ __forceinline__ u32x2 pack4v(float a, float b, float c, float d) { u32x2 w; w.x = pk2v(a, b); w.y = pk2v(c, d); return w; }
__device__ __forceinline__ void p2_fused(const Ptrs& P, unsigned char* ws, LAS unsigned char* lds, int tid, int wave, int lane) {
    constexpr int AWP = 144, AGP = 336;
    LAS unsigned char* AW = lds; LAS unsigned char* AA = lds + 4608; LAS unsigned char* AG = lds + 9216;
    LAS unsigned char* wl = lds + 20480 + wave * 15872;
    LAS unsigned char* AH = wl, *BH = wl + 2048, *KH = wl + 4096, *RH = wl + 6144;
    LAS unsigned char* AT = wl + 8192, *RT = wl + 10240, *VTl = wl + 12288;
    LAS unsigned char* MX = wl + 14336;
    LAS unsigned char* WTl = wl, *U0Tl = wl + 2048, *PT = wl + 8192; LAS float* LmT = (LAS float*)(wl + 4096);
    const int lane0 = lane, fr0 = lane & 15, fq0 = lane >> 4;
    unsigned char* s1 = ws + WS_S1;
    for (int u = blockIdx.x; u < T / 64; u += gridDim.x) {
#pragma unroll 1
      for (int half = 0; half < 2; ++half) {
        const int m0 = u * 64 + half * 32;
        __syncthreads();
        for (int item = tid; item < 32 * 36; item += NTHREADS) { const int tk = item / 36, c8 = item - tk * 36, m = m0 + tk, col0 = 3072 + 8 * c8;
            const u32x4 pw = *(const GAS u32x4*)(P.ZP + (size_t)m * ZPW + col0); u32x4 qw = {0u, 0u, 0u, 0u}; if (m % SEQ) qw = *(const GAS u32x4*)(P.ZP + (size_t)(m - 1) * ZPW + col0);
            f32x4 p0, p1, q0, q1; unpack8(pw, p0, p1); unpack8(qw, q0, q1);
            const f32x4 mu0 = *(const GAS f32x4*)(P.shift_mu + col0), mu1 = *(const GAS f32x4*)(P.shift_mu + col0 + 4);
            f32x4 z0 = p0 + (q0 - p0) * mu0, z1 = p1 + (q1 - p1) * mu1;
            if (c8 < 8) {
#pragma unroll
                for (int j = 0; j < 4; ++j) { z0[j] = tanhf_(z0[j]); z1[j] = tanhf_(z1[j]); }
                *(LAS u32x4*)(AW + tk * AWP + c8 * 16) = pack8(z0, z1);
            } else if (c8 < 16) { *(LAS u32x4*)(AA + tk * AWP + (c8 - 8) * 16) = pack8(z0, z1);
            } else {
#pragma unroll
                for (int j = 0; j < 4; ++j) { z0[j] = sigmoidf_(z0[j]); z1[j] = sigmoidf_(z1[j]); }
                *(LAS u32x4*)(AG + tk * AGP + (c8 - 16) * 16) = pack8(z0, z1); } }
        __syncthreads();
        const int tloc = wave >> 2;
        const int mbase = m0 + tloc * 16, bb_ = mbase / SEQ, c16 = (mbase % SEQ) >> 4;
#pragma unroll 1
        for (int hh = 0; hh < 4; ++hh) {
            int fr = fr0, fq = fq0, lane = lane0; asm volatile("" : "+v"(fr), "+v"(fq), "+v"(lane));
            const int fq1 = fq & 1, m = mbase + fr; const bool hasp = (m % SEQ) != 0;
            const int h = (wave & 3) * 4 + hh, uidx = ((bb_ * 16 + h) << 8) + c16;
            f32x4 accw[4], acca[4], accg[4];
#pragma unroll
            for (int ct = 0; ct < 4; ++ct) { accw[ct] = (f32x4){0.f, 0.f, 0.f, 0.f}; acca[ct] = accw[ct]; accg[ct] = accw[ct]; const int chrow = h * 64 + ct * 16 + fr;
#pragma unroll
                for (int ks = 0; ks < 2; ++ks) { const bf16x8 wf = *(const GAS bf16x8*)(P.LW + (size_t)chrow * 64 + ks * 32 + 8 * fq), af = *(const GAS bf16x8*)(P.LA + (size_t)chrow * 64 + ks * 32 + 8 * fq);
                    accw[ct] = mfma16(wf, *(const LAS bf16x8*)(AW + (tloc * 16 + fr) * AWP + (ks * 32 + 8 * fq) * 2), accw[ct]);
                    acca[ct] = mfma16(af, *(const LAS bf16x8*)(AA + (tloc * 16 + fr) * AWP + (ks * 32 + 8 * fq) * 2), acca[ct]); }
#pragma unroll
                for (int ks = 0; ks < 5; ++ks) { const bf16x8 gf = *(const GAS bf16x8*)(P.LG + (size_t)chrow * 160 + ks * 32 + 8 * fq);
                    accg[ct] = mfma16(gf, *(const LAS bf16x8*)(AG + (tloc * 16 + fr) * AGP + (ks * 32 + 8 * fq) * 2), accg[ct]); } }
            float dec[16], aa[16], kkp[16], kn[16], rr[16]; float ss = 0.f, bon = 0.f;
#pragma unroll
            for (int ct = 0; ct < 4; ++ct) { const int c0 = h * 64 + 16 * ct + 4 * fq; const bf16* zp = P.ZP + (size_t)m * ZPW + c0;
                float cur[3][4], prv[3][4], v4[4];
#pragma unroll
                for (int sg = 0; sg < 3; ++sg) { const u32x2 pw = *(const GAS u32x2*)(zp + sg * 1024); u32x2 qw = {0u, 0u}; if (hasp) qw = *(const GAS u32x2*)(zp - ZPW + sg * 1024);
                    cur[sg][0] = bflo(pw.x); cur[sg][1] = bfhi(pw.x); cur[sg][2] = bflo(pw.y); cur[sg][3] = bfhi(pw.y); prv[sg][0] = bflo(qw.x); prv[sg][1] = bfhi(qw.x); prv[sg][2] = bflo(qw.y); prv[sg][3] = bfhi(qw.y); }
                const f32x4 mur = *(const GAS f32x4*)(P.shift_mu + c0), muk = *(const GAS f32x4*)(P.shift_mu + 1024 + c0), muv = *(const GAS f32x4*)(P.shift_mu + 2048 + c0);
                const f32x4 w0v = *(const GAS f32x4*)(P.w0 + c0), a0v = *(const GAS f32x4*)(P.a0 + c0), kkv = *(const GAS f32x4*)(P.k_k + c0), kav = *(const GAS f32x4*)(P.k_a + c0), rkv = *(const GAS f32x4*)(P.r_k + c0);
#pragma unroll
                for (int rg = 0; rg < 4; ++rg) { const int i = ct * 4 + rg;
                    const float r = cur[0][rg] + (prv[0][rg] - cur[0][rg]) * mur[rg], k = cur[1][rg] + (prv[1][rg] - cur[1][rg]) * muk[rg], v = cur[2][rg] + (prv[2][rg] - cur[2][rg]) * muv[rg];
                    dec[i] = __expf(-0.6065306597126334f * sigmoidf_(w0v[rg] + accw[ct][rg])); aa[i] = sigmoidf_(a0v[rg] + acca[ct][rg]);
                    kkp[i] = k * kkv[rg]; ss += kkp[i] * kkp[i]; kn[i] = k * (1.0f + (aa[i] - 1.0f) * kav[rg]); bon += r * kn[i] * rkv[rg]; rr[i] = r; v4[rg] = v; }
                { const u32x2 vp = pack4v(v4[0], v4[1], v4[2], v4[3]); LAS unsigned char* vt = VTl + (16 * ct + 4 * fq) * 32 + fr * 2;
                  *(LAS unsigned short*)(vt) = (unsigned short)(vp.x & 0xffffu); *(LAS unsigned short*)(vt + 32) = (unsigned short)(vp.x >> 16); *(LAS unsigned short*)(vt + 64) = (unsigned short)(vp.y & 0xffffu); *(LAS unsigned short*)(vt + 96) = (unsigned short)(vp.y >> 16);
                  *(GAS u32x2*)(P.SCH + SH_V * SC_STRIDE + (size_t)m * RW + c0) = vp; }
                *(GAS u32x2*)(P.G + (size_t)m * RW + c0) = pack4(accg[ct][0], accg[ct][1], accg[ct][2], accg[ct][3]); }
            ss = sum_fq(ss); bon = sum_fq(bon);
            const float rn = __builtin_amdgcn_rsqf(fmaxf(ss, 1e-24f));
            if (fq == 0) P.BONUS[(size_t)m * NH + h] = bon;
            asm volatile("" : "+v"(fr), "+v"(fq), "+v"(lane));
            bf16* gbt = (bf16*)(s1 + S1_BT) + (size_t)uidx * 1024 + fr; bf16* gkt = (bf16*)(s1 + S1_KT) + (size_t)uidx * 1024 + fr;
#pragma unroll
            for (int ct = 0; ct < 4; ++ct) { float a4[4], b4[4], k4[4], r4[4], g15[4];
#pragma unroll
                for (int rg = 0; rg < 4; ++rg) { const int i = ct * 4 + rg;
                    float g = dec[i]; g *= dpp_shr1<1>(g); g *= dpp_shr1<2>(g); g *= dpp_shr1<4>(g); g *= dpp_shr1<8>(g);
                    const float gp = dpp_shr1<1>(g), gl = __shfl(g, (lane & 48) | 15), inv = __builtin_amdgcn_rcpf(g);
                    const float kkn = -kkp[i] * rn, bbv = -kkn * aa[i];
                    a4[rg] = kkn * gp; b4[rg] = bbv * inv; k4[rg] = kn[i] * inv; r4[rg] = rr[i] * g; g15[rg] = gl;
                    const int kx = 16 * ct + 4 * fq + rg;
                    { const unsigned bk = pk2v(b4[rg] * gl, k4[rg] * gl), ar = pk2v(a4[rg], r4[rg]);
                      gbt[kx * 16] = (bf16)(bk & 0xffffu); gkt[kx * 16] = (bf16)(bk >> 16);
                      *(LAS unsigned short*)(AT + kx * 32 + fr * 2) = (unsigned short)(ar & 0xffffu); *(LAS unsigned short*)(RT + kx * 32 + fr * 2) = (unsigned short)(ar >> 16); } }
                const int o = fr * 128 + (16 * ct + 4 * fq) * 2;
                *(LAS u32x2*)(AH + o) = pack4v(a4[0], a4[1], a4[2], a4[3]); *(LAS u32x2*)(BH + o) = pack4v(b4[0], b4[1], b4[2], b4[3]);
                *(LAS u32x2*)(KH + o) = pack4v(k4[0], k4[1], k4[2], k4[3]); *(LAS u32x2*)(RH + o) = pack4v(r4[0], r4[1], r4[2], r4[3]);
                if (fr == 0) *(GAS f32x4*)(s1 + S1_GAM + ((size_t)uidx * 64 + 16 * ct + 4 * fq) * 4) = (f32x4){g15[0], g15[1], g15[2], g15[3]}; }
            LDS_WAIT(); asm volatile("" ::: "memory");
            { GAS u32x4* gv = (GAS u32x4*)(s1 + S1_VT + ((size_t)uidx * 64 + lane) * 32); gv[0] = *(const LAS u32x4*)(VTl + lane * 32); gv[1] = *(const LAS u32x4*)(VTl + lane * 32 + 16); }
        asm volatile("" : "+v"(fr), "+v"(fq), "+v"(lane));
        f32x4 lab = {0.f, 0.f, 0.f, 0.f}, lak = lab, mrb = lab, mrk = lab;
#pragma unroll
        for (int ks = 0; ks < 2; ++ks) { const int off = fr * 128 + (32 * ks + 8 * fq) * 2;
            const bf16x8 a = *(const LAS bf16x8*)(AH + off), r_ = *(const LAS bf16x8*)(RH + off), b_ = *(const LAS bf16x8*)(BH + off), k_ = *(const LAS bf16x8*)(KH + off);
            lab = mfma16(a, b_, lab); lak = mfma16(a, k_, lak); mrb = mfma16(r_, b_, mrb); mrk = mfma16(r_, k_, mrk); }
#pragma unroll
        for (int rg = 0; rg < 4; ++rg) { const int t = 4 * fq + rg; const bool lo = fr < t, le = fr <= t; lab[rg] = lo ? lab[rg] : 0.f; lak[rg] = lo ? lak[rg] : 0.f; mrb[rg] = le ? mrb[rg] : 0.f; mrk[rg] = le ? mrk[rg] : 0.f; }
        asm volatile("" ::: "memory");
        *(LAS f32x4*)(LmT + fr * 16 + 4 * fq) = lab;
#pragma unroll
        for (int rg = 0; rg < 4; ++rg) { const int o = ((4 * fq + rg) * 16 + fr) * 2;
            *(LAS unsigned short*)(MX + o) = (unsigned short)f2bf(lak[rg]); *(LAS unsigned short*)(MX + 512 + o) = (unsigned short)f2bf(mrb[rg]); *(LAS unsigned short*)(MX + 1024 + o) = (unsigned short)f2bf(mrk[rg]); }
        LDS_WAIT(); asm volatile("" ::: "memory");
        float Tr[16];
#pragma unroll
        for (int m = 0; m < 16; ++m) Tr[m] = (m == fr) ? 1.0f : 0.0f;
#pragma unroll
        for (int j = 14; j >= 0; --j) { float acc = (j == fr) ? 1.0f : 0.0f;
#pragma unroll
            for (int q = 0; q < 4; ++q) { const f32x4 l4 = *(const LAS f32x4*)(LmT + j * 16 + 4 * q);
#pragma unroll
                for (int e = 0; e < 4; ++e) { const int m = 4 * q + e; if (m > j) acc += Tr[m] * l4[e]; } }
            Tr[j] = acc; }
        bf16x8 tfrag;
        { float sel[8];
#pragma unroll
          for (int j = 0; j < 8; ++j) sel[j] = (fq == 0) ? Tr[j] : ((fq == 1) ? Tr[8 + j] : 0.0f);
          tfrag = __builtin_bit_cast(bf16x8, pack8s(sel)); }
        f32x4 wacc[4];
#pragma unroll
        for (int nt = 0; nt < 4; ++nt) wacc[nt] = mfma16(tfrag, *(const LAS bf16x8*)(AT + (16 * nt + fr) * 32 + fq1 * 16), (f32x4){0.f, 0.f, 0.f, 0.f});
        asm volatile("" ::: "memory");
        { bf16* gwh = (bf16*)(s1 + S1_WH) + (size_t)uidx * 1024;
          asm volatile("s_nop 7\n\ts_nop 7" : "+v"(wacc[0]), "+v"(wacc[1]), "+v"(wacc[2]), "+v"(wacc[3]));
#pragma unroll
          for (int nt = 0; nt < 4; ++nt) { u32x2 w2; w2.x = pk2v(wacc[nt][0], wacc[nt][1]); w2.y = pk2v(wacc[nt][2], wacc[nt][3]); *(LAS u32x2*)(WTl + ((16 * nt + fr) * 16 + 4 * fq) * 2) = w2;
              bf16* gp_ = gwh + (4 * fq) * 64 + 16 * nt + fr; gp_[0] = (bf16)(w2.x & 0xffffu); gp_[64] = (bf16)(w2.x >> 16); gp_[128] = (bf16)(w2.y & 0xffffu); gp_[192] = (bf16)(w2.y >> 16); } }
        asm volatile("" : "+v"(fr), "+v"(fq), "+v"(lane));
        bf16x8 lkf, mbf, mkf, idf;
        { const u32x4 z4 = {0u, 0u, 0u, 0u};
          const u32x4 lk4 = *(const LAS u32x4*)(MX + (fr * 16 + 8 * fq1) * 2), mb4 = *(const LAS u32x4*)(MX + 512 + (fr * 16 + 8 * fq1) * 2), mk4 = *(const LAS u32x4*)(MX + 1024 + (fr * 16 + 8 * fq1) * 2);
          lkf = __builtin_bit_cast(bf16x8, (fq < 2) ? lk4 : z4);
          mbf = __builtin_bit_cast(bf16x8, mb4);
          mkf = __builtin_bit_cast(bf16x8, mk4);
          u32x4 id4; const int d = fr - 8 * fq1;
          id4.x = (d == 0 ? 0x3f80u : 0u) | (d == 1 ? 0x3f800000u : 0u); id4.y = (d == 2 ? 0x3f80u : 0u) | (d == 3 ? 0x3f800000u : 0u);
          id4.z = (d == 4 ? 0x3f80u : 0u) | (d == 5 ? 0x3f800000u : 0u); id4.w = (d == 6 ? 0x3f80u : 0u) | (d == 7 ? 0x3f800000u : 0u);
          idf = __builtin_bit_cast(bf16x8, id4); }
        LDS_WAIT(); asm volatile("" ::: "memory");
        f32x4 pacc[4];
#pragma unroll
        for (int nt = 0; nt < 4; ++nt) pacc[nt] = mfma16(lkf, *(const LAS bf16x8*)(VTl + (16 * nt + fr) * 32 + fq1 * 16), (f32x4){0.f, 0.f, 0.f, 0.f});
        asm volatile("" ::: "memory");
        asm volatile("s_nop 7\n\ts_nop 7" : "+v"(pacc[0]), "+v"(pacc[1]), "+v"(pacc[2]), "+v"(pacc[3]));
#pragma unroll
        for (int nt = 0; nt < 4; ++nt) { u32x2 w2; w2.x = pk2v(pacc[nt][0], pacc[nt][1]); w2.y = pk2v(pacc[nt][2], pacc[nt][3]); *(LAS u32x2*)(PT + ((16 * nt + fr) * 16 + 4 * fq) * 2) = w2; }
        LDS_WAIT(); asm volatile("" ::: "memory");
        f32x4 uacc[4];
#pragma unroll
        for (int nt = 0; nt < 4; ++nt) uacc[nt] = mfma16(tfrag, *(const LAS bf16x8*)(PT + (16 * nt + fr) * 32 + fq1 * 16), (f32x4){0.f, 0.f, 0.f, 0.f});
        asm volatile("" ::: "memory");
        asm volatile("s_nop 7\n\ts_nop 7" : "+v"(uacc[0]), "+v"(uacc[1]), "+v"(uacc[2]), "+v"(uacc[3]));
#pragma unroll
        for (int nt = 0; nt < 4; ++nt) { u32x2 w2; w2.x = pk2v(uacc[nt][0], uacc[nt][1]); w2.y = pk2v(uacc[nt][2], uacc[nt][3]); *(LAS u32x2*)(U0Tl + ((16 * nt + fr) * 16 + 4 * fq) * 2) = w2;
            { u32x2 w; w.x = pk2(uacc[nt][0], uacc[nt][1]); w.y = pk2(uacc[nt][2], uacc[nt][3]); *(GAS u32x2*)(s1 + S1_U0T + (((size_t)uidx * 64 + 16 * nt + fr) * 16 + 4 * fq) * 2) = w; } }
        LDS_WAIT(); asm volatile("" ::: "memory");
        { const bf16x8 aq = (fq < 2) ? mbf : idf, ay = (fq < 2) ? mbf : mkf;
          bf16* gqh = (bf16*)(s1 + S1_QH) + (size_t)uidx * 1024;
#pragma unroll
          for (int nt = 0; nt < 4; ++nt) { const int row = 16 * nt + fr;
              const bf16x8 bq = *(const LAS bf16x8*)(((fq < 2) ? WTl : RT) + row * 32 + fq1 * 16), by = *(const LAS bf16x8*)(((fq < 2) ? U0Tl : VTl) + row * 32 + fq1 * 16);
              const f32x4 qa = mfma16(aq, bq, (f32x4){0.f, 0.f, 0.f, 0.f}), ya = mfma16(ay, by, (f32x4){0.f, 0.f, 0.f, 0.f});
#pragma unroll
              for (int rg = 0; rg < 4; ++rg) gqh[(4 * fq + rg) * 64 + row] = (bf16)f2bf(qa[rg]);
              { u32x2 w; w.x = pk2(ya[0], ya[1]); w.y = pk2(ya[2], ya[3]); *(GAS u32x2*)(s1 + S1_Y0T + (((size_t)uidx * 64 + row) * 16 + 4 * fq) * 2) = w; } } }
        LDS_WAIT(); asm volatile("" ::: "memory");
        }
      }
    }
}

__device__ __forceinline__ void p3_attention(const Ptrs& P, LAS unsigned char* lds, int tid, int wave, int lane) {
    const int fr = lane & 15, fq = lane >> 4;
    LAS unsigned char* Ks = lds; LAS unsigned char* Vt = lds + 34816;
    for (int u = blockIdx.x; u < NB * 12 * 32; u += gridDim.x) {
        const int b = u / 384, r = u - b * 384, gh = r >> 5, idx = r & 31, g = gh >> 2;
        const int d = (g == 0) ? 1 : ((g == 1) ? 4 : 16), nb = 32 / d, c = idx / nb, n = idx - c * nb;
        const int qi = wave * 16 + fr; const size_t mq = (size_t)b * SEQ + (size_t)(n * 128 + qi) * d + c;
        const bf16* qrow = P.QKV + mq * QKVW + gh * 128;
        bf16x8 qf[4];
#pragma unroll
        for (int ks = 0; ks < 4; ++ks) qf[ks] = *(const GAS bf16x8*)(qrow + 32 * ks + 8 * fq);
        f32x4 o[8];
#pragma unroll
        for (int dt = 0; dt < 8; ++dt) o[dt] = (f32x4){0.f, 0.f, 0.f, 0.f};
        float mrun = -1e30f, lrun = 0.f;
        for (int kb = (n == 0) ? 1 : 0; kb < 2; ++kb) {
            const int kblk = n - 1 + kb;
            __syncthreads();
#pragma unroll
            for (int i = 0; i < 4; ++i) { const int p = tid + 512 * i, key = p >> 4, part = p & 15; const size_t mk = (size_t)b * SEQ + (size_t)(kblk * 128 + key) * d + c;
                *(LAS u32x4*)(Ks + key * 272 + part * 16) = *(const GAS u32x4*)(P.QKV + mk * QKVW + 1536 + gh * 128 + part * 8); }
#pragma unroll
            for (int i = 0; i < 4; ++i) { const int key = tid & 127, part = (tid >> 7) + 4 * i; const size_t mk = (size_t)b * SEQ + (size_t)(kblk * 128 + key) * d + c;
                const u32x4 v = *(const GAS u32x4*)(P.QKV + mk * QKVW + 3072 + gh * 128 + part * 8);
                LAS unsigned char* vp = Vt + (8 * part) * 272 + key * 2;
                *(LAS unsigned short*)(vp + 0 * 272) = (unsigned short)(v.x & 0xffffu); *(LAS unsigned short*)(vp + 1 * 272) = (unsigned short)(v.x >> 16);
                *(LAS unsigned short*)(vp + 2 * 272) = (unsigned short)(v.y & 0xffffu); *(LAS unsigned short*)(vp + 3 * 272) = (unsigned short)(v.y >> 16);
                *(LAS unsigned short*)(vp + 4 * 272) = (unsigned short)(v.z & 0xffffu); *(LAS unsigned short*)(vp + 5 * 272) = (unsigned short)(v.z >> 16);
                *(LAS unsigned short*)(vp + 6 * 272) = (unsigned short)(v.w & 0xffffu); *(LAS unsigned short*)(vp + 7 * 272) = (unsigned short)(v.w >> 16); }
            __syncthreads();
            f32x4 s[8];
#pragma unroll
            for (int kt = 0; kt < 8; ++kt) { s[kt] = (f32x4){0.f, 0.f, 0.f, 0.f};
#pragma unroll
                for (int ks = 0; ks < 4; ++ks) { const bf16x8 a = *(const LAS bf16x8*)(Ks + (kt * 16 + fr) * 272 + (32 * ks + 8 * fq) * 2); s[kt] = mfma16(a, qf[ks], s[kt]); } }
            float mx = -1e30f;
#pragma unroll
            for (int kt = 0; kt < 8; ++kt)
#pragma unroll
                for (int rg = 0; rg < 4; ++rg) { const int j = kt * 16 + 4 * fq + rg; const bool ok = (kb == 0) ? (j >= qi) : (j <= qi); const float sv = ok ? s[kt][rg] : -1e30f; s[kt][rg] = sv; mx = fmaxf(mx, sv); }
            mx = fmaxf(mx, __shfl_xor(mx, 16)); mx = fmaxf(mx, __shfl_xor(mx, 32));
            const float mnew = fmaxf(mrun, mx), alpha = __builtin_amdgcn_exp2f(mrun - mnew); mrun = mnew;
            float ls = 0.f;
#pragma unroll
            for (int kt = 0; kt < 8; ++kt)
#pragma unroll
                for (int rg = 0; rg < 4; ++rg) { const float p = __builtin_amdgcn_exp2f(s[kt][rg] - mnew); s[kt][rg] = p; ls += p; }
            lrun = lrun * alpha + ls;
#pragma unroll
            for (int dt = 0; dt < 8; ++dt) o[dt] = o[dt] * alpha;
#pragma unroll
            for (int pi = 0; pi < 4; ++pi) {
                u32x4 bw; bw.x = pk2v(s[2 * pi][0], s[2 * pi][1]); bw.y = pk2v(s[2 * pi][2], s[2 * pi][3]); bw.z = pk2v(s[2 * pi + 1][0], s[2 * pi + 1][1]); bw.w = pk2v(s[2 * pi + 1][2], s[2 * pi + 1][3]); const bf16x8 bfrag = __builtin_bit_cast(bf16x8, bw);
#pragma unroll
                for (int dt = 0; dt < 8; ++dt) { const LAS unsigned char* vp = Vt + (dt * 16 + fr) * 272 + (2 * pi * 16 + 4 * fq) * 2;
                    const u32x2 lo = *(const LAS u32x2*)vp, hi = *(const LAS u32x2*)(vp + 32);
                    const u32x4 aw = {lo.x, lo.y, hi.x, hi.y}; o[dt] = mfma16(__builtin_bit_cast(bf16x8, aw), bfrag, o[dt]); } }
        }
        lrun += __shfl_xor(lrun, 16); lrun += __shfl_xor(lrun, 32);
        bf16* orow = P.ATTO + (mq * 12 + gh) * 128;
#pragma unroll
        for (int dt = 0; dt < 8; ++dt) { u32x2 w; w.x = pk2(o[dt][0], o[dt][1]); w.y = pk2(o[dt][2], o[dt][3]); *(GAS u32x2*)(orow + dt * 16 + 4 * fq) = w; }
        if (fq == 0) { P.ATTML[(mq * 12 + gh) * 2] = mrun; P.ATTML[(mq * 12 + gh) * 2 + 1] = lrun; }
    }
}

struct S2Regs { u32x2 wf[4], qf[4], bt[4], kt[4], vt; f32x4 u0, y0, gm[4]; };
__device__ __forceinline__ void s2_load(S2Regs& R, const unsigned char* s1, size_t ui, int vg, int fr, int fq) {
    const unsigned char* wh = s1 + S1_WH + ui * 2048 + (fr * 64 + 4 * fq) * 2; const unsigned char* qh = s1 + S1_QH + ui * 2048 + (fr * 64 + 4 * fq) * 2;
#pragma unroll
    for (int ks = 0; ks < 2; ++ks) { R.wf[2 * ks] = *(const GAS u32x2*)(wh + ks * 64); R.wf[2 * ks + 1] = *(const GAS u32x2*)(wh + ks * 64 + 32); R.qf[2 * ks] = *(const GAS u32x2*)(qh + ks * 64); R.qf[2 * ks + 1] = *(const GAS u32x2*)(qh + ks * 64 + 32); }
#pragma unroll
    for (int mt = 0; mt < 4; ++mt) { R.bt[mt] = *(const GAS u32x2*)(s1 + S1_BT + ui * 2048 + ((16 * mt + fr) * 16 + 4 * fq) * 2); R.kt[mt] = *(const GAS u32x2*)(s1 + S1_KT + ui * 2048 + ((16 * mt + fr) * 16 + 4 * fq) * 2);
        R.gm[mt] = *(const GAS f32x4*)(s1 + S1_GAM + ui * 256 + (16 * mt + 4 * fq) * 4); }
    const size_t vr = ui * 64 + vg * 16 + fr;
    R.vt = *(const GAS u32x2*)(s1 + S1_VT + (vr * 16 + 4 * fq) * 2); { const u32x2 uw = *(const GAS u32x2*)(s1 + S1_U0T + (vr * 16 + 4 * fq) * 2), yw = *(const GAS u32x2*)(s1 + S1_Y0T + (vr * 16 + 4 * fq) * 2);
      R.u0 = (f32x4){bflo(uw.x), bfhi(uw.x), bflo(uw.y), bfhi(uw.y)}; R.y0 = (f32x4){bflo(yw.x), bfhi(yw.x), bflo(yw.y), bfhi(yw.y)}; }
}
__device__ __forceinline__ void s2_step(const S2Regs& R, f32x4 (&st4)[4], float* yp) {
    bf16x8 sf[2];
#pragma unroll
    for (int ks = 0; ks < 2; ++ks) sf[ks] = __builtin_bit_cast(bf16x8, pack8(st4[2 * ks], st4[2 * ks + 1]));
    f32x4 sa = R.u0, y = R.y0;
#pragma unroll
    for (int ks = 0; ks < 2; ++ks) { sa = mfma16(__builtin_bit_cast(bf16x8, (u32x4){R.wf[2 * ks].x, R.wf[2 * ks].y, R.wf[2 * ks + 1].x, R.wf[2 * ks + 1].y}), sf[ks], sa);
        y = mfma16(__builtin_bit_cast(bf16x8, (u32x4){R.qf[2 * ks].x, R.qf[2 * ks].y, R.qf[2 * ks + 1].x, R.qf[2 * ks + 1].y}), sf[ks], y); }
#pragma unroll
    for (int rg = 0; rg < 4; ++rg) yp[(size_t)rg * RW] = y[rg];
    const bf16x8 ub = __builtin_bit_cast(bf16x8, (u32x4){pk2(sa[0], sa[1]), pk2(sa[2], sa[3]), R.vt.x, R.vt.y});
#pragma unroll
    for (int mt = 0; mt < 4; ++mt) st4[mt] = mfma16(__builtin_bit_cast(bf16x8, (u32x4){R.bt[mt].x, R.bt[mt].y, R.kt[mt].x, R.kt[mt].y}), ub, st4[mt] * R.gm[mt]);
}
__device__ __forceinline__ void p4b_scan(const Ptrs& P, unsigned char* ws, LAS unsigned char* lds, int tid, int wave, int lane) {
    if (wave == 0) {
        const int fr = lane & 15, fq = lane >> 4;
        const unsigned char* s1 = ws + WS_S1;
        for (int unit = blockIdx.x; unit < 256; unit += gridDim.x) {
            const int bh = unit >> 2, vg = unit & 3, b = bh >> 4, h = bh & 15;
            const size_t u0idx = (size_t)bh * 256;
            f32x4 st4[4];
#pragma unroll
            for (int mt = 0; mt < 4; ++mt) st4[mt] = (f32x4){0.f, 0.f, 0.f, 0.f};
            float* yb = P.Y + ((size_t)b * SEQ + 4 * fq) * RW + h * 64 + vg * 16 + fr;
            S2Regs RA, RB;
            s2_load(RA, s1, u0idx, vg, fr, fq);
#pragma unroll 1
            for (int c = 0; c < 256; c += 2) {
                s2_load(RB, s1, u0idx + c + 1, vg, fr, fq);
                s2_step(RA, st4, yb + (size_t)(c * 16) * RW);
                s2_load(RA, s1, u0idx + ((c + 2 < 256) ? c + 2 : c), vg, fr, fq);
                s2_step(RB, st4, yb + (size_t)((c + 1) * 16) * RW);
            }
        }
    } else {
        LAS float* scr = (LAS float*)(lds + (wave - 1) * 16896);
        const int gw = blockIdx.x * (NWAVES - 1) + (wave - 1), NGW = gridDim.x * (NWAVES - 1);
        constexpr int I_W1 = NE * 16 * 128, I_W2 = NE * 16 * 64;
        for (int it = gw; it < I_W1 + I_W2; it += NGW) {
            int r = it;
            if (r < I_W1) { const int e = r >> 11, q = r & 2047, kb = q >> 7, nb = q & 127, c0 = 32 * nb;
                tr8_tile(P.w1 + (size_t)e * D * 4096, 4096, 128 * kb, c0, (unsigned char*)P.W1, (size_t)e * 4096 + ((c0 & 2047) >> 7) * 256 + ((c0 & 127) >> 5) * 64 + (c0 >> 11) * 32, D, 32.0f, scr, lane); continue; }
            r -= I_W1;
            { const int e = r >> 10, q = r & 1023, kb = q >> 6, nb = q & 63; tr8_tile(P.w2 + (size_t)e * FF * D, D, 128 * kb, 32 * nb, (unsigned char*)P.W2, (size_t)e * D + 32 * nb, FF, 32.0f, scr, lane); }
        }
    }
}

__device__ __forceinline__ float sum4q(float x) { x += dppf<0xB1>(x); x += dppf<0x4E>(x); return x; }
__device__ __forceinline__ void p5_post(const Ptrs& P, int tid, int wave, int lane) {
    const int gw = blockIdx.x * NWAVES + wave, NGW = gridDim.x * NWAVES;
    const int c0 = 16 * lane, head = lane >> 2;
    for (int m = gw; m < T; m += NGW) {
        const size_t o = (size_t)m * RW + c0;
        f32x4 y[4], v[4];
#pragma unroll
        for (int q = 0; q < 4; ++q) y[q] = *(const GAS f32x4*)(P.Y + o + 4 * q);
        { const u32x4 v0 = *(const GAS u32x4*)(P.SCH + SH_V * SC_STRIDE + o), v1 = *(const GAS u32x4*)(P.SCH + SH_V * SC_STRIDE + o + 8); unpack8(v0, v[0], v[1]); unpack8(v1, v[2], v[3]); }
        const u32x4 g0 = *(const GAS u32x4*)(P.G + o), g1 = *(const GAS u32x4*)(P.G + o + 8);
        const float bon = P.BONUS[(size_t)m * NH + head];
        const int hh = lane >> 4, d0 = (lane & 15) * 8; float mm[3], ll[3]; u32x4 ow[3];
#pragma unroll
        for (int g = 0; g < 3; ++g) { const size_t q = (size_t)m * 12 + g * 4 + hh; mm[g] = P.ATTML[q * 2]; ll[g] = P.ATTML[q * 2 + 1]; ow[g] = *(const GAS u32x4*)(P.ATTO + q * 128 + d0); }
        float s = 0.f;
#pragma unroll
        for (int q = 0; q < 4; ++q) s += (y[q].x + y[q].y) + (y[q].z + y[q].w);
        const float mean = sum4q(s) * (1.0f / 64.0f); float s2 = 0.f;
#pragma unroll
        for (int q = 0; q < 4; ++q) { y[q] = y[q] - mean; s2 += (y[q].x * y[q].x + y[q].y * y[q].y) + (y[q].z * y[q].z + y[q].w * y[q].w); }
        const float rstd = 1.0f / sqrtf(sum4q(s2) * (1.0f / 64.0f) + GN_EPS);
        f32x4 gq[4]; unpack8(g0, gq[0], gq[1]); unpack8(g1, gq[2], gq[3]);
#pragma unroll
        for (int q = 0; q < 4; ++q) { const f32x4 lw = *(const GAS f32x4*)(P.ln_x_w + c0 + 4 * q), lb = *(const GAS f32x4*)(P.ln_x_b + c0 + 4 * q); y[q] = ((y[q] * rstd) * lw + lb + v[q] * bon) * gq[q]; }
        { bf16* ap = P.YAIN + (size_t)m * 1536 + c0; *(GAS u32x4*)ap = pack8(y[0], y[1]); *(GAS u32x4*)(ap + 8) = pack8(y[2], y[3]); }
        const float M = fmaxf(mm[0], fmaxf(mm[1], mm[2])); float den = 0.f; f32x4 n0 = {0.f, 0.f, 0.f, 0.f}, n1 = n0;
#pragma unroll
        for (int g = 0; g < 3; ++g) { const float wg = exp2f(mm[g] - M); den += wg * ll[g]; f32x4 a, b; unpack8(ow[g], a, b); n0 = n0 + a * wg; n1 = n1 + b * wg; }
        const float inv = 1.0f / den;
        *(GAS u32x4*)(P.YAIN + (size_t)m * 1536 + 1024 + 8 * lane) = pack8(n0 * inv, n1 * inv);
    }
}

template <int CTRL> __device__ __forceinline__ int dppi(int x) { return __builtin_amdgcn_mov_dpp(x, CTRL, 0xf, 0xf, true); }
__device__ __forceinline__ float row16_max(float x) { x = fmaxf(x, dppf<0xB1>(x)); x = fmaxf(x, dppf<0x4E>(x)); x = fmaxf(x, dppf<0x141>(x)); x = fmaxf(x, dppf<0x140>(x)); return x; }
__device__ __forceinline__ int row16_min(int x) { x = min(x, dppi<0xB1>(x)); x = min(x, dppi<0x4E>(x)); x = min(x, dppi<0x141>(x)); x = min(x, dppi<0x140>(x)); return x; }
__device__ __forceinline__ void p8_router(const Ptrs& P, LAS unsigned char* lds, int tid, int wave, int lane, int cnt_base = CW_CNT) {
    LAS float* rsv = (LAS float*)lds;
    LAS float* part = (LAS float*)(lds + 1024);
    LAS int* picks = (LAS int*)(lds + 1024 + 8192); LAS int* pbase = picks + 256; LAS float* pgate = (LAS float*)(pbase + 64);
    const int fr = lane & 15, fq = lane >> 4;
    for (int grp = blockIdx.x; grp < T / 64; grp += gridDim.x) {
        const int mb = grp * 64;
        __syncthreads();
#pragma unroll 2
        for (int tk = 0; tk < 8; ++tk) { const int m = mb + wave * 8 + tk; const bf16* xr = P.X1 + (size_t)m * D; f32x4 v[8]; float s = 0.f;
#pragma unroll
            for (int j = 0; j < 8; ++j) { const u32x2 xw = *(const GAS u32x2*)(xr + 4 * lane + 256 * j); v[j] = (f32x4){bflo(xw.x), bfhi(xw.x), bflo(xw.y), bfhi(xw.y)}; s += (v[j].x * v[j].x + v[j].y * v[j].y) + (v[j].z * v[j].z + v[j].w * v[j].w); }
            const float r = 1.0f / sqrtf(wave_sum(s) * (1.0f / D) + NORM_EPS); if (lane == 0) rsv[wave * 8 + tk] = r;
            unsigned char* hr = (unsigned char*)P.H + (size_t)m * D;
#pragma unroll
            for (int j = 0; j < 8; ++j) { const f32x4 gv = *(const GAS f32x4*)(P.norm_ffn + 4 * lane + 256 * j);
                *(GAS unsigned*)(hr + 4 * lane + 256 * j) = pk4_fp8(v[j].x * r * gv.x, v[j].y * r * gv.y, v[j].z * r * gv.z, v[j].w * r * gv.w); } }
        const int tt = wave & 3, kh = wave >> 2;
        f32x4 acc[2] = {{0.f, 0.f, 0.f, 0.f}, {0.f, 0.f, 0.f, 0.f}};
        { const bf16* xa = P.X1 + (size_t)(mb + tt * 16 + fr) * D + kh * 1024 + 8 * fq; const bf16* wh = P.WRH + (size_t)fr * D + kh * 1024 + 8 * fq; const bf16* wl = P.WRL + (size_t)fr * D + kh * 1024 + 8 * fq;
#pragma unroll 4
          for (int ks = 0; ks < 32; ++ks) { const bf16x8 ah = *(const GAS bf16x8*)(xa + 32 * ks);
#pragma unroll
              for (int nt = 0; nt < 2; ++nt) { const bf16x8 bh = *(const GAS bf16x8*)(wh + (size_t)nt * 16 * D + 32 * ks), bl = *(const GAS bf16x8*)(wl + (size_t)nt * 16 * D + 32 * ks);
                  acc[nt] = mfma16(ah, bh, acc[nt]); acc[nt] = mfma16(ah, bl, acc[nt]); } } }
        if (kh == 1) { *(LAS f32x4*)(part + ((tt * 2 + 0) * 64 + lane) * 4) = acc[0]; *(LAS f32x4*)(part + ((tt * 2 + 1) * 64 + lane) * 4) = acc[1]; }
        __syncthreads();
        if (kh == 0) {
            acc[0] = acc[0] + *(const LAS f32x4*)(part + ((tt * 2 + 0) * 64 + lane) * 4); acc[1] = acc[1] + *(const LAS f32x4*)(part + ((tt * 2 + 1) * 64 + lane) * 4);
            const float b0 = P.b_router[fr], b1 = P.b_router[16 + fr];
#pragma unroll
            for (int rg = 0; rg < 4; ++rg) { const int tl = tt * 16 + 4 * fq + rg; const float r = rsv[tl];
                float v0 = acc[0][rg] * r + b0, v1 = acc[1][rg] * r + b1; int sel[4]; float val[4];
#pragma unroll
                for (int k = 0; k < 4; ++k) { const float mx = row16_max(fmaxf(v0, v1)); const int cand = (v0 == mx) ? fr : ((v1 == mx) ? 16 + fr : 99); const int s_ = row16_min(cand);
                    sel[k] = s_; val[k] = mx; v0 = (s_ == fr) ? -3.0e38f : v0; v1 = (s_ == 16 + fr) ? -3.0e38f : v1; }
                const float e1 = __expf(val[1] - val[0]), e2 = __expf(val[2] - val[0]), e3 = __expf(val[3] - val[0]); const float inv = 1.0f / (1.0f + e1 + e2 + e3);
                const float gate[4] = {inv, e1 * inv, e2 * inv, e3 * inv};
                if (fr == 0) { const int m = mb + tl;
#pragma unroll
                    for (int k = 0; k < 4; ++k) { picks[tl * 4 + k] = sel[k]; pgate[tl * 4 + k] = gate[k]; P.TOPK_E[m * 4 + k] = sel[k]; P.TOPK_GATE[m * 4 + k] = gate[k]; } } }
        }
        __syncthreads();
        if (tid < 32) { int cnt = 0;
            for (int j = 0; j < 256; ++j) cnt += (picks[j] == tid) ? 1 : 0;
            pbase[tid] = (int)__hip_atomic_fetch_add((unsigned*)(P.ctl + cnt_base + 64 * tid), (unsigned)cnt, RLX_AGENT); }
        __syncthreads();
        if (tid < 256) { const int mine = picks[tid]; int rank = 0;
            for (int j = 0; j < tid; ++j) rank += (picks[j] == mine) ? 1 : 0;
            const int pos = pbase[mine] + rank; P.TOPK_POS[mb * 4 + tid] = pos;
            P.RT2[mine * 16384 + pos] = mb * 4 + tid; P.RG2[mine * 16384 + pos] = pgate[tid]; }
    }
}

__device__ __forceinline__ void moe_tables(const Ptrs& P, LAS int* tab, int tid) {
    if (tid == 0) { int acc = 0;
        for (int e = 0; e < NE; ++e) { tab[e] = acc; const int c = (int)__hip_atomic_load((unsigned*)(P.ctl + CW_CNT + 64 * e), RLX_AGENT); acc += (c + 255) >> 8; tab[64 + e] = c; }
        tab[32] = acc; }
    __syncthreads();
}

__device__ __forceinline__ void p9_gather(const Ptrs& P, LAS unsigned char* lds, int tid, int wave, int lane) {
    LAS int* tab = (LAS int*)(lds + TAB_OFF);
    moe_tables(P, tab, tid);
    const int gw = blockIdx.x * NWAVES + wave, NGW = gridDim.x * NWAVES;
    for (int p = gw; p < T * 4; p += NGW) { const int e = P.TOPK_E[p], pos = P.TOPK_POS[p]; const int row = tab[e] * 256 + pos;
        const GAS u32x4* src = (const GAS u32x4*)((const unsigned char*)P.H + (size_t)(p >> 2) * D); GAS u32x4* dst = (GAS u32x4*)((unsigned char*)P.XS + (size_t)row * D);
#pragma unroll
        for (int i = 0; i < 2; ++i) dst[lane + 64 * i] = src[lane + 64 * i];
        if (lane == 0) { P.ROWTOK[row] = p; P.ROWGATE[row] = P.TOPK_GATE[p]; } }
    for (int e = blockIdx.x; e < NE; e += gridDim.x) { const int cnt = tab[64 + e], r0 = tab[e] * 256, rend = tab[e + 1] * 256;
        for (int r = r0 + cnt + tid; r < rend; r += NTHREADS) { P.ROWTOK[r] = -1; P.ROWGATE[r] = 0.f; } }
}

__device__ __forceinline__ void p12_final(const Ptrs& P, int tid, int wave, int lane) {
    const int gw = blockIdx.x * NWAVES + wave, NGW = gridDim.x * NWAVES;
    for (int m = gw; m < T; m += NGW) {
        f32x4 v[8]; float s = 0.f;
#pragma unroll
        for (int j = 0; j < 8; ++j) { const int col = 4 * lane + 256 * j; { const u32x2 xw = *(const GAS u32x2*)(P.X1 + (size_t)m * D + col); v[j] = (f32x4){bflo(xw.x), bfhi(xw.x), bflo(xw.y), bfhi(xw.y)}; }
            f32x4 mo = {0.f, 0.f, 0.f, 0.f};
#pragma unroll
            for (int k = 0; k < 4; ++k) { const unsigned w = *(const GAS unsigned*)((const unsigned char*)P.OUTK + ((size_t)m * 4 + k) * D + col);
                const f32x2 lo = __builtin_amdgcn_cvt_pk_f32_fp8((int)w, false), hi = __builtin_amdgcn_cvt_pk_f32_fp8((int)w, true); mo.x += lo[0]; mo.y += lo[1]; mo.z += hi[0]; mo.w += hi[1]; }
            v[j] = v[j] + mo * 0.03125f;
            s += (v[j].x * v[j].x + v[j].y * v[j].y) + (v[j].z * v[j].z + v[j].w * v[j].w); }
        const float rs = 1.0f / sqrtf(wave_sum(s) * (1.0f / D) + NORM_EPS);
#pragma unroll
        for (int j = 0; j < 8; ++j) { const int col = 4 * lane + 256 * j; const f32x4 g = *(const GAS f32x4*)(P.norm_final + col); *(GAS f32x4*)(P.out + (size_t)m * D + col) = v[j] * rs * g; }
    }
}

struct Args { const void* in[26]; float* out; unsigned char* ws; int ph_lo, ph_hi; };
__global__ void __launch_bounds__(NTHREADS, 2) fwd(Args args) {
    extern __shared__ __attribute__((aligned(16))) unsigned char lds_raw[];
    LAS unsigned char* lds = (LAS unsigned char*)lds_raw;
    const int tid = threadIdx.x, lane = tid & 63, wave = __builtin_amdgcn_readfirstlane(tid >> 6);
    unsigned char* ws = args.ws;
    Ptrs P;
    P.x = (const float*)args.in[0]; P.positions = (const int*)args.in[1]; P.norm_mix = (const float*)args.in[2]; P.w_in = (const float*)args.in[3]; P.shift_mu = (const float*)args.in[4];
    P.w0 = (const float*)args.in[5]; P.w2_decay = (const float*)args.in[6]; P.a0 = (const float*)args.in[7]; P.a2_iclr = (const float*)args.in[8]; P.g2_gate = (const float*)args.in[9];
    P.k_k = (const float*)args.in[10]; P.k_a = (const float*)args.in[11]; P.r_k = (const float*)args.in[12]; P.ln_x_w = (const float*)args.in[13]; P.ln_x_b = (const float*)args.in[14];
    P.w_o_rwkv = (const float*)args.in[15]; P.w_o_attn = (const float*)args.in[16]; P.w_out = (const float*)args.in[17]; P.norm_ffn = (const float*)args.in[18]; P.w_router = (const float*)args.in[19];
    P.b_router = (const float*)args.in[20]; P.w1 = (const float*)args.in[21]; P.b1 = (const float*)args.in[22]; P.w2 = (const float*)args.in[23]; P.b2 = (const float*)args.in[24]; P.norm_final = (const float*)args.in[25];
    P.out = args.out; P.ctl = (gu32*)(ws + WS_CTL);
    P.WIN = (bf16*)(ws + WS_WIN); P.W1 = (bf16*)(ws + WS_W1); P.W2 = (bf16*)(ws + WS_W2); P.WOR = (bf16*)(ws + WS_WOR); P.WOA = (bf16*)(ws + WS_WOA); P.WOUT = (bf16*)(ws + WS_WOUT);
    P.H = (bf16*)(ws + WS_H); P.ZP = (bf16*)(ws + WS_ZP); P.QKV = (bf16*)(ws + WS_QKV); P.GATES = (bf16*)(ws + WS_GATES); P.ROT = (float*)(ws + WS_ROT); P.SC = (float*)(ws + WS_SC); P.SCH = (bf16*)(ws + WS_SC + 64 * MiB);
    P.G = (bf16*)(ws + WS_G); P.BONUS = (float*)(ws + WS_BONUS); P.Y = (float*)(ws + WS_Y); P.ATTO = (bf16*)(ws + WS_ATTO); P.ATTML = (float*)(ws + WS_ATTML); P.YAIN = (bf16*)(ws + WS_YAIN);
    P.OIN = (bf16*)(ws + WS_OIN); P.MERGED = (bf16*)(ws + WS_MERGED); P.X1 = (bf16*)(ws + WS_X1);
    P.TOPK_E = (int*)(ws + WS_TOPK); P.TOPK_POS = P.TOPK_E + T * 4; P.TOPK_GATE = (float*)(P.TOPK_POS + T * 4);
    P.ROWTOK = (int*)(ws + WS_ROWS); P.ROWGATE = (float*)(P.ROWTOK + XS_ROWS); P.RT2 = (int*)(ws + WS_ROWS2); P.RG2 = (float*)(P.RT2 + NE * 16384);
    P.LW = (bf16*)(ws + WS_LORA); P.LA = P.LW + 1024 * 64; P.LG = P.LA + 1024 * 64; P.WRH = P.LG + 1024 * 160; P.WRL = P.WRH + NE * D;
    P.XS = (bf16*)(ws + WS_XS); P.ACT = (bf16*)(ws + WS_ACT); P.OUTK = (bf16*)(ws + WS_OUTK);

    for (int u = tid; u < (LDS_BYTES - TAB_OFF) / 4; u += NTHREADS) ((LAS unsigned*)(lds + TAB_OFF))[u] = 0u;
    __syncthreads();
#if MK_ONE_LAUNCH
    XcdBarrier bar = xcd_barrier_post((unsigned*)(P.ctl + CW_BAR), (volatile LAS unsigned*)(lds + MISC_OFF));
#define GRID_BAR() xcd_barrier(bar)
#else
#define GRID_BAR() do { } while (0)
#endif
    const int lo = args.ph_lo, hi = args.ph_hi;
#ifndef PHASE_MASK
#define PHASE_MASK 0x3fff
#endif
#define IN(k) (((PHASE_MASK >> (k)) & 1) && lo <= (k) && (k) < hi)
#define SEAM(k) do { if (IN(k) && IN((k) + 1)) GRID_BAR(); } while (0)
    const int G = gridDim.x, c = blockIdx.x;

#ifndef REP_MASK
#define REP_MASK 0
#endif
#define REPS(k) (1 + ((REP_MASK >> (k)) & 1))
#define PHASE(k, ...) do { if (IN(k)) { { __VA_ARGS__ } if (REPS(k) == 2) { GRID_BAR(); { __VA_ARGS__ } } SEAM(k); } } while (0)
    PHASE(0, p0_prologue(P, ws, lds, tid, wave, lane););
#ifdef PROBE_DRY
    if (IN(1)) { pg8::Gemm g{P.H, P.WIN, T, NPROJ, D}; pg8::StaticOrder S; S.init(T, NPROJ, G, c); EpiProj E{P.ZP, P.QKV, P.GATES, P.ROT, PROBE_DRY + (int)__hip_atomic_load(P.ctl + CW_TMO, RLX_AGENT)};
        pg8::gemm_phase<EpiProj, pg8::StaticOrder, true, true>(lds, g, S, E); GRID_BAR(); }
#endif
#ifndef P1_ALIGN
#define P1_ALIGN true
#endif
#ifndef STAG_US
#define STAG_US 0
#endif
    PHASE(1, { if (STAG_US > 0) { const unsigned long long t0_ = __builtin_amdgcn_s_memrealtime(), d_ = (unsigned long long)(((blockIdx.x >> 3) & 7) * STAG_US * 100);
            while (__builtin_amdgcn_s_memrealtime() - t0_ < d_) __builtin_amdgcn_s_sleep(8); }
        { pg8::Gemm g{P.H, P.WIN, T, 3072, D}; pg8::StaticOrder S; S.init(T, 3072, G, c); EpiProj E{P.ZP, P.QKV, P.GATES, P.ROT, 0, 0, 1.0f};
          pg8::gemm_phase<EpiProj, pg8::StaticOrder, P1_ALIGN, true>(lds, g, S, E); }
        __syncthreads();
        { pg8::Gemm g{(const bf16*)(ws + WS_H8), (const bf16*)(ws + WS_WG8B), T, 9216, D / 2}; pg8::StaticOrder S; S.init(T, 9216, G, c); EpiProj E{P.ZP, P.QKV, P.GATES, P.ROT, 0, 12, 0.03125f};
          pg8::gemm_phase<EpiProj, pg8::StaticOrder, P1_ALIGN, true, 127, 127>(lds, g, S, E); } });
#ifndef PROBE_SUB
#define PROBE_SUB 0
#endif
    PHASE(2, { p2_fused(P, ws, lds, tid, wave, lane); __syncthreads(); if (PROBE_SUB == 1) { p2_fused(P, ws, lds, tid, wave, lane); __syncthreads(); }
        p3_attention(P, lds, tid, wave, lane); if (PROBE_SUB == 2) { __syncthreads(); p3_attention(P, lds, tid, wave, lane); } });
    PHASE(5, p4b_scan(P, ws, lds, tid, wave, lane););
    PHASE(6, p5_post(P, tid, wave, lane););
    PHASE(7, {
        { pg8::Gemm g{P.YAIN, P.WOR, T, D, 1536}; pg8::StaticOrder S; S.init(T, D, G, c); EpiMerge2 E{P.GATES, ws + WS_MERGED8}; pg8::gemm_phase<EpiMerge2, pg8::StaticOrder, true, true, -1, -1, false, false, true>(lds, g, S, E); } });
    PHASE(8, { pg8::Gemm g{(const bf16*)(ws + WS_MERGED8), P.WOUT, T, D, D / 2}; pg8::StaticOrder S; S.init(T, D, G, c); EpiResid E{P.x, P.X1, 1.0f / 512.0f}; pg8::gemm_phase<EpiResid, pg8::StaticOrder, true, true, 127, 127>(lds, g, S, E); });
#ifdef ROUTER_TWICE
    if (IN(9)) { p8_router(P, lds, tid, wave, lane, CW_CNT + 4096); GRID_BAR(); }
#endif
    PHASE(9, p8_router(P, lds, tid, wave, lane););
#ifdef PROBE_DRY_MOE
#ifndef PROBE_FP8A
#define PROBE_FP8A 4
#endif
    if (IN(11)) { LAS int* tab = (LAS int*)(lds + TAB_OFF); moe_tables(P, tab, tid);
        if (PROBE_DRY_MOE & 1) { { pg8::Gemm g{P.XS, P.W1, XS_ROWS, NE * 4096, D / 2}; MoeOrder S{tab, 16, G, c}; EpiMoe1 E{P.ACT, P.b1, 1}; pg8::gemm_phase<EpiMoe1, MoeOrder, true, true, 122, PROBE_FP8A, true, false>(lds, g, S, E); }
        GRID_BAR(); }
        if (PROBE_DRY_MOE & 2) { { pg8::Gemm g{P.ACT, P.W2, XS_ROWS, NE * D, FF / 2}; MoeOrder S{tab, 8, G, c}; EpiMoe2 E{P.OUTK, P.b2, P.ROWTOK, P.ROWGATE, 1}; pg8::gemm_phase<EpiMoe2, MoeOrder, true, true, 122, PROBE_FP8A, true, false>(lds, g, S, E); }
        GRID_BAR(); } }
#endif
    PHASE(11, { LAS int* tab = (LAS int*)(lds + TAB_OFF); moe_tables(P, tab, tid);
        pg8::Gemm g{P.H, P.W1, XS_ROWS, NE * 4096, D / 2}; MoeOrder S{tab, 16, G, c}; EpiMoe1 E{P.ACT, P.b1, 0, P.RT2, tab};
        pg8::gemm_phase<EpiMoe1, MoeOrder, true, true, 122, 127, true, false, false, true>(lds, g, S, E); });
    PHASE(12, { LAS int* tab = (LAS int*)(lds + TAB_OFF); moe_tables(P, tab, tid);
        pg8::Gemm g{P.ACT, P.W2, XS_ROWS, NE * D, FF / 2}; MoeOrder S{tab, 8, G, c}; EpiMoe2 E{P.OUTK, P.b2, P.RT2, P.RG2, 0, tab};
        pg8::gemm_phase<EpiMoe2, MoeOrder, true, true, 122, 124, true, false>(lds, g, S, E); });
    PHASE(13, p12_final(P, tid, wave, lane););
#undef IN
#undef SEAM
}

extern "C" void kernel_launch(void* const* d_in, const int* in_sizes, int n_in, void* d_out, int out_size, void* d_ws, size_t ws_size, hipStream_t stream) {
    static int grid = 0;
    if (grid == 0) {
        if (n_in != 26 || out_size != T * D || ws_size < WS_END) { fprintf(stderr, "kernel_launch: unexpected shapes (n_in %d, out %d, ws %zu, need %zu); nothing launched\n", n_in, out_size, ws_size, (size_t)WS_END); grid = -1; return; }
        int dev = 0, cus = 0, per_cu = 0;
        if (hipGetDevice(&dev) != hipSuccess || hipDeviceGetAttribute(&cus, hipDeviceAttributeMultiprocessorCount, dev) != hipSuccess) { grid = -1; return; }
        if (hipFuncSetAttribute((const void*)fwd, hipFuncAttributeMaxDynamicSharedMemorySize, LDS_BYTES) != hipSuccess) { fprintf(stderr, "kernel_launch: hipFuncSetAttribute failed\n"); grid = -1; return; }
        if (hipOccupancyMaxActiveBlocksPerMultiprocessor(&per_cu, (const void*)fwd, NTHREADS, LDS_BYTES) != hipSuccess || per_cu < 1) fprintf(stderr, "kernel_launch: occupancy query says %d\n", per_cu);
        (void)hipGetLastError();
        grid = cus;
    }
    if (grid < 0) return;
    if (hipMemsetAsync((char*)d_ws + WS_CTL, 0, CTL_ZERO_BYTES, stream) != hipSuccess) return;
    Args a{};
    for (int i = 0; i < 26; ++i) a.in[i] = d_in[i];
    a.out = (float*)d_out; a.ws = (unsigned char*)d_ws;
#if MK_ONE_LAUNCH
    a.ph_lo = 0; a.ph_hi = NPHASES;
    hipLaunchKernelGGL(fwd, dim3(grid), dim3(NTHREADS), LDS_BYTES, stream, a);
#else
    for (int ph = 0; ph < NPHASES; ++ph) { a.ph_lo = ph; a.ph_hi = ph + 1; hipLaunchKernelGGL(fwd, dim3(grid), dim3(NTHREADS), LDS_BYTES, stream, a); }
#endif
}
```

```cpp
#include <hip/hip_runtime.h>
#include <cstdio>
#include <cstdint>
#include <cmath>
#ifndef PG8_KROT
#define PG8_KROT 1
#endif
namespace pg8 {
#define PG8_LAS __attribute__((address_space(3)))
typedef unsigned short bf16_t;
typedef short bf16x8 __attribute__((ext_vector_type(8)));
typedef float f32x4 __attribute__((ext_vector_type(4)));
typedef unsigned u32x4 __attribute__((ext_vector_type(4)));
constexpr int BM = 256, BK = 64, HALF = 128, HTB = HALF * BK * 2  , STAGE_BYTES = 8 * HTB, NXCD = 8, WGM = 8;

__host__ __device__ __forceinline__ int lds_byte(int r, int c) { const int st = (r >> 4) * 2 + (c >> 5), rr = r & 15, cc = c & 31, ob = rr * 64 + cc * 2; return st * 1024 + (ob ^ (((ob >> 9) & 1) << 5)); }
__host__ __device__ __forceinline__ void stage_rc(int b, int& R, int& C) { const int st = b / 1024, sb = b % 1024, swz = sb ^ (((sb >> 9) & 1) << 5); R = (st >> 1) * 16 + swz / 64; C = (st & 1) * 32 + (swz % 64) / 2; }
__host__ __device__ __forceinline__ int perm32(int rho) { const int n = rho >> 4, i = rho & 15; return 8 * (i >> 2) + 4 * n + (i & 3); }

struct Unit { int pm, pn; };
struct Gemm { const bf16_t* A; const bf16_t* Bt; int M, N, K; };

struct StaticOrder {
    int nM, nN, nwg, G, c;
    __host__ __device__ void init(int M, int N, int G_, int c_) { nM = M / BM; nN = N / BM; nwg = nM * nN; G = G_; c = c_; }
    __host__ __device__ bool next(int i, Unit& u) const {
        const long L = (long)i * G + c; if (L >= nwg) return false;
        int wgid = (int)L; { const int q = nwg / NXCD, r = nwg % NXCD, xcd = wgid % NXCD, off = wgid / NXCD; wgid = (xcd < r ? xcd * (q + 1) : r * (q + 1) + (xcd - r) * q) + off; }
        const int nig = WGM * nN, gid = wgid / nig, fm = gid * WGM, gsz = (nM - fm) < WGM ? (nM - fm) : WGM;
        u.pm = fm + ((wgid % nig) % gsz); u.pn = (wgid % nig) / gsz; return true;
    }
    __device__ __forceinline__ void a_ready(const Unit&) const {}
    __device__ __forceinline__ void done(const Unit&) const {}
};

__device__ __forceinline__ unsigned cvt_pk_bf16(float lo, float hi) { unsigned r; asm volatile("v_cvt_pk_bf16_f32 %0, %1, %2" : "=v"(r) : "v"(lo), "v"(hi)); return r; }
typedef float f32x2 __attribute__((ext_vector_type(2)));

typedef int i32x4_t __attribute__((ext_vector_type(4)));
typedef int i32x8_t __attribute__((ext_vector_type(8)));
__device__ __forceinline__ f32x4 mfma_fp8(bf16x8 w0, bf16x8 w1, bf16x8 a0, bf16x8 a1, f32x4 c, int sw, int sa) {
    const i32x4_t x0 = __builtin_bit_cast(i32x4_t, w0), x1 = __builtin_bit_cast(i32x4_t, w1), y0 = __builtin_bit_cast(i32x4_t, a0), y1 = __builtin_bit_cast(i32x4_t, a1);
    const i32x8_t X = {x0.x, x0.y, x0.z, x0.w, x1.x, x1.y, x1.z, x1.w}, Y = {y0.x, y0.y, y0.z, y0.w, y1.x, y1.y, y1.z, y1.w};
    return __builtin_amdgcn_mfma_scale_f32_16x16x128_f8f6f4(X, Y, c, 0, 0, 0, sw, 0, sa);
}
template <class Epi, class Sched, bool ALIGN_EPI = false, bool SP2 = false, int FP8W = -1, int FP8A = -1, bool PRE = false, bool KROT = true, bool MID = false, bool GATH = false>
__device__ __forceinline__ void gemm_phase(PG8_LAS unsigned char* lds, const Gemm g, const Sched& S, const Epi& E) {
    const int tid = threadIdx.x, wid = __builtin_amdgcn_readfirstlane(tid >> 6), lane = tid & 63, wr = wid >> 2, wc = wid & 3, fr = lane & 15, fq = lane >> 4;
    const int K = g.K, nt = K / BK;
    int kpre = 0; if constexpr (PRE) kpre = E.npre(wid);
    constexpr int PRE_OFF = 131072, PRE_SLOT = 4096;
    unsigned voffA[2], voffB[2]; int arow[2]; unsigned acol[2];
#pragma unroll
    for (int i = 0; i < 2; ++i) { int R, C; stage_rc(tid * 16 + i * 8192, R, C); const int Rb = 64 * (R >> 5) + (Epi::PERM ? perm32(R & 31) : (R & 31));
        voffA[i] = (unsigned)(R * K + C) * 2u; voffB[i] = (unsigned)(Rb * K + C) * 2u; arow[i] = R; acol[i] = (unsigned)C * 2u; }
    const size_t kstep = (size_t)(BK * 2);
    const int krot = (PG8_KROT && KROT) ? (int)(blockIdx.x & 7) * (nt >> 3) : 0;
#define PG8_KP(x) ((size_t)(((x) + krot) >= nt ? ((x) + krot - nt) : ((x) + krot)) * kstep)
    const size_t kp0 = PG8_KP(0), kp1 = PG8_KP(1);
    const size_t hstep = (size_t)HALF * K * 2;
    const size_t tstep = 2 * hstep;
    const size_t bh1 = (size_t)32 * K * 2;
    const unsigned ldsw = (unsigned)wid * 1024u;
    const int aoff = lds_byte(wr * 64 + fr, fq * 8), boff = lds_byte(wc * 32 + fr, fq * 8);
#define PG8_SA(b, h) (((b) * 2 + (h)) * HTB)
#define PG8_SB(b, h) ((4 + (b) * 2 + (h)) * HTB)
#define PG8_STAGE(bufoff, gbase, voff) do { _Pragma("unroll") for (int _i = 0; _i < 2; ++_i) \
        __builtin_amdgcn_global_load_lds((const unsigned*)((const char*)(gbase) + (voff)[_i]), (PG8_LAS unsigned*)(lds + (bufoff) + ldsw + _i * 8192), 16, 0, 0); } while (0)
#define PG8_LD8(p) __builtin_shufflevector(*(const PG8_LAS i32x4_t*)(p), *(const PG8_LAS i32x4_t*)((p) + 1024), 0, 1, 2, 3, 4, 5, 6, 7)
#define PG8_LDA(dst, b, h) do { if constexpr (FP8W >= 0) { _Pragma("unroll") for (int m = 0; m < 4; ++m) dst##8[m] = PG8_LD8(lds + PG8_SA(b, h) + aoff + m * 2048); } \
        else { _Pragma("unroll") for (int m = 0; m < 4; ++m) _Pragma("unroll") for (int k = 0; k < 2; ++k) dst[m][k] = *(const PG8_LAS bf16x8*)(lds + PG8_SA(b, h) + aoff + m * 2048 + k * 1024); } } while (0)
#define PG8_LDB(dst, b, h) do { if constexpr (FP8W >= 0) { _Pragma("unroll") for (int n = 0; n < 2; ++n) dst##8[n] = PG8_LD8(lds + PG8_SB(b, h) + boff + n * 2048); } \
        else { _Pragma("unroll") for (int n = 0; n < 2; ++n) _Pragma("unroll") for (int k = 0; k < 2; ++k) dst[n][k] = *(const PG8_LAS bf16x8*)(lds + PG8_SB(b, h) + boff + n * 2048 + k * 1024); } } while (0)
#define PG8_MMA(ai, bj, At, Bt) do { __builtin_amdgcn_s_setprio(1); _Pragma("unroll") for (int m = 0; m < 4; ++m) _Pragma("unroll") for (int n = 0; n < 2; ++n) { \
        if constexpr (FP8W >= 0) { if constexpr (FP8A == 4) { const i32x4_t b4_ = __builtin_shufflevector(Bt##8[n], Bt##8[n], 0, 1, 2, 3), a4_ = __builtin_shufflevector(At##8[m], At##8[m], 0, 1, 2, 3); asm volatile("v_mfma_f32_16x16x128_f8f6f4 %0, %1, %2, %0 cbsz:4 blgp:4" : "+v"(acc[ai][bj][m][n]) : "v"(b4_), "v"(a4_)); } else asm volatile("v_mfma_f32_16x16x128_f8f6f4 %0, %1, %2, %0" : "+v"(acc[ai][bj][m][n]) : "v"(Bt##8[n]), "v"(At##8[m])); } \
        else { _Pragma("unroll") for (int k = 0; k < 2; ++k) acc[ai][bj][m][n] = __builtin_amdgcn_mfma_f32_16x16x32_bf16(Bt[n][k], At[m][k], acc[ai][bj][m][n], 0, 0, 0); } } \
        __builtin_amdgcn_s_setprio(0); } while (0)
#define PG8_WAIT_V(n) asm volatile("s_waitcnt vmcnt(" #n ")" ::: "memory")
#define PG8_WAIT_L(n) asm volatile("s_waitcnt lgkmcnt(" #n ")" ::: "memory")
#define PG8_BAR __builtin_amdgcn_s_barrier()
#define PG8_SCHED __builtin_amdgcn_sched_barrier(0)
    Unit cur, nxt; int ui = 0;
    if (!S.next(0, cur)) return;
    f32x4 acc[2][2][4][2];
#pragma unroll
    for (int a = 0; a < 2; ++a)
#pragma unroll
        for (int b = 0; b < 2; ++b)
#pragma unroll
            for (int m = 0; m < 4; ++m)
#pragma unroll
                for (int n = 0; n < 2; ++n) acc[a][b][m][n] = (f32x4){0.f, 0.f, 0.f, 0.f};
    const int fp8sw = FP8W, fp8sa = FP8A; (void)fp8sw; (void)fp8sa;
    bf16x8 At[4][2], B0[2][2], B1[2][2]; i32x8_t At8[4], B08[2], B18[2];
    const char* cA = (const char*)g.A + (size_t)cur.pm * tstep; const char* cB = (const char*)g.Bt + (size_t)cur.pn * tstep;
    S.a_ready(cur);
    const char* gA = (const char*)g.A; unsigned oc[2][2] = {{0u, 0u}, {0u, 0u}}, on[2][2] = {{0u, 0u}, {0u, 0u}};
    if constexpr (GATH) { static_assert(!GATH || (SP2 && PRE), "gathered A rows: SP2 + PRE form only"); int sb_, nv_; E.arows(cur, sb_, nv_);
#pragma unroll
        for (int h = 0; h < 2; ++h)
#pragma unroll
            for (int i = 0; i < 2; ++i) { const int row = arow[i] + 128 * h; const int p_ = E.RT2[sb_ + row]; oc[h][i] = ((row < nv_) ? (unsigned)(p_ >> 2) : 0u) * (unsigned)(K * 2) + acol[i]; } }
#define PG8_STA(bufslot, h, kbytes, origptr) do { if constexpr (GATH) PG8_STAGE(bufslot, gA + (kbytes), oc[h]); else PG8_STAGE(bufslot, origptr, voffA); } while (0)
    if constexpr (SP2) {
        PG8_STAGE(PG8_SB(0, 0), cB + kp0, voffB); PG8_STAGE(PG8_SB(0, 1), cB + bh1 + kp0, voffB); PG8_STA(PG8_SA(0, 0), 0, kp0, cA + kp0); PG8_STA(PG8_SA(0, 1), 1, kp0, cA + hstep + kp0);
        if (wr == 1) PG8_BAR;
        PG8_WAIT_V(2); PG8_BAR;
        PG8_STAGE(PG8_SB(1, 0), cB + kp1, voffB); PG8_STA(PG8_SA(1, 0), 0, kp1, cA + kp1); PG8_STAGE(PG8_SB(1, 1), cB + bh1 + kp1, voffB);
        PG8_WAIT_V(6); PG8_BAR;
    } else {
        PG8_STAGE(PG8_SB(0, 0), cB + kp0, voffB); PG8_STAGE(PG8_SA(0, 0), cA + kp0, voffA); PG8_STAGE(PG8_SB(0, 1), cB + bh1 + kp0, voffB); PG8_STAGE(PG8_SA(0, 1), cA + hstep + kp0, voffA);
        if (wr == 1) PG8_BAR;
        PG8_WAIT_V(4); PG8_BAR;
        PG8_STAGE(PG8_SB(1, 0), cB + kp1, voffB); PG8_STAGE(PG8_SA(1, 0), cA + kp1, voffA); PG8_STAGE(PG8_SB(1, 1), cB + bh1 + kp1, voffB);
        PG8_WAIT_V(6); PG8_BAR;
    }
    for (;;) {
        const bool has_next = S.next(ui + 1, nxt);
        const char* nA = has_next ? (const char*)g.A + (size_t)nxt.pm * tstep : cA; const char* nB = has_next ? (const char*)g.Bt + (size_t)nxt.pn * tstep : cB;
        for (int t = 0; t < nt; t += 2) {
            if constexpr (MID) { if (t == Epi::MID_T) E.mid(acc, cur, wr, wc, fr, fq); }
            const bool last = (t == nt - 2);
            const char* a1 = cA + PG8_KP(t + 1);
            const size_t k2 = last ? kp0 : PG8_KP(t + 2), k3 = last ? kp1 : PG8_KP(t + 3);
            const char* a2 = (last ? nA : cA) + k2; const char* b2 = (last ? nB : cB) + k2;
            const char* a3 = (last ? nA : cA) + k3; const char* b3 = (last ? nB : cB) + k3;
            if (last && has_next) S.a_ready(nxt);
            if constexpr (SP2) {
            if constexpr (PRE) { if (t == 0) E.prefetch(cur, lds + PRE_OFF + (ui & 1) * PRE_SLOT, wid, lane); }
            if constexpr (GATH) {
                if (t == 0 && has_next && wid < 4) { int sb_, nv_; E.arows(nxt, sb_, nv_);
                    __builtin_amdgcn_global_load_lds((const unsigned*)(E.RT2 + sb_ + wid * 64 + lane), (PG8_LAS unsigned*)(lds + PRE_OFF + ((ui + 1) & 1) * PRE_SLOT + 2048 + wid * 256), 4, 0, 0); }
                if (last) {
                    if (has_next) { int sb_, nv_; E.arows(nxt, sb_, nv_); const PG8_LAS int* rt_ = (const PG8_LAS int*)(lds + PRE_OFF + ((ui + 1) & 1) * PRE_SLOT + 2048);
#pragma unroll
                        for (int h = 0; h < 2; ++h)
#pragma unroll
                            for (int i = 0; i < 2; ++i) { const int row = arow[i] + 128 * h; const int p_ = rt_[row]; on[h][i] = ((row < nv_) ? (unsigned)(p_ >> 2) : 0u) * (unsigned)(K * 2) + acol[i]; } }
                    else { on[0][0] = oc[0][0]; on[0][1] = oc[0][1]; on[1][0] = oc[1][0]; on[1][1] = oc[1][1]; } } }
            PG8_LDB(B0, 0, 0); PG8_LDB(B1, 0, 1); PG8_SCHED; PG8_LDA(At, 0, 0); PG8_STA(PG8_SA(1, 1), 1, PG8_KP(t + 1), a1 + hstep);
            if constexpr (GATH) { if (last) { oc[0][0] = on[0][0]; oc[0][1] = on[0][1]; oc[1][0] = on[1][0]; oc[1][1] = on[1][1]; } }
            if (PRE && t == 0 && kpre == 1) PG8_WAIT_V(9); else if (PRE && t == 0 && kpre == 2) PG8_WAIT_V(10); else PG8_WAIT_V(8);
            PG8_WAIT_L(0); PG8_BAR; PG8_MMA(0, 0, At, B0); PG8_MMA(0, 1, At, B1); PG8_BAR; PG8_SCHED;
            PG8_LDA(At, 0, 1); PG8_STAGE(PG8_SB(0, 0), b2, voffB); PG8_STAGE(PG8_SB(0, 1), b2 + bh1, voffB); PG8_STA(PG8_SA(0, 0), 0, k2, a2);
            if (PRE && t == 0 && kpre == 1) PG8_WAIT_V(9); else if (PRE && t == 0 && kpre == 2) PG8_WAIT_V(10); else PG8_WAIT_V(8);
            PG8_WAIT_L(0); PG8_BAR; PG8_MMA(1, 0, At, B0); PG8_MMA(1, 1, At, B1); PG8_BAR; PG8_SCHED;
            PG8_LDB(B0, 1, 0); PG8_LDB(B1, 1, 1); PG8_SCHED; PG8_LDA(At, 1, 0); PG8_STA(PG8_SA(0, 1), 1, k2, a2 + hstep);
            PG8_WAIT_V(8); PG8_WAIT_L(0); PG8_BAR; PG8_MMA(0, 0, At, B0); PG8_MMA(0, 1, At, B1); PG8_BAR; PG8_SCHED;
            PG8_LDA(At, 1, 1); PG8_STAGE(PG8_SB(1, 0), b3, voffB); PG8_STAGE(PG8_SB(1, 1), b3 + bh1, voffB); PG8_STA(PG8_SA(1, 0), 0, k3, a3);
            PG8_WAIT_V(8); PG8_WAIT_L(0); PG8_BAR; PG8_MMA(1, 0, At, B0); PG8_MMA(1, 1, At, B1); PG8_BAR; PG8_SCHED;
            } else {
            PG8_LDB(B0, 0, 0); PG8_SCHED; PG8_LDA(At, 0, 0); PG8_STAGE(PG8_SA(1, 1), a1 + hstep, voffA);
            PG8_WAIT_L(8); PG8_BAR; PG8_WAIT_L(0); PG8_MMA(0, 0, At, B0); PG8_BAR; PG8_SCHED;
            PG8_LDB(B1, 0, 1); PG8_STAGE(PG8_SB(0, 0), b2, voffB);
            PG8_BAR; PG8_WAIT_L(0); PG8_MMA(0, 1, At, B1); PG8_BAR;
            PG8_LDA(At, 0, 1); PG8_STAGE(PG8_SA(0, 0), a2, voffA);
            PG8_BAR; PG8_WAIT_L(0); PG8_MMA(1, 0, At, B0); PG8_BAR; PG8_SCHED;
            PG8_STAGE(PG8_SB(0, 1), b2 + bh1, voffB);
            PG8_WAIT_V(6); PG8_BAR; PG8_MMA(1, 1, At, B1); PG8_BAR;
            PG8_LDB(B0, 1, 0); PG8_SCHED; PG8_LDA(At, 1, 0); PG8_STAGE(PG8_SA(0, 1), a2 + hstep, voffA);
            PG8_WAIT_L(8); PG8_BAR; PG8_WAIT_L(0); PG8_MMA(0, 0, At, B0); PG8_BAR; PG8_SCHED;
            PG8_LDB(B1, 1, 1); PG8_STAGE(PG8_SB(1, 0), b3, voffB);
            PG8_BAR; PG8_WAIT_L(0); PG8_MMA(0, 1, At, B1); PG8_BAR;
            PG8_LDA(At, 1, 1); PG8_STAGE(PG8_SA(1, 0), a3, voffA);
            PG8_BAR; PG8_WAIT_L(0); PG8_MMA(1, 0, At, B0); PG8_BAR; PG8_SCHED;
            PG8_STAGE(PG8_SB(1, 1), b3 + bh1, voffB);
            PG8_WAIT_V(6); PG8_BAR; PG8_MMA(1, 1, At, B1); PG8_BAR;
            }
        }
        {
#pragma unroll
            for (int a_ = 0; a_ < 2; ++a_)
#pragma unroll
                for (int b_ = 0; b_ < 2; ++b_)
                    asm volatile("s_nop 15\n\ts_nop 15" : "+v"(acc[a_][b_][0][0]), "+v"(acc[a_][b_][0][1]), "+v"(acc[a_][b_][1][0]), "+v"(acc[a_][b_][1][1]), "+v"(acc[a_][b_][2][0]), "+v"(acc[a_][b_][2][1]), "+v"(acc[a_][b_][3][0]), "+v"(acc[a_][b_][3][1]));
        }
        if constexpr (ALIGN_EPI) { if (wr == 0) PG8_BAR; }
        if constexpr (!Epi::AFTER_DRAIN) { if constexpr (PRE) E(acc, cur, wr, wc, fr, fq, lds + PRE_OFF + (ui & 1) * PRE_SLOT); else E(acc, cur, wr, wc, fr, fq); S.done(cur); }
        if (!has_next) break;
#pragma unroll
        for (int a = 0; a < 2; ++a)
#pragma unroll
            for (int b = 0; b < 2; ++b)
#pragma unroll
                for (int m = 0; m < 4; ++m)
#pragma unroll
                    for (int n = 0; n < 2; ++n) acc[a][b][m][n] = (f32x4){0.f, 0.f, 0.f, 0.f};
        cur = nxt; cA = nA; cB = nB; ++ui;
        if constexpr (ALIGN_EPI) { if (wr == 1) PG8_BAR; }
    }
    PG8_WAIT_V(0);
    if constexpr (!ALIGN_EPI) { if (wr == 0) PG8_BAR; }
    PG8_BAR;
    if constexpr (Epi::AFTER_DRAIN) { E.fused(acc, cur, wr, wc, fr, fq, lds, wid, lane); S.done(cur); }
#undef PG8_KP
#undef PG8_STA
#undef PG8_SA
#undef PG8_SB
#undef PG8_STAGE
#undef PG8_LD8
#undef PG8_LDA
#undef PG8_LDB
#undef PG8_MMA
#undef PG8_WAIT_V
#undef PG8_WAIT_L
#undef PG8_BAR
#undef PG8_SCHED
}
}


constexpr int NB = 4, SEQ = 4096, T = NB * SEQ, D = 2048;
constexpr int RW = 1024, NH = 16, HD = 64;
constexpr int IN_W = 12064, SHIFT_W = 3360;
constexpr int ZPW = 3584, QKVW = 4608, GATEW = 4096, NPROJ = 12288;
constexpr int NE = 32, FF = 2048;
constexpr int XS_ROWS = T * 4 + NE * 256;
constexpr int NWAVES = 8, NTHREADS = 512;
constexpr float NORM_EPS = 1e-5f, GN_EPS = 64e-5f;
constexpr float QSCALE = 0.08838834764831845f * 1.4426950408889634f;

#ifndef MK_ONE_LAUNCH
#define MK_ONE_LAUNCH 1
#endif
constexpr int NPHASES = 14;

constexpr size_t MiB = 1ull << 20;
constexpr size_t WS_CTL = 0, CTL_ZERO_BYTES = 1 * MiB;
constexpr size_t WS_WIN = 1 * MiB;
constexpr size_t WS_W1 = WS_WIN + 48 * MiB;
constexpr size_t WS_W2 = WS_W1 + 512 * MiB;
constexpr size_t WS_WOR = WS_W2 + 256 * MiB;
constexpr size_t WS_WOA = WS_WOR + 4 * MiB;
constexpr size_t WS_WOUT = WS_WOA + 2 * MiB;
constexpr size_t WS_H = WS_WOUT + 8 * MiB;
constexpr size_t WS_ZP = WS_H + 64 * MiB;
constexpr size_t WS_QKV = WS_ZP + 112 * MiB;
constexpr size_t WS_GATES = WS_QKV + 144 * MiB;
constexpr size_t WS_ROT = WS_GATES + 128 * MiB;
constexpr size_t WS_SC = WS_ROT + 2 * MiB;
constexpr size_t WS_G = WS_SC + 384 * MiB;
constexpr size_t WS_BONUS = WS_G + 32 * MiB;
constexpr size_t WS_Y = WS_BONUS + 1 * MiB;
constexpr size_t WS_ATTO = WS_Y + 64 * MiB;
constexpr size_t WS_ATTML = WS_ATTO + 48 * MiB;
constexpr size_t WS_YAIN = WS_ATTML + 2 * MiB;
constexpr size_t WS_OIN = WS_YAIN + 32 * MiB;
constexpr size_t WS_MERGED = WS_OIN + 16 * MiB;
constexpr size_t WS_X1 = WS_MERGED + 64 * MiB;
constexpr size_t WS_TOPK = WS_X1 + 128 * MiB;
constexpr size_t WS_ROWS = WS_TOPK + 1 * MiB;
constexpr size_t WS_XS = WS_ROWS + 1 * MiB;
constexpr size_t WS_ACT = WS_XS + 288 * MiB;
constexpr size_t WS_OUTK = WS_ACT + 288 * MiB;
constexpr size_t WS_LORA = WS_OUTK + 256 * MiB;
constexpr size_t WS_H8 = WS_LORA + 1 * MiB;
constexpr size_t WS_WG8 = WS_H8 + 32 * MiB;
constexpr size_t WS_MERGED8 = WS_WG8 + 16 * MiB;
constexpr size_t WS_ROWS2 = WS_MERGED8 + 32 * MiB;
constexpr size_t WS_WG8B = WS_ROWS2 + 4 * MiB;
constexpr size_t WS_END = WS_WG8B + 20 * MiB;
constexpr size_t WS_S1 = WS_XS;
constexpr int NU16 = NB * NH * (SEQ / 16);
constexpr size_t S1_WH = 0, S1_QH = 32 * MiB, S1_BT = 64 * MiB, S1_KT = 96 * MiB, S1_VT = 128 * MiB, S1_U0T = 160 * MiB, S1_Y0T = 224 * MiB, S1_GAM = 288 * MiB;
constexpr size_t SC_STRIDE = (size_t)T * RW;
enum { SH_KK = 0, SH_BB = 1, SH_K = 2, SH_R = 3, SH_V = 4 };

constexpr int CW_TMO = 0, CW_CODE = 1, CW_BAR = 4096, CW_CNT = 8192;

constexpr int RING_BYTES = 131072;
constexpr int TAB_OFF = 147456;
constexpr int MISC_OFF = TAB_OFF + 512;
constexpr int LDS_BYTES = 151552;

#define GAS __attribute__((address_space(1)))
#define LAS __attribute__((address_space(3)))
typedef unsigned short bf16;
typedef unsigned u32x4 __attribute__((ext_vector_type(4)));
typedef unsigned u32x2 __attribute__((ext_vector_type(2)));
typedef float f32x2 __attribute__((ext_vector_type(2)));
typedef float f32x4 __attribute__((ext_vector_type(4)));
typedef short bf16x8 __attribute__((ext_vector_type(8)));
typedef short bf16x4 __attribute__((ext_vector_type(4)));
typedef GAS unsigned gu32;
#define RLX_AGENT __ATOMIC_RELAXED, __HIP_MEMORY_SCOPE_AGENT
#define LDS_WAIT() asm volatile("s_waitcnt lgkmcnt(0)" ::: "memory")
#define VM_WAIT() asm volatile("s_waitcnt vmcnt(0)" ::: "memory")
__device__ __forceinline__ unsigned f2bf(float f) { unsigned u = __builtin_bit_cast(unsigned, f); return (u + 0x7fffu + ((u >> 16) & 1u)) >> 16; }
__device__ __forceinline__ unsigned pk2(float lo, float hi) { return f2bf(lo) | (f2bf(hi) << 16); }
__device__ __forceinline__ unsigned pk2h(float lo, float hi) { unsigned r; asm("s_nop 1\n\tv_cvt_pk_bf16_f32 %0, %1, %2" : "=v"(r) : "v"(lo), "v"(hi)); return r; }
__device__ __forceinline__ u32x4 pack8h(const f32x4& a, const f32x4& b) { u32x4 w; w.x = pk2h(a[0], a[1]); w.y = pk2h(a[2], a[3]); w.z = pk2h(b[0], b[1]); w.w = pk2h(b[2], b[3]); return w; }
__device__ __forceinline__ float bflo(unsigned w) { return __uint_as_float(w << 16); }
__device__ __forceinline__ float bfhi(unsigned w) { return __uint_as_float(w & 0xffff0000u); }
__device__ __forceinline__ float bf2f(bf16 h) { return __uint_as_float((unsigned)h << 16); }
__device__ __forceinline__ float sigmoidf_(float x) { return __builtin_amdgcn_rcpf(1.0f + __builtin_amdgcn_exp2f(-1.4426950408889634f * x)); }
__device__ __forceinline__ float tanhf_(float x) { return 1.0f - 2.0f * __builtin_amdgcn_rcpf(1.0f + __builtin_amdgcn_exp2f(2.8853900817779268f * x)); }
__device__ __forceinline__ unsigned pk2v(float lo, float hi) { unsigned r; asm("s_nop 1\n\tv_cvt_pk_bf16_f32 %0, %1, %2" : "=v"(r) : "v"(lo), "v"(hi)); return r; }
__device__ __forceinline__ float wave_sum(float v) {
#pragma unroll
    for (int o = 1; o < 64; o <<= 1) v += __shfl_xor(v, o);
    return v;
}
__device__ __forceinline__ unsigned pk4_fp8(float a, float b, float c, float d) { int r = __builtin_amdgcn_cvt_pk_fp8_f32(a, b, 0, false); r = __builtin_amdgcn_cvt_pk_fp8_f32(c, d, r, true); return (unsigned)r; }
__device__ __forceinline__ u32x4 pack8(const f32x4& a, const f32x4& b) { u32x4 w; w.x = pk2(a[0], a[1]); w.y = pk2(a[2], a[3]); w.z = pk2(b[0], b[1]); w.w = pk2(b[2], b[3]); return w; }
__device__ __forceinline__ void unpack8(const u32x4& w, f32x4& a, f32x4& b) { a = (f32x4){bflo(w.x), bfhi(w.x), bflo(w.y), bfhi(w.y)}; b = (f32x4){bflo(w.z), bfhi(w.z), bflo(w.w), bfhi(w.w)}; }

#define XB_TMO      128
#define XB_XCNT(j)  (256  + 64 * (j))
#define XB_XSUB(j)  (1280 + 64 * (j))
#define XB_XGEN(j)  (2304 + 64 * (j))
#define XB_TOP      3328
#define XB_TOPGEN   3392
#define XCD_BAR_WORDS 3456
#define XB_SPIN_CAP (1u << 18)

__device__ __forceinline__ unsigned xb_ld(unsigned* p)              { return __hip_atomic_load(p, __ATOMIC_RELAXED, __HIP_MEMORY_SCOPE_AGENT); }
__device__ __forceinline__ unsigned xb_add(unsigned* p, unsigned v) { return __hip_atomic_fetch_add(p, v, __ATOMIC_RELAXED, __HIP_MEMORY_SCOPE_AGENT); }
__device__ __forceinline__ unsigned xb_xcc_id() { return (unsigned)__builtin_amdgcn_s_getreg((3 << 11) | 20) & 0xFu; }
#define XB_SPIN(cond, bar) do { unsigned _sp = 0; while (cond) { __builtin_amdgcn_s_sleep(1); \
    if ((++_sp & 255u) == 0u) { if (xb_ld(&(bar)[XB_TMO])) break; if (_sp > XB_SPIN_CAP) { atomicAdd(&(bar)[XB_TMO], 1u); break; } } } } while (0)

struct XcdBarrier {
    unsigned* bar; unsigned x;
    volatile LAS unsigned* st;
};

__device__ __forceinline__ XcdBarrier xcd_barrier_post(unsigned* bar, volatile LAS unsigned* st) {
    XcdBarrier b; b.bar = bar; b.x = xb_xcc_id(); b.st = st;
    if (threadIdx.x == 0) (void)xb_add(&bar[XB_XCNT(b.x)], 1u);
    return b;
}
__device__ __forceinline__ void xcd_barrier_complete(unsigned* bar, unsigned x, unsigned& nloc, unsigned& nx) {
    const unsigned G = gridDim.x * gridDim.y * gridDim.z;
    unsigned sum, cnt, mine, sp = 0u;
    for (;;) {
        sum = 0u; cnt = 0u; mine = 0u;
#pragma unroll
        for (unsigned j = 0; j < 16; ++j) { const unsigned c = xb_ld(&bar[XB_XCNT(j)]); sum += c; cnt += (c > 0u) ? 1u : 0u; mine = (j == x) ? c : mine; }
        if (sum == G) break;
        __builtin_amdgcn_s_sleep(1);
        if ((++sp & 255u) == 0u) { if (xb_ld(&bar[XB_TMO])) break; if (sp > XB_SPIN_CAP) { atomicAdd(&bar[XB_TMO], 1u); break; } }
    }
    nloc = mine > 0u ? mine : 1u; nx = cnt > 0u ? cnt : 1u;
}

__device__ __forceinline__ void xcd_barrier(const XcdBarrier& b) {
    asm volatile("s_waitcnt vmcnt(0)" ::: "memory");
    __syncthreads();
    if (threadIdx.x == 0) {
        unsigned* bar = b.bar;
        __builtin_amdgcn_s_waitcnt(0);
        unsigned nloc = b.st[0], nx = b.st[1];
        if (nloc == 0u) { xcd_barrier_complete(bar, b.x, nloc, nx); b.st[0] = nloc; b.st[1] = nx; }
        const unsigned old = xb_add(&bar[XB_XSUB(b.x)], 1u);
        const unsigned gen = old / nloc;
        if (old + 1u == (gen + 1u) * nloc) {
            __builtin_amdgcn_fence(__ATOMIC_RELEASE, "agent");
            asm volatile("s_waitcnt vmcnt(0)" ::: "memory");
            const unsigned og = xb_add(&bar[XB_TOP], 1u);
            const unsigned tg = og / nx;
            if (og + 1u == (tg + 1u) * nx) xb_add(&bar[XB_TOPGEN], 1u);
            else XB_SPIN(xb_ld(&bar[XB_TOPGEN]) == tg, bar);
            __builtin_amdgcn_fence(__ATOMIC_ACQUIRE, "agent");
            xb_add(&bar[XB_XGEN(b.x)], 1u);
            asm volatile("s_waitcnt vmcnt(0)" ::: "memory");
        } else {
            XB_SPIN(xb_ld(&bar[XB_XGEN(b.x)]) == gen, bar);
            __builtin_amdgcn_fence(__ATOMIC_ACQUIRE, "agent");
            asm volatile("s_waitcnt vmcnt(0)" ::: "memory");
        }
    }
    __syncthreads();
}


struct Ptrs {
    const float *x, *norm_mix, *w_in, *shift_mu, *w0, *w2_decay, *a0, *a2_iclr, *g2_gate, *k_k, *k_a, *r_k, *ln_x_w, *ln_x_b, *w_o_rwkv, *w_o_attn, *w_out, *norm_ffn, *w_router, *b_router, *w1, *b1, *w2, *b2, *norm_final;
    const int* positions;
    float* out;
    bf16 *LW, *LA, *LG, *WRH, *WRL, *WIN, *W1, *W2, *WOR, *WOA, *WOUT, *H, *ZP, *QKV, *GATES, *G, *ATTO, *YAIN, *OIN, *MERGED, *XS, *ACT, *OUTK;
    bf16* SCH;
    float *ROT, *SC, *BONUS, *Y, *ATTML, *TOPK_GATE, *ROWGATE, *RG2; bf16* X1; int* RT2;
    int *TOPK_E, *TOPK_POS, *ROWTOK;
    gu32* ctl;
};

using pg8::Unit;
__device__ __forceinline__ void store8(bf16* p, const f32x4& a, const f32x4& b) { *(u32x4*)p = pack8h(a, b); }

struct EpiProj {
    static constexpr bool PERM = true, AFTER_DRAIN = false;
    bf16* ZP; bf16* QKV; bf16* GATES; const float* ROT; int dry; int pn_off; float descale;
    __device__ __forceinline__ void operator()(const f32x4 (&accq)[2][2][4][2], const Unit& u, int wr, int wc, int fr, int fq) const {
        if (dry == 1) return;
        f32x4 acc[2][2][4][2];
#pragma unroll
        for (int a_ = 0; a_ < 2; ++a_)
#pragma unroll
            for (int b_ = 0; b_ < 2; ++b_)
#pragma unroll
                for (int m_ = 0; m_ < 4; ++m_)
#pragma unroll
                    for (int n_ = 0; n_ < 2; ++n_) acc[a_][b_][m_][n_] = accq[a_][b_][m_][n_] * descale;
        const int pn = u.pn + pn_off, rbase = u.pm * 256 + wr * 64 + fr, cw = wc * 64 + 8 * fq;
        if (pn < 14) {
#pragma unroll
            for (int ai = 0; ai < 2; ++ai)
#pragma unroll
                for (int m = 0; m < 4; ++m) { bf16* rp = ZP + (size_t)(rbase + ai * 128 + m * 16) * ZPW + pn * 256 + cw;
#pragma unroll
                    for (int bj = 0; bj < 2; ++bj) if ((dry != 3 || bj == 0) && (dry != 4 || (bj == 0 && ai == 0 && m == 0))) store8(rp + bj * 32, acc[ai][bj][m][0], acc[ai][bj][m][1]); }
        } else if (pn < 32) {
            const int t = pn - 14; const bool rotw = (t < 12) && ((wc & 1) == 0);   const float sc = (t < 6) ? QSCALE : 1.0f; const float sg = (fq < 2) ? -1.0f : 1.0f;
#pragma unroll
            for (int ai = 0; ai < 2; ++ai)
#pragma unroll
                for (int m = 0; m < 4; ++m) { const int row = rbase + ai * 128 + m * 16; bf16* rp = QKV + (size_t)row * QKVW + t * 256 + cw;
                    f32x4 c0 = {1.f, 1.f, 1.f, 1.f}, c1 = c0, s0 = {0.f, 0.f, 0.f, 0.f}, s1 = s0;
                    if (rotw) { const float* rt = ROT + (size_t)row * 32 + 8 * (fq & 1); c0 = *(const f32x4*)rt; c1 = *(const f32x4*)(rt + 4); s0 = *(const f32x4*)(rt + 16); s1 = *(const f32x4*)(rt + 20); }
#pragma unroll
                    for (int bj = 0; bj < 2; ++bj) { f32x4 v0 = acc[ai][bj][m][0], v1 = acc[ai][bj][m][1];
                        if (rotw && bj == 0) { f32x4 p0, p1;
#pragma unroll
                            for (int j = 0; j < 4; ++j) { p0[j] = __shfl_xor(v0[j], 32); p1[j] = __shfl_xor(v1[j], 32); }
                            v0 = v0 * c0 + (p0 * s0) * sg; v1 = v1 * c1 + (p1 * s1) * sg; }
                        v0 = v0 * sc; v1 = v1 * sc; store8(rp + bj * 32, v0, v1); } }
        } else {
            const int t = pn - 32;
#pragma unroll
            for (int ai = 0; ai < 2; ++ai)
#pragma unroll
                for (int m = 0; m < 4; ++m) { unsigned char* rp = (unsigned char*)GATES + (size_t)(rbase + ai * 128 + m * 16) * GATEW + t * 256 + cw;
#pragma unroll
                    for (int bj = 0; bj < 2; ++bj) { f32x4 v0 = acc[ai][bj][m][0], v1 = acc[ai][bj][m][1]; unsigned q0[4], q1[4];
#pragma unroll
                        for (int j = 0; j < 4; ++j) { q0[j] = (unsigned)(sigmoidf_(v0[j]) * 255.0f + 0.5f); q1[j] = (unsigned)(sigmoidf_(v1[j]) * 255.0f + 0.5f); }
                        u32x2 w; w.x = q0[0] | (q0[1] << 8) | (q0[2] << 16) | (q0[3] << 24); w.y = q1[0] | (q1[1] << 8) | (q1[2] << 16) | (q1[3] << 24);
                        *(u32x2*)(rp + bj * 32) = w; } }
        }
    }
};

template <int STAGE> struct EpiMerge {
    static constexpr bool PERM = true, AFTER_DRAIN = false;
    bf16* MERGED; const bf16* GATES; unsigned char* M8;
    __device__ __forceinline__ void operator()(const f32x4 (&acc)[2][2][4][2], const Unit& u, int wr, int wc, int fr, int fq) const {
        const int rbase = u.pm * 256 + wr * 64 + fr, cb = u.pn * 256 + wc * 64 + 8 * fq;
#pragma unroll
        for (int ai = 0; ai < 2; ++ai)
#pragma unroll
            for (int m = 0; m < 4; ++m) { const int row = rbase + ai * 128 + m * 16;
#pragma unroll
                for (int bj = 0; bj < 2; ++bj) { const int col = cb + bj * 32;
                    const u32x2 gw = *(const u32x2*)((const unsigned char*)GATES + (size_t)row * GATEW + STAGE * 2048 + col);
                    const f32x4 g0 = (f32x4){(float)(gw.x & 255u), (float)((gw.x >> 8) & 255u), (float)((gw.x >> 16) & 255u), (float)(gw.x >> 24)} * (1.0f / 255.0f);
                    const f32x4 g1 = (f32x4){(float)(gw.y & 255u), (float)((gw.y >> 8) & 255u), (float)((gw.y >> 16) & 255u), (float)(gw.y >> 24)} * (1.0f / 255.0f);
                    f32x4 v0 = acc[ai][bj][m][0] * g0, v1 = acc[ai][bj][m][1] * g1; bf16* dp = MERGED + (size_t)row * D + col;
                    if (STAGE == 1) { const u32x4 tw = *(const u32x4*)dp; f32x4 t0, t1; unpack8(tw, t0, t1); v0 = v0 + t0; v1 = v1 + t1; }
                    if (STAGE == 1) { u32x2 w8; w8.x = pk4_fp8(v0[0] * 16.0f, v0[1] * 16.0f, v0[2] * 16.0f, v0[3] * 16.0f); w8.y = pk4_fp8(v1[0] * 16.0f, v1[1] * 16.0f, v1[2] * 16.0f, v1[3] * 16.0f); *(u32x2*)(M8 + (size_t)row * D + col) = w8; }
                    else store8(dp, v0, v1); } }
    }
};

struct EpiMerge2 {
    static constexpr bool PERM = true, AFTER_DRAIN = false; static constexpr int MID_T = 16;
    const bf16* GATES; unsigned char* M8;
    __device__ __forceinline__ void gates8(const unsigned char* gp, f32x4& a, f32x4& b) const { const u32x2 w = *(const u32x2*)gp;
        a = (f32x4){(float)(w.x & 255u), (float)((w.x >> 8) & 255u), (float)((w.x >> 16) & 255u), (float)(w.x >> 24)}; b = (f32x4){(float)(w.y & 255u), (float)((w.y >> 8) & 255u), (float)((w.y >> 16) & 255u), (float)(w.y >> 24)}; }
    __device__ __forceinline__ void mid(f32x4 (&acc)[2][2][4][2], const Unit& u, int wr, int wc, int fr, int fq) const {
        int rbase = u.pm * 256 + wr * 64 + fr, cb = u.pn * 256 + wc * 64 + 8 * fq; asm volatile("" : "+v"(rbase), "+v"(cb));
#pragma unroll
        for (int ai = 0; ai < 2; ++ai)
#pragma unroll
            for (int m = 0; m < 4; ++m) { const int row = rbase + ai * 128 + m * 16;
#pragma unroll
                for (int bj = 0; bj < 2; ++bj) { const unsigned char* gp = (const unsigned char*)GATES + (size_t)row * GATEW + cb + bj * 32;
                    f32x4 r0, r1, a0, a1; gates8(gp, r0, r1); gates8(gp + 2048, a0, a1);
#pragma unroll
                    for (int j = 0; j < 4; ++j) { acc[ai][bj][m][0][j] *= r0[j] * __builtin_amdgcn_rcpf(fmaxf(a0[j], 1.0f)); acc[ai][bj][m][1][j] *= r1[j] * __builtin_amdgcn_rcpf(fmaxf(a1[j], 1.0f)); }
                    __builtin_amdgcn_sched_barrier(0); } }
    }
    __device__ __forceinline__ void operator()(const f32x4 (&acc)[2][2][4][2], const Unit& u, int wr, int wc, int fr, int fq) const {
        const int rbase = u.pm * 256 + wr * 64 + fr, cb = u.pn * 256 + wc * 64 + 8 * fq;
#pragma unroll
        for (int ai = 0; ai < 2; ++ai)
#pragma unroll
            for (int m = 0; m < 4; ++m) { const int row = rbase + ai * 128 + m * 16;
#pragma unroll
                for (int bj = 0; bj < 2; ++bj) { const int col = cb + bj * 32; f32x4 a0, a1; gates8((const unsigned char*)GATES + (size_t)row * GATEW + 2048 + col, a0, a1);
                    f32x4 v0, v1;
#pragma unroll
                    for (int j = 0; j < 4; ++j) { v0[j] = acc[ai][bj][m][0][j] * (fmaxf(a0[j], 1.0f) * (16.0f / 255.0f)); v1[j] = acc[ai][bj][m][1][j] * (fmaxf(a1[j], 1.0f) * (16.0f / 255.0f)); }
                    u32x2 w8; w8.x = pk4_fp8(v0[0], v0[1], v0[2], v0[3]); w8.y = pk4_fp8(v1[0], v1[1], v1[2], v1[3]); *(u32x2*)(M8 + (size_t)row * D + col) = w8; } }
    }
};

struct EpiResid {
    static constexpr bool PERM = true, AFTER_DRAIN = false;
    const float* X; bf16* X1; float descale;
    __device__ __forceinline__ void operator()(const f32x4 (&acc)[2][2][4][2], const Unit& u, int wr, int wc, int fr, int fq) const {
        const int rbase = u.pm * 256 + wr * 64 + fr, cb = u.pn * 256 + wc * 64 + 8 * fq;
#pragma unroll
        for (int ai = 0; ai < 2; ++ai)
#pragma unroll
            for (int m = 0; m < 4; ++m) { const size_t ro = (size_t)(rbase + ai * 128 + m * 16) * D;
#pragma unroll
                for (int bj = 0; bj < 2; ++bj) { const int col = cb + bj * 32;
                    const f32x4 v0 = *(const f32x4*)(X + ro + col) + acc[ai][bj][m][0] * descale, v1 = *(const f32x4*)(X + ro + col + 4) + acc[ai][bj][m][1] * descale;
                    store8(X1 + ro + col, v0, v1); } }
    }
};

struct EpiMoe1 {
    static constexpr bool PERM = true, AFTER_DRAIN = false;
    bf16* ACT; const float* b1; int dry; const int* RT2; const LAS int* tab;
    __device__ __forceinline__ void arows(const Unit& u, int& sbase, int& nvalid) const { const int e = u.pn >> 4, pml = u.pm - tab[e]; sbase = e * 16384 + pml * 256; nvalid = tab[64 + e] - pml * 256; }
    __device__ __forceinline__ int npre(int wid) const { return wid < 4 ? 2 : 0; }
    __device__ __forceinline__ void prefetch(const Unit& u, LAS unsigned char* slot, int wid, int lane) const {
        if (wid < 4) { const int e = u.pn >> 4, pnl = u.pn & 15, i = wid * 64 + lane;
            __builtin_amdgcn_global_load_lds((const unsigned*)(b1 + (size_t)e * 4096 + (i >> 7) * 2048 + pnl * 128 + (i & 127)), (LAS unsigned*)(slot + wid * 256), 4, 0, 0); }
    }
    __device__ __forceinline__ void operator()(const f32x4 (&acc)[2][2][4][2], const Unit& u, int wr, int wc, int fr, int fq, const LAS unsigned char* slot) const {
        if (dry) return;
        const int pnl = u.pn & 15, rbase = u.pm * 256 + wr * 64 + fr, col = pnl * 128 + wc * 32 + 8 * fq;
        const LAS float* bg = (const LAS float*)slot + wc * 32 + 8 * fq; const LAS float* bl = bg + 128;
        const f32x4 bg0 = *(const LAS f32x4*)bg, bg1 = *(const LAS f32x4*)(bg + 4), bl0 = *(const LAS f32x4*)bl, bl1 = *(const LAS f32x4*)(bl + 4);
        const f32x2 S1 = {0.03125f, 0.03125f}, S8 = {0.25f, 0.25f}, CE = {-2.4554669595930156f, -2.4554669595930156f}, ONE = {1.0f, 1.0f};
        f32x2 bgp[4], blp[4];
        bgp[0] = (f32x2){bg0[0], bg0[1]}; bgp[1] = (f32x2){bg0[2], bg0[3]}; bgp[2] = (f32x2){bg1[0], bg1[1]}; bgp[3] = (f32x2){bg1[2], bg1[3]};
        blp[0] = (f32x2){bl0[0], bl0[1]} * 8.0f + 8.0f; blp[1] = (f32x2){bl0[2], bl0[3]} * 8.0f + 8.0f; blp[2] = (f32x2){bl1[0], bl1[1]} * 8.0f + 8.0f; blp[3] = (f32x2){bl1[2], bl1[3]} * 8.0f + 8.0f;
#pragma unroll
        for (int ai = 0; ai < 2; ++ai)
#pragma unroll
            for (int m = 0; m < 4; ++m) { const int row = rbase + ai * 128 + m * 16;
                f32x2 o[4];
#pragma unroll
                for (int q = 0; q < 4; ++q) { const f32x4 ag = acc[ai][0][m][q >> 1], al = acc[ai][1][m][q >> 1];
                    const f32x2 agp = (q & 1) ? (f32x2){ag[2], ag[3]} : (f32x2){ag[0], ag[1]}, alp = (q & 1) ? (f32x2){al[2], al[3]} : (f32x2){al[0], al[1]};
                    const f32x2 G = __builtin_elementwise_fma(agp, S1, bgp[q]), L = __builtin_elementwise_fma(alp, S8, blp[q]);
                    const f32x2 xg = {fminf(G[0], 7.0f), fminf(G[1], 7.0f)};
                    const f32x2 xl = {fminf(fmaxf(L[0], -48.0f), 64.0f), fminf(fmaxf(L[1], -48.0f), 64.0f)};
                    const f32x2 ea = xg * CE;
                    const f32x2 en = (f32x2){__builtin_amdgcn_exp2f(ea[0]), __builtin_amdgcn_exp2f(ea[1])} + ONE;
                    const f32x2 rc = {__builtin_amdgcn_rcpf(en[0]), __builtin_amdgcn_rcpf(en[1])};
                    o[q] = (xg * rc) * xl; }
                u32x2 w8; w8.x = pk4_fp8(o[0][0], o[0][1], o[1][0], o[1][1]); w8.y = pk4_fp8(o[2][0], o[2][1], o[3][0], o[3][1]);
                *(u32x2*)((unsigned char*)ACT + (size_t)row * FF + col) = w8; }
    }
};

struct EpiMoe2 {
    static constexpr bool PERM = true, AFTER_DRAIN = false;
    bf16* OUTK; const float* b2; const int* ROWTOK; const float* ROWGATE; int dry; const LAS int* tab;
    __device__ __forceinline__ int npre(int wid) const { return wid < 4 ? 2 : 1; }
    __device__ __forceinline__ void prefetch(const Unit& u, LAS unsigned char* slot, int wid, int lane) const {
        const int e = u.pn >> 3, pnl = u.pn & 7, i = (wid & 3) * 64 + lane; const size_t sb = (size_t)e * 16384 + (size_t)(u.pm - tab[e]) * 256;
        if (wid < 4) { __builtin_amdgcn_global_load_lds((const unsigned*)(b2 + (size_t)e * D + pnl * 256 + i), (LAS unsigned*)(slot + wid * 256), 4, 0, 0);
                       __builtin_amdgcn_global_load_lds((const unsigned*)(ROWGATE + sb + i), (LAS unsigned*)(slot + 2048 + wid * 256), 4, 0, 0); }
        else __builtin_amdgcn_global_load_lds((const unsigned*)(ROWTOK + sb + i), (LAS unsigned*)(slot + 1024 + (wid & 3) * 256), 4, 0, 0);
    }
    __device__ __forceinline__ void operator()(const f32x4 (&acc)[2][2][4][2], const Unit& u, int wr, int wc, int fr, int fq, const LAS unsigned char* slot) const {
        if (dry) return;
        const int pnl = u.pn & 7, cb = pnl * 256 + wc * 64 + 8 * fq, e_ = u.pn >> 3, nvalid = tab[64 + e_] - (u.pm - tab[e_]) * 256;
        f32x4 bv[2][2];
#pragma unroll
        for (int bj = 0; bj < 2; ++bj) { const LAS float* bp = (const LAS float*)slot + wc * 64 + 8 * fq + bj * 32; bv[bj][0] = *(const LAS f32x4*)bp; bv[bj][1] = *(const LAS f32x4*)(bp + 4); }
        int pr[8]; float gr[8];
#pragma unroll
        for (int i = 0; i < 8; ++i) { const int rl = wr * 64 + fr + (i >> 2) * 128 + (i & 3) * 16; pr[i] = ((const LAS int*)(slot + 1024))[rl]; gr[i] = ((const LAS float*)(slot + 2048))[rl]; }
#pragma unroll
        for (int ai = 0; ai < 2; ++ai)
#pragma unroll
            for (int m = 0; m < 4; ++m) { const int p = pr[ai * 4 + m];
                if (wr * 64 + fr + ai * 128 + m * 16 < nvalid) { const float gt = gr[ai * 4 + m] * 32.0f;
#pragma unroll
                    for (int bj = 0; bj < 2; ++bj) { const f32x4 v0 = (acc[ai][bj][m][0] * 0.00390625f + bv[bj][0]) * gt, v1 = (acc[ai][bj][m][1] * 0.00390625f + bv[bj][1]) * gt;   { u32x2 w8; w8.x = pk4_fp8(v0[0], v0[1], v0[2], v0[3]); w8.y = pk4_fp8(v1[0], v1[1], v1[2], v1[3]); *(u32x2*)((unsigned char*)OUTK + (size_t)p * D + cb + bj * 32) = w8; } } } }
    }
};

struct MoeOrder {
    const LAS int* toff; int npn, G, c;
    __device__ __forceinline__ bool next(int i, Unit& u) const {
        const int L0 = i * G + c, NT = toff[32], NU = NT * npn;
        if (L0 >= NU) return false;
        const int q8 = NU >> 3, r8 = NU & 7, xcd = L0 & 7, off = L0 >> 3;
        const int L = (xcd < r8 ? xcd * (q8 + 1) : r8 * (q8 + 1) + (xcd - r8) * q8) + off;
        int e = 0;
#pragma unroll 1
        for (int j = 1; j < 32; ++j) e += (L >= toff[j] * npn) ? 1 : 0;
        const int t0 = toff[e], te = toff[e + 1] - t0, rem = L - t0 * npn;
        const int pnl = rem / te, pml = rem - pnl * te;
        u.pm = __builtin_amdgcn_readfirstlane(t0 + pml); u.pn = __builtin_amdgcn_readfirstlane(e * npn + pnl); return true;
    }
    __device__ __forceinline__ void a_ready(const Unit&) const {}
    __device__ __forceinline__ void done(const Unit&) const {}
};

__device__ __forceinline__ void tr_item(const float* src, int ldn, int k0, int c0, bf16* dst, size_t dstrow0, int K, LAS float* scr, int lane) {
    f32x4 v[8];
#pragma unroll
    for (int i = 0; i < 8; ++i) v[i] = *(const GAS f32x4*)(src + (size_t)(k0 + 8 * i + (lane >> 3)) * ldn + c0 + 4 * (lane & 7));
#pragma unroll
    for (int i = 0; i < 8; ++i) { LAS float* p = scr + (8 * i + (lane >> 3)) * 33 + 4 * (lane & 7); p[0] = v[i].x; p[1] = v[i].y; p[2] = v[i].z; p[3] = v[i].w; }
    LDS_WAIT(); asm volatile("" ::: "memory");
    const int c = lane & 7;
#pragma unroll
    for (int j = 0; j < 4; ++j) { const int n = (lane >> 3) + 8 * j; const LAS float* s = scr + (8 * c) * 33 + n;
        u32x4 o; o.x = pk2(s[0 * 33], s[1 * 33]); o.y = pk2(s[2 * 33], s[3 * 33]); o.z = pk2(s[4 * 33], s[5 * 33]); o.w = pk2(s[6 * 33], s[7 * 33]);
        *(GAS u32x4*)(dst + (dstrow0 + n) * (size_t)K + k0 + 8 * c) = o; }
    LDS_WAIT(); asm volatile("" ::: "memory");
}
__device__ __forceinline__ void tr8_tile(const float* src, int ldn, int k0, int c0, unsigned char* dst, size_t dstrow0, int K, float sc, LAS float* scr, int lane) {
    f32x4 v[16];
#pragma unroll
    for (int i = 0; i < 16; ++i) v[i] = *(const GAS f32x4*)(src + (size_t)(k0 + 8 * i + (lane >> 3)) * ldn + c0 + 4 * (lane & 7));
#pragma unroll
    for (int i = 0; i < 16; ++i) { LAS float* p = scr + (8 * i + (lane >> 3)) * 33 + 4 * (lane & 7); p[0] = v[i].x * sc; p[1] = v[i].y * sc; p[2] = v[i].z * sc; p[3] = v[i].w * sc; }
    LDS_WAIT(); asm volatile("" ::: "memory");
    const int n = lane & 31;
#pragma unroll
    for (int j = 0; j < 4; ++j) { const int kc = (lane >> 5) + 2 * j; const LAS float* s = scr + (16 * kc) * 33 + n;
        u32x4 o; o.x = pk4_fp8(s[0 * 33], s[1 * 33], s[2 * 33], s[3 * 33]); o.y = pk4_fp8(s[4 * 33], s[5 * 33], s[6 * 33], s[7 * 33]);
        o.z = pk4_fp8(s[8 * 33], s[9 * 33], s[10 * 33], s[11 * 33]); o.w = pk4_fp8(s[12 * 33], s[13 * 33], s[14 * 33], s[15 * 33]);
        *(GAS u32x4*)(dst + (dstrow0 + n) * (size_t)K + k0 + 16 * kc) = o; }
    LDS_WAIT(); asm volatile("" ::: "memory");
}
__device__ __forceinline__ void tr_item8(const float* src, int ldn, int k0, int c0, unsigned char* dst, size_t dstrow0, int K, float sc, LAS float* scr, int lane) {
    f32x4 v[8];
#pragma unroll
    for (int i = 0; i < 8; ++i) v[i] = *(const GAS f32x4*)(src + (size_t)(k0 + 8 * i + (lane >> 3)) * ldn + c0 + 4 * (lane & 7));
#pragma unroll
    for (int i = 0; i < 8; ++i) { LAS float* p = scr + (8 * i + (lane >> 3)) * 33 + 4 * (lane & 7); p[0] = v[i].x * sc; p[1] = v[i].y * sc; p[2] = v[i].z * sc; p[3] = v[i].w * sc; }
    LDS_WAIT(); asm volatile("" ::: "memory");
    const int c = lane & 7;
#pragma unroll
    for (int j = 0; j < 4; ++j) { const int n = (lane >> 3) + 8 * j; const LAS float* s = scr + (8 * c) * 33 + n;
        u32x2 o; o.x = pk4_fp8(s[0 * 33], s[1 * 33], s[2 * 33], s[3 * 33]); o.y = pk4_fp8(s[4 * 33], s[5 * 33], s[6 * 33], s[7 * 33]);
        *(GAS u32x2*)(dst + (dstrow0 + n) * (size_t)K + k0 + 8 * c) = o; }
    LDS_WAIT(); asm volatile("" ::: "memory");
}
__device__ __forceinline__ void rms_row_to_bf16(const float* xrow, const float* g, bf16* orow, int lane) {
    f32x4 v[8]; float s = 0.f;
#pragma unroll
    for (int j = 0; j < 8; ++j) { v[j] = *(const GAS f32x4*)(xrow + 4 * lane + 256 * j); s += (v[j].x * v[j].x + v[j].y * v[j].y) + (v[j].z * v[j].z + v[j].w * v[j].w); }
    const float rs = 1.0f / sqrtf(wave_sum(s) * (1.0f / D) + NORM_EPS);
#pragma unroll
    for (int j = 0; j < 8; ++j) { const f32x4 gv = *(const GAS f32x4*)(g + 4 * lane + 256 * j); u32x2 w; w.x = pk2(v[j].x * rs * gv.x, v[j].y * rs * gv.y); w.y = pk2(v[j].z * rs * gv.z, v[j].w * rs * gv.w);
        *(GAS u32x2*)(orow + 4 * lane + 256 * j) = w; }
}
__device__ __forceinline__ void p0_prologue(const Ptrs& P, unsigned char* ws, LAS unsigned char* lds, int tid, int wave, int lane) {
    LAS float* scr = (LAS float*)(lds + wave * 8704);
    const int gw = blockIdx.x * NWAVES + wave, NGW = gridDim.x * NWAVES;
    constexpr int I_IN = 32 * 377, I_OR = 16 * 64, I_OA = 8 * 64, I_OUT = 32 * 64;
    constexpr int NITEMS = I_IN + I_OR + I_OA + I_OUT;
    for (int it = gw; it < NITEMS; it += NGW) {
        int r = it;
        if (r < I_IN) { const int kb = r / 377, nb = r % 377, c0 = 32 * nb;
            if (c0 >= 3072) tr_item8(P.w_in, IN_W, 64 * kb, c0, ws + WS_WG8B, (size_t)((c0 < SHIFT_W ? c0 : c0 + 224) - 3072), D, 32.0f, scr, lane);
            else tr_item(P.w_in, IN_W, 64 * kb, c0, P.WIN, (size_t)(c0 < SHIFT_W ? c0 : c0 + 224), D, scr, lane);
            continue; }
        r -= I_IN;
        if (r < I_OR) { const int kb = r >> 6, nb = r & 63; tr_item(P.w_o_rwkv, D, 64 * kb, 32 * nb, P.WOR, (size_t)32 * nb, 1536, scr, lane); continue; }
        r -= I_OR;
        if (r < I_OA) { const int kb = r >> 6, nb = r & 63; tr_item(P.w_o_attn, D, 64 * kb, 32 * nb, P.WOR + 1024, (size_t)32 * nb, 1536, scr, lane); continue; }
        r -= I_OA;
        { const int kb = r >> 6, nb = r & 63; tr_item8(P.w_out, D, 64 * kb, 32 * nb, (unsigned char*)P.WOUT, (size_t)32 * nb, D, 32.0f, scr, lane); }
    }
    { const int gt = blockIdx.x * NTHREADS + tid, NGT = gridDim.x * NTHREADS; GAS u32x4* z = (GAS u32x4*)(ws + WS_WG8B + (size_t)(SHIFT_W - 3072) * D);
      for (int i = gt; i < 224 * D / 16; i += NGT) z[i] = (u32x4){0u, 0u, 0u, 0u}; }
    { const int gt = blockIdx.x * NTHREADS + tid, NGT = gridDim.x * NTHREADS;
      for (int i = gt; i < 1024 * 64; i += NGT) { const int n = i >> 6, k = i & 63; P.LW[i] = (bf16)f2bf(P.w2_decay[k * RW + n]); P.LA[i] = (bf16)f2bf(P.a2_iclr[k * RW + n]); }
      for (int i = gt; i < 1024 * 160; i += NGT) { const int n = i / 160, k = i - n * 160; P.LG[i] = (bf16)f2bf(P.g2_gate[k * RW + n]); } }
    { const int gt = blockIdx.x * NTHREADS + tid, NGT = gridDim.x * NTHREADS;
      for (int i = gt; i < NE * D; i += NGT) { const int e = i >> 11, k = i & 2047; const float v = P.w_router[(size_t)k * NE + e] * P.norm_ffn[k]; const unsigned h = f2bf(v); P.WRH[i] = (bf16)h; P.WRL[i] = (bf16)f2bf(v - bf2f((bf16)h)); } }
    for (int m = gw; m < T; m += NGW) { const float* xrow = P.x + (size_t)m * D; f32x4 v[8]; float sq = 0.f;
#pragma unroll
        for (int j = 0; j < 8; ++j) { v[j] = *(const GAS f32x4*)(xrow + 4 * lane + 256 * j); sq += (v[j].x * v[j].x + v[j].y * v[j].y) + (v[j].z * v[j].z + v[j].w * v[j].w); }
        const float rs = 1.0f / sqrtf(wave_sum(sq) * (1.0f / D) + NORM_EPS); unsigned char* h8 = ws + WS_H8 + (size_t)m * D; bf16* hb = P.H + (size_t)m * D;
#pragma unroll
        for (int j = 0; j < 8; ++j) { const f32x4 gv = *(const GAS f32x4*)(P.norm_mix + 4 * lane + 256 * j); const float a0 = v[j].x * rs * gv.x, a1 = v[j].y * rs * gv.y, a2 = v[j].z * rs * gv.z, a3 = v[j].w * rs * gv.w;
            *(GAS unsigned*)(h8 + 4 * lane + 256 * j) = pk4_fp8(a0, a1, a2, a3); u32x2 w; w.x = pk2(a0, a1); w.y = pk2(a2, a3); *(GAS u32x2*)(hb + 4 * lane + 256 * j) = w; } }
    { const int gt = blockIdx.x * NTHREADS + tid, NGT = gridDim.x * NTHREADS;
      for (int i = gt; i < T * 16; i += NGT) { const int m = i >> 4, f = i & 15; const float inv = exp2f(-(float)f * (18.931568569324174f / 16.0f));
          const float ang = (float)P.positions[m] * inv; double rev = (double)ang * 0.15915494309189535; rev -= floor(rev); const float rv = (float)rev; const float sn = __builtin_amdgcn_sinf(rv), cs = __builtin_amdgcn_cosf(rv); P.ROT[(size_t)m * 32 + f] = cs; P.ROT[(size_t)m * 32 + 16 + f] = sn; } }
}

template <int CTRL> __device__ __forceinline__ float dppf(float x) { return __builtin_bit_cast(float, __builtin_amdgcn_mov_dpp(__builtin_bit_cast(int, x), CTRL, 0xf, 0xf, true)); }
__device__ __forceinline__ float sum8(float x) { x += dppf<0xB1>(x); x += dppf<0x4E>(x); x += dppf<0x141>(x); return x; }
__device__ __forceinline__ f32x4 mfma16(bf16x8 a, bf16x8 b, f32x4 c) { return __builtin_amdgcn_mfma_f32_16x16x32_bf16(a, b, c, 0, 0, 0); }
__device__ __forceinline__ u32x4 pack8s(const float* p) { u32x4 w; w.x = pk2(p[0], p[1]); w.y = pk2(p[2], p[3]); w.z = pk2(p[4], p[5]); w.w = pk2(p[6], p[7]); return w; }
__device__ __forceinline__ void p4a_chunk_prep(const Ptrs& P, unsigned char* ws, LAS unsigned char* lds, int tid, int wave, int lane, int u64) {
    LAS unsigned char* wl = lds + wave * 16384;
    LAS unsigned char* AH = wl, *BH = wl + 2048, *KH = wl + 4096, *RH = wl + 6144;
    LAS unsigned char* AT = wl + 8192, *RT = wl + 10240, *VTl = wl + 12288;
    LAS unsigned char* MX = wl + 14336;
    LAS unsigned char* WTl = wl, *U0Tl = wl + 2048, *PT = wl + 8192; LAS float* LmT = (LAS float*)(wl + 4096);
    const int fr = lane & 15, fq = lane >> 4, fq1 = fq & 1;
    unsigned char* s1 = ws + WS_S1;
    for (int jj = 0; jj < 8; ++jj) {
        const int j = wave * 8 + jj, h = j & 15, b = u64 >> 6, c16 = (u64 & 63) * 4 + (j >> 4), bh = b * 16 + h, uidx = (bh << 8) + c16;
        const size_t gbase = ((size_t)b * SEQ + (size_t)c16 * 16) * RW + h * 64 + lane;
        float av[16], bv[16], kv[16], rv[16], vv[16];
        {   float wv[16];
#pragma unroll
            for (int t = 0; t < 16; ++t) { const size_t o = gbase + (size_t)t * RW; wv[t] = P.SC[o]; av[t] = bf2f(P.SCH[SH_KK * SC_STRIDE + o]); bv[t] = bf2f(P.SCH[SH_BB * SC_STRIDE + o]);
                kv[t] = bf2f(P.SCH[SH_K * SC_STRIDE + o]); rv[t] = bf2f(P.SCH[SH_R * SC_STRIDE + o]); vv[t] = bf2f(P.SCH[SH_V * SC_STRIDE + o]); }
            float g = 1.0f;
#pragma unroll
            for (int t = 0; t < 16; ++t) { const float gp = g; g *= wv[t]; const float inv = 1.0f / g; av[t] *= gp; bv[t] *= inv; kv[t] *= inv; rv[t] *= g;
                *(LAS unsigned short*)(AH + t * 128 + lane * 2) = (unsigned short)f2bf(av[t]); *(LAS unsigned short*)(BH + t * 128 + lane * 2) = (unsigned short)f2bf(bv[t]);
                *(LAS unsigned short*)(KH + t * 128 + lane * 2) = (unsigned short)f2bf(kv[t]); *(LAS unsigned short*)(RH + t * 128 + lane * 2) = (unsigned short)f2bf(rv[t]); }
            *(LAS u32x4*)(AT + lane * 32) = pack8s(av); *(LAS u32x4*)(AT + lane * 32 + 16) = pack8s(av + 8);
            *(LAS u32x4*)(RT + lane * 32) = pack8s(rv); *(LAS u32x4*)(RT + lane * 32 + 16) = pack8s(rv + 8);
            const u32x4 v0 = pack8s(vv), v1 = pack8s(vv + 8);
            *(LAS u32x4*)(VTl + lane * 32) = v0; *(LAS u32x4*)(VTl + lane * 32 + 16) = v1;
            GAS u32x4* gv = (GAS u32x4*)(s1 + S1_VT + ((size_t)uidx * 64 + lane) * 32); gv[0] = v0; gv[1] = v1;
#pragma unroll
            for (int t = 0; t < 16; ++t) { bv[t] *= g; kv[t] *= g; }
            GAS u32x4* gb = (GAS u32x4*)(s1 + S1_BT + ((size_t)uidx * 64 + lane) * 32); gb[0] = pack8s(bv); gb[1] = pack8s(bv + 8);
            GAS u32x4* gk = (GAS u32x4*)(s1 + S1_KT + ((size_t)uidx * 64 + lane) * 32); gk[0] = pack8s(kv); gk[1] = pack8s(kv + 8);
            *(GAS float*)(s1 + S1_GAM + ((size_t)uidx * 64 + lane) * 4) = g; }
        LDS_WAIT(); asm volatile("" ::: "memory");
        f32x4 lab = {0.f, 0.f, 0.f, 0.f}, lak = lab, mrb = lab, mrk = lab;
#pragma unroll
        for (int ks = 0; ks < 2; ++ks) { const int off = fr * 128 + (32 * ks + 8 * fq) * 2;
            const bf16x8 a = *(const LAS bf16x8*)(AH + off), r_ = *(const LAS bf16x8*)(RH + off), b_ = *(const LAS bf16x8*)(BH + off), k_ = *(const LAS bf16x8*)(KH + off);
            lab = mfma16(a, b_, lab); lak = mfma16(a, k_, lak); mrb = mfma16(r_, b_, mrb); mrk = mfma16(r_, k_, mrk); }
#pragma unroll
        for (int rg = 0; rg < 4; ++rg) { const int t = 4 * fq + rg; const bool lo = fr < t, le = fr <= t; lab[rg] = lo ? lab[rg] : 0.f; lak[rg] = lo ? lak[rg] : 0.f; mrb[rg] = le ? mrb[rg] : 0.f; mrk[rg] = le ? mrk[rg] : 0.f; }
        asm volatile("" ::: "memory");
        *(LAS f32x4*)(LmT + fr * 16 + 4 * fq) = lab;
#pragma unroll
        for (int rg = 0; rg < 4; ++rg) { const int o = ((4 * fq + rg) * 16 + fr) * 2;
            *(LAS unsigned short*)(MX + o) = (unsigned short)f2bf(lak[rg]); *(LAS unsigned short*)(MX + 512 + o) = (unsigned short)f2bf(mrb[rg]); *(LAS unsigned short*)(MX + 1024 + o) = (unsigned short)f2bf(mrk[rg]); }
        LDS_WAIT(); asm volatile("" ::: "memory");
        float Tr[16];
#pragma unroll
        for (int m = 0; m < 16; ++m) Tr[m] = (m == fr) ? 1.0f : 0.0f;
#pragma unroll
        for (int j = 14; j >= 0; --j) { float acc = (j == fr) ? 1.0f : 0.0f;
#pragma unroll
            for (int q = 0; q < 4; ++q) { const f32x4 l4 = *(const LAS f32x4*)(LmT + j * 16 + 4 * q);
#pragma unroll
                for (int e = 0; e < 4; ++e) { const int m = 4 * q + e; if (m > j) acc += Tr[m] * l4[e]; } }
            Tr[j] = acc; }
        bf16x8 tfrag;
        { float sel[8];
#pragma unroll
          for (int j = 0; j < 8; ++j) sel[j] = (fq == 0) ? Tr[j] : ((fq == 1) ? Tr[8 + j] : 0.0f);
          tfrag = __builtin_bit_cast(bf16x8, pack8s(sel)); }
        f32x4 wacc[4];
#pragma unroll
        for (int nt = 0; nt < 4; ++nt) wacc[nt] = mfma16(tfrag, *(const LAS bf16x8*)(AT + (16 * nt + fr) * 32 + fq1 * 16), (f32x4){0.f, 0.f, 0.f, 0.f});
        asm volatile("" ::: "memory");
        { bf16* gwh = (bf16*)(s1 + S1_WH) + (size_t)uidx * 1024;
#pragma unroll
          for (int nt = 0; nt < 4; ++nt) { u32x2 w2; w2.x = pk2(wacc[nt][0], wacc[nt][1]); w2.y = pk2(wacc[nt][2], wacc[nt][3]); *(LAS u32x2*)(WTl + ((16 * nt + fr) * 16 + 4 * fq) * 2) = w2;
#pragma unroll
              for (int rg = 0; rg < 4; ++rg) gwh[(4 * fq + rg) * 64 + 16 * nt + fr] = (bf16)f2bf(wacc[nt][rg]); } }
        bf16x8 lkf, mbf, mkf, idf;
        { const u32x4 z4 = {0u, 0u, 0u, 0u};
          const u32x4 lk4 = *(const LAS u32x4*)(MX + (fr * 16 + 8 * fq1) * 2), mb4 = *(const LAS u32x4*)(MX + 512 + (fr * 16 + 8 * fq1) * 2), mk4 = *(const LAS u32x4*)(MX + 1024 + (fr * 16 + 8 * fq1) * 2);
          lkf = __builtin_bit_cast(bf16x8, (fq < 2) ? lk4 : z4);
          mbf = __builtin_bit_cast(bf16x8, mb4);
          mkf = __builtin_bit_cast(bf16x8, mk4);
          u32x4 id4; const int d = fr - 8 * fq1;
          id4.x = (d == 0 ? 0x3f80u : 0u) | (d == 1 ? 0x3f800000u : 0u); id4.y = (d == 2 ? 0x3f80u : 0u) | (d == 3 ? 0x3f800000u : 0u);
          id4.z = (d == 4 ? 0x3f80u : 0u) | (d == 5 ? 0x3f800000u : 0u); id4.w = (d == 6 ? 0x3f80u : 0u) | (d == 7 ? 0x3f800000u : 0u);
          idf = __builtin_bit_cast(bf16x8, id4); }
        LDS_WAIT(); asm volatile("" ::: "memory");
        f32x4 pacc[4];
#pragma unroll
        for (int nt = 0; nt < 4; ++nt) pacc[nt] = mfma16(lkf, *(const LAS bf16x8*)(VTl + (16 * nt + fr) * 32 + fq1 * 16), (f32x4){0.f, 0.f, 0.f, 0.f});
        asm volatile("" ::: "memory");
#pragma unroll
        for (int nt = 0; nt < 4; ++nt) { u32x2 w2; w2.x = pk2(pacc[nt][0], pacc[nt][1]); w2.y = pk2(pacc[nt][2], pacc[nt][3]); *(LAS u32x2*)(PT + ((16 * nt + fr) * 16 + 4 * fq) * 2) = w2; }
        LDS_WAIT(); asm volatile("" ::: "memory");
        f32x4 uacc[4];
#pragma unroll
        for (int nt = 0; nt < 4; ++nt) uacc[nt] = mfma16(tfrag, *(const LAS bf16x8*)(PT + (16 * nt + fr) * 32 + fq1 * 16), (f32x4){0.f, 0.f, 0.f, 0.f});
        asm volatile("" ::: "memory");
#pragma unroll
        for (int nt = 0; nt < 4; ++nt) { u32x2 w2; w2.x = pk2(uacc[nt][0], uacc[nt][1]); w2.y = pk2(uacc[nt][2], uacc[nt][3]); *(LAS u32x2*)(U0Tl + ((16 * nt + fr) * 16 + 4 * fq) * 2) = w2;
            { u32x2 w; w.x = pk2(uacc[nt][0], uacc[nt][1]); w.y = pk2(uacc[nt][2], uacc[nt][3]); *(GAS u32x2*)(s1 + S1_U0T + (((size_t)uidx * 64 + 16 * nt + fr) * 16 + 4 * fq) * 2) = w; } }
        LDS_WAIT(); asm volatile("" ::: "memory");
        { const bf16x8 aq = (fq < 2) ? mbf : idf, ay = (fq < 2) ? mbf : mkf;
          bf16* gqh = (bf16*)(s1 + S1_QH) + (size_t)uidx * 1024;
#pragma unroll
          for (int nt = 0; nt < 4; ++nt) { const int row = 16 * nt + fr;
              const bf16x8 bq = *(const LAS bf16x8*)(((fq < 2) ? WTl : RT) + row * 32 + fq1 * 16), by = *(const LAS bf16x8*)(((fq < 2) ? U0Tl : VTl) + row * 32 + fq1 * 16);
              const f32x4 qa = mfma16(aq, bq, (f32x4){0.f, 0.f, 0.f, 0.f}), ya = mfma16(ay, by, (f32x4){0.f, 0.f, 0.f, 0.f});
#pragma unroll
              for (int rg = 0; rg < 4; ++rg) gqh[(4 * fq + rg) * 64 + row] = (bf16)f2bf(qa[rg]);
              { u32x2 w; w.x = pk2(ya[0], ya[1]); w.y = pk2(ya[2], ya[3]); *(GAS u32x2*)(s1 + S1_Y0T + (((size_t)uidx * 64 + row) * 16 + 4 * fq) * 2) = w; } } }
        LDS_WAIT(); asm volatile("" ::: "memory");
    }
}

__device__ __forceinline__ void p2_rwkv_prep(const Ptrs& P, unsigned char* ws, LAS unsigned char* lds, int tid, int wave, int lane) {
    constexpr int AWP = 144, AGP = 336, SLP = 196;
    LAS unsigned char* AW = lds; LAS unsigned char* AA = lds + 9216; LAS unsigned char* AG = lds + 18432; LAS float* slab = (LAS float*)(lds + 40960);
    const int fr = lane & 15, fq = lane >> 4;
    for (int u = blockIdx.x; u < T / 64; u += gridDim.x) {
        const int m0 = u * 64;
        __syncthreads();
        for (int item = tid; item < 64 * 36; item += NTHREADS) { const int tk = item / 36, c8 = item - tk * 36, m = m0 + tk, col0 = 3072 + 8 * c8;
            const u32x4 pw = *(const GAS u32x4*)(P.ZP + (size_t)m * ZPW + col0); u32x4 qw = {0u, 0u, 0u, 0u}; if (m % SEQ) qw = *(const GAS u32x4*)(P.ZP + (size_t)(m - 1) * ZPW + col0);
            f32x4 p0, p1, q0, q1; unpack8(pw, p0, p1); unpack8(qw, q0, q1);
            const f32x4 mu0 = *(const GAS f32x4*)(P.shift_mu + col0), mu1 = *(const GAS f32x4*)(P.shift_mu + col0 + 4);
            f32x4 z0 = p0 + (q0 - p0) * mu0, z1 = p1 + (q1 - p1) * mu1;
            if (c8 < 8) {
#pragma unroll
                for (int j = 0; j < 4; ++j) { z0[j] = tanhf(z0[j]); z1[j] = tanhf(z1[j]); }
                *(LAS u32x4*)(AW + tk * AWP + c8 * 16) = pack8(z0, z1);
            } else if (c8 < 16) { *(LAS u32x4*)(AA + tk * AWP + (c8 - 8) * 16) = pack8(z0, z1);
            } else {
#pragma unroll
                for (int j = 0; j < 4; ++j) { z0[j] = sigmoidf_(z0[j]); z1[j] = sigmoidf_(z1[j]); }
                *(LAS u32x4*)(AG + tk * AGP + (c8 - 16) * 16) = pack8(z0, z1); } }
        __syncthreads();
        const int ct = wave & 3, tt0 = (wave >> 2) * 2;
        const int etk = tid >> 3, ec8 = tid & 7, em = m0 + etk; const bool ehasp = (em % SEQ) != 0;
        u32x4 zc[3], zq[3]; bf16x8 fw[2], fa[2], fg[5];
#define P2_PREF_M(h_) do { const int chrow_ = (h_) * 64 + ct * 16 + fr; \
            _Pragma("unroll") for (int ks = 0; ks < 2; ++ks) { fw[ks] = *(const GAS bf16x8*)(P.LW + (size_t)chrow_ * 64 + ks * 32 + 8 * fq); fa[ks] = *(const GAS bf16x8*)(P.LA + (size_t)chrow_ * 64 + ks * 32 + 8 * fq); } \
            _Pragma("unroll") for (int ks = 0; ks < 5; ++ks) fg[ks] = *(const GAS bf16x8*)(P.LG + (size_t)chrow_ * 160 + ks * 32 + 8 * fq); } while (0)
#define P2_PREF_E(h_) do { const int ch0_ = (h_) * 64 + 8 * ec8; const bf16* zp_ = P.ZP + (size_t)em * ZPW + ch0_; \
            _Pragma("unroll") for (int sg = 0; sg < 3; ++sg) { zc[sg] = *(const GAS u32x4*)(zp_ + sg * 1024); zq[sg] = (u32x4){0u, 0u, 0u, 0u}; if (ehasp) zq[sg] = *(const GAS u32x4*)(zp_ - ZPW + sg * 1024); \
                } } while (0)
        P2_PREF_E(0);
#pragma unroll 1
        for (int h = 0; h < NH; ++h) {
            { f32x4 acc[2][3]; P2_PREF_M(h);
#pragma unroll
              for (int t = 0; t < 2; ++t)
#pragma unroll
                  for (int kd = 0; kd < 3; ++kd) acc[t][kd] = (f32x4){0.f, 0.f, 0.f, 0.f};
#pragma unroll
              for (int ks = 0; ks < 2; ++ks)
#pragma unroll
                  for (int t = 0; t < 2; ++t) { const int tok = (tt0 + t) * 16 + fr;
                      acc[t][0] = mfma16(fw[ks], *(const LAS bf16x8*)(AW + tok * AWP + (ks * 32 + 8 * fq) * 2), acc[t][0]);
                      acc[t][1] = mfma16(fa[ks], *(const LAS bf16x8*)(AA + tok * AWP + (ks * 32 + 8 * fq) * 2), acc[t][1]); }
#pragma unroll
              for (int ks = 0; ks < 5; ++ks)
#pragma unroll
                  for (int t = 0; t < 2; ++t) { const int tok = (tt0 + t) * 16 + fr; acc[t][2] = mfma16(fg[ks], *(const LAS bf16x8*)(AG + tok * AGP + (ks * 32 + 8 * fq) * 2), acc[t][2]); }
#pragma unroll
              for (int t = 0; t < 2; ++t)
#pragma unroll
                  for (int kd = 0; kd < 3; ++kd) *(LAS f32x4*)(slab + ((tt0 + t) * 16 + fr) * SLP + kd * 64 + ct * 16 + 4 * fq) = acc[t][kd]; }
            __syncthreads();
            { const int ch0 = h * 64 + 8 * ec8; const LAS float* sl = slab + etk * SLP + 8 * ec8;
              float rr[8], kv[8], vv[8];
#pragma unroll
              for (int sg = 0; sg < 3; ++sg) { f32x4 p0, p1, q0, q1; unpack8(zc[sg], p0, p1); unpack8(zq[sg], q0, q1);
                  const f32x4 mu0 = *(const GAS f32x4*)(P.shift_mu + sg * 1024 + ch0), mu1 = *(const GAS f32x4*)(P.shift_mu + sg * 1024 + ch0 + 4);
                  const f32x4 z0 = p0 + (q0 - p0) * mu0, z1 = p1 + (q1 - p1) * mu1;
#pragma unroll
                  for (int j = 0; j < 4; ++j) { if (sg == 0) { rr[j] = z0[j]; rr[4 + j] = z1[j]; } else if (sg == 1) { kv[j] = z0[j]; kv[4 + j] = z1[j]; } else { vv[j] = z0[j]; vv[4 + j] = z1[j]; } } }
              float dec[8], av[8], gv[8], kkp[8], kn[8]; float ss = 0.f, bon = 0.f;
#pragma unroll
              for (int q = 0; q < 2; ++q) { const f32x4 wr_ = *(const LAS f32x4*)(sl + 4 * q), ap = *(const LAS f32x4*)(sl + 64 + 4 * q), gg = *(const LAS f32x4*)(sl + 128 + 4 * q);
                  const f32x4 w0v = *(const GAS f32x4*)(P.w0 + ch0 + 4 * q), a0v = *(const GAS f32x4*)(P.a0 + ch0 + 4 * q), kkv = *(const GAS f32x4*)(P.k_k + ch0 + 4 * q), kav = *(const GAS f32x4*)(P.k_a + ch0 + 4 * q), rkv = *(const GAS f32x4*)(P.r_k + ch0 + 4 * q);
#pragma unroll
                  for (int j = 0; j < 4; ++j) { const int i = 4 * q + j;
                      dec[i] = __expf(-0.6065306597126334f * sigmoidf_(w0v[j] + wr_[j])); av[i] = sigmoidf_(a0v[j] + ap[j]); gv[i] = gg[j];
                      kkp[i] = kv[i] * kkv[j]; ss += kkp[i] * kkp[i]; kn[i] = kv[i] * (1.0f + (av[i] - 1.0f) * kav[j]); bon += rr[i] * kn[i] * rkv[j]; } }
              if (h + 1 < NH) P2_PREF_E(h + 1);
              ss = sum8(ss); bon = sum8(bon);
              const float rn = 1.0f / fmaxf(sqrtf(ss), 1e-12f);
              const size_t o = (size_t)em * RW + ch0;
              f32x4 t0, t1;
#pragma unroll
              for (int j = 0; j < 4; ++j) { t0[j] = -kkp[j] * rn; t1[j] = -kkp[4 + j] * rn; }
              *(GAS u32x4*)(P.SCH + SH_KK * SC_STRIDE + o) = pack8(t0, t1);
#pragma unroll
              for (int j = 0; j < 4; ++j) { t0[j] = -t0[j] * av[j]; t1[j] = -t1[j] * av[4 + j]; }
              *(GAS u32x4*)(P.SCH + SH_BB * SC_STRIDE + o) = pack8(t0, t1);
              *(GAS f32x4*)(P.SC + o) = (f32x4){dec[0], dec[1], dec[2], dec[3]}; *(GAS f32x4*)(P.SC + o + 4) = (f32x4){dec[4], dec[5], dec[6], dec[7]};
              *(GAS u32x4*)(P.SCH + SH_K * SC_STRIDE + o) = pack8((f32x4){kn[0], kn[1], kn[2], kn[3]}, (f32x4){kn[4], kn[5], kn[6], kn[7]});
              *(GAS u32x4*)(P.SCH + SH_R * SC_STRIDE + o) = pack8((f32x4){rr[0], rr[1], rr[2], rr[3]}, (f32x4){rr[4], rr[5], rr[6], rr[7]});
              *(GAS u32x4*)(P.SCH + SH_V * SC_STRIDE + o) = pack8((f32x4){vv[0], vv[1], vv[2], vv[3]}, (f32x4){vv[4], vv[5], vv[6], vv[7]});
              *(GAS u32x4*)(P.G + o) = pack8((f32x4){gv[0], gv[1], gv[2], gv[3]}, (f32x4){gv[4], gv[5], gv[6], gv[7]});
              if (ec8 == 0) P.BONUS[(size_t)em * NH + h] = bon; }
            __syncthreads();
        }
#undef P2_PREF_M
#undef P2_PREF_E
        VM_WAIT(); __builtin_amdgcn_fence(__ATOMIC_ACQUIRE, "agent"); VM_WAIT(); __syncthreads();
        p4a_chunk_prep(P, ws, lds, tid, wave, lane, u);
    }
}

template <int N> __device__ __forceinline__ float dpp_shr1(float x) { return __builtin_bit_cast(float, __builtin_amdgcn_update_dpp(0x3f800000, __builtin_bit_cast(int, x), 0x110 + N, 0xf, 0xf, false)); }
__device__ __forceinline__ float sum_fq(float x) {
    auto s = __builtin_amdgcn_permlane16_swap(__float_as_uint(x), __float_as_uint(x), false, false); x = __uint_as_float(s[0]) + __uint_as_float(s[1]);
    auto t = __builtin_amdgcn_permlane32_swap(__float_as_uint(x), __float_as_uint(x), false, false); return __uint_as_float(t[0]) + __uint_as_float(t[1]);
}
__device__ __forceinline__ u32x2 pack4(float a, float b, float c, float d) { u32x2 w; w.x = pk2(a, b); w.y = pk2(c, d); return w; }
__device__ __forceinline__ u32x2 pack4v(float a, float b, float c, float d) { u32x2 w; w.x = pk2v(a, b); w.y = pk2v(c, d); return w; }
__device__ __forceinline__ void p2_fused(const Ptrs& P, unsigned char* ws, LAS unsigned char* lds, int tid, int wave, int lane) {
    constexpr int AWP = 144, AGP = 336;
    LAS unsigned char* AW = lds; LAS unsigned char* AA = lds + 4608; LAS unsigned char* AG = lds + 9216;
    LAS unsigned char* wl = lds + 20480 + wave * 15872;
    LAS unsigned char* AH = wl, *BH = wl + 2048, *KH = wl + 4096, *RH = wl + 6144;
    LAS unsigned char* AT = wl + 8192, *RT = wl + 10240, *VTl = wl + 12288;
    LAS unsigned char* MX = wl + 14336;
    LAS unsigned char* WTl = wl, *U0Tl = wl + 2048, *PT = wl + 8192; LAS float* LmT = (LAS float*)(wl + 4096);
    const int lane0 = lane, fr0 = lane & 15, fq0 = lane >> 4;
    unsigned char* s1 = ws + WS_S1;
    for (int u = blockIdx.x; u < T / 64; u += gridDim.x) {
#pragma unroll 1
      for (int half = 0; half < 2; ++half) {
        const int m0 = u * 64 + half * 32;
        __syncthreads();
        for (int item = tid; item < 32 * 36; item += NTHREADS) { const int tk = item / 36, c8 = item - tk * 36, m = m0 + tk, col0 = 3072 + 8 * c8;
            const u32x4 pw = *(const GAS u32x4*)(P.ZP + (size_t)m * ZPW + col0); u32x4 qw = {0u, 0u, 0u, 0u}; if (m % SEQ) qw = *(const GAS u32x4*)(P.ZP + (size_t)(m - 1) * ZPW + col0);
            f32x4 p0, p1, q0, q1; unpack8(pw, p0, p1); unpack8(qw, q0, q1);
            const f32x4 mu0 = *(const GAS f32x4*)(P.shift_mu + col0), mu1 = *(const GAS f32x4*)(P.shift_mu + col0 + 4);
            f32x4 z0 = p0 + (q0 - p0) * mu0, z1 = p1 + (q1 - p1) * mu1;
            if (c8 < 8) {
#pragma unroll
                for (int j = 0; j < 4; ++j) { z0[j] = tanhf_(z0[j]); z1[j] = tanhf_(z1[j]); }
                *(LAS u32x4*)(AW + tk * AWP + c8 * 16) = pack8(z0, z1);
            } else if (c8 < 16) { *(LAS u32x4*)(AA + tk * AWP + (c8 - 8) * 16) = pack8(z0, z1);
            } else {
#pragma unroll
                for (int j = 0; j < 4; ++j) { z0[j] = sigmoidf_(z0[j]); z1[j] = sigmoidf_(z1[j]); }
                *(LAS u32x4*)(AG + tk * AGP + (c8 - 16) * 16) = pack8(z0, z1); } }
        __syncthreads();
        const int tloc = wave >> 2;
        const int mbase = m0 + tloc * 16, bb_ = mbase / SEQ, c16 = (mbase % SEQ) >> 4;
#pragma unroll 1
        for (int hh = 0; hh < 4; ++hh) {
            int fr = fr0, fq = fq0, lane = lane0; asm volatile("" : "+v"(fr), "+v"(fq), "+v"(lane));
            const int fq1 = fq & 1, m = mbase + fr; const bool hasp = (m % SEQ) != 0;
            const int h = (wave & 3) * 4 + hh, uidx = ((bb_ * 16 + h) << 8) + c16;
            f32x4 accw[4], acca[4], accg[4];
#pragma unroll
            for (int ct = 0; ct < 4; ++ct) { accw[ct] = (f32x4){0.f, 0.f, 0.f, 0.f}; acca[ct] = accw[ct]; accg[ct] = accw[ct]; const int chrow = h * 64 + ct * 16 + fr;
#pragma unroll
                for (int ks = 0; ks < 2; ++ks) { const bf16x8 wf = *(const GAS bf16x8*)(P.LW + (size_t)chrow * 64 + ks * 32 + 8 * fq), af = *(const GAS bf16x8*)(P.LA + (size_t)chrow * 64 + ks * 32 + 8 * fq);
                    accw[ct] = mfma16(wf, *(const LAS bf16x8*)(AW + (tloc * 16 + fr) * AWP + (ks * 32 + 8 * fq) * 2), accw[ct]);
                    acca[ct] = mfma16(af, *(const LAS bf16x8*)(AA + (tloc * 16 + fr) * AWP + (ks * 32 + 8 * fq) * 2), acca[ct]); }
#pragma unroll
                for (int ks = 0; ks < 5; ++ks) { const bf16x8 gf = *(const GAS bf16x8*)(P.LG + (size_t)chrow * 160 + ks * 32 + 8 * fq);
                    accg[ct] = mfma16(gf, *(const LAS bf16x8*)(AG + (tloc * 16 + fr) * AGP + (ks * 32 + 8 * fq) * 2), accg[ct]); } }
            float dec[16], aa[16], kkp[16], kn[16], rr[16]; float ss = 0.f, bon = 0.f;
#pragma unroll
            for (int ct = 0; ct < 4; ++ct) { const int c0 = h * 64 + 16 * ct + 4 * fq; const bf16* zp = P.ZP + (size_t)m * ZPW + c0;
                float cur[3][4], prv[3][4], v4[4];
#pragma unroll
                for (int sg = 0; sg < 3; ++sg) { const u32x2 pw = *(const GAS u32x2*)(zp + sg * 1024); u32x2 qw = {0u, 0u}; if (hasp) qw = *(const GAS u32x2*)(zp - ZPW + sg * 1024);
                    cur[sg][0] = bflo(pw.x); cur[sg][1] = bfhi(pw.x); cur[sg][2] = bflo(pw.y); cur[sg][3] = bfhi(pw.y); prv[sg][0] = bflo(qw.x); prv[sg][1] = bfhi(qw.x); prv[sg][2] = bflo(qw.y); prv[sg][3] = bfhi(qw.y); }
                const f32x4 mur = *(const GAS f32x4*)(P.shift_mu + c0), muk = *(const GAS f32x4*)(P.shift_mu + 1024 + c0), muv = *(const GAS f32x4*)(P.shift_mu + 2048 + c0);
                const f32x4 w0v = *(const GAS f32x4*)(P.w0 + c0), a0v = *(const GAS f32x4*)(P.a0 + c0), kkv = *(const GAS f32x4*)(P.k_k + c0), kav = *(const GAS f32x4*)(P.k_a + c0), rkv = *(const GAS f32x4*)(P.r_k + c0);
#pragma unroll
                for (int rg = 0; rg < 4; ++rg) { const int i = ct * 4 + rg;
                    const float r = cur[0][rg] + (prv[0][rg] - cur[0][rg]) * mur[rg], k = cur[1][rg] + (prv[1][rg] - cur[1][rg]) * muk[rg], v = cur[2][rg] + (prv[2][rg] - cur[2][rg]) * muv[rg];
                    dec[i] = __expf(-0.6065306597126334f * sigmoidf_(w0v[rg] + accw[ct][rg])); aa[i] = sigmoidf_(a0v[rg] + acca[ct][rg]);
                    kkp[i] = k * kkv[rg]; ss += kkp[i] * kkp[i]; kn[i] = k * (1.0f + (aa[i] - 1.0f) * kav[rg]); bon += r * kn[i] * rkv[rg]; rr[i] = r; v4[rg] = v; }
                { const u32x2 vp = pack4v(v4[0], v4[1], v4[2], v4[3]); LAS unsigned char* vt = VTl + (16 * ct + 4 * fq) * 32 + fr * 2;
                  *(LAS unsigned short*)(vt) = (unsigned short)(vp.x & 0xffffu); *(LAS unsigned short*)(vt + 32) = (unsigned short)(vp.x >> 16); *(LAS unsigned short*)(vt + 64) = (unsigned short)(vp.y & 0xffffu); *(LAS unsigned short*)(vt + 96) = (unsigned short)(vp.y >> 16);
                  *(GAS u32x2*)(P.SCH + SH_V * SC_STRIDE + (size_t)m * RW + c0) = vp; }
                *(GAS u32x2*)(P.G + (size_t)m * RW + c0) = pack4(accg[ct][0], accg[ct][1], accg[ct][2], accg[ct][3]); }
            ss = sum_fq(ss); bon = sum_fq(bon);
            const float rn = __builtin_amdgcn_rsqf(fmaxf(ss, 1e-24f));
            if (fq == 0) P.BONUS[(size_t)m * NH + h] = bon;
            asm volatile("" : "+v"(fr), "+v"(fq), "+v"(lane));
            bf16* gbt = (bf16*)(s1 + S1_BT) + (size_t)uidx * 1024 + fr; bf16* gkt = (bf16*)(s1 + S1_KT) + (size_t)uidx * 1024 + fr;
#pragma unroll
            for (int ct = 0; ct < 4; ++ct) { float a4[4], b4[4], k4[4], r4[4], g15[4];
#pragma unroll
                for (int rg = 0; rg < 4; ++rg) { const int i = ct * 4 + rg;
                    float g = dec[i]; g *= dpp_shr1<1>(g); g *= dpp_shr1<2>(g); g *= dpp_shr1<4>(g); g *= dpp_shr1<8>(g);
                    const float gp = dpp_shr1<1>(g), gl = __shfl(g, (lane & 48) | 15), inv = __builtin_amdgcn_rcpf(g);
                    const float kkn = -kkp[i] * rn, bbv = -kkn * aa[i];
                    a4[rg] = kkn * gp; b4[rg] = bbv * inv; k4[rg] = kn[i] * inv; r4[rg] = rr[i] * g; g15[rg] = gl;
                    const int kx = 16 * ct + 4 * fq + rg;
                    { const unsigned bk = pk2v(b4[rg] * gl, k4[rg] * gl), ar = pk2v(a4[rg], r4[rg]);
                      gbt[kx * 16] = (bf16)(bk & 0xffffu); gkt[kx * 16] = (bf16)(bk >> 16);
                      *(LAS unsigned short*)(AT + kx * 32 + fr * 2) = (unsigned short)(ar & 0xffffu); *(LAS unsigned short*)(RT + kx * 32 + fr * 2) = (unsigned short)(ar >> 16); } }
                const int o = fr * 128 + (16 * ct + 4 * fq) * 2;
                *(LAS u32x2*)(AH + o) = pack4v(a4[0], a4[1], a4[2], a4[3]); *(LAS u32x2*)(BH + o) = pack4v(b4[0], b4[1], b4[2], b4[3]);
                *(LAS u32x2*)(KH + o) = pack4v(k4[0], k4[1], k4[2], k4[3]); *(LAS u32x2*)(RH + o) = pack4v(r4[0], r4[1], r4[2], r4[3]);
                if (fr == 0) *(GAS f32x4*)(s1 + S1_GAM + ((size_t)uidx * 64 + 16 * ct + 4 * fq) * 4) = (f32x4){g15[0], g15[1], g15[2], g15[3]}; }
            LDS_WAIT(); asm volatile("" ::: "memory");
            { GAS u32x4* gv = (GAS u32x4*)(s1 + S1_VT + ((size_t)uidx * 64 + lane) * 32); gv[0] = *(const LAS u32x4*)(VTl + lane * 32); gv[1] = *(const LAS u32x4*)(VTl + lane * 32 + 16); }
        asm volatile("" : "+v"(fr), "+v"(fq), "+v"(lane));
        f32x4 lab = {0.f, 0.f, 0.f, 0.f}, lak = lab, mrb = lab, mrk = lab;
#pragma unroll
        for (int ks = 0; ks < 2; ++ks) { const int off = fr * 128 + (32 * ks + 8 * fq) * 2;
            const bf16x8 a = *(const LAS bf16x8*)(AH + off), r_ = *(const LAS bf16x8*)(RH + off), b_ = *(const LAS bf16x8*)(BH + off), k_ = *(const LAS bf16x8*)(KH + off);
            lab = mfma16(a, b_, lab); lak = mfma16(a, k_, lak); mrb = mfma16(r_, b_, mrb); mrk = mfma16(r_, k_, mrk); }
#pragma unroll
        for (int rg = 0; rg < 4; ++rg) { const int t = 4 * fq + rg; const bool lo = fr < t, le = fr <= t; lab[rg] = lo ? lab[rg] : 0.f; lak[rg] = lo ? lak[rg] : 0.f; mrb[rg] = le ? mrb[rg] : 0.f; mrk[rg] = le ? mrk[rg] : 0.f; }
        asm volatile("" ::: "memory");
        *(LAS f32x4*)(LmT + fr * 16 + 4 * fq) = lab;
#pragma unroll
        for (int rg = 0; rg < 4; ++rg) { const int o = ((4 * fq + rg) * 16 + fr) * 2;
            *(LAS unsigned short*)(MX + o) = (unsigned short)f2bf(lak[rg]); *(LAS unsigned short*)(MX + 512 + o) = (unsigned short)f2bf(mrb[rg]); *(LAS unsigned short*)(MX + 1024 + o) = (unsigned short)f2bf(mrk[rg]); }
        LDS_WAIT(); asm volatile("" ::: "memory");
        float Tr[16];
#pragma unroll
        for (int m = 0; m < 16; ++m) Tr[m] = (m == fr) ? 1.0f : 0.0f;
#pragma unroll
        for (int j = 14; j >= 0; --j) { float acc = (j == fr) ? 1.0f : 0.0f;
#pragma unroll
            for (int q = 0; q < 4; ++q) { const f32x4 l4 = *(const LAS f32x4*)(LmT + j * 16 + 4 * q);
#pragma unroll
                for (int e = 0; e < 4; ++e) { const int m = 4 * q + e; if (m > j) acc += Tr[m] * l4[e]; } }
            Tr[j] = acc; }
        bf16x8 tfrag;
        { float sel[8];
#pragma unroll
          for (int j = 0; j < 8; ++j) sel[j] = (fq == 0) ? Tr[j] : ((fq == 1) ? Tr[8 + j] : 0.0f);
          tfrag = __builtin_bit_cast(bf16x8, pack8s(sel)); }
        f32x4 wacc[4];
#pragma unroll
        for (int nt = 0; nt < 4; ++nt) wacc[nt] = mfma16(tfrag, *(const LAS bf16x8*)(AT + (16 * nt + fr) * 32 + fq1 * 16), (f32x4){0.f, 0.f, 0.f, 0.f});
        asm volatile("" ::: "memory");
        { bf16* gwh = (bf16*)(s1 + S1_WH) + (size_t)uidx * 1024;
          asm volatile("s_nop 7\n\ts_nop 7" : "+v"(wacc[0]), "+v"(wacc[1]), "+v"(wacc[2]), "+v"(wacc[3]));
#pragma unroll
          for (int nt = 0; nt < 4; ++nt) { u32x2 w2; w2.x = pk2v(wacc[nt][0], wacc[nt][1]); w2.y = pk2v(wacc[nt][2], wacc[nt][3]); *(LAS u32x2*)(WTl + ((16 * nt + fr) * 16 + 4 * fq) * 2) = w2;
              bf16* gp_ = gwh + (4 * fq) * 64 + 16 * nt + fr; gp_[0] = (bf16)(w2.x & 0xffffu); gp_[64] = (bf16)(w2.x >> 16); gp_[128] = (bf16)(w2.y & 0xffffu); gp_[192] = (bf16)(w2.y >> 16); } }
        asm volatile("" : "+v"(fr), "+v"(fq), "+v"(lane));
        bf16x8 lkf, mbf, mkf, idf;
        { const u32x4 z4 = {0u, 0u, 0u, 0u};
          const u32x4 lk4 = *(const LAS u32x4*)(MX + (fr * 16 + 8 * fq1) * 2), mb4 = *(const LAS u32x4*)(MX + 512 + (fr * 16 + 8 * fq1) * 2), mk4 = *(const LAS u32x4*)(MX + 1024 + (fr * 16 + 8 * fq1) * 2);
          lkf = __builtin_bit_cast(bf16x8, (fq < 2) ? lk4 : z4);
          mbf = __builtin_bit_cast(bf16x8, mb4);
          mkf = __builtin_bit_cast(bf16x8, mk4);
          u32x4 id4; const int d = fr - 8 * fq1;
          id4.x = (d == 0 ? 0x3f80u : 0u) | (d == 1 ? 0x3f800000u : 0u); id4.y = (d == 2 ? 0x3f80u : 0u) | (d == 3 ? 0x3f800000u : 0u);
          id4.z = (d == 4 ? 0x3f80u : 0u) | (d == 5 ? 0x3f800000u : 0u); id4.w = (d == 6 ? 0x3f80u : 0u) | (d == 7 ? 0x3f800000u : 0u);
          idf = __builtin_bit_cast(bf16x8, id4); }
        LDS_WAIT(); asm volatile("" ::: "memory");
        f32x4 pacc[4];
#pragma unroll
        for (int nt = 0; nt < 4; ++nt) pacc[nt] = mfma16(lkf, *(const LAS bf16x8*)(VTl + (16 * nt + fr) * 32 + fq1 * 16), (f32x4){0.f, 0.f, 0.f, 0.f});
        asm volatile("" ::: "memory");
        asm volatile("s_nop 7\n\ts_nop 7" : "+v"(pacc[0]), "+v"(pacc[1]), "+v"(pacc[2]), "+v"(pacc[3]));
#pragma unroll
        for (int nt = 0; nt < 4; ++nt) { u32x2 w2; w2.x = pk2v(pacc[nt][0], pacc[nt][1]); w2.y = pk2v(pacc[nt][2], pacc[nt][3]); *(LAS u32x2*)(PT + ((16 * nt + fr) * 16 + 4 * fq) * 2) = w2; }
        LDS_WAIT(); asm volatile("" ::: "memory");
        f32x4 uacc[4];
#pragma unroll
        for (int nt = 0; nt < 4; ++nt) uacc[nt] = mfma16(tfrag, *(const LAS bf16x8*)(PT + (16 * nt + fr) * 32 + fq1 * 16), (f32x4){0.f, 0.f, 0.f, 0.f});
        asm volatile("" ::: "memory");
        asm volatile("s_nop 7\n\ts_nop 7" : "+v"(uacc[0]), "+v"(uacc[1]), "+v"(uacc[2]), "+v"(uacc[3]));
#pragma unroll
        for (int nt = 0; nt < 4; ++nt) { u32x2 w2; w2.x = pk2v(uacc[nt][0], uacc[nt][1]); w2.y = pk2v(uacc[nt][2], uacc[nt][3]); *(LAS u32x2*)(U0Tl + ((16 * nt + fr) * 16 + 4 * fq) * 2) = w2;
            { u32x2 w; w.x = pk2(uacc[nt][0], uacc[nt][1]); w.y = pk2(uacc[nt][2], uacc[nt][3]); *(GAS u32x2*)(s1 + S1_U0T + (((size_t)uidx * 64 + 16 * nt + fr) * 16 + 4 * fq) * 2) = w; } }
        LDS_WAIT(); asm volatile("" ::: "memory");
        { const bf16x8 aq = (fq < 2) ? mbf : idf, ay = (fq < 2) ? mbf : mkf;
          bf16* gqh = (bf16*)(s1 + S1_QH) + (size_t)uidx * 1024;
#pragma unroll
          for (int nt = 0; nt < 4; ++nt) { const int row = 16 * nt + fr;
              const bf16x8 bq = *(const LAS bf16x8*)(((fq < 2) ? WTl : RT) + row * 32 + fq1 * 16), by = *(const LAS bf16x8*)(((fq < 2) ? U0Tl : VTl) + row * 32 + fq1 * 16);
              const f32x4 qa = mfma16(aq, bq, (f32x4){0.f, 0.f, 0.f, 0.f}), ya = mfma16(ay, by, (f32x4){0.f, 0.f, 0.f, 0.f});
#pragma unroll
              for (int rg = 0; rg < 4; ++rg) gqh[(4 * fq + rg) * 64 + row] = (bf16)f2bf(qa[rg]);
              { u32x2 w; w.x = pk2(ya[0], ya[1]); w.y = pk2(ya[2], ya[3]); *(GAS u32x2*)(s1 + S1_Y0T + (((size_t)uidx * 64 + row) * 16 + 4 * fq) * 2) = w; } } }
        LDS_WAIT(); asm volatile("" ::: "memory");
        }
      }
    }
}

struct AttU { int b, gh, d, c, n; };
__device__ __forceinline__ AttU att_decode(int u) {
    AttU a; a.b = u / 384; const int r = u - a.b * 384; a.gh = r >> 5; const int idx = r & 31, g = a.gh >> 2;
    a.d = (g == 0) ? 1 : ((g == 1) ? 4 : 16); const int nb = 32 / a.d; a.c = idx / nb; a.n = idx - a.c * nb; return a;
}
typedef short v4i16_t __attribute__((ext_vector_type(4)));
__device__ __forceinline__ u32x2 vtr(const LAS unsigned char* p) { return __builtin_bit_cast(u32x2, __builtin_amdgcn_ds_read_tr16_b64_v4i16((LAS v4i16_t*)p)); }
__device__ __forceinline__ void att_load(const Ptrs& P, const AttU& a, int kblk, int skey, int spart, u32x4 (&kr)[4], u32x4 (&vr)[4]) {
#pragma unroll
    for (int i = 0; i < 4; ++i) { const size_t mk = (size_t)a.b * SEQ + (size_t)(kblk * 128 + skey + 32 * i) * a.d + a.c; const bf16* row = P.QKV + mk * QKVW + a.gh * 128 + spart * 8;
        kr[i] = *(const GAS u32x4*)(row + 1536); vr[i] = *(const GAS u32x4*)(row + 3072); }
}
__device__ __forceinline__ void att_write(LAS unsigned char* Kb, int kwo, int vwo, const u32x4 (&kr)[4], const u32x4 (&vr)[4]) {
#pragma unroll
    for (int i = 0; i < 4; ++i) { *(LAS u32x4*)(Kb + kwo + 8704 * i) = kr[i]; *(LAS u32x4*)(Kb + 34816 + vwo + 1024 * i) = vr[i]; }
}
__device__ __forceinline__ void p3_attention(const Ptrs& P, LAS unsigned char* lds, int tid, int wave, int lane) {
    const int fr = lane & 15, fq = lane >> 4;
    const int skey = tid >> 4, spart = tid & 15, sdt = spart >> 1;
    const int kwo = skey * 272 + spart * 16;
    const int vwo = (sdt * 32 + (skey >> 2)) * 128 + (((skey & 3) ^ (sdt & 3)) * 32) + (spart & 1) * 16;
    int vro[4];
#pragma unroll
    for (int x = 0; x < 4; ++x) vro[x] = 34816 + x * 4096 + fq * 128 + (((fr >> 2) ^ x) * 32) + (fr & 3) * 8;
    const int NU = NB * 12 * 32;
    int u = blockIdx.x;
    if (u >= NU) return;
    AttU a = att_decode(u);
    int kb = (a.n == 0) ? 1 : 0;
    u32x4 kr[4], vr[4];
    __syncthreads();
    att_load(P, a, a.n - 1 + kb, skey, spart, kr, vr);
    att_write(lds, kwo, vwo, kr, vr);
    bf16x8 qf[4], qn[4];
    const int qi = wave * 16 + fr;
    { const size_t mq = (size_t)a.b * SEQ + (size_t)(a.n * 128 + qi) * a.d + a.c; const bf16* qrow = P.QKV + mq * QKVW + a.gh * 128;
#pragma unroll
      for (int ks = 0; ks < 4; ++ks) qn[ks] = *(const GAS bf16x8*)(qrow + 32 * ks + 8 * fq); }
    __syncthreads();
    int cur = 0; bool first = true;
    f32x4 o[8]; float mrun = -1e30f, lrun = 0.f;
    while (true) {
        bool hn = true; AttU na = a; int nkb = 1;
        if (kb == 1) { const int nu = u + gridDim.x; hn = nu < NU; if (hn) { na = att_decode(nu); nkb = (na.n == 0) ? 1 : 0; } }
        if (first) {
#pragma unroll
            for (int ks = 0; ks < 4; ++ks) qf[ks] = qn[ks];
#pragma unroll
            for (int dt = 0; dt < 8; ++dt) o[dt] = (f32x4){0.f, 0.f, 0.f, 0.f};
            mrun = -1e30f; lrun = 0.f;
        }
        if (hn) { att_load(P, na, na.n - 1 + nkb, skey, spart, kr, vr);
            if (kb == 1) { const size_t mq = (size_t)na.b * SEQ + (size_t)(na.n * 128 + qi) * na.d + na.c; const bf16* qrow = P.QKV + mq * QKVW + na.gh * 128;
#pragma unroll
                for (int ks = 0; ks < 4; ++ks) qn[ks] = *(const GAS bf16x8*)(qrow + 32 * ks + 8 * fq); } }
        LAS unsigned char* Kb = lds + cur * 67584;
        f32x4 s[8];
#pragma unroll
        for (int kt = 0; kt < 8; ++kt) { s[kt] = (f32x4){0.f, 0.f, 0.f, 0.f};
#pragma unroll
            for (int ks = 0; ks < 4; ++ks) { const bf16x8 af = *(const LAS bf16x8*)(Kb + (kt * 16 + fr) * 272 + (32 * ks + 8 * fq) * 2); s[kt] = mfma16(af, qf[ks], s[kt]); } }
        float mx = -1e30f;
#pragma unroll
        for (int kt = 0; kt < 8; ++kt)
#pragma unroll
            for (int rg = 0; rg < 4; ++rg) { const int j = kt * 16 + 4 * fq + rg; const bool ok = (kb == 0) ? (j >= qi) : (j <= qi); const float sv = ok ? s[kt][rg] : -1e30f; s[kt][rg] = sv; mx = fmaxf(mx, sv); }
        mx = fmaxf(mx, __shfl_xor(mx, 16)); mx = fmaxf(mx, __shfl_xor(mx, 32));
        const float mnew = fmaxf(mrun, mx), alpha = __builtin_amdgcn_exp2f(mrun - mnew); mrun = mnew;
        float ls = 0.f;
#pragma unroll
        for (int kt = 0; kt < 8; ++kt)
#pragma unroll
            for (int rg = 0; rg < 4; ++rg) { const float p = __builtin_amdgcn_exp2f(s[kt][rg] - mnew); s[kt][rg] = p; ls += p; }
        lrun = lrun * alpha + ls;
#pragma unroll
        for (int dt = 0; dt < 8; ++dt) o[dt] = o[dt] * alpha;
#pragma unroll
        for (int pi = 0; pi < 4; ++pi) {
            u32x4 bw; bw.x = pk2v(s[2 * pi][0], s[2 * pi][1]); bw.y = pk2v(s[2 * pi][2], s[2 * pi][3]); bw.z = pk2v(s[2 * pi + 1][0], s[2 * pi + 1][1]); bw.w = pk2v(s[2 * pi + 1][2], s[2 * pi + 1][3]);
            const bf16x8 bfrag = __builtin_bit_cast(bf16x8, bw);
#pragma unroll
            for (int dt = 0; dt < 8; ++dt) { const LAS unsigned char* vp = Kb + vro[dt & 3] + (dt >> 2) * 16384 + (2 * pi) * 512;
                const u32x2 lo = vtr(vp), hi = vtr(vp + 512);
                const u32x4 aw = {lo.x, lo.y, hi.x, hi.y}; o[dt] = mfma16(__builtin_bit_cast(bf16x8, aw), bfrag, o[dt]); } }
        if (kb == 1) {
            float lt = lrun; lt += __shfl_xor(lt, 16); lt += __shfl_xor(lt, 32);
            const size_t mq = (size_t)a.b * SEQ + (size_t)(a.n * 128 + qi) * a.d + a.c;
            bf16* orow = P.ATTO + (mq * 12 + a.gh) * 128;
#pragma unroll
            for (int dt = 0; dt < 8; ++dt) { u32x2 w; w.x = pk2(o[dt][0], o[dt][1]); w.y = pk2(o[dt][2], o[dt][3]); *(GAS u32x2*)(orow + dt * 16 + 4 * fq) = w; }
            if (fq == 0) { P.ATTML[(mq * 12 + a.gh) * 2] = mrun; P.ATTML[(mq * 12 + a.gh) * 2 + 1] = lt; }
        }
        if (hn) att_write(lds + (cur ^ 1) * 67584, kwo, vwo, kr, vr);
        __syncthreads();
        if (!hn) break;
        first = (kb == 1); if (kb == 1) u += gridDim.x;
        a = na; kb = nkb; cur ^= 1;
    }
}

struct S2Regs { u32x2 wf[4], qf[4], bt[4], kt[4], vt; f32x4 u0, y0, gm[4]; };
__device__ __forceinline__ void s2_load(S2Regs& R, const unsigned char* s1, size_t ui, int vg, int fr, int fq) {
    const unsigned char* wh = s1 + S1_WH + ui * 2048 + (fr * 64 + 4 * fq) * 2; const unsigned char* qh = s1 + S1_QH + ui * 2048 + (fr * 64 + 4 * fq) * 2;
#pragma unroll
    for (int ks = 0; ks < 2; ++ks) { R.wf[2 * ks] = *(const GAS u32x2*)(wh + ks * 64); R.wf[2 * ks + 1] = *(const GAS u32x2*)(wh + ks * 64 + 32); R.qf[2 * ks] = *(const GAS u32x2*)(qh + ks * 64); R.qf[2 * ks + 1] = *(const GAS u32x2*)(qh + ks * 64 + 32); }
#pragma unroll
    for (int mt = 0; mt < 4; ++mt) { R.bt[mt] = *(const GAS u32x2*)(s1 + S1_BT + ui * 2048 + ((16 * mt + fr) * 16 + 4 * fq) * 2); R.kt[mt] = *(const GAS u32x2*)(s1 + S1_KT + ui * 2048 + ((16 * mt + fr) * 16 + 4 * fq) * 2);
        R.gm[mt] = *(const GAS f32x4*)(s1 + S1_GAM + ui * 256 + (16 * mt + 4 * fq) * 4); }
    const size_t vr = ui * 64 + vg * 16 + fr;
    R.vt = *(const GAS u32x2*)(s1 + S1_VT + (vr * 16 + 4 * fq) * 2); { const u32x2 uw = *(const GAS u32x2*)(s1 + S1_U0T + (vr * 16 + 4 * fq) * 2), yw = *(const GAS u32x2*)(s1 + S1_Y0T + (vr * 16 + 4 * fq) * 2);
      R.u0 = (f32x4){bflo(uw.x), bfhi(uw.x), bflo(uw.y), bfhi(uw.y)}; R.y0 = (f32x4){bflo(yw.x), bfhi(yw.x), bflo(yw.y), bfhi(yw.y)}; }
}
__device__ __forceinline__ void s2_step(const S2Regs& R, f32x4 (&st4)[4], float* yp) {
    bf16x8 sf[2];
#pragma unroll
    for (int ks = 0; ks < 2; ++ks) sf[ks] = __builtin_bit_cast(bf16x8, pack8(st4[2 * ks], st4[2 * ks + 1]));
    f32x4 sa = R.u0, y = R.y0;
#pragma unroll
    for (int ks = 0; ks < 2; ++ks) { sa = mfma16(__builtin_bit_cast(bf16x8, (u32x4){R.wf[2 * ks].x, R.wf[2 * ks].y, R.wf[2 * ks + 1].x, R.wf[2 * ks + 1].y}), sf[ks], sa);
        y = mfma16(__builtin_bit_cast(bf16x8, (u32x4){R.qf[2 * ks].x, R.qf[2 * ks].y, R.qf[2 * ks + 1].x, R.qf[2 * ks + 1].y}), sf[ks], y); }
#pragma unroll
    for (int rg = 0; rg < 4; ++rg) yp[(size_t)rg * RW] = y[rg];
    const bf16x8 ub = __builtin_bit_cast(bf16x8, (u32x4){pk2(sa[0], sa[1]), pk2(sa[2], sa[3]), R.vt.x, R.vt.y});
#pragma unroll
    for (int mt = 0; mt < 4; ++mt) st4[mt] = mfma16(__builtin_bit_cast(bf16x8, (u32x4){R.bt[mt].x, R.bt[mt].y, R.kt[mt].x, R.kt[mt].y}), ub, st4[mt] * R.gm[mt]);
}
__device__ __forceinline__ void p4b_scan(const Ptrs& P, unsigned char* ws, LAS unsigned char* lds, int tid, int wave, int lane) {
    if (wave == 0) {
        const int fr = lane & 15, fq = lane >> 4;
        const unsigned char* s1 = ws + WS_S1;
        for (int unit = blockIdx.x; unit < 256; unit += gridDim.x) {
            const int bh = unit >> 2, vg = unit & 3, b = bh >> 4, h = bh & 15;
            const size_t u0idx = (size_t)bh * 256;
            f32x4 st4[4];
#pragma unroll
            for (int mt = 0; mt < 4; ++mt) st4[mt] = (f32x4){0.f, 0.f, 0.f, 0.f};
            float* yb = P.Y + ((size_t)b * SEQ + 4 * fq) * RW + h * 64 + vg * 16 + fr;
            S2Regs RA, RB;
            s2_load(RA, s1, u0idx, vg, fr, fq);
#pragma unroll 1
            for (int c = 0; c < 256; c += 2) {
                s2_load(RB, s1, u0idx + c + 1, vg, fr, fq);
                s2_step(RA, st4, yb + (size_t)(c * 16) * RW);
                s2_load(RA, s1, u0idx + ((c + 2 < 256) ? c + 2 : c), vg, fr, fq);
                s2_step(RB, st4, yb + (size_t)((c + 1) * 16) * RW);
            }
        }
    } else {
        LAS float* scr = (LAS float*)(lds + (wave - 1) * 16896);
        const int gw = blockIdx.x * (NWAVES - 1) + (wave - 1), NGW = gridDim.x * (NWAVES - 1);
        constexpr int I_W1 = NE * 16 * 128, I_W2 = NE * 16 * 64;
        for (int it = gw; it < I_W1 + I_W2; it += NGW) {
            int r = it;
            if (r < I_W1) { const int e = r >> 11, q = r & 2047, kb = q >> 7, nb = q & 127, c0 = 32 * nb;
                tr8_tile(P.w1 + (size_t)e * D * 4096, 4096, 128 * kb, c0, (unsigned char*)P.W1, (size_t)e * 4096 + ((c0 & 2047) >> 7) * 256 + ((c0 & 127) >> 5) * 64 + (c0 >> 11) * 32, D, 32.0f, scr, lane); continue; }
            r -= I_W1;
            { const int e = r >> 10, q = r & 1023, kb = q >> 6, nb = q & 63; tr8_tile(P.w2 + (size_t)e * FF * D, D, 128 * kb, 32 * nb, (unsigned char*)P.W2, (size_t)e * D + 32 * nb, FF, 32.0f, scr, lane); }
        }
    }
}

__device__ __forceinline__ float sum4q(float x) { x += dppf<0xB1>(x); x += dppf<0x4E>(x); return x; }
__device__ __forceinline__ void p5_post(const Ptrs& P, int tid, int wave, int lane) {
    const int gw = blockIdx.x * NWAVES + wave, NGW = gridDim.x * NWAVES;
    const int c0 = 16 * lane, head = lane >> 2;
    for (int m = gw; m < T; m += NGW) {
        const size_t o = (size_t)m * RW + c0;
        f32x4 y[4], v[4];
#pragma unroll
        for (int q = 0; q < 4; ++q) y[q] = *(const GAS f32x4*)(P.Y + o + 4 * q);
        { const u32x4 v0 = *(const GAS u32x4*)(P.SCH + SH_V * SC_STRIDE + o), v1 = *(const GAS u32x4*)(P.SCH + SH_V * SC_STRIDE + o + 8); unpack8(v0, v[0], v[1]); unpack8(v1, v[2], v[3]); }
        const u32x4 g0 = *(const GAS u32x4*)(P.G + o), g1 = *(const GAS u32x4*)(P.G + o + 8);
        const float bon = P.BONUS[(size_t)m * NH + head];
        const int hh = lane >> 4, d0 = (lane & 15) * 8; float mm[3], ll[3]; u32x4 ow[3];
#pragma unroll
        for (int g = 0; g < 3; ++g) { const size_t q = (size_t)m * 12 + g * 4 + hh; mm[g] = P.ATTML[q * 2]; ll[g] = P.ATTML[q * 2 + 1]; ow[g] = *(const GAS u32x4*)(P.ATTO + q * 128 + d0); }
        float s = 0.f;
#pragma unroll
        for (int q = 0; q < 4; ++q) s += (y[q].x + y[q].y) + (y[q].z + y[q].w);
        const float mean = sum4q(s) * (1.0f / 64.0f); float s2 = 0.f;
#pragma unroll
        for (int q = 0; q < 4; ++q) { y[q] = y[q] - mean; s2 += (y[q].x * y[q].x + y[q].y * y[q].y) + (y[q].z * y[q].z + y[q].w * y[q].w); }
        const float rstd = 1.0f / sqrtf(sum4q(s2) * (1.0f / 64.0f) + GN_EPS);
        f32x4 gq[4]; unpack8(g0, gq[0], gq[1]); unpack8(g1, gq[2], gq[3]);
#pragma unroll
        for (int q = 0; q < 4; ++q) { const f32x4 lw = *(const GAS f32x4*)(P.ln_x_w + c0 + 4 * q), lb = *(const GAS f32x4*)(P.ln_x_b + c0 + 4 * q); y[q] = ((y[q] * rstd) * lw + lb + v[q] * bon) * gq[q]; }
        { bf16* ap = P.YAIN + (size_t)m * 1536 + c0; *(GAS u32x4*)ap = pack8(y[0], y[1]); *(GAS u32x4*)(ap + 8) = pack8(y[2], y[3]); }
        const float M = fmaxf(mm[0], fmaxf(mm[1], mm[2])); float den = 0.f; f32x4 n0 = {0.f, 0.f, 0.f, 0.f}, n1 = n0;
#pragma unroll
        for (int g = 0; g < 3; ++g) { const float wg = exp2f(mm[g] - M); den += wg * ll[g]; f32x4 a, b; unpack8(ow[g], a, b); n0 = n0 + a * wg; n1 = n1 + b * wg; }
        const float inv = 1.0f / den;
        *(GAS u32x4*)(P.YAIN + (size_t)m * 1536 + 1024 + 8 * lane) = pack8(n0 * inv, n1 * inv);
    }
}

template <int CTRL> __device__ __forceinline__ int dppi(int x) { return __builtin_amdgcn_mov_dpp(x, CTRL, 0xf, 0xf, true); }
__device__ __forceinline__ float row16_max(float x) { x = fmaxf(x, dppf<0xB1>(x)); x = fmaxf(x, dppf<0x4E>(x)); x = fmaxf(x, dppf<0x141>(x)); x = fmaxf(x, dppf<0x140>(x)); return x; }
__device__ __forceinline__ int row16_min(int x) { x = min(x, dppi<0xB1>(x)); x = min(x, dppi<0x4E>(x)); x = min(x, dppi<0x141>(x)); x = min(x, dppi<0x140>(x)); return x; }
__device__ __forceinline__ void p8_router(const Ptrs& P, LAS unsigned char* lds, int tid, int wave, int lane, int cnt_base = CW_CNT) {
    LAS float* rsv = (LAS float*)lds;
    LAS float* part = (LAS float*)(lds + 1024);
    LAS int* picks = (LAS int*)(lds + 1024 + 8192); LAS int* pbase = picks + 256; LAS float* pgate = (LAS float*)(pbase + 64);
    const int fr = lane & 15, fq = lane >> 4;
    for (int grp = blockIdx.x; grp < T / 64; grp += gridDim.x) {
        const int mb = grp * 64;
        __syncthreads();
#pragma unroll 2
        for (int tk = 0; tk < 8; ++tk) { const int m = mb + wave * 8 + tk; const bf16* xr = P.X1 + (size_t)m * D; f32x4 v[8]; float s = 0.f;
#pragma unroll
            for (int j = 0; j < 8; ++j) { const u32x2 xw = *(const GAS u32x2*)(xr + 4 * lane + 256 * j); v[j] = (f32x4){bflo(xw.x), bfhi(xw.x), bflo(xw.y), bfhi(xw.y)}; s += (v[j].x * v[j].x + v[j].y * v[j].y) + (v[j].z * v[j].z + v[j].w * v[j].w); }
            const float r = 1.0f / sqrtf(wave_sum(s) * (1.0f / D) + NORM_EPS); if (lane == 0) rsv[wave * 8 + tk] = r;
            unsigned char* hr = (unsigned char*)P.H + (size_t)m * D;
#pragma unroll
            for (int j = 0; j < 8; ++j) { const f32x4 gv = *(const GAS f32x4*)(P.norm_ffn + 4 * lane + 256 * j);
                *(GAS unsigned*)(hr + 4 * lane + 256 * j) = pk4_fp8(v[j].x * r * gv.x, v[j].y * r * gv.y, v[j].z * r * gv.z, v[j].w * r * gv.w); } }
        const int tt = wave & 3, kh = wave >> 2;
        f32x4 acc[2] = {{0.f, 0.f, 0.f, 0.f}, {0.f, 0.f, 0.f, 0.f}};
        { const bf16* xa = P.X1 + (size_t)(mb + tt * 16 + fr) * D + kh * 1024 + 8 * fq; const bf16* wh = P.WRH + (size_t)fr * D + kh * 1024 + 8 * fq; const bf16* wl = P.WRL + (size_t)fr * D + kh * 1024 + 8 * fq;
#pragma unroll 4
          for (int ks = 0; ks < 32; ++ks) { const bf16x8 ah = *(const GAS bf16x8*)(xa + 32 * ks);
#pragma unroll
              for (int nt = 0; nt < 2; ++nt) { const bf16x8 bh = *(const GAS bf16x8*)(wh + (size_t)nt * 16 * D + 32 * ks), bl = *(const GAS bf16x8*)(wl + (size_t)nt * 16 * D + 32 * ks);
                  acc[nt] = mfma16(ah, bh, acc[nt]); acc[nt] = mfma16(ah, bl, acc[nt]); } } }
        if (kh == 1) { *(LAS f32x4*)(part + ((tt * 2 + 0) * 64 + lane) * 4) = acc[0]; *(LAS f32x4*)(part + ((tt * 2 + 1) * 64 + lane) * 4) = acc[1]; }
        __syncthreads();
        if (kh == 0) {
            acc[0] = acc[0] + *(const LAS f32x4*)(part + ((tt * 2 + 0) * 64 + lane) * 4); acc[1] = acc[1] + *(const LAS f32x4*)(part + ((tt * 2 + 1) * 64 + lane) * 4);
            const float b0 = P.b_router[fr], b1 = P.b_router[16 + fr];
#pragma unroll
            for (int rg = 0; rg < 4; ++rg) { const int tl = tt * 16 + 4 * fq + rg; const float r = rsv[tl];
                float v0 = acc[0][rg] * r + b0, v1 = acc[1][rg] * r + b1; int sel[4]; float val[4];
#pragma unroll
                for (int k = 0; k < 4; ++k) { const float mx = row16_max(fmaxf(v0, v1)); const int cand = (v0 == mx) ? fr : ((v1 == mx) ? 16 + fr : 99); const int s_ = row16_min(cand);
                    sel[k] = s_; val[k] = mx; v0 = (s_ == fr) ? -3.0e38f : v0; v1 = (s_ == 16 + fr) ? -3.0e38f : v1; }
                const float e1 = __expf(val[1] - val[0]), e2 = __expf(val[2] - val[0]), e3 = __expf(val[3] - val[0]); const float inv = 1.0f / (1.0f + e1 + e2 + e3);
                const float gate[4] = {inv, e1 * inv, e2 * inv, e3 * inv};
                if (fr == 0) { const int m = mb + tl;
#pragma unroll
                    for (int k = 0; k < 4; ++k) { picks[tl * 4 + k] = sel[k]; pgate[tl * 4 + k] = gate[k]; P.TOPK_E[m * 4 + k] = sel[k]; P.TOPK_GATE[m * 4 + k] = gate[k]; } } }
        }
        __syncthreads();
        if (tid < 32) { int cnt = 0;
            for (int j = 0; j < 256; ++j) cnt += (picks[j] == tid) ? 1 : 0;
            pbase[tid] = (int)__hip_atomic_fetch_add((unsigned*)(P.ctl + cnt_base + 64 * tid), (unsigned)cnt, RLX_AGENT); }
        __syncthreads();
        if (tid < 256) { const int mine = picks[tid]; int rank = 0;
            for (int j = 0; j < tid; ++j) rank += (picks[j] == mine) ? 1 : 0;
            const int pos = pbase[mine] + rank; P.TOPK_POS[mb * 4 + tid] = pos;
            P.RT2[mine * 16384 + pos] = mb * 4 + tid; P.RG2[mine * 16384 + pos] = pgate[tid]; }
    }
}

__device__ __forceinline__ void moe_tables(const Ptrs& P, LAS int* tab, int tid) {
    if (tid == 0) { int acc = 0;
        for (int e = 0; e < NE; ++e) { tab[e] = acc; const int c = (int)__hip_atomic_load((unsigned*)(P.ctl + CW_CNT + 64 * e), RLX_AGENT); acc += (c + 255) >> 8; tab[64 + e] = c; }
        tab[32] = acc; }
    __syncthreads();
}

__device__ __forceinline__ void p9_gather(const Ptrs& P, LAS unsigned char* lds, int tid, int wave, int lane) {
    LAS int* tab = (LAS int*)(lds + TAB_OFF);
    moe_tables(P, tab, tid);
    const int gw = blockIdx.x * NWAVES + wave, NGW = gridDim.x * NWAVES;
    for (int p = gw; p < T * 4; p += NGW) { const int e = P.TOPK_E[p], pos = P.TOPK_POS[p]; const int row = tab[e] * 256 + pos;
        const GAS u32x4* src = (const GAS u32x4*)((const unsigned char*)P.H + (size_t)(p >> 2) * D); GAS u32x4* dst = (GAS u32x4*)((unsigned char*)P.XS + (size_t)row * D);
#pragma unroll
        for (int i = 0; i < 2; ++i) dst[lane + 64 * i] = src[lane + 64 * i];
        if (lane == 0) { P.ROWTOK[row] = p; P.ROWGATE[row] = P.TOPK_GATE[p]; } }
    for (int e = blockIdx.x; e < NE; e += gridDim.x) { const int cnt = tab[64 + e], r0 = tab[e] * 256, rend = tab[e + 1] * 256;
        for (int r = r0 + cnt + tid; r < rend; r += NTHREADS) { P.ROWTOK[r] = -1; P.ROWGATE[r] = 0.f; } }
}

__device__ __forceinline__ void p12_final(const Ptrs& P, int tid, int wave, int lane) {
    const int gw = blockIdx.x * NWAVES + wave, NGW = gridDim.x * NWAVES;
    for (int m = gw; m < T; m += NGW) {
        f32x4 v[8]; float s = 0.f;
#pragma unroll
        for (int j = 0; j < 8; ++j) { const int col = 4 * lane + 256 * j; { const u32x2 xw = *(const GAS u32x2*)(P.X1 + (size_t)m * D + col); v[j] = (f32x4){bflo(xw.x), bfhi(xw.x), bflo(xw.y), bfhi(xw.y)}; }
            f32x4 mo = {0.f, 0.f, 0.f, 0.f};
#pragma unroll
            for (int k = 0; k < 4; ++k) { const unsigned w = *(const GAS unsigned*)((const unsigned char*)P.OUTK + ((size_t)m * 4 + k) * D + col);
                const f32x2 lo = __builtin_amdgcn_cvt_pk_f32_fp8((int)w, false), hi = __builtin_amdgcn_cvt_pk_f32_fp8((int)w, true); mo.x += lo[0]; mo.y += lo[1]; mo.z += hi[0]; mo.w += hi[1]; }
            v[j] = v[j] + mo * 0.03125f;
            s += (v[j].x * v[j].x + v[j].y * v[j].y) + (v[j].z * v[j].z + v[j].w * v[j].w); }
        const float rs = 1.0f / sqrtf(wave_sum(s) * (1.0f / D) + NORM_EPS);
#pragma unroll
        for (int j = 0; j < 8; ++j) { const int col = 4 * lane + 256 * j; const f32x4 g = *(const GAS f32x4*)(P.norm_final + col); *(GAS f32x4*)(P.out + (size_t)m * D + col) = v[j] * rs * g; }
    }
}

struct Args { const void* in[26]; float* out; unsigned char* ws; int ph_lo, ph_hi; };
__global__ void __launch_bounds__(NTHREADS, 2) fwd(Args args) {
    extern __shared__ __attribute__((aligned(16))) unsigned char lds_raw[];
    LAS unsigned char* lds = (LAS unsigned char*)lds_raw;
    const int tid = threadIdx.x, lane = tid & 63, wave = __builtin_amdgcn_readfirstlane(tid >> 6);
    unsigned char* ws = args.ws;
    Ptrs P;
    P.x = (const float*)args.in[0]; P.positions = (const int*)args.in[1]; P.norm_mix = (const float*)args.in[2]; P.w_in = (const float*)args.in[3]; P.shift_mu = (const float*)args.in[4];
    P.w0 = (const float*)args.in[5]; P.w2_decay = (const float*)args.in[6]; P.a0 = (const float*)args.in[7]; P.a2_iclr = (const float*)args.in[8]; P.g2_gate = (const float*)args.in[9];
    P.k_k = (const float*)args.in[10]; P.k_a = (const float*)args.in[11]; P.r_k = (const float*)args.in[12]; P.ln_x_w = (const float*)args.in[13]; P.ln_x_b = (const float*)args.in[14];
    P.w_o_rwkv = (const float*)args.in[15]; P.w_o_attn = (const float*)args.in[16]; P.w_out = (const float*)args.in[17]; P.norm_ffn = (const float*)args.in[18]; P.w_router = (const float*)args.in[19];
    P.b_router = (const float*)args.in[20]; P.w1 = (const float*)args.in[21]; P.b1 = (const float*)args.in[22]; P.w2 = (const float*)args.in[23]; P.b2 = (const float*)args.in[24]; P.norm_final = (const float*)args.in[25];
    P.out = args.out; P.ctl = (gu32*)(ws + WS_CTL);
    P.WIN = (bf16*)(ws + WS_WIN); P.W1 = (bf16*)(ws + WS_W1); P.W2 = (bf16*)(ws + WS_W2); P.WOR = (bf16*)(ws + WS_WOR); P.WOA = (bf16*)(ws + WS_WOA); P.WOUT = (bf16*)(ws + WS_WOUT);
    P.H = (bf16*)(ws + WS_H); P.ZP = (bf16*)(ws + WS_ZP); P.QKV = (bf16*)(ws + WS_QKV); P.GATES = (bf16*)(ws + WS_GATES); P.ROT = (float*)(ws + WS_ROT); P.SC = (float*)(ws + WS_SC); P.SCH = (bf16*)(ws + WS_SC + 64 * MiB);
    P.G = (bf16*)(ws + WS_G); P.BONUS = (float*)(ws + WS_BONUS); P.Y = (float*)(ws + WS_Y); P.ATTO = (bf16*)(ws + WS_ATTO); P.ATTML = (float*)(ws + WS_ATTML); P.YAIN = (bf16*)(ws + WS_YAIN);
    P.OIN = (bf16*)(ws + WS_OIN); P.MERGED = (bf16*)(ws + WS_MERGED); P.X1 = (bf16*)(ws + WS_X1);
    P.TOPK_E = (int*)(ws + WS_TOPK); P.TOPK_POS = P.TOPK_E + T * 4; P.TOPK_GATE = (float*)(P.TOPK_POS + T * 4);
    P.ROWTOK = (int*)(ws + WS_ROWS); P.ROWGATE = (float*)(P.ROWTOK + XS_ROWS); P.RT2 = (int*)(ws + WS_ROWS2); P.RG2 = (float*)(P.RT2 + NE * 16384);
    P.LW = (bf16*)(ws + WS_LORA); P.LA = P.LW + 1024 * 64; P.LG = P.LA + 1024 * 64; P.WRH = P.LG + 1024 * 160; P.WRL = P.WRH + NE * D;
    P.XS = (bf16*)(ws + WS_XS); P.ACT = (bf16*)(ws + WS_ACT); P.OUTK = (bf16*)(ws + WS_OUTK);

    for (int u = tid; u < (LDS_BYTES - TAB_OFF) / 4; u += NTHREADS) ((LAS unsigned*)(lds + TAB_OFF))[u] = 0u;
    __syncthreads();
#if MK_ONE_LAUNCH
    XcdBarrier bar = xcd_barrier_post((unsigned*)(P.ctl + CW_BAR), (volatile LAS unsigned*)(lds + MISC_OFF));
#define GRID_BAR() xcd_barrier(bar)
#else
#define GRID_BAR() do { } while (0)
#endif
    const int lo = args.ph_lo, hi = args.ph_hi;
#ifndef PHASE_MASK
#define PHASE_MASK 0x3fff
#endif
#define IN(k) (((PHASE_MASK >> (k)) & 1) && lo <= (k) && (k) < hi)
#define SEAM(k) do { if (IN(k) && IN((k) + 1)) GRID_BAR(); } while (0)
    const int G = gridDim.x, c = blockIdx.x;

#ifndef REP_MASK
#define REP_MASK 0
#endif
#define REPS(k) (1 + ((REP_MASK >> (k)) & 1))
#define PHASE(k, ...) do { if (IN(k)) { { __VA_ARGS__ } if (REPS(k) == 2) { GRID_BAR(); { __VA_ARGS__ } } SEAM(k); } } while (0)
    PHASE(0, p0_prologue(P, ws, lds, tid, wave, lane););
#ifdef PROBE_DRY
    if (IN(1)) { pg8::Gemm g{P.H, P.WIN, T, NPROJ, D}; pg8::StaticOrder S; S.init(T, NPROJ, G, c); EpiProj E{P.ZP, P.QKV, P.GATES, P.ROT, PROBE_DRY + (int)__hip_atomic_load(P.ctl + CW_TMO, RLX_AGENT)};
        pg8::gemm_phase<EpiProj, pg8::StaticOrder, true, true>(lds, g, S, E); GRID_BAR(); }
#endif
#ifndef P1_ALIGN
#define P1_ALIGN true
#endif
#ifndef STAG_US
#define STAG_US 0
#endif
    PHASE(1, { if (STAG_US > 0) { const unsigned long long t0_ = __builtin_amdgcn_s_memrealtime(), d_ = (unsigned long long)(((blockIdx.x >> 3) & 7) * STAG_US * 100);
            while (__builtin_amdgcn_s_memrealtime() - t0_ < d_) __builtin_amdgcn_s_sleep(8); }
        { pg8::Gemm g{P.H, P.WIN, T, 3072, D}; pg8::StaticOrder S; S.init(T, 3072, G, c); EpiProj E{P.ZP, P.QKV, P.GATES, P.ROT, 0, 0, 1.0f};
          pg8::gemm_phase<EpiProj, pg8::StaticOrder, P1_ALIGN, true>(lds, g, S, E); }
        __syncthreads();
        { pg8::Gemm g{(const bf16*)(ws + WS_H8), (const bf16*)(ws + WS_WG8B), T, 9216, D / 2}; pg8::StaticOrder S; S.init(T, 9216, G, c); EpiProj E{P.ZP, P.QKV, P.GATES, P.ROT, 0, 12, 0.03125f};
          pg8::gemm_phase<EpiProj, pg8::StaticOrder, P1_ALIGN, true, 127, 127>(lds, g, S, E); } });
#ifndef PROBE_SUB
#define PROBE_SUB 0
#endif
    PHASE(2, { p2_fused(P, ws, lds, tid, wave, lane); __syncthreads(); if (PROBE_SUB == 1) { p2_fused(P, ws, lds, tid, wave, lane); __syncthreads(); }
        p3_attention(P, lds, tid, wave, lane); if (PROBE_SUB == 2) { __syncthreads(); p3_attention(P, lds, tid, wave, lane); } });
    PHASE(5, p4b_scan(P, ws, lds, tid, wave, lane););
    PHASE(6, p5_post(P, tid, wave, lane););
    PHASE(7, {
        { pg8::Gemm g{P.YAIN, P.WOR, T, D, 1536}; pg8::StaticOrder S; S.init(T, D, G, c); EpiMerge2 E{P.GATES, ws + WS_MERGED8}; pg8::gemm_phase<EpiMerge2, pg8::StaticOrder, true, true, -1, -1, false, false, true>(lds, g, S, E); } });
    PHASE(8, { pg8::Gemm g{(const bf16*)(ws + WS_MERGED8), P.WOUT, T, D, D / 2}; pg8::StaticOrder S; S.init(T, D, G, c); EpiResid E{P.x, P.X1, 1.0f / 512.0f}; pg8::gemm_phase<EpiResid, pg8::StaticOrder, true, true, 127, 127>(lds, g, S, E); });
#ifdef ROUTER_TWICE
    if (IN(9)) { p8_router(P, lds, tid, wave, lane, CW_CNT + 4096); GRID_BAR(); }
#endif
    PHASE(9, p8_router(P, lds, tid, wave, lane););
#ifdef PROBE_DRY_MOE
#ifndef PROBE_FP8A
#define PROBE_FP8A 4
#endif
    if (IN(11)) { LAS int* tab = (LAS int*)(lds + TAB_OFF); moe_tables(P, tab, tid);
        if (PROBE_DRY_MOE & 1) { { pg8::Gemm g{P.XS, P.W1, XS_ROWS, NE * 4096, D / 2}; MoeOrder S{tab, 16, G, c}; EpiMoe1 E{P.ACT, P.b1, 1}; pg8::gemm_phase<EpiMoe1, MoeOrder, true, true, 122, PROBE_FP8A, true, false>(lds, g, S, E); }
        GRID_BAR(); }
        if (PROBE_DRY_MOE & 2) { { pg8::Gemm g{P.ACT, P.W2, XS_ROWS, NE * D, FF / 2}; MoeOrder S{tab, 8, G, c}; EpiMoe2 E{P.OUTK, P.b2, P.ROWTOK, P.ROWGATE, 1}; pg8::gemm_phase<EpiMoe2, MoeOrder, true, true, 122, PROBE_FP8A, true, false>(lds, g, S, E); }
        GRID_BAR(); } }
#endif
    PHASE(11, { LAS int* tab = (LAS int*)(lds + TAB_OFF); moe_tables(P, tab, tid);
        pg8::Gemm g{P.H, P.W1, XS_ROWS, NE * 4096, D / 2}; MoeOrder S{tab, 16, G, c}; EpiMoe1 E{P.ACT, P.b1, 0, P.RT2, tab};
        pg8::gemm_phase<EpiMoe1, MoeOrder, true, true, 122, 127, true, false, false, true>(lds, g, S, E); });
    PHASE(12, { LAS int* tab = (LAS int*)(lds + TAB_OFF); moe_tables(P, tab, tid);
        pg8::Gemm g{P.ACT, P.W2, XS_ROWS, NE * D, FF / 2}; MoeOrder S{tab, 8, G, c}; EpiMoe2 E{P.OUTK, P.b2, P.RT2, P.RG2, 0, tab};
        pg8::gemm_phase<EpiMoe2, MoeOrder, true, true, 122, 124, true, false>(lds, g, S, E); });
    PHASE(13, p12_final(P, tid, wave, lane););
#undef IN
#undef SEAM
}

extern "C" void kernel_launch(void* const* d_in, const int* in_sizes, int n_in, void* d_out, int out_size, void* d_ws, size_t ws_size, hipStream_t stream) {
    static int grid = 0;
    if (grid == 0) {
        if (n_in != 26 || out_size != T * D || ws_size < WS_END) { fprintf(stderr, "kernel_launch: unexpected shapes (n_in %d, out %d, ws %zu, need %zu); nothing launched\n", n_in, out_size, ws_size, (size_t)WS_END); grid = -1; return; }
        int dev = 0, cus = 0, per_cu = 0;
        if (hipGetDevice(&dev) != hipSuccess || hipDeviceGetAttribute(&cus, hipDeviceAttributeMultiprocessorCount, dev) != hipSuccess) { grid = -1; return; }
        if (hipFuncSetAttribute((const void*)fwd, hipFuncAttributeMaxDynamicSharedMemorySize, LDS_BYTES) != hipSuccess) { fprintf(stderr, "kernel_launch: hipFuncSetAttribute failed\n"); grid = -1; return; }
        if (hipOccupancyMaxActiveBlocksPerMultiprocessor(&per_cu, (const void*)fwd, NTHREADS, LDS_BYTES) != hipSuccess || per_cu < 1) fprintf(stderr, "kernel_launch: occupancy query says %d\n", per_cu);
        (void)hipGetLastError();
        grid = cus;
    }
    if (grid < 0) return;
    if (hipMemsetAsync((char*)d_ws + WS_CTL, 0, CTL_ZERO_BYTES, stream) != hipSuccess) return;
    Args a{};
    for (int i = 0; i < 26; ++i) a.in[i] = d_in[i];
    a.out = (float*)d_out; a.ws = (unsigned char*)d_ws;
#if MK_ONE_LAUNCH
    a.ph_lo = 0; a.ph_hi = NPHASES;
    hipLaunchKernelGGL(fwd, dim3(grid), dim3(NTHREADS), LDS_BYTES, stream, a);
#else
    for (int ph = 0; ph < NPHASES; ++ph) { a.ph_lo = ph; a.ph_hi = ph + 1; hipLaunchKernelGGL(fwd, dim3(grid), dim3(NTHREADS), LDS_BYTES, stream, a); }
#endif
}
```

```cpp
#include <hip/hip_runtime.h>
#include <cstdio>
#include <cstdint>
#include <cmath>
#ifndef PG8_KROT
#define PG8_KROT 1
#endif
namespace pg8 {
#define PG8_LAS __attribute__((address_space(3)))
typedef unsigned short bf16_t;
typedef short bf16x8 __attribute__((ext_vector_type(8)));
typedef float f32x4 __attribute__((ext_vector_type(4)));
typedef unsigned u32x4 __attribute__((ext_vector_type(4)));
constexpr int BM = 256, BK = 64, HALF = 128, HTB = HALF * BK * 2  , STAGE_BYTES = 8 * HTB, NXCD = 8, WGM = 8;

__host__ __device__ __forceinline__ int lds_byte(int r, int c) { const int st = (r >> 4) * 2 + (c >> 5), rr = r & 15, cc = c & 31, ob = rr * 64 + cc * 2; return st * 1024 + (ob ^ (((ob >> 9) & 1) << 5)); }
__host__ __device__ __forceinline__ void stage_rc(int b, int& R, int& C) { const int st = b / 1024, sb = b % 1024, swz = sb ^ (((sb >> 9) & 1) << 5); R = (st >> 1) * 16 + swz / 64; C = (st & 1) * 32 + (swz % 64) / 2; }
__host__ __device__ __forceinline__ int perm32b(int rho) { const int n = rho >> 4, i = rho & 15, q = i >> 2; return 8 * (((q & 1) << 1) | (q >> 1)) + 4 * n + (i & 3); }
__host__ __device__ __forceinline__ int perm32(int rho) { const int n = rho >> 4, i = rho & 15; return 8 * (i >> 2) + 4 * n + (i & 3); }

struct Unit { int pm, pn; };
struct Gemm { const bf16_t* A; const bf16_t* Bt; int M, N, K; };

struct StaticOrder {
    int nM, nN, nwg, G, c;
    __host__ __device__ void init(int M, int N, int G_, int c_) { nM = M / BM; nN = N / BM; nwg = nM * nN; G = G_; c = c_; }
    __host__ __device__ bool next(int i, Unit& u) const {
        const long L = (long)i * G + c; if (L >= nwg) return false;
        int wgid = (int)L; { const int q = nwg / NXCD, r = nwg % NXCD, xcd = wgid % NXCD, off = wgid / NXCD; wgid = (xcd < r ? xcd * (q + 1) : r * (q + 1) + (xcd - r) * q) + off; }
        const int nig = WGM * nN, gid = wgid / nig, fm = gid * WGM, gsz = (nM - fm) < WGM ? (nM - fm) : WGM;
        u.pm = fm + ((wgid % nig) % gsz); u.pn = (wgid % nig) / gsz; return true;
    }
    __device__ __forceinline__ void a_ready(const Unit&) const {}
    __device__ __forceinline__ void done(const Unit&) const {}
};

__device__ __forceinline__ unsigned cvt_pk_bf16(float lo, float hi) { unsigned r; asm volatile("v_cvt_pk_bf16_f32 %0, %1, %2" : "=v"(r) : "v"(lo), "v"(hi)); return r; }
typedef float f32x2 __attribute__((ext_vector_type(2)));

typedef int i32x4_t __attribute__((ext_vector_type(4)));
typedef int i32x8_t __attribute__((ext_vector_type(8)));
__device__ __forceinline__ f32x4 mfma_fp8(bf16x8 w0, bf16x8 w1, bf16x8 a0, bf16x8 a1, f32x4 c, int sw, int sa) {
    const i32x4_t x0 = __builtin_bit_cast(i32x4_t, w0), x1 = __builtin_bit_cast(i32x4_t, w1), y0 = __builtin_bit_cast(i32x4_t, a0), y1 = __builtin_bit_cast(i32x4_t, a1);
    const i32x8_t X = {x0.x, x0.y, x0.z, x0.w, x1.x, x1.y, x1.z, x1.w}, Y = {y0.x, y0.y, y0.z, y0.w, y1.x, y1.y, y1.z, y1.w};
    return __builtin_amdgcn_mfma_scale_f32_16x16x128_f8f6f4(X, Y, c, 0, 0, 0, sw, 0, sa);
}
template <class Epi, class Sched, bool ALIGN_EPI = false, bool SP2 = false, int FP8W = -1, int FP8A = -1, bool PRE = false, bool KROT = true, bool MID = false, bool GATH = false>
__device__ __forceinline__ void gemm_phase(PG8_LAS unsigned char* lds, const Gemm g, const Sched& S, const Epi& E) {
    const int tid = threadIdx.x, wid = __builtin_amdgcn_readfirstlane(tid >> 6), lane = tid & 63, wr = wid >> 2, wc = wid & 3, fr = lane & 15, fq = lane >> 4;
    const int K = g.K, nt = K / BK;
    int kpre = 0; if constexpr (PRE) kpre = E.npre(wid);
    constexpr int PRE_OFF = 131072, PRE_SLOT = 4096;
    unsigned voffA[2], voffB[2]; int arow[2]; unsigned acol[2];
#pragma unroll
    for (int i = 0; i < 2; ++i) { int R, C; stage_rc(tid * 16 + i * 8192, R, C); const int Rb = 64 * (R >> 5) + (Epi::PERM ? (Epi::PERM2 ? perm32b(R & 31) : perm32(R & 31)) : (R & 31));
        voffA[i] = (unsigned)(R * K + C) * 2u; voffB[i] = (unsigned)(Rb * K + C) * 2u; arow[i] = R; acol[i] = (unsigned)C * 2u; }
    const size_t kstep = (size_t)(BK * 2);
    const int krot = (PG8_KROT && KROT) ? (int)(blockIdx.x & 7) * (nt >> 3) : 0;
#define PG8_KP(x) ((size_t)(((x) + krot) >= nt ? ((x) + krot - nt) : ((x) + krot)) * kstep)
    const size_t kp0 = PG8_KP(0), kp1 = PG8_KP(1);
    const size_t hstep = (size_t)HALF * K * 2;
    const size_t tstep = 2 * hstep;
    const size_t bh1 = (size_t)32 * K * 2;
    const unsigned ldsw = (unsigned)wid * 1024u;
    const int aoff = lds_byte(wr * 64 + fr, fq * 8), boff = lds_byte(wc * 32 + fr, fq * 8);
#define PG8_SA(b, h) (((b) * 2 + (h)) * HTB)
#define PG8_SB(b, h) ((4 + (b) * 2 + (h)) * HTB)
#define PG8_STAGE(bufoff, gbase, voff) do { _Pragma("unroll") for (int _i = 0; _i < 2; ++_i) \
        __builtin_amdgcn_global_load_lds((const unsigned*)((const char*)(gbase) + (voff)[_i]), (PG8_LAS unsigned*)(lds + (bufoff) + ldsw + _i * 8192), 16, 0, 0); } while (0)
#define PG8_LD8(p) __builtin_shufflevector(*(const PG8_LAS i32x4_t*)(p), *(const PG8_LAS i32x4_t*)((p) + 1024), 0, 1, 2, 3, 4, 5, 6, 7)
#define PG8_LDA(dst, b, h) do { if constexpr (FP8W >= 0) { _Pragma("unroll") for (int m = 0; m < 4; ++m) dst##8[m] = PG8_LD8(lds + PG8_SA(b, h) + aoff + m * 2048); } \
        else { _Pragma("unroll") for (int m = 0; m < 4; ++m) _Pragma("unroll") for (int k = 0; k < 2; ++k) dst[m][k] = *(const PG8_LAS bf16x8*)(lds + PG8_SA(b, h) + aoff + m * 2048 + k * 1024); } } while (0)
#define PG8_LDB(dst, b, h) do { if constexpr (FP8W >= 0) { _Pragma("unroll") for (int n = 0; n < 2; ++n) dst##8[n] = PG8_LD8(lds + PG8_SB(b, h) + boff + n * 2048); } \
        else { _Pragma("unroll") for (int n = 0; n < 2; ++n) _Pragma("unroll") for (int k = 0; k < 2; ++k) dst[n][k] = *(const PG8_LAS bf16x8*)(lds + PG8_SB(b, h) + boff + n * 2048 + k * 1024); } } while (0)
#define PG8_MMA(ai, bj, At, Bt) do { __builtin_amdgcn_s_setprio(1); _Pragma("unroll") for (int m = 0; m < 4; ++m) _Pragma("unroll") for (int n = 0; n < 2; ++n) { \
        if constexpr (FP8W >= 0) { if constexpr (FP8A == 4) { const i32x4_t b4_ = __builtin_shufflevector(Bt##8[n], Bt##8[n], 0, 1, 2, 3), a4_ = __builtin_shufflevector(At##8[m], At##8[m], 0, 1, 2, 3); asm volatile("v_mfma_f32_16x16x128_f8f6f4 %0, %1, %2, %0 cbsz:4 blgp:4" : "+v"(acc[ai][bj][m][n]) : "v"(b4_), "v"(a4_)); } else asm volatile("v_mfma_f32_16x16x128_f8f6f4 %0, %1, %2, %0" : "+v"(acc[ai][bj][m][n]) : "v"(Bt##8[n]), "v"(At##8[m])); } \
        else { _Pragma("unroll") for (int k = 0; k < 2; ++k) acc[ai][bj][m][n] = __builtin_amdgcn_mfma_f32_16x16x32_bf16(Bt[n][k], At[m][k], acc[ai][bj][m][n], 0, 0, 0); } } \
        __builtin_amdgcn_s_setprio(0); } while (0)
#define PG8_WAIT_V(n) asm volatile("s_waitcnt vmcnt(" #n ")" ::: "memory")
#define PG8_WAIT_L(n) asm volatile("s_waitcnt lgkmcnt(" #n ")" ::: "memory")
#define PG8_BAR __builtin_amdgcn_s_barrier()
#define PG8_SCHED __builtin_amdgcn_sched_barrier(0)
    Unit cur, nxt; int ui = 0;
    if (!S.next(0, cur)) return;
    f32x4 acc[2][2][4][2];
#pragma unroll
    for (int a = 0; a < 2; ++a)
#pragma unroll
        for (int b = 0; b < 2; ++b)
#pragma unroll
            for (int m = 0; m < 4; ++m)
#pragma unroll
                for (int n = 0; n < 2; ++n) acc[a][b][m][n] = (f32x4){0.f, 0.f, 0.f, 0.f};
    const int fp8sw = FP8W, fp8sa = FP8A; (void)fp8sw; (void)fp8sa;
    bf16x8 At[4][2], B0[2][2], B1[2][2]; i32x8_t At8[4], B08[2], B18[2];
    const char* cA = (const char*)g.A + (size_t)cur.pm * tstep; const char* cB = (const char*)g.Bt + (size_t)cur.pn * tstep;
    S.a_ready(cur);
    const char* gA = (const char*)g.A; unsigned oc[2][2] = {{0u, 0u}, {0u, 0u}}, on[2][2] = {{0u, 0u}, {0u, 0u}};
    if constexpr (GATH) { static_assert(!GATH || (SP2 && PRE), "gathered A rows: SP2 + PRE form only"); int sb_, nv_; E.arows(cur, sb_, nv_);
#pragma unroll
        for (int h = 0; h < 2; ++h)
#pragma unroll
            for (int i = 0; i < 2; ++i) { const int row = arow[i] + 128 * h; const int p_ = E.RT2[sb_ + row]; oc[h][i] = ((row < nv_) ? (unsigned)(p_ >> 2) : 0u) * (unsigned)(K * 2) + acol[i]; } }
#define PG8_STA(bufslot, h, kbytes, origptr) do { if constexpr (GATH) PG8_STAGE(bufslot, gA + (kbytes), oc[h]); else PG8_STAGE(bufslot, origptr, voffA); } while (0)
    if constexpr (SP2) {
        PG8_STAGE(PG8_SB(0, 0), cB + kp0, voffB); PG8_STAGE(PG8_SB(0, 1), cB + bh1 + kp0, voffB); PG8_STA(PG8_SA(0, 0), 0, kp0, cA + kp0); PG8_STA(PG8_SA(0, 1), 1, kp0, cA + hstep + kp0);
        if (wr == 1) PG8_BAR;
        PG8_WAIT_V(2); PG8_BAR;
        PG8_STAGE(PG8_SB(1, 0), cB + kp1, voffB); PG8_STA(PG8_SA(1, 0), 0, kp1, cA + kp1); PG8_STAGE(PG8_SB(1, 1), cB + bh1 + kp1, voffB);
        PG8_WAIT_V(6); PG8_BAR;
    } else {
        PG8_STAGE(PG8_SB(0, 0), cB + kp0, voffB); PG8_STAGE(PG8_SA(0, 0), cA + kp0, voffA); PG8_STAGE(PG8_SB(0, 1), cB + bh1 + kp0, voffB); PG8_STAGE(PG8_SA(0, 1), cA + hstep + kp0, voffA);
        if (wr == 1) PG8_BAR;
        PG8_WAIT_V(4); PG8_BAR;
        PG8_STAGE(PG8_SB(1, 0), cB + kp1, voffB); PG8_STAGE(PG8_SA(1, 0), cA + kp1, voffA); PG8_STAGE(PG8_SB(1, 1), cB + bh1 + kp1, voffB);
        PG8_WAIT_V(6); PG8_BAR;
    }
    for (;;) {
        const bool has_next = S.next(ui + 1, nxt);
        const char* nA = has_next ? (const char*)g.A + (size_t)nxt.pm * tstep : cA; const char* nB = has_next ? (const char*)g.Bt + (size_t)nxt.pn * tstep : cB;
        for (int t = 0; t < nt; t += 2) {
            if constexpr (MID) { if (t == Epi::MID_T) E.mid(acc, cur, wr, wc, fr, fq); }
            const bool last = (t == nt - 2);
            const char* a1 = cA + PG8_KP(t + 1);
            const size_t k2 = last ? kp0 : PG8_KP(t + 2), k3 = last ? kp1 : PG8_KP(t + 3);
            const char* a2 = (last ? nA : cA) + k2; const char* b2 = (last ? nB : cB) + k2;
            const char* a3 = (last ? nA : cA) + k3; const char* b3 = (last ? nB : cB) + k3;
            if (last && has_next) S.a_ready(nxt);
            if constexpr (SP2) {
            if constexpr (PRE) { if (t == 0) E.prefetch(cur, lds + PRE_OFF + (ui & 1) * PRE_SLOT, wid, lane); }
            if constexpr (GATH) {
                if (t == 0 && has_next && wid < 4) { int sb_, nv_; E.arows(nxt, sb_, nv_);
                    __builtin_amdgcn_global_load_lds((const unsigned*)(E.RT2 + sb_ + wid * 64 + lane), (PG8_LAS unsigned*)(lds + PRE_OFF + ((ui + 1) & 1) * PRE_SLOT + 2048 + wid * 256), 4, 0, 0); }
                if (last) {
                    if (has_next) { int sb_, nv_; E.arows(nxt, sb_, nv_); const PG8_LAS int* rt_ = (const PG8_LAS int*)(lds + PRE_OFF + ((ui + 1) & 1) * PRE_SLOT + 2048);
#pragma unroll
                        for (int h = 0; h < 2; ++h)
#pragma unroll
                            for (int i = 0; i < 2; ++i) { const int row = arow[i] + 128 * h; const int p_ = rt_[row]; on[h][i] = ((row < nv_) ? (unsigned)(p_ >> 2) : 0u) * (unsigned)(K * 2) + acol[i]; } }
                    else { on[0][0] = oc[0][0]; on[0][1] = oc[0][1]; on[1][0] = oc[1][0]; on[1][1] = oc[1][1]; } } }
            PG8_LDB(B0, 0, 0); PG8_LDB(B1, 0, 1); PG8_SCHED; PG8_LDA(At, 0, 0); PG8_STA(PG8_SA(1, 1), 1, PG8_KP(t + 1), a1 + hstep);
            if constexpr (GATH) { if (last) { oc[0][0] = on[0][0]; oc[0][1] = on[0][1]; oc[1][0] = on[1][0]; oc[1][1] = on[1][1]; } }
            if (PRE && t == 0 && kpre == 1) PG8_WAIT_V(9); else if (PRE && t == 0 && kpre == 2) PG8_WAIT_V(10); else PG8_WAIT_V(8);
            PG8_WAIT_L(0); PG8_BAR; PG8_MMA(0, 0, At, B0); PG8_MMA(0, 1, At, B1); PG8_BAR; PG8_SCHED;
            PG8_LDA(At, 0, 1); PG8_STAGE(PG8_SB(0, 0), b2, voffB); PG8_STAGE(PG8_SB(0, 1), b2 + bh1, voffB); PG8_STA(PG8_SA(0, 0), 0, k2, a2);
            if (PRE && t == 0 && kpre == 1) PG8_WAIT_V(9); else if (PRE && t == 0 && kpre == 2) PG8_WAIT_V(10); else PG8_WAIT_V(8);
            PG8_WAIT_L(0); PG8_BAR; PG8_MMA(1, 0, At, B0); PG8_MMA(1, 1, At, B1); PG8_BAR; PG8_SCHED;
            PG8_LDB(B0, 1, 0); PG8_LDB(B1, 1, 1); PG8_SCHED; PG8_LDA(At, 1, 0); PG8_STA(PG8_SA(0, 1), 1, k2, a2 + hstep);
            PG8_WAIT_V(8); PG8_WAIT_L(0); PG8_BAR; PG8_MMA(0, 0, At, B0); PG8_MMA(0, 1, At, B1); PG8_BAR; PG8_SCHED;
            PG8_LDA(At, 1, 1); PG8_STAGE(PG8_SB(1, 0), b3, voffB); PG8_STAGE(PG8_SB(1, 1), b3 + bh1, voffB); PG8_STA(PG8_SA(1, 0), 0, k3, a3);
            PG8_WAIT_V(8); PG8_WAIT_L(0); PG8_BAR; PG8_MMA(1, 0, At, B0); PG8_MMA(1, 1, At, B1); PG8_BAR; PG8_SCHED;
            } else {
            PG8_LDB(B0, 0, 0); PG8_SCHED; PG8_LDA(At, 0, 0); PG8_STAGE(PG8_SA(1, 1), a1 + hstep, voffA);
            PG8_WAIT_L(8); PG8_BAR; PG8_WAIT_L(0); PG8_MMA(0, 0, At, B0); PG8_BAR; PG8_SCHED;
            PG8_LDB(B1, 0, 1); PG8_STAGE(PG8_SB(0, 0), b2, voffB);
            PG8_BAR; PG8_WAIT_L(0); PG8_MMA(0, 1, At, B1); PG8_BAR;
            PG8_LDA(At, 0, 1); PG8_STAGE(PG8_SA(0, 0), a2, voffA);
            PG8_BAR; PG8_WAIT_L(0); PG8_MMA(1, 0, At, B0); PG8_BAR; PG8_SCHED;
            PG8_STAGE(PG8_SB(0, 1), b2 + bh1, voffB);
            PG8_WAIT_V(6); PG8_BAR; PG8_MMA(1, 1, At, B1); PG8_BAR;
            PG8_LDB(B0, 1, 0); PG8_SCHED; PG8_LDA(At, 1, 0); PG8_STAGE(PG8_SA(0, 1), a2 + hstep, voffA);
            PG8_WAIT_L(8); PG8_BAR; PG8_WAIT_L(0); PG8_MMA(0, 0, At, B0); PG8_BAR; PG8_SCHED;
            PG8_LDB(B1, 1, 1); PG8_STAGE(PG8_SB(1, 0), b3, voffB);
            PG8_BAR; PG8_WAIT_L(0); PG8_MMA(0, 1, At, B1); PG8_BAR;
            PG8_LDA(At, 1, 1); PG8_STAGE(PG8_SA(1, 0), a3, voffA);
            PG8_BAR; PG8_WAIT_L(0); PG8_MMA(1, 0, At, B0); PG8_BAR; PG8_SCHED;
            PG8_STAGE(PG8_SB(1, 1), b3 + bh1, voffB);
            PG8_WAIT_V(6); PG8_BAR; PG8_MMA(1, 1, At, B1); PG8_BAR;
            }
        }
        {
#pragma unroll
            for (int a_ = 0; a_ < 2; ++a_)
#pragma unroll
                for (int b_ = 0; b_ < 2; ++b_)
                    asm volatile("s_nop 15\n\ts_nop 15" : "+v"(acc[a_][b_][0][0]), "+v"(acc[a_][b_][0][1]), "+v"(acc[a_][b_][1][0]), "+v"(acc[a_][b_][1][1]), "+v"(acc[a_][b_][2][0]), "+v"(acc[a_][b_][2][1]), "+v"(acc[a_][b_][3][0]), "+v"(acc[a_][b_][3][1]));
        }
        if constexpr (ALIGN_EPI) { if (wr == 0) PG8_BAR; }
        if constexpr (!Epi::AFTER_DRAIN) { if constexpr (PRE) E(acc, cur, wr, wc, fr, fq, lds + PRE_OFF + (ui & 1) * PRE_SLOT); else E(acc, cur, wr, wc, fr, fq); S.done(cur); }
        if (!has_next) break;
#pragma unroll
        for (int a = 0; a < 2; ++a)
#pragma unroll
            for (int b = 0; b < 2; ++b)
#pragma unroll
                for (int m = 0; m < 4; ++m)
#pragma unroll
                    for (int n = 0; n < 2; ++n) acc[a][b][m][n] = (f32x4){0.f, 0.f, 0.f, 0.f};
        cur = nxt; cA = nA; cB = nB; ++ui;
        if constexpr (ALIGN_EPI) { if (wr == 1) PG8_BAR; }
    }
    PG8_WAIT_V(0);
    if constexpr (!ALIGN_EPI) { if (wr == 0) PG8_BAR; }
    PG8_BAR;
    if constexpr (Epi::AFTER_DRAIN) { E.fused(acc, cur, wr, wc, fr, fq, lds, wid, lane); S.done(cur); }
#undef PG8_KP
#undef PG8_STA
#undef PG8_SA
#undef PG8_SB
#undef PG8_STAGE
#undef PG8_LD8
#undef PG8_LDA
#undef PG8_LDB
#undef PG8_MMA
#undef PG8_WAIT_V
#undef PG8_WAIT_L
#undef PG8_BAR
#undef PG8_SCHED
}
}


constexpr int NB = 4, SEQ = 4096, T = NB * SEQ, D = 2048;
constexpr int RW = 1024, NH = 16, HD = 64;
constexpr int IN_W = 12064, SHIFT_W = 3360;
constexpr int ZPW = 3584, QKVW = 4608, GATEW = 4096, NPROJ = 12288;
constexpr int NE = 32, FF = 2048;
constexpr int XS_ROWS = T * 4 + NE * 256;
constexpr int NWAVES = 8, NTHREADS = 512;
constexpr float NORM_EPS = 1e-5f, GN_EPS = 64e-5f;
constexpr float QSCALE = 0.08838834764831845f * 1.4426950408889634f;

#ifndef MK_ONE_LAUNCH
#define MK_ONE_LAUNCH 1
#endif
constexpr int NPHASES = 14;

constexpr size_t MiB = 1ull << 20;
constexpr size_t WS_CTL = 0, CTL_ZERO_BYTES = 1 * MiB;
constexpr size_t WS_WIN = 1 * MiB;
constexpr size_t WS_W1 = WS_WIN + 48 * MiB;
constexpr size_t WS_W2 = WS_W1 + 512 * MiB;
constexpr size_t WS_WOR = WS_W2 + 256 * MiB;
constexpr size_t WS_WOA = WS_WOR + 4 * MiB;
constexpr size_t WS_WOUT = WS_WOA + 2 * MiB;
constexpr size_t WS_H = WS_WOUT + 8 * MiB;
constexpr size_t WS_ZP = WS_H + 64 * MiB;
constexpr size_t WS_QKV = WS_ZP + 112 * MiB;
constexpr size_t WS_GATES = WS_QKV + 144 * MiB;
constexpr size_t WS_ROT = WS_GATES + 128 * MiB;
constexpr size_t WS_SC = WS_ROT + 2 * MiB;
constexpr size_t WS_G = WS_SC + 384 * MiB;
constexpr size_t WS_BONUS = WS_G + 32 * MiB;
constexpr size_t WS_Y = WS_BONUS + 1 * MiB;
constexpr size_t WS_ATTO = WS_Y + 64 * MiB;
constexpr size_t WS_ATTML = WS_ATTO + 48 * MiB;
constexpr size_t WS_YAIN = WS_ATTML + 2 * MiB;
constexpr size_t WS_OIN = WS_YAIN + 32 * MiB;
constexpr size_t WS_MERGED = WS_OIN + 16 * MiB;
constexpr size_t WS_X1 = WS_MERGED + 64 * MiB;
constexpr size_t WS_TOPK = WS_X1 + 128 * MiB;
constexpr size_t WS_ROWS = WS_TOPK + 1 * MiB;
constexpr size_t WS_XS = WS_ROWS + 1 * MiB;
constexpr size_t WS_ACT = WS_XS + 288 * MiB;
constexpr size_t WS_OUTK = WS_ACT + 288 * MiB;
constexpr size_t WS_LORA = WS_OUTK + 256 * MiB;
constexpr size_t WS_H8 = WS_LORA + 1 * MiB;
constexpr size_t WS_WG8 = WS_H8 + 32 * MiB;
constexpr size_t WS_MERGED8 = WS_WG8 + 16 * MiB;
constexpr size_t WS_ROWS2 = WS_MERGED8 + 32 * MiB;
constexpr size_t WS_WG8B = WS_ROWS2 + 4 * MiB;
constexpr size_t WS_END = WS_WG8B + 20 * MiB;
constexpr size_t WS_S1 = WS_XS;
constexpr int NU16 = NB * NH * (SEQ / 16);
constexpr size_t S1_WH = 0, S1_QH = 32 * MiB, S1_BT = 64 * MiB, S1_KT = 96 * MiB, S1_VT = 128 * MiB, S1_U0T = 160 * MiB, S1_Y0T = 224 * MiB, S1_GAM = 288 * MiB;
constexpr size_t SC_STRIDE = (size_t)T * RW;
enum { SH_KK = 0, SH_BB = 1, SH_K = 2, SH_R = 3, SH_V = 4 };

constexpr int CW_TMO = 0, CW_CODE = 1, CW_BAR = 4096, CW_CNT = 8192;

constexpr int RING_BYTES = 131072;
constexpr int TAB_OFF = 147456;
constexpr int MISC_OFF = TAB_OFF + 512;
constexpr int LDS_BYTES = 151552;

#define GAS __attribute__((address_space(1)))
#define LAS __attribute__((address_space(3)))
typedef unsigned short bf16;
typedef unsigned u32x4 __attribute__((ext_vector_type(4)));
typedef unsigned u32x2 __attribute__((ext_vector_type(2)));
typedef float f32x2 __attribute__((ext_vector_type(2)));
typedef float f32x4 __attribute__((ext_vector_type(4)));
typedef short bf16x8 __attribute__((ext_vector_type(8)));
typedef short bf16x4 __attribute__((ext_vector_type(4)));
typedef GAS unsigned gu32;
#define RLX_AGENT __ATOMIC_RELAXED, __HIP_MEMORY_SCOPE_AGENT
#define LDS_WAIT() asm volatile("s_waitcnt lgkmcnt(0)" ::: "memory")
#define VM_WAIT() asm volatile("s_waitcnt vmcnt(0)" ::: "memory")
__device__ __forceinline__ unsigned f2bf(float f) { unsigned u = __builtin_bit_cast(unsigned, f); return (u + 0x7fffu + ((u >> 16) & 1u)) >> 16; }
__device__ __forceinline__ unsigned pk2(float lo, float hi) { return f2bf(lo) | (f2bf(hi) << 16); }
__device__ __forceinline__ unsigned pk2h(float lo, float hi) { unsigned r; asm("s_nop 1\n\tv_cvt_pk_bf16_f32 %0, %1, %2" : "=v"(r) : "v"(lo), "v"(hi)); return r; }
__device__ __forceinline__ u32x4 pack8h(const f32x4& a, const f32x4& b) { u32x4 w; w.x = pk2h(a[0], a[1]); w.y = pk2h(a[2], a[3]); w.z = pk2h(b[0], b[1]); w.w = pk2h(b[2], b[3]); return w; }
__device__ __forceinline__ float bflo(unsigned w) { return __uint_as_float(w << 16); }
__device__ __forceinline__ float bfhi(unsigned w) { return __uint_as_float(w & 0xffff0000u); }
__device__ __forceinline__ float bf2f(bf16 h) { return __uint_as_float((unsigned)h << 16); }
__device__ __forceinline__ float sigmoidf_(float x) { return __builtin_amdgcn_rcpf(1.0f + __builtin_amdgcn_exp2f(-1.4426950408889634f * x)); }
__device__ __forceinline__ float tanhf_(float x) { return 1.0f - 2.0f * __builtin_amdgcn_rcpf(1.0f + __builtin_amdgcn_exp2f(2.8853900817779268f * x)); }
__device__ __forceinline__ unsigned pk2v(float lo, float hi) { unsigned r; asm("s_nop 1\n\tv_cvt_pk_bf16_f32 %0, %1, %2" : "=v"(r) : "v"(lo), "v"(hi)); return r; }
__device__ __forceinline__ float wave_sum(float v) {
#pragma unroll
    for (int o = 1; o < 64; o <<= 1) v += __shfl_xor(v, o);
    return v;
}
__device__ __forceinline__ unsigned pk4_fp8(float a, float b, float c, float d) { int r = __builtin_amdgcn_cvt_pk_fp8_f32(a, b, 0, false); r = __builtin_amdgcn_cvt_pk_fp8_f32(c, d, r, true); return (unsigned)r; }
__device__ __forceinline__ u32x4 pack8(const f32x4& a, const f32x4& b) { u32x4 w; w.x = pk2(a[0], a[1]); w.y = pk2(a[2], a[3]); w.z = pk2(b[0], b[1]); w.w = pk2(b[2], b[3]); return w; }
__device__ __forceinline__ void unpack8(const u32x4& w, f32x4& a, f32x4& b) { a = (f32x4){bflo(w.x), bfhi(w.x), bflo(w.y), bfhi(w.y)}; b = (f32x4){bflo(w.z), bfhi(w.z), bflo(w.w), bfhi(w.w)}; }

#define XB_TMO      128
#define XB_XCNT(j)  (256  + 64 * (j))
#define XB_XSUB(j)  (1280 + 64 * (j))
#define XB_XGEN(j)  (2304 + 64 * (j))
#define XB_TOP      3328
#define XB_TOPGEN   3392
#define XCD_BAR_WORDS 3456
#define XB_SPIN_CAP (1u << 18)

__device__ __forceinline__ unsigned xb_ld(unsigned* p)              { return __hip_atomic_load(p, __ATOMIC_RELAXED, __HIP_MEMORY_SCOPE_AGENT); }
__device__ __forceinline__ unsigned xb_add(unsigned* p, unsigned v) { return __hip_atomic_fetch_add(p, v, __ATOMIC_RELAXED, __HIP_MEMORY_SCOPE_AGENT); }
__device__ __forceinline__ unsigned xb_xcc_id() { return (unsigned)__builtin_amdgcn_s_getreg((3 << 11) | 20) & 0xFu; }
#define XB_SPIN(cond, bar) do { unsigned _sp = 0; while (cond) { __builtin_amdgcn_s_sleep(1); \
    if ((++_sp & 255u) == 0u) { if (xb_ld(&(bar)[XB_TMO])) break; if (_sp > XB_SPIN_CAP) { atomicAdd(&(bar)[XB_TMO], 1u); break; } } } } while (0)

struct XcdBarrier {
    unsigned* bar; unsigned x;
    volatile LAS unsigned* st;
};

__device__ __forceinline__ XcdBarrier xcd_barrier_post(unsigned* bar, volatile LAS unsigned* st) {
    XcdBarrier b; b.bar = bar; b.x = xb_xcc_id(); b.st = st;
    if (threadIdx.x == 0) (void)xb_add(&bar[XB_XCNT(b.x)], 1u);
    return b;
}
__device__ __forceinline__ void xcd_barrier_complete(unsigned* bar, unsigned x, unsigned& nloc, unsigned& nx) {
    const unsigned G = gridDim.x * gridDim.y * gridDim.z;
    unsigned sum, cnt, mine, sp = 0u;
    for (;;) {
        sum = 0u; cnt = 0u; mine = 0u;
#pragma unroll
        for (unsigned j = 0; j < 16; ++j) { const unsigned c = xb_ld(&bar[XB_XCNT(j)]); sum += c; cnt += (c > 0u) ? 1u : 0u; mine = (j == x) ? c : mine; }
        if (sum == G) break;
        __builtin_amdgcn_s_sleep(1);
        if ((++sp & 255u) == 0u) { if (xb_ld(&bar[XB_TMO])) break; if (sp > XB_SPIN_CAP) { atomicAdd(&bar[XB_TMO], 1u); break; } }
    }
    nloc = mine > 0u ? mine : 1u; nx = cnt > 0u ? cnt : 1u;
}

__device__ __forceinline__ void xcd_barrier(const XcdBarrier& b) {
    asm volatile("s_waitcnt vmcnt(0)" ::: "memory");
    __syncthreads();
    if (threadIdx.x == 0) {
        unsigned* bar = b.bar;
        __builtin_amdgcn_s_waitcnt(0);
        unsigned nloc = b.st[0], nx = b.st[1];
        if (nloc == 0u) { xcd_barrier_complete(bar, b.x, nloc, nx); b.st[0] = nloc; b.st[1] = nx; }
        const unsigned old = xb_add(&bar[XB_XSUB(b.x)], 1u);
        const unsigned gen = old / nloc;
        if (old + 1u == (gen + 1u) * nloc) {
            __builtin_amdgcn_fence(__ATOMIC_RELEASE, "agent");
            asm volatile("s_waitcnt vmcnt(0)" ::: "memory");
            const unsigned og = xb_add(&bar[XB_TOP], 1u);
            const unsigned tg = og / nx;
            if (og + 1u == (tg + 1u) * nx) xb_add(&bar[XB_TOPGEN], 1u);
            else XB_SPIN(xb_ld(&bar[XB_TOPGEN]) == tg, bar);
            __builtin_amdgcn_fence(__ATOMIC_ACQUIRE, "agent");
            xb_add(&bar[XB_XGEN(b.x)], 1u);
            asm volatile("s_waitcnt vmcnt(0)" ::: "memory");
        } else {
            XB_SPIN(xb_ld(&bar[XB_XGEN(b.x)]) == gen, bar);
            __builtin_amdgcn_fence(__ATOMIC_ACQUIRE, "agent");
            asm volatile("s_waitcnt vmcnt(0)" ::: "memory");
        }
    }
    __syncthreads();
}


struct Ptrs {
    const float *x, *norm_mix, *w_in, *shift_mu, *w0, *w2_decay, *a0, *a2_iclr, *g2_gate, *k_k, *k_a, *r_k, *ln_x_w, *ln_x_b, *w_o_rwkv, *w_o_attn, *w_out, *norm_ffn, *w_router, *b_router, *w1, *b1, *w2, *b2, *norm_final;
    const int* positions;
    float* out;
    bf16 *LW, *LA, *LG, *WRH, *WRL, *WIN, *W1, *W2, *WOR, *WOA, *WOUT, *H, *ZP, *QKV, *GATES, *G, *ATTO, *YAIN, *OIN, *MERGED, *XS, *ACT, *OUTK;
    bf16* SCH;
    float *ROT, *SC, *BONUS, *Y, *ATTML, *TOPK_GATE, *ROWGATE, *RG2; bf16* X1; int* RT2;
    int *TOPK_E, *TOPK_POS, *ROWTOK;
    gu32* ctl;
};

using pg8::Unit;
__device__ __forceinline__ void swap32(unsigned& a, unsigned& b) { const auto r = __builtin_amdgcn_permlane32_swap(a, b, false, false); a = r[0]; b = r[1]; }
__device__ __forceinline__ void store8(bf16* p, const f32x4& a, const f32x4& b) { *(u32x4*)p = pack8h(a, b); }

struct EpiProj {
    static constexpr bool PERM = true, AFTER_DRAIN = false, PERM2 = false;
    bf16* ZP; bf16* QKV; bf16* GATES; const float* ROT; int dry; int pn_off; float descale;
    __device__ __forceinline__ void operator()(const f32x4 (&accq)[2][2][4][2], const Unit& u, int wr, int wc, int fr, int fq) const {
        if (dry == 1) return;
        f32x4 acc[2][2][4][2];
#pragma unroll
        for (int a_ = 0; a_ < 2; ++a_)
#pragma unroll
            for (int b_ = 0; b_ < 2; ++b_)
#pragma unroll
                for (int m_ = 0; m_ < 4; ++m_)
#pragma unroll
                    for (int n_ = 0; n_ < 2; ++n_) acc[a_][b_][m_][n_] = accq[a_][b_][m_][n_] * descale;
        const int pn = u.pn + pn_off, rbase = u.pm * 256 + wr * 64 + fr, cw = wc * 64 + 8 * fq;
        if (pn < 14) {
#pragma unroll
            for (int ai = 0; ai < 2; ++ai)
#pragma unroll
                for (int m = 0; m < 4; ++m) { bf16* rp = ZP + (size_t)(rbase + ai * 128 + m * 16) * ZPW + pn * 256 + cw;
#pragma unroll
                    for (int bj = 0; bj < 2; ++bj) if ((dry != 3 || bj == 0) && (dry != 4 || (bj == 0 && ai == 0 && m == 0))) store8(rp + bj * 32, acc[ai][bj][m][0], acc[ai][bj][m][1]); }
        } else if (pn < 32) {
            const int t = pn - 14; const bool rotw = (t < 12) && ((wc & 1) == 0);   const float sc = (t < 6) ? QSCALE : 1.0f; const float sg = (fq < 2) ? -1.0f : 1.0f;
#pragma unroll
            for (int ai = 0; ai < 2; ++ai)
#pragma unroll
                for (int m = 0; m < 4; ++m) { const int row = rbase + ai * 128 + m * 16; bf16* rp = QKV + (size_t)row * QKVW + t * 256 + cw;
                    f32x4 c0 = {1.f, 1.f, 1.f, 1.f}, c1 = c0, s0 = {0.f, 0.f, 0.f, 0.f}, s1 = s0;
                    if (rotw) { const float* rt = ROT + (size_t)row * 32 + 8 * (fq & 1); c0 = *(const f32x4*)rt; c1 = *(const f32x4*)(rt + 4); s0 = *(const f32x4*)(rt + 16); s1 = *(const f32x4*)(rt + 20); }
#pragma unroll
                    for (int bj = 0; bj < 2; ++bj) { f32x4 v0 = acc[ai][bj][m][0], v1 = acc[ai][bj][m][1];
                        if (rotw && bj == 0) { f32x4 p0, p1;
#pragma unroll
                            for (int j = 0; j < 4; ++j) { p0[j] = __shfl_xor(v0[j], 32); p1[j] = __shfl_xor(v1[j], 32); }
                            v0 = v0 * c0 + (p0 * s0) * sg; v1 = v1 * c1 + (p1 * s1) * sg; }
                        v0 = v0 * sc; v1 = v1 * sc; store8(rp + bj * 32, v0, v1); } }
        } else {
            const int t = pn - 32;
#pragma unroll
            for (int ai = 0; ai < 2; ++ai)
#pragma unroll
                for (int m = 0; m < 4; ++m) { unsigned char* rp = (unsigned char*)GATES + (size_t)(rbase + ai * 128 + m * 16) * GATEW + t * 256 + cw;
#pragma unroll
                    for (int bj = 0; bj < 2; ++bj) { f32x4 v0 = acc[ai][bj][m][0], v1 = acc[ai][bj][m][1]; unsigned q0[4], q1[4];
#pragma unroll
                        for (int j = 0; j < 4; ++j) { q0[j] = (unsigned)(sigmoidf_(v0[j]) * 255.0f + 0.5f); q1[j] = (unsigned)(sigmoidf_(v1[j]) * 255.0f + 0.5f); }
                        u32x2 w; w.x = q0[0] | (q0[1] << 8) | (q0[2] << 16) | (q0[3] << 24); w.y = q1[0] | (q1[1] << 8) | (q1[2] << 16) | (q1[3] << 24);
                        *(u32x2*)(rp + bj * 32) = w; } }
        }
    }
};

template <int STAGE> struct EpiMerge {
    static constexpr bool PERM = true, AFTER_DRAIN = false, PERM2 = false;
    bf16* MERGED; const bf16* GATES; unsigned char* M8;
    __device__ __forceinline__ void operator()(const f32x4 (&acc)[2][2][4][2], const Unit& u, int wr, int wc, int fr, int fq) const {
        const int rbase = u.pm * 256 + wr * 64 + fr, cb = u.pn * 256 + wc * 64 + 8 * fq;
#pragma unroll
        for (int ai = 0; ai < 2; ++ai)
#pragma unroll
            for (int m = 0; m < 4; ++m) { const int row = rbase + ai * 128 + m * 16;
#pragma unroll
                for (int bj = 0; bj < 2; ++bj) { const int col = cb + bj * 32;
                    const u32x2 gw = *(const u32x2*)((const unsigned char*)GATES + (size_t)row * GATEW + STAGE * 2048 + col);
                    const f32x4 g0 = (f32x4){(float)(gw.x & 255u), (float)((gw.x >> 8) & 255u), (float)((gw.x >> 16) & 255u), (float)(gw.x >> 24)} * (1.0f / 255.0f);
                    const f32x4 g1 = (f32x4){(float)(gw.y & 255u), (float)((gw.y >> 8) & 255u), (float)((gw.y >> 16) & 255u), (float)(gw.y >> 24)} * (1.0f / 255.0f);
                    f32x4 v0 = acc[ai][bj][m][0] * g0, v1 = acc[ai][bj][m][1] * g1; bf16* dp = MERGED + (size_t)row * D + col;
                    if (STAGE == 1) { const u32x4 tw = *(const u32x4*)dp; f32x4 t0, t1; unpack8(tw, t0, t1); v0 = v0 + t0; v1 = v1 + t1; }
                    if (STAGE == 1) { u32x2 w8; w8.x = pk4_fp8(v0[0] * 16.0f, v0[1] * 16.0f, v0[2] * 16.0f, v0[3] * 16.0f); w8.y = pk4_fp8(v1[0] * 16.0f, v1[1] * 16.0f, v1[2] * 16.0f, v1[3] * 16.0f); *(u32x2*)(M8 + (size_t)row * D + col) = w8; }
                    else store8(dp, v0, v1); } }
    }
};

struct EpiMerge2 {
    static constexpr bool PERM = true, AFTER_DRAIN = false, PERM2 = true; static constexpr int MID_T = 16;
    const bf16* GATES; unsigned char* M8;
    __device__ __forceinline__ void gates8(const unsigned char* gp, f32x4& a, f32x4& b) const { const u32x2 w = *(const u32x2*)gp;
        a = (f32x4){(float)(w.x & 255u), (float)((w.x >> 8) & 255u), (float)((w.x >> 16) & 255u), (float)(w.x >> 24)}; b = (f32x4){(float)(w.y & 255u), (float)((w.y >> 8) & 255u), (float)((w.y >> 16) & 255u), (float)(w.y >> 24)}; }
    __device__ __forceinline__ void mid(f32x4 (&acc)[2][2][4][2], const Unit& u, int wr, int wc, int fr, int fq) const {
        int rbase = u.pm * 256 + wr * 64 + fr, cb = u.pn * 256 + wc * 64 + 8 * (((fq & 1) << 1) | (fq >> 1)); asm volatile("" : "+v"(rbase), "+v"(cb));
#pragma unroll
        for (int ai = 0; ai < 2; ++ai)
#pragma unroll
            for (int m = 0; m < 4; ++m) { const int row = rbase + ai * 128 + m * 16;
#pragma unroll
                for (int bj = 0; bj < 2; ++bj) { const unsigned char* gp = (const unsigned char*)GATES + (size_t)row * GATEW + cb + bj * 32;
                    f32x4 r0, r1, a0, a1; gates8(gp, r0, r1); gates8(gp + 2048, a0, a1);
#pragma unroll
                    for (int j = 0; j < 4; ++j) { acc[ai][bj][m][0][j] *= r0[j] * __builtin_amdgcn_rcpf(fmaxf(a0[j], 1.0f)); acc[ai][bj][m][1][j] *= r1[j] * __builtin_amdgcn_rcpf(fmaxf(a1[j], 1.0f)); }
                    __builtin_amdgcn_sched_barrier(0); } }
    }
    __device__ __forceinline__ void operator()(const f32x4 (&acc)[2][2][4][2], const Unit& u, int wr, int wc, int fr, int fq) const {
        const int fqs = ((fq & 1) << 1) | (fq >> 1), up = fq >> 1;
        const int rbase = u.pm * 256 + wr * 64 + fr, cb = u.pn * 256 + wc * 64 + 8 * fqs, scol = u.pn * 256 + wc * 64 + (up ? 32 + 8 * (fqs - 1) : 8 * fqs);
#pragma unroll
        for (int ai = 0; ai < 2; ++ai)
#pragma unroll
            for (int m = 0; m < 4; ++m) { const int row = rbase + ai * 128 + m * 16; unsigned wx[2], wy[2];
#pragma unroll
                for (int bj = 0; bj < 2; ++bj) { const int col = cb + bj * 32; f32x4 a0, a1; gates8((const unsigned char*)GATES + (size_t)row * GATEW + 2048 + col, a0, a1);
                    f32x4 v0, v1;
#pragma unroll
                    for (int j = 0; j < 4; ++j) { v0[j] = acc[ai][bj][m][0][j] * (fmaxf(a0[j], 1.0f) * (16.0f / 255.0f)); v1[j] = acc[ai][bj][m][1][j] * (fmaxf(a1[j], 1.0f) * (16.0f / 255.0f)); }
                    wx[bj] = pk4_fp8(v0[0], v0[1], v0[2], v0[3]); wy[bj] = pk4_fp8(v1[0], v1[1], v1[2], v1[3]); }
                swap32(wx[0], wx[1]); swap32(wy[0], wy[1]);
                *(u32x4*)(M8 + (size_t)row * D + scol) = (u32x4){wx[0], wy[0], wx[1], wy[1]}; }
    }
};

struct EpiResid {
    static constexpr bool PERM = true, AFTER_DRAIN = false, PERM2 = false;
    const float* X; bf16* X1; float descale;
    __device__ __forceinline__ void operator()(const f32x4 (&acc)[2][2][4][2], const Unit& u, int wr, int wc, int fr, int fq) const {
        const int rbase = u.pm * 256 + wr * 64 + fr, cb = u.pn * 256 + wc * 64 + 8 * fq;
#pragma unroll
        for (int ai = 0; ai < 2; ++ai)
#pragma unroll
            for (int m = 0; m < 4; ++m) { const size_t ro = (size_t)(rbase + ai * 128 + m * 16) * D;
#pragma unroll
                for (int bj = 0; bj < 2; ++bj) { const int col = cb + bj * 32;
                    const f32x4 v0 = *(const f32x4*)(X + ro + col) + acc[ai][bj][m][0] * descale, v1 = *(const f32x4*)(X + ro + col + 4) + acc[ai][bj][m][1] * descale;
                    store8(X1 + ro + col, v0, v1); } }
    }
};

struct EpiMoe1 {
    static constexpr bool PERM = true, AFTER_DRAIN = false, PERM2 = true;
    bf16* ACT; const float* b1; int dry; const int* RT2; const LAS int* tab;
    __device__ __forceinline__ void arows(const Unit& u, int& sbase, int& nvalid) const { const int e = u.pn >> 4, pml = u.pm - tab[e]; sbase = e * 16384 + pml * 256; nvalid = tab[64 + e] - pml * 256; }
    __device__ __forceinline__ int npre(int wid) const { return wid < 4 ? 2 : 0; }
    __device__ __forceinline__ void prefetch(const Unit& u, LAS unsigned char* slot, int wid, int lane) const {
        if (wid < 4) { const int e = u.pn >> 4, pnl = u.pn & 15, i = wid * 64 + lane;
            __builtin_amdgcn_global_load_lds((const unsigned*)(b1 + (size_t)e * 4096 + (i >> 7) * 2048 + pnl * 128 + (i & 127)), (LAS unsigned*)(slot + wid * 256), 4, 0, 0); }
    }
    __device__ __forceinline__ void operator()(const f32x4 (&acc)[2][2][4][2], const Unit& u, int wr, int wc, int fr, int fq, const LAS unsigned char* slot) const {
        if (dry) return;
        const int fqs = ((fq & 1) << 1) | (fq >> 1), up = fq >> 1;
        const int pnl = u.pn & 15, rbase = u.pm * 256 + wr * 64 + fr, scol = pnl * 128 + wc * 32 + 8 * (fqs & 2);
        const LAS float* bg = (const LAS float*)slot + wc * 32 + 8 * fqs; const LAS float* bl = bg + 128;
        const f32x4 bg0 = *(const LAS f32x4*)bg, bg1 = *(const LAS f32x4*)(bg + 4), bl0 = *(const LAS f32x4*)bl, bl1 = *(const LAS f32x4*)(bl + 4);
        const f32x2 S1 = {0.03125f, 0.03125f}, S8 = {0.25f, 0.25f}, CE = {-2.4554669595930156f, -2.4554669595930156f}, ONE = {1.0f, 1.0f};
        f32x2 bgp[4], blp[4];
        bgp[0] = (f32x2){bg0[0], bg0[1]}; bgp[1] = (f32x2){bg0[2], bg0[3]}; bgp[2] = (f32x2){bg1[0], bg1[1]}; bgp[3] = (f32x2){bg1[2], bg1[3]};
        blp[0] = (f32x2){bl0[0], bl0[1]} * 8.0f + 8.0f; blp[1] = (f32x2){bl0[2], bl0[3]} * 8.0f + 8.0f; blp[2] = (f32x2){bl1[0], bl1[1]} * 8.0f + 8.0f; blp[3] = (f32x2){bl1[2], bl1[3]} * 8.0f + 8.0f;
#pragma unroll
        for (int ai = 0; ai < 2; ++ai)
#pragma unroll
          for (int mp = 0; mp < 2; ++mp) { unsigned wx[2], wy[2];
#pragma unroll
            for (int mm = 0; mm < 2; ++mm) { const int m = 2 * mp + mm;
                f32x2 o[4];
#pragma unroll
                for (int q = 0; q < 4; ++q) { const f32x4 ag = acc[ai][0][m][q >> 1], al = acc[ai][1][m][q >> 1];
                    const f32x2 agp = (q & 1) ? (f32x2){ag[2], ag[3]} : (f32x2){ag[0], ag[1]}, alp = (q & 1) ? (f32x2){al[2], al[3]} : (f32x2){al[0], al[1]};
                    const f32x2 G = __builtin_elementwise_fma(agp, S1, bgp[q]), L = __builtin_elementwise_fma(alp, S8, blp[q]);
                    const f32x2 xg = {fminf(G[0], 7.0f), fminf(G[1], 7.0f)};
                    const f32x2 xl = {fminf(fmaxf(L[0], -48.0f), 64.0f), fminf(fmaxf(L[1], -48.0f), 64.0f)};
                    const f32x2 ea = xg * CE;
                    const f32x2 en = (f32x2){__builtin_amdgcn_exp2f(ea[0]), __builtin_amdgcn_exp2f(ea[1])} + ONE;
                    const f32x2 rc = {__builtin_amdgcn_rcpf(en[0]), __builtin_amdgcn_rcpf(en[1])};
                    o[q] = (xg * rc) * xl; }
                wx[mm] = pk4_fp8(o[0][0], o[0][1], o[1][0], o[1][1]); wy[mm] = pk4_fp8(o[2][0], o[2][1], o[3][0], o[3][1]); }
            swap32(wx[0], wx[1]); swap32(wy[0], wy[1]);
            const int row = rbase + ai * 128 + (2 * mp + up) * 16;
            *(u32x4*)((unsigned char*)ACT + (size_t)row * FF + scol) = (u32x4){wx[0], wy[0], wx[1], wy[1]}; }
    }
};

struct EpiMoe2 {
    static constexpr bool PERM = true, AFTER_DRAIN = false, PERM2 = true;
    bf16* OUTK; const float* b2; const int* ROWTOK; const float* ROWGATE; int dry; const LAS int* tab;
    __device__ __forceinline__ int npre(int wid) const { return wid < 4 ? 2 : 1; }
    __device__ __forceinline__ void prefetch(const Unit& u, LAS unsigned char* slot, int wid, int lane) const {
        const int e = u.pn >> 3, pnl = u.pn & 7, i = (wid & 3) * 64 + lane; const size_t sb = (size_t)e * 16384 + (size_t)(u.pm - tab[e]) * 256;
        if (wid < 4) { __builtin_amdgcn_global_load_lds((const unsigned*)(b2 + (size_t)e * D + pnl * 256 + i), (LAS unsigned*)(slot + wid * 256), 4, 0, 0);
                       __builtin_amdgcn_global_load_lds((const unsigned*)(ROWGATE + sb + i), (LAS unsigned*)(slot + 2048 + wid * 256), 4, 0, 0); }
        else __builtin_amdgcn_global_load_lds((const unsigned*)(ROWTOK + sb + i), (LAS unsigned*)(slot + 1024 + (wid & 3) * 256), 4, 0, 0);
    }
    __device__ __forceinline__ void operator()(const f32x4 (&acc)[2][2][4][2], const Unit& u, int wr, int wc, int fr, int fq, const LAS unsigned char* slot) const {
        if (dry) return;
        const int fqs = ((fq & 1) << 1) | (fq >> 1), up = fq >> 1;
        const int pnl = u.pn & 7, cbw = pnl * 256 + wc * 64, e_ = u.pn >> 3, nvalid = tab[64 + e_] - (u.pm - tab[e_]) * 256;
        f32x4 bv[2][2];
#pragma unroll
        for (int bj = 0; bj < 2; ++bj) { const LAS float* bp = (const LAS float*)slot + wc * 64 + 8 * fqs + bj * 32; bv[bj][0] = *(const LAS f32x4*)bp; bv[bj][1] = *(const LAS f32x4*)(bp + 4); }
        int pr[8]; float gr[8];
#pragma unroll
        for (int i = 0; i < 8; ++i) { const int rl = wr * 64 + fr + (i >> 2) * 128 + (i & 3) * 16; pr[i] = ((const LAS int*)(slot + 1024))[rl]; gr[i] = ((const LAS float*)(slot + 2048))[rl]; }
        const int scol = cbw + (up ? 32 + 8 * (fqs - 1) : 8 * fqs);
#pragma unroll
        for (int ai = 0; ai < 2; ++ai)
#pragma unroll
            for (int m = 0; m < 4; ++m) { const int p = pr[ai * 4 + m]; const float gt = gr[ai * 4 + m] * 32.0f;
                unsigned wx[2], wy[2];
#pragma unroll
                for (int bj = 0; bj < 2; ++bj) { const f32x4 v0 = (acc[ai][bj][m][0] * 0.00390625f + bv[bj][0]) * gt, v1 = (acc[ai][bj][m][1] * 0.00390625f + bv[bj][1]) * gt;
                    wx[bj] = pk4_fp8(v0[0], v0[1], v0[2], v0[3]); wy[bj] = pk4_fp8(v1[0], v1[1], v1[2], v1[3]); }
                swap32(wx[0], wx[1]); swap32(wy[0], wy[1]);
                if (wr * 64 + fr + ai * 128 + m * 16 < nvalid) *(u32x4*)((unsigned char*)OUTK + (size_t)p * D + scol) = (u32x4){wx[0], wy[0], wx[1], wy[1]}; }
    }
};

struct MoeOrder {
    const LAS int* toff; int npn, G, c;
    __device__ __forceinline__ bool next(int i, Unit& u) const {
        const int L0 = i * G + c, NT = toff[32], NU = NT * npn;
        if (L0 >= NU) return false;
        const int q8 = NU >> 3, r8 = NU & 7, xcd = L0 & 7, off = L0 >> 3;
        const int L = (xcd < r8 ? xcd * (q8 + 1) : r8 * (q8 + 1) + (xcd - r8) * q8) + off;
        const int lj = (int)(threadIdx.x & 31u) + 1;
        const unsigned long long bm = __ballot(lj < 32 && L >= toff[lj] * npn);
        const int e = __builtin_popcount((unsigned)(bm & 0xffffffffull));
        const int t0 = toff[e], te = toff[e + 1] - t0, rem = L - t0 * npn;
        const int pnl = rem / te, pml = rem - pnl * te;
        u.pm = __builtin_amdgcn_readfirstlane(t0 + pml); u.pn = __builtin_amdgcn_readfirstlane(e * npn + pnl); return true;
    }
    __device__ __forceinline__ void a_ready(const Unit&) const {}
    __device__ __forceinline__ void done(const Unit&) const {}
};

__device__ __forceinline__ void tr_item(const float* src, int ldn, int k0, int c0, bf16* dst, size_t dstrow0, int K, LAS float* scr, int lane) {
    f32x4 v[8];
#pragma unroll
    for (int i = 0; i < 8; ++i) v[i] = *(const GAS f32x4*)(src + (size_t)(k0 + 8 * i + (lane >> 3)) * ldn + c0 + 4 * (lane & 7));
#pragma unroll
    for (int i = 0; i < 8; ++i) { LAS float* p = scr + (8 * i + (lane >> 3)) * 33 + 4 * (lane & 7); p[0] = v[i].x; p[1] = v[i].y; p[2] = v[i].z; p[3] = v[i].w; }
    LDS_WAIT(); asm volatile("" ::: "memory");
    const int c = lane & 7;
#pragma unroll
    for (int j = 0; j < 4; ++j) { const int n = (lane >> 3) + 8 * j; const LAS float* s = scr + (8 * c) * 33 + n;
        u32x4 o; o.x = pk2(s[0 * 33], s[1 * 33]); o.y = pk2(s[2 * 33], s[3 * 33]); o.z = pk2(s[4 * 33], s[5 * 33]); o.w = pk2(s[6 * 33], s[7 * 33]);
        *(GAS u32x4*)(dst + (dstrow0 + n) * (size_t)K + k0 + 8 * c) = o; }
    LDS_WAIT(); asm volatile("" ::: "memory");
}
__device__ __forceinline__ void tr8_tile(const float* src, int ldn, int k0, int c0, unsigned char* dst, size_t dstrow0, int K, float sc, LAS float* scr, int lane) {
    f32x4 v[16];
#pragma unroll
    for (int i = 0; i < 16; ++i) v[i] = *(const GAS f32x4*)(src + (size_t)(k0 + 8 * i + (lane >> 3)) * ldn + c0 + 4 * (lane & 7));
#pragma unroll
    for (int i = 0; i < 16; ++i) { LAS float* p = scr + (8 * i + (lane >> 3)) * 33 + 4 * (lane & 7); p[0] = v[i].x * sc; p[1] = v[i].y * sc; p[2] = v[i].z * sc; p[3] = v[i].w * sc; }
    LDS_WAIT(); asm volatile("" ::: "memory");
    const int n = lane & 31;
#pragma unroll
    for (int j = 0; j < 4; ++j) { const int kc = (lane >> 5) + 2 * j; const LAS float* s = scr + (16 * kc) * 33 + n;
        u32x4 o; o.x = pk4_fp8(s[0 * 33], s[1 * 33], s[2 * 33], s[3 * 33]); o.y = pk4_fp8(s[4 * 33], s[5 * 33], s[6 * 33], s[7 * 33]);
        o.z = pk4_fp8(s[8 * 33], s[9 * 33], s[10 * 33], s[11 * 33]); o.w = pk4_fp8(s[12 * 33], s[13 * 33], s[14 * 33], s[15 * 33]);
        *(GAS u32x4*)(dst + (dstrow0 + n) * (size_t)K + k0 + 16 * kc) = o; }
    LDS_WAIT(); asm volatile("" ::: "memory");
}
__device__ __forceinline__ void tr_item8(const float* src, int ldn, int k0, int c0, unsigned char* dst, size_t dstrow0, int K, float sc, LAS float* scr, int lane) {
    f32x4 v[8];
#pragma unroll
    for (int i = 0; i < 8; ++i) v[i] = *(const GAS f32x4*)(src + (size_t)(k0 + 8 * i + (lane >> 3)) * ldn + c0 + 4 * (lane & 7));
#pragma unroll
    for (int i = 0; i < 8; ++i) { LAS float* p = scr + (8 * i + (lane >> 3)) * 33 + 4 * (lane & 7); p[0] = v[i].x * sc; p[1] = v[i].y * sc; p[2] = v[i].z * sc; p[3] = v[i].w * sc; }
    LDS_WAIT(); asm volatile("" ::: "memory");
    const int c = lane & 7;
#pragma unroll
    for (int j = 0; j < 4; ++j) { const int n = (lane >> 3) + 8 * j; const LAS float* s = scr + (8 * c) * 33 + n;
        u32x2 o; o.x = pk4_fp8(s[0 * 33], s[1 * 33], s[2 * 33], s[3 * 33]); o.y = pk4_fp8(s[4 * 33], s[5 * 33], s[6 * 33], s[7 * 33]);
        *(GAS u32x2*)(dst + (dstrow0 + n) * (size_t)K + k0 + 8 * c) = o; }
    LDS_WAIT(); asm volatile("" ::: "memory");
}
__device__ __forceinline__ void rms_row_to_bf16(const float* xrow, const float* g, bf16* orow, int lane) {
    f32x4 v[8]; float s = 0.f;
#pragma unroll
    for (int j = 0; j < 8; ++j) { v[j] = *(const GAS f32x4*)(xrow + 4 * lane + 256 * j); s += (v[j].x * v[j].x + v[j].y * v[j].y) + (v[j].z * v[j].z + v[j].w * v[j].w); }
    const float rs = 1.0f / sqrtf(wave_sum(s) * (1.0f / D) + NORM_EPS);
#pragma unroll
    for (int j = 0; j < 8; ++j) { const f32x4 gv = *(const GAS f32x4*)(g + 4 * lane + 256 * j); u32x2 w; w.x = pk2(v[j].x * rs * gv.x, v[j].y * rs * gv.y); w.y = pk2(v[j].z * rs * gv.z, v[j].w * rs * gv.w);
        *(GAS u32x2*)(orow + 4 * lane + 256 * j) = w; }
}
__device__ __forceinline__ void p0_prologue(const Ptrs& P, unsigned char* ws, LAS unsigned char* lds, int tid, int wave, int lane) {
    LAS float* scr = (LAS float*)(lds + wave * 8704);
    const int gw = blockIdx.x * NWAVES + wave, NGW = gridDim.x * NWAVES;
    constexpr int I_IN = 32 * 377, I_OR = 16 * 64, I_OA = 8 * 64, I_OUT = 32 * 64;
    constexpr int NITEMS = I_IN + I_OR + I_OA + I_OUT;
    for (int it = gw; it < NITEMS; it += NGW) {
        int r = it;
        if (r < I_IN) { const int kb = r / 377, nb = r % 377, c0 = 32 * nb;
            if (c0 >= 3072) tr_item8(P.w_in, IN_W, 64 * kb, c0, ws + WS_WG8B, (size_t)((c0 < SHIFT_W ? c0 : c0 + 224) - 3072), D, 32.0f, scr, lane);
            else tr_item(P.w_in, IN_W, 64 * kb, c0, P.WIN, (size_t)(c0 < SHIFT_W ? c0 : c0 + 224), D, scr, lane);
            continue; }
        r -= I_IN;
        if (r < I_OR) { const int kb = r >> 6, nb = r & 63; tr_item(P.w_o_rwkv, D, 64 * kb, 32 * nb, P.WOR, (size_t)32 * nb, 1536, scr, lane); continue; }
        r -= I_OR;
        if (r < I_OA) { const int kb = r >> 6, nb = r & 63; tr_item(P.w_o_attn, D, 64 * kb, 32 * nb, P.WOR + 1024, (size_t)32 * nb, 1536, scr, lane); continue; }
        r -= I_OA;
        { const int kb = r >> 6, nb = r & 63; tr_item8(P.w_out, D, 64 * kb, 32 * nb, (unsigned char*)P.WOUT, (size_t)32 * nb, D, 32.0f, scr, lane); }
    }
    { const int gt = blockIdx.x * NTHREADS + tid, NGT = gridDim.x * NTHREADS; GAS u32x4* z = (GAS u32x4*)(ws + WS_WG8B + (size_t)(SHIFT_W - 3072) * D);
      for (int i = gt; i < 224 * D / 16; i += NGT) z[i] = (u32x4){0u, 0u, 0u, 0u}; }
    { const int gt = blockIdx.x * NTHREADS + tid, NGT = gridDim.x * NTHREADS;
      for (int i = gt; i < 1024 * 64; i += NGT) { const int n = i >> 6, k = i & 63; P.LW[i] = (bf16)f2bf(P.w2_decay[k * RW + n]); P.LA[i] = (bf16)f2bf(P.a2_iclr[k * RW + n]); }
      for (int i = gt; i < 1024 * 160; i += NGT) { const int n = i / 160, k = i - n * 160; P.LG[i] = (bf16)f2bf(P.g2_gate[k * RW + n]); } }
    { const int gt = blockIdx.x * NTHREADS + tid, NGT = gridDim.x * NTHREADS;
      for (int i = gt; i < NE * D; i += NGT) { const int e = i >> 11, k = i & 2047; const float v = P.w_router[(size_t)k * NE + e] * P.norm_ffn[k]; const unsigned h = f2bf(v); P.WRH[i] = (bf16)h; P.WRL[i] = (bf16)f2bf(v - bf2f((bf16)h)); } }
    for (int m = gw; m < T; m += NGW) { const float* xrow = P.x + (size_t)m * D; f32x4 v[8]; float sq = 0.f;
#pragma unroll
        for (int j = 0; j < 8; ++j) { v[j] = *(const GAS f32x4*)(xrow + 4 * lane + 256 * j); sq += (v[j].x * v[j].x + v[j].y * v[j].y) + (v[j].z * v[j].z + v[j].w * v[j].w); }
        const float rs = 1.0f / sqrtf(wave_sum(sq) * (1.0f / D) + NORM_EPS); unsigned char* h8 = ws + WS_H8 + (size_t)m * D; bf16* hb = P.H + (size_t)m * D;
#pragma unroll
        for (int j = 0; j < 8; ++j) { const f32x4 gv = *(const GAS f32x4*)(P.norm_mix + 4 * lane + 256 * j); const float a0 = v[j].x * rs * gv.x, a1 = v[j].y * rs * gv.y, a2 = v[j].z * rs * gv.z, a3 = v[j].w * rs * gv.w;
            *(GAS unsigned*)(h8 + 4 * lane + 256 * j) = pk4_fp8(a0, a1, a2, a3); u32x2 w; w.x = pk2(a0, a1); w.y = pk2(a2, a3); *(GAS u32x2*)(hb + 4 * lane + 256 * j) = w; } }
    { const int gt = blockIdx.x * NTHREADS + tid, NGT = gridDim.x * NTHREADS;
      for (int i = gt; i < T * 16; i += NGT) { const int m = i >> 4, f = i & 15; const float inv = exp2f(-(float)f * (18.931568569324174f / 16.0f));
          const float ang = (float)P.positions[m] * inv; double rev = (double)ang * 0.15915494309189535; rev -= floor(rev); const float rv = (float)rev; const float sn = __builtin_amdgcn_sinf(rv), cs = __builtin_amdgcn_cosf(rv); P.ROT[(size_t)m * 32 + f] = cs; P.ROT[(size_t)m * 32 + 16 + f] = sn; } }
}

template <int CTRL> __device__ __forceinline__ float dppf(float x) { return __builtin_bit_cast(float, __builtin_amdgcn_mov_dpp(__builtin_bit_cast(int, x), CTRL, 0xf, 0xf, true)); }
__device__ __forceinline__ float sum8(float x) { x += dppf<0xB1>(x); x += dppf<0x4E>(x); x += dppf<0x141>(x); return x; }
__device__ __forceinline__ f32x4 mfma16(bf16x8 a, bf16x8 b, f32x4 c) { return __builtin_amdgcn_mfma_f32_16x16x32_bf16(a, b, c, 0, 0, 0); }
__device__ __forceinline__ u32x4 pack8s(const float* p) { u32x4 w; w.x = pk2(p[0], p[1]); w.y = pk2(p[2], p[3]); w.z = pk2(p[4], p[5]); w.w = pk2(p[6], p[7]); return w; }
__device__ __forceinline__ void p4a_chunk_prep(const Ptrs& P, unsigned char* ws, LAS unsigned char* lds, int tid, int wave, int lane, int u64) {
    LAS unsigned char* wl = lds + wave * 16384;
    LAS unsigned char* AH = wl, *BH = wl + 2048, *KH = wl + 4096, *RH = wl + 6144;
    LAS unsigned char* AT = wl + 8192, *RT = wl + 10240, *VTl = wl + 12288;
    LAS unsigned char* MX = wl + 14336;
    LAS unsigned char* WTl = wl, *U0Tl = wl + 2048, *PT = wl + 8192; LAS float* LmT = (LAS float*)(wl + 4096);
    const int fr = lane & 15, fq = lane >> 4, fq1 = fq & 1;
    unsigned char* s1 = ws + WS_S1;
    for (int jj = 0; jj < 8; ++jj) {
        const int j = wave * 8 + jj, h = j & 15, b = u64 >> 6, c16 = (u64 & 63) * 4 + (j >> 4), bh = b * 16 + h, uidx = (bh << 8) + c16;
        const size_t gbase = ((size_t)b * SEQ + (size_t)c16 * 16) * RW + h * 64 + lane;
        float av[16], bv[16], kv[16], rv[16], vv[16];
        {   float wv[16];
#pragma unroll
            for (int t = 0; t < 16; ++t) { const size_t o = gbase + (size_t)t * RW; wv[t] = P.SC[o]; av[t] = bf2f(P.SCH[SH_KK * SC_STRIDE + o]); bv[t] = bf2f(P.SCH[SH_BB * SC_STRIDE + o]);
                kv[t] = bf2f(P.SCH[SH_K * SC_STRIDE + o]); rv[t] = bf2f(P.SCH[SH_R * SC_STRIDE + o]); vv[t] = bf2f(P.SCH[SH_V * SC_STRIDE + o]); }
            float g = 1.0f;
#pragma unroll
            for (int t = 0; t < 16; ++t) { const float gp = g; g *= wv[t]; const float inv = 1.0f / g; av[t] *= gp; bv[t] *= inv; kv[t] *= inv; rv[t] *= g;
                *(LAS unsigned short*)(AH + t * 128 + lane * 2) = (unsigned short)f2bf(av[t]); *(LAS unsigned short*)(BH + t * 128 + lane * 2) = (unsigned short)f2bf(bv[t]);
                *(LAS unsigned short*)(KH + t * 128 + lane * 2) = (unsigned short)f2bf(kv[t]); *(LAS unsigned short*)(RH + t * 128 + lane * 2) = (unsigned short)f2bf(rv[t]); }
            *(LAS u32x4*)(AT + lane * 32) = pack8s(av); *(LAS u32x4*)(AT + lane * 32 + 16) = pack8s(av + 8);
            *(LAS u32x4*)(RT + lane * 32) = pack8s(rv); *(LAS u32x4*)(RT + lane * 32 + 16) = pack8s(rv + 8);
            const u32x4 v0 = pack8s(vv), v1 = pack8s(vv + 8);
            *(LAS u32x4*)(VTl + lane * 32) = v0; *(LAS u32x4*)(VTl + lane * 32 + 16) = v1;
            GAS u32x4* gv = (GAS u32x4*)(s1 + S1_VT + ((size_t)uidx * 64 + lane) * 32); gv[0] = v0; gv[1] = v1;
#pragma unroll
            for (int t = 0; t < 16; ++t) { bv[t] *= g; kv[t] *= g; }
            GAS u32x4* gb = (GAS u32x4*)(s1 + S1_BT + ((size_t)uidx * 64 + lane) * 32); gb[0] = pack8s(bv); gb[1] = pack8s(bv + 8);
            GAS u32x4* gk = (GAS u32x4*)(s1 + S1_KT + ((size_t)uidx * 64 + lane) * 32); gk[0] = pack8s(kv); gk[1] = pack8s(kv + 8);
            *(GAS float*)(s1 + S1_GAM + ((size_t)uidx * 64 + lane) * 4) = g; }
        LDS_WAIT(); asm volatile("" ::: "memory");
        f32x4 lab = {0.f, 0.f, 0.f, 0.f}, lak = lab, mrb = lab, mrk = lab;
#pragma unroll
        for (int ks = 0; ks < 2; ++ks) { const int off = fr * 128 + (32 * ks + 8 * fq) * 2;
            const bf16x8 a = *(const LAS bf16x8*)(AH + off), r_ = *(const LAS bf16x8*)(RH + off), b_ = *(const LAS bf16x8*)(BH + off), k_ = *(const LAS bf16x8*)(KH + off);
            lab = mfma16(a, b_, lab); lak = mfma16(a, k_, lak); mrb = mfma16(r_, b_, mrb); mrk = mfma16(r_, k_, mrk); }
#pragma unroll
        for (int rg = 0; rg < 4; ++rg) { const int t = 4 * fq + rg; const bool lo = fr < t, le = fr <= t; lab[rg] = lo ? lab[rg] : 0.f; lak[rg] = lo ? lak[rg] : 0.f; mrb[rg] = le ? mrb[rg] : 0.f; mrk[rg] = le ? mrk[rg] : 0.f; }
        asm volatile("" ::: "memory");
        *(LAS f32x4*)(LmT + fr * 16 + 4 * fq) = lab;
#pragma unroll
        for (int rg = 0; rg < 4; ++rg) { const int o = ((4 * fq + rg) * 16 + fr) * 2;
            *(LAS unsigned short*)(MX + o) = (unsigned short)f2bf(lak[rg]); *(LAS unsigned short*)(MX + 512 + o) = (unsigned short)f2bf(mrb[rg]); *(LAS unsigned short*)(MX + 1024 + o) = (unsigned short)f2bf(mrk[rg]); }
        LDS_WAIT(); asm volatile("" ::: "memory");
        float Tr[16];
#pragma unroll
        for (int m = 0; m < 16; ++m) Tr[m] = (m == fr) ? 1.0f : 0.0f;
#pragma unroll
        for (int j = 14; j >= 0; --j) { float acc = (j == fr) ? 1.0f : 0.0f;
#pragma unroll
            for (int q = 0; q < 4; ++q) { const f32x4 l4 = *(const LAS f32x4*)(LmT + j * 16 + 4 * q);
#pragma unroll
                for (int e = 0; e < 4; ++e) { const int m = 4 * q + e; if (m > j) acc += Tr[m] * l4[e]; } }
            Tr[j] = acc; }
        bf16x8 tfrag;
        { float sel[8];
#pragma unroll
          for (int j = 0; j < 8; ++j) sel[j] = (fq == 0) ? Tr[j] : ((fq == 1) ? Tr[8 + j] : 0.0f);
          tfrag = __builtin_bit_cast(bf16x8, pack8s(sel)); }
        f32x4 wacc[4];
#pragma unroll
        for (int nt = 0; nt < 4; ++nt) wacc[nt] = mfma16(tfrag, *(const LAS bf16x8*)(AT + (16 * nt + fr) * 32 + fq1 * 16), (f32x4){0.f, 0.f, 0.f, 0.f});
        asm volatile("" ::: "memory");
        { bf16* gwh = (bf16*)(s1 + S1_WH) + (size_t)uidx * 1024;
#pragma unroll
          for (int nt = 0; nt < 4; ++nt) { u32x2 w2; w2.x = pk2(wacc[nt][0], wacc[nt][1]); w2.y = pk2(wacc[nt][2], wacc[nt][3]); *(LAS u32x2*)(WTl + ((16 * nt + fr) * 16 + 4 * fq) * 2) = w2;
#pragma unroll
              for (int rg = 0; rg < 4; ++rg) gwh[(4 * fq + rg) * 64 + 16 * nt + fr] = (bf16)f2bf(wacc[nt][rg]); } }
        bf16x8 lkf, mbf, mkf, idf;
        { const u32x4 z4 = {0u, 0u, 0u, 0u};
          const u32x4 lk4 = *(const LAS u32x4*)(MX + (fr * 16 + 8 * fq1) * 2), mb4 = *(const LAS u32x4*)(MX + 512 + (fr * 16 + 8 * fq1) * 2), mk4 = *(const LAS u32x4*)(MX + 1024 + (fr * 16 + 8 * fq1) * 2);
          lkf = __builtin_bit_cast(bf16x8, (fq < 2) ? lk4 : z4);
          mbf = __builtin_bit_cast(bf16x8, mb4);
          mkf = __builtin_bit_cast(bf16x8, mk4);
          u32x4 id4; const int d = fr - 8 * fq1;
          id4.x = (d == 0 ? 0x3f80u : 0u) | (d == 1 ? 0x3f800000u : 0u); id4.y = (d == 2 ? 0x3f80u : 0u) | (d == 3 ? 0x3f800000u : 0u);
          id4.z = (d == 4 ? 0x3f80u : 0u) | (d == 5 ? 0x3f800000u : 0u); id4.w = (d == 6 ? 0x3f80u : 0u) | (d == 7 ? 0x3f800000u : 0u);
          idf = __builtin_bit_cast(bf16x8, id4); }
        LDS_WAIT(); asm volatile("" ::: "memory");
        f32x4 pacc[4];
#pragma unroll
        for (int nt = 0; nt < 4; ++nt) pacc[nt] = mfma16(lkf, *(const LAS bf16x8*)(VTl + (16 * nt + fr) * 32 + fq1 * 16), (f32x4){0.f, 0.f, 0.f, 0.f});
        asm volatile("" ::: "memory");
#pragma unroll
        for (int nt = 0; nt < 4; ++nt) { u32x2 w2; w2.x = pk2(pacc[nt][0], pacc[nt][1]); w2.y = pk2(pacc[nt][2], pacc[nt][3]); *(LAS u32x2*)(PT + ((16 * nt + fr) * 16 + 4 * fq) * 2) = w2; }
        LDS_WAIT(); asm volatile("" ::: "memory");
        f32x4 uacc[4];
#pragma unroll
        for (int nt = 0; nt < 4; ++nt) uacc[nt] = mfma16(tfrag, *(const LAS bf16x8*)(PT + (16 * nt + fr) * 32 + fq1 * 16), (f32x4){0.f, 0.f, 0.f, 0.f});
        asm volatile("" ::: "memory");
#pragma unroll
        for (int nt = 0; nt < 4; ++nt) { u32x2 w2; w2.x = pk2(uacc[nt][0], uacc[nt][1]); w2.y = pk2(uacc[nt][2], uacc[nt][3]); *(LAS u32x2*)(U0Tl + ((16 * nt + fr) * 16 + 4 * fq) * 2) = w2;
            { u32x2 w; w.x = pk2(uacc[nt][0], uacc[nt][1]); w.y = pk2(uacc[nt][2], uacc[nt][3]); *(GAS u32x2*)(s1 + S1_U0T + (((size_t)uidx * 64 + 16 * nt + fr) * 16 + 4 * fq) * 2) = w; } }
        LDS_WAIT(); asm volatile("" ::: "memory");
        { const bf16x8 aq = (fq < 2) ? mbf : idf, ay = (fq < 2) ? mbf : mkf;
          bf16* gqh = (bf16*)(s1 + S1_QH) + (size_t)uidx * 1024;
#pragma unroll
          for (int nt = 0; nt < 4; ++nt) { const int row = 16 * nt + fr;
              const bf16x8 bq = *(const LAS bf16x8*)(((fq < 2) ? WTl : RT) + row * 32 + fq1 * 16), by = *(const LAS bf16x8*)(((fq < 2) ? U0Tl : VTl) + row * 32 + fq1 * 16);
              const f32x4 qa = mfma16(aq, bq, (f32x4){0.f, 0.f, 0.f, 0.f}), ya = mfma16(ay, by, (f32x4){0.f, 0.f, 0.f, 0.f});
#pragma unroll
              for (int rg = 0; rg < 4; ++rg) gqh[(4 * fq + rg) * 64 + row] = (bf16)f2bf(qa[rg]);
              { u32x2 w; w.x = pk2(ya[0], ya[1]); w.y = pk2(ya[2], ya[3]); *(GAS u32x2*)(s1 + S1_Y0T + (((size_t)uidx * 64 + row) * 16 + 4 * fq) * 2) = w; } } }
        LDS_WAIT(); asm volatile("" ::: "memory");
    }
}

__device__ __forceinline__ void p2_rwkv_prep(const Ptrs& P, unsigned char* ws, LAS unsigned char* lds, int tid, int wave, int lane) {
    constexpr int AWP = 144, AGP = 336, SLP = 196;
    LAS unsigned char* AW = lds; LAS unsigned char* AA = lds + 9216; LAS unsigned char* AG = lds + 18432; LAS float* slab = (LAS float*)(lds + 40960);
    const int fr = lane & 15, fq = lane >> 4;
    for (int u = blockIdx.x; u < T / 64; u += gridDim.x) {
        const int m0 = u * 64;
        __syncthreads();
        for (int item = tid; item < 64 * 36; item += NTHREADS) { const int tk = item / 36, c8 = item - tk * 36, m = m0 + tk, col0 = 3072 + 8 * c8;
            const u32x4 pw = *(const GAS u32x4*)(P.ZP + (size_t)m * ZPW + col0); u32x4 qw = {0u, 0u, 0u, 0u}; if (m % SEQ) qw = *(const GAS u32x4*)(P.ZP + (size_t)(m - 1) * ZPW + col0);
            f32x4 p0, p1, q0, q1; unpack8(pw, p0, p1); unpack8(qw, q0, q1);
            const f32x4 mu0 = *(const GAS f32x4*)(P.shift_mu + col0), mu1 = *(const GAS f32x4*)(P.shift_mu + col0 + 4);
            f32x4 z0 = p0 + (q0 - p0) * mu0, z1 = p1 + (q1 - p1) * mu1;
            if (c8 < 8) {
#pragma unroll
                for (int j = 0; j < 4; ++j) { z0[j] = tanhf(z0[j]); z1[j] = tanhf(z1[j]); }
                *(LAS u32x4*)(AW + tk * AWP + c8 * 16) = pack8(z0, z1);
            } else if (c8 < 16) { *(LAS u32x4*)(AA + tk * AWP + (c8 - 8) * 16) = pack8(z0, z1);
            } else {
#pragma unroll
                for (int j = 0; j < 4; ++j) { z0[j] = sigmoidf_(z0[j]); z1[j] = sigmoidf_(z1[j]); }
                *(LAS u32x4*)(AG + tk * AGP + (c8 - 16) * 16) = pack8(z0, z1); } }
        __syncthreads();
        const int ct = wave & 3, tt0 = (wave >> 2) * 2;
        const int etk = tid >> 3, ec8 = tid & 7, em = m0 + etk; const bool ehasp = (em % SEQ) != 0;
        u32x4 zc[3], zq[3]; bf16x8 fw[2], fa[2], fg[5];
#define P2_PREF_M(h_) do { const int chrow_ = (h_) * 64 + ct * 16 + fr; \
            _Pragma("unroll") for (int ks = 0; ks < 2; ++ks) { fw[ks] = *(const GAS bf16x8*)(P.LW + (size_t)chrow_ * 64 + ks * 32 + 8 * fq); fa[ks] = *(const GAS bf16x8*)(P.LA + (size_t)chrow_ * 64 + ks * 32 + 8 * fq); } \
            _Pragma("unroll") for (int ks = 0; ks < 5; ++ks) fg[ks] = *(const GAS bf16x8*)(P.LG + (size_t)chrow_ * 160 + ks * 32 + 8 * fq); } while (0)
#define P2_PREF_E(h_) do { const int ch0_ = (h_) * 64 + 8 * ec8; const bf16* zp_ = P.ZP + (size_t)em * ZPW + ch0_; \
            _Pragma("unroll") for (int sg = 0; sg < 3; ++sg) { zc[sg] = *(const GAS u32x4*)(zp_ + sg * 1024); zq[sg] = (u32x4){0u, 0u, 0u, 0u}; if (ehasp) zq[sg] = *(const GAS u32x4*)(zp_ - ZPW + sg * 1024); \
                } } while (0)
        P2_PREF_E(0);
#pragma unroll 1
        for (int h = 0; h < NH; ++h) {
            { f32x4 acc[2][3]; P2_PREF_M(h);
#pragma unroll
              for (int t = 0; t < 2; ++t)
#pragma unroll
                  for (int kd = 0; kd < 3; ++kd) acc[t][kd] = (f32x4){0.f, 0.f, 0.f, 0.f};
#pragma unroll
              for (int ks = 0; ks < 2; ++ks)
#pragma unroll
                  for (int t = 0; t < 2; ++t) { const int tok = (tt0 + t) * 16 + fr;
                      acc[t][0] = mfma16(fw[ks], *(const LAS bf16x8*)(AW + tok * AWP + (ks * 32 + 8 * fq) * 2), acc[t][0]);
                      acc[t][1] = mfma16(fa[ks], *(const LAS bf16x8*)(AA + tok * AWP + (ks * 32 + 8 * fq) * 2), acc[t][1]); }
#pragma unroll
              for (int ks = 0; ks < 5; ++ks)
#pragma unroll
                  for (int t = 0; t < 2; ++t) { const int tok = (tt0 + t) * 16 + fr; acc[t][2] = mfma16(fg[ks], *(const LAS bf16x8*)(AG + tok * AGP + (ks * 32 + 8 * fq) * 2), acc[t][2]); }
#pragma unroll
              for (int t = 0; t < 2; ++t)
#pragma unroll
                  for (int kd = 0; kd < 3; ++kd) *(LAS f32x4*)(slab + ((tt0 + t) * 16 + fr) * SLP + kd * 64 + ct * 16 + 4 * fq) = acc[t][kd]; }
            __syncthreads();
            { const int ch0 = h * 64 + 8 * ec8; const LAS float* sl = slab + etk * SLP + 8 * ec8;
              float rr[8], kv[8], vv[8];
#pragma unroll
              for (int sg = 0; sg < 3; ++sg) { f32x4 p0, p1, q0, q1; unpack8(zc[sg], p0, p1); unpack8(zq[sg], q0, q1);
                  const f32x4 mu0 = *(const GAS f32x4*)(P.shift_mu + sg * 1024 + ch0), mu1 = *(const GAS f32x4*)(P.shift_mu + sg * 1024 + ch0 + 4);
                  const f32x4 z0 = p0 + (q0 - p0) * mu0, z1 = p1 + (q1 - p1) * mu1;
#pragma unroll
                  for (int j = 0; j < 4; ++j) { if (sg == 0) { rr[j] = z0[j]; rr[4 + j] = z1[j]; } else if (sg == 1) { kv[j] = z0[j]; kv[4 + j] = z1[j]; } else { vv[j] = z0[j]; vv[4 + j] = z1[j]; } } }
              float dec[8], av[8], gv[8], kkp[8], kn[8]; float ss = 0.f, bon = 0.f;
#pragma unroll
              for (int q = 0; q < 2; ++q) { const f32x4 wr_ = *(const LAS f32x4*)(sl + 4 * q), ap = *(const LAS f32x4*)(sl + 64 + 4 * q), gg = *(const LAS f32x4*)(sl + 128 + 4 * q);
                  const f32x4 w0v = *(const GAS f32x4*)(P.w0 + ch0 + 4 * q), a0v = *(const GAS f32x4*)(P.a0 + ch0 + 4 * q), kkv = *(const GAS f32x4*)(P.k_k + ch0 + 4 * q), kav = *(const GAS f32x4*)(P.k_a + ch0 + 4 * q), rkv = *(const GAS f32x4*)(P.r_k + ch0 + 4 * q);
#pragma unroll
                  for (int j = 0; j < 4; ++j) { const int i = 4 * q + j;
                      dec[i] = __expf(-0.6065306597126334f * sigmoidf_(w0v[j] + wr_[j])); av[i] = sigmoidf_(a0v[j] + ap[j]); gv[i] = gg[j];
                      kkp[i] = kv[i] * kkv[j]; ss += kkp[i] * kkp[i]; kn[i] = kv[i] * (1.0f + (av[i] - 1.0f) * kav[j]); bon += rr[i] * kn[i] * rkv[j]; } }
              if (h + 1 < NH) P2_PREF_E(h + 1);
              ss = sum8(ss); bon = sum8(bon);
              const float rn = 1.0f / fmaxf(sqrtf(ss), 1e-12f);
              const size_t o = (size_t)em * RW + ch0;
              f32x4 t0, t1;
#pragma unroll
              for (int j = 0; j < 4; ++j) { t0[j] = -kkp[j] * rn; t1[j] = -kkp[4 + j] * rn; }
              *(GAS u32x4*)(P.SCH + SH_KK * SC_STRIDE + o) = pack8(t0, t1);
#pragma unroll
              for (int j = 0; j < 4; ++j) { t0[j] = -t0[j] * av[j]; t1[j] = -t1[j] * av[4 + j]; }
              *(GAS u32x4*)(P.SCH + SH_BB * SC_STRIDE + o) = pack8(t0, t1);
              *(GAS f32x4*)(P.SC + o) = (f32x4){dec[0], dec[1], dec[2], dec[3]}; *(GAS f32x4*)(P.SC + o + 4) = (f32x4){dec[4], dec[5], dec[6], dec[7]};
              *(GAS u32x4*)(P.SCH + SH_K * SC_STRIDE + o) = pack8((f32x4){kn[0], kn[1], kn[2], kn[3]}, (f32x4){kn[4], kn[5], kn[6], kn[7]});
              *(GAS u32x4*)(P.SCH + SH_R * SC_STRIDE + o) = pack8((f32x4){rr[0], rr[1], rr[2], rr[3]}, (f32x4){rr[4], rr[5], rr[6], rr[7]});
              *(GAS u32x4*)(P.SCH + SH_V * SC_STRIDE + o) = pack8((f32x4){vv[0], vv[1], vv[2], vv[3]}, (f32x4){vv[4], vv[5], vv[6], vv[7]});
              *(GAS u32x4*)(P.G + o) = pack8((f32x4){gv[0], gv[1], gv[2], gv[3]}, (f32x4){gv[4], gv[5], gv[6], gv[7]});
              if (ec8 == 0) P.BONUS[(size_t)em * NH + h] = bon; }
            __syncthreads();
        }
#undef P2_PREF_M
#undef P2_PREF_E
        VM_WAIT(); __builtin_amdgcn_fence(__ATOMIC_ACQUIRE, "agent"); VM_WAIT(); __syncthreads();
        p4a_chunk_prep(P, ws, lds, tid, wave, lane, u);
    }
}

template <int N> __device__ __forceinline__ float dpp_shr1(float x) { return __builtin_bit_cast(float, __builtin_amdgcn_update_dpp(0x3f800000, __builtin_bit_cast(int, x), 0x110 + N, 0xf, 0xf, false)); }
__device__ __forceinline__ float sum_fq(float x) {
    auto s = __builtin_amdgcn_permlane16_swap(__float_as_uint(x), __float_as_uint(x), false, false); x = __uint_as_float(s[0]) + __uint_as_float(s[1]);
    auto t = __builtin_amdgcn_permlane32_swap(__float_as_uint(x), __float_as_uint(x), false, false); return __uint_as_float(t[0]) + __uint_as_float(t[1]);
}
__device__ __forceinline__ u32x2 pack4(float a, float b, float c, float d) { u32x2 w; w.x = pk2(a, b); w.y = pk2(c, d); return w; }
__device__ __forceinline__ u32x2 pack4v(float a, float b, float c, float d) { u32x2 w; w.x = pk2v(a, b); w.y = pk2v(c, d); return w; }
__device__ __forceinline__ void p2_fused(const Ptrs& P, unsigned char* ws, LAS unsigned char* lds, int tid, int wave, int lane) {
    constexpr int AWP = 144, AGP = 336;
    LAS unsigned char* AW = lds; LAS unsigned char* AA = lds + 4608; LAS unsigned char* AG = lds + 9216;
    LAS unsigned char* wl = lds + 20480 + wave * 15872;
    LAS unsigned char* AH = wl, *BH = wl + 2048, *KH = wl + 4096, *RH = wl + 6144;
    LAS unsigned char* AT = wl + 8192, *RT = wl + 10240, *VTl = wl + 12288;
    LAS unsigned char* MX = wl + 14336;
    LAS unsigned char* WTl = wl, *U0Tl = wl + 2048, *PT = wl + 8192; LAS float* LmT = (LAS float*)(wl + 4096);
    const int lane0 = lane, fr0 = lane & 15, fq0 = lane >> 4;
    unsigned char* s1 = ws + WS_S1;
    for (int u = blockIdx.x; u < T / 64; u += gridDim.x) {
#pragma unroll 1
      for (int half = 0; half < 2; ++half) {
        const int m0 = u * 64 + half * 32;
        __syncthreads();
        for (int item = tid; item < 32 * 36; item += NTHREADS) { const int tk = item / 36, c8 = item - tk * 36, m = m0 + tk, col0 = 3072 + 8 * c8;
            const u32x4 pw = *(const GAS u32x4*)(P.ZP + (size_t)m * ZPW + col0); u32x4 qw = {0u, 0u, 0u, 0u}; if (m % SEQ) qw = *(const GAS u32x4*)(P.ZP + (size_t)(m - 1) * ZPW + col0);
            f32x4 p0, p1, q0, q1; unpack8(pw, p0, p1); unpack8(qw, q0, q1);
            const f32x4 mu0 = *(const GAS f32x4*)(P.shift_mu + col0), mu1 = *(const GAS f32x4*)(P.shift_mu + col0 + 4);
            f32x4 z0 = p0 + (q0 - p0) * mu0, z1 = p1 + (q1 - p1) * mu1;
            if (c8 < 8) {
#pragma unroll
                for (int j = 0; j < 4; ++j) { z0[j] = tanhf_(z0[j]); z1[j] = tanhf_(z1[j]); }
                *(LAS u32x4*)(AW + tk * AWP + c8 * 16) = pack8(z0, z1);
            } else if (c8 < 16) { *(LAS u32x4*)(AA + tk * AWP + (c8 - 8) * 16) = pack8(z0, z1);
            } else {
#pragma unroll
                for (int j = 0; j < 4; ++j) { z0[j] = sigmoidf_(z0[j]); z1[j] = sigmoidf_(z1[j]); }
                *(LAS u32x4*)(AG + tk * AGP + (c8 - 16) * 16) = pack8(z0, z1); } }
        __syncthreads();
        const int tloc = wave >> 2;
        const int mbase = m0 + tloc * 16, bb_ = mbase / SEQ, c16 = (mbase % SEQ) >> 4;
#pragma unroll 1
        for (int hh = 0; hh < 4; ++hh) {
            int fr = fr0, fq = fq0, lane = lane0; asm volatile("" : "+v"(fr), "+v"(fq), "+v"(lane));
            const int fq1 = fq & 1, m = mbase + fr; const bool hasp = (m % SEQ) != 0;
            const int h = (wave & 3) * 4 + hh, uidx = ((bb_ * 16 + h) << 8) + c16;
            f32x4 accw[4], acca[4], accg[4];
#pragma unroll
            for (int ct = 0; ct < 4; ++ct) { accw[ct] = (f32x4){0.f, 0.f, 0.f, 0.f}; acca[ct] = accw[ct]; accg[ct] = accw[ct]; const int chrow = h * 64 + ct * 16 + fr;
#pragma unroll
                for (int ks = 0; ks < 2; ++ks) { const bf16x8 wf = *(const GAS bf16x8*)(P.LW + (size_t)chrow * 64 + ks * 32 + 8 * fq), af = *(const GAS bf16x8*)(P.LA + (size_t)chrow * 64 + ks * 32 + 8 * fq);
                    accw[ct] = mfma16(wf, *(const LAS bf16x8*)(AW + (tloc * 16 + fr) * AWP + (ks * 32 + 8 * fq) * 2), accw[ct]);
                    acca[ct] = mfma16(af, *(const LAS bf16x8*)(AA + (tloc * 16 + fr) * AWP + (ks * 32 + 8 * fq) * 2), acca[ct]); }
#pragma unroll
                for (int ks = 0; ks < 5; ++ks) { const bf16x8 gf = *(const GAS bf16x8*)(P.LG + (size_t)chrow * 160 + ks * 32 + 8 * fq);
                    accg[ct] = mfma16(gf, *(const LAS bf16x8*)(AG + (tloc * 16 + fr) * AGP + (ks * 32 + 8 * fq) * 2), accg[ct]); } }
            float dec[16], aa[16], kkp[16], kn[16], rr[16]; float ss = 0.f, bon = 0.f;
#pragma unroll
            for (int ct = 0; ct < 4; ++ct) { const int c0 = h * 64 + 16 * ct + 4 * fq; const bf16* zp = P.ZP + (size_t)m * ZPW + c0;
                float cur[3][4], prv[3][4], v4[4];
#pragma unroll
                for (int sg = 0; sg < 3; ++sg) { const u32x2 pw = *(const GAS u32x2*)(zp + sg * 1024); u32x2 qw = {0u, 0u}; if (hasp) qw = *(const GAS u32x2*)(zp - ZPW + sg * 1024);
                    cur[sg][0] = bflo(pw.x); cur[sg][1] = bfhi(pw.x); cur[sg][2] = bflo(pw.y); cur[sg][3] = bfhi(pw.y); prv[sg][0] = bflo(qw.x); prv[sg][1] = bfhi(qw.x); prv[sg][2] = bflo(qw.y); prv[sg][3] = bfhi(qw.y); }
                const f32x4 mur = *(const GAS f32x4*)(P.shift_mu + c0), muk = *(const GAS f32x4*)(P.shift_mu + 1024 + c0), muv = *(const GAS f32x4*)(P.shift_mu + 2048 + c0);
                const f32x4 w0v = *(const GAS f32x4*)(P.w0 + c0), a0v = *(const GAS f32x4*)(P.a0 + c0), kkv = *(const GAS f32x4*)(P.k_k + c0), kav = *(const GAS f32x4*)(P.k_a + c0), rkv = *(const GAS f32x4*)(P.r_k + c0);
#pragma unroll
                for (int rg = 0; rg < 4; ++rg) { const int i = ct * 4 + rg;
                    const float r = cur[0][rg] + (prv[0][rg] - cur[0][rg]) * mur[rg], k = cur[1][rg] + (prv[1][rg] - cur[1][rg]) * muk[rg], v = cur[2][rg] + (prv[2][rg] - cur[2][rg]) * muv[rg];
                    dec[i] = __expf(-0.6065306597126334f * sigmoidf_(w0v[rg] + accw[ct][rg])); aa[i] = sigmoidf_(a0v[rg] + acca[ct][rg]);
                    kkp[i] = k * kkv[rg]; ss += kkp[i] * kkp[i]; kn[i] = k * (1.0f + (aa[i] - 1.0f) * kav[rg]); bon += r * kn[i] * rkv[rg]; rr[i] = r; v4[rg] = v; }
                { const u32x2 vp = pack4v(v4[0], v4[1], v4[2], v4[3]); LAS unsigned char* vt = VTl + (16 * ct + 4 * fq) * 32 + fr * 2;
                  *(LAS unsigned short*)(vt) = (unsigned short)(vp.x & 0xffffu); *(LAS unsigned short*)(vt + 32) = (unsigned short)(vp.x >> 16); *(LAS unsigned short*)(vt + 64) = (unsigned short)(vp.y & 0xffffu); *(LAS unsigned short*)(vt + 96) = (unsigned short)(vp.y >> 16);
                  *(GAS u32x2*)(P.SCH + SH_V * SC_STRIDE + (size_t)m * RW + c0) = vp; }
                *(GAS u32x2*)(P.G + (size_t)m * RW + c0) = pack4(accg[ct][0], accg[ct][1], accg[ct][2], accg[ct][3]); }
            ss = sum_fq(ss); bon = sum_fq(bon);
            const float rn = __builtin_amdgcn_rsqf(fmaxf(ss, 1e-24f));
            if (fq == 0) P.BONUS[(size_t)m * NH + h] = bon;
            asm volatile("" : "+v"(fr), "+v"(fq), "+v"(lane));
            bf16* gbt = (bf16*)(s1 + S1_BT) + (size_t)uidx * 1024 + fr; bf16* gkt = (bf16*)(s1 + S1_KT) + (size_t)uidx * 1024 + fr;
#pragma unroll
            for (int ct = 0; ct < 4; ++ct) { float a4[4], b4[4], k4[4], r4[4], g15[4];
#pragma unroll
                for (int rg = 0; rg < 4; ++rg) { const int i = ct * 4 + rg;
                    float g = dec[i]; g *= dpp_shr1<1>(g); g *= dpp_shr1<2>(g); g *= dpp_shr1<4>(g); g *= dpp_shr1<8>(g);
                    const float gp = dpp_shr1<1>(g), gl = __shfl(g, (lane & 48) | 15), inv = __builtin_amdgcn_rcpf(g);
                    const float kkn = -kkp[i] * rn, bbv = -kkn * aa[i];
                    a4[rg] = kkn * gp; b4[rg] = bbv * inv; k4[rg] = kn[i] * inv; r4[rg] = rr[i] * g; g15[rg] = gl;
                    const int kx = 16 * ct + 4 * fq + rg;
                    { const unsigned bk = pk2v(b4[rg] * gl, k4[rg] * gl), ar = pk2v(a4[rg], r4[rg]);
                      gbt[kx * 16] = (bf16)(bk & 0xffffu); gkt[kx * 16] = (bf16)(bk >> 16);
                      *(LAS unsigned short*)(AT + kx * 32 + fr * 2) = (unsigned short)(ar & 0xffffu); *(LAS unsigned short*)(RT + kx * 32 + fr * 2) = (unsigned short)(ar >> 16); } }
                const int o = fr * 128 + (16 * ct + 4 * fq) * 2;
                *(LAS u32x2*)(AH + o) = pack4v(a4[0], a4[1], a4[2], a4[3]); *(LAS u32x2*)(BH + o) = pack4v(b4[0], b4[1], b4[2], b4[3]);
                *(LAS u32x2*)(KH + o) = pack4v(k4[0], k4[1], k4[2], k4[3]); *(LAS u32x2*)(RH + o) = pack4v(r4[0], r4[1], r4[2], r4[3]);
                if (fr == 0) *(GAS f32x4*)(s1 + S1_GAM + ((size_t)uidx * 64 + 16 * ct + 4 * fq) * 4) = (f32x4){g15[0], g15[1], g15[2], g15[3]}; }
            LDS_WAIT(); asm volatile("" ::: "memory");
            { GAS u32x4* gv = (GAS u32x4*)(s1 + S1_VT + ((size_t)uidx * 64 + lane) * 32); gv[0] = *(const LAS u32x4*)(VTl + lane * 32); gv[1] = *(const LAS u32x4*)(VTl + lane * 32 + 16); }
        asm volatile("" : "+v"(fr), "+v"(fq), "+v"(lane));
        f32x4 lab = {0.f, 0.f, 0.f, 0.f}, lak = lab, mrb = lab, mrk = lab;
#pragma unroll
        for (int ks = 0; ks < 2; ++ks) { const int off = fr * 128 + (32 * ks + 8 * fq) * 2;
            const bf16x8 a = *(const LAS bf16x8*)(AH + off), r_ = *(const LAS bf16x8*)(RH + off), b_ = *(const LAS bf16x8*)(BH + off), k_ = *(const LAS bf16x8*)(KH + off);
            lab = mfma16(a, b_, lab); lak = mfma16(a, k_, lak); mrb = mfma16(r_, b_, mrb); mrk = mfma16(r_, k_, mrk); }
#pragma unroll
        for (int rg = 0; rg < 4; ++rg) { const int t = 4 * fq + rg; const bool lo = fr < t, le = fr <= t; lab[rg] = lo ? lab[rg] : 0.f; lak[rg] = lo ? lak[rg] : 0.f; mrb[rg] = le ? mrb[rg] : 0.f; mrk[rg] = le ? mrk[rg] : 0.f; }
        asm volatile("" ::: "memory");
        *(LAS f32x4*)(LmT + fr * 16 + 4 * fq) = lab;
#pragma unroll
        for (int rg = 0; rg < 4; ++rg) { const int o = ((4 * fq + rg) * 16 + fr) * 2;
            *(LAS unsigned short*)(MX + o) = (unsigned short)f2bf(lak[rg]); *(LAS unsigned short*)(MX + 512 + o) = (unsigned short)f2bf(mrb[rg]); *(LAS unsigned short*)(MX + 1024 + o) = (unsigned short)f2bf(mrk[rg]); }
        LDS_WAIT(); asm volatile("" ::: "memory");
        float Tr[16];
#pragma unroll
        for (int m = 0; m < 16; ++m) Tr[m] = (m == fr) ? 1.0f : 0.0f;
#pragma unroll
        for (int j = 14; j >= 0; --j) { float acc = (j == fr) ? 1.0f : 0.0f;
#pragma unroll
            for (int q = 0; q < 4; ++q) { const f32x4 l4 = *(const LAS f32x4*)(LmT + j * 16 + 4 * q);
#pragma unroll
                for (int e = 0; e < 4; ++e) { const int m = 4 * q + e; if (m > j) acc += Tr[m] * l4[e]; } }
            Tr[j] = acc; }
        bf16x8 tfrag;
        { float sel[8];
#pragma unroll
          for (int j = 0; j < 8; ++j) sel[j] = (fq == 0) ? Tr[j] : ((fq == 1) ? Tr[8 + j] : 0.0f);
          tfrag = __builtin_bit_cast(bf16x8, pack8s(sel)); }
        f32x4 wacc[4];
#pragma unroll
        for (int nt = 0; nt < 4; ++nt) wacc[nt] = mfma16(tfrag, *(const LAS bf16x8*)(AT + (16 * nt + fr) * 32 + fq1 * 16), (f32x4){0.f, 0.f, 0.f, 0.f});
        asm volatile("" ::: "memory");
        { bf16* gwh = (bf16*)(s1 + S1_WH) + (size_t)uidx * 1024;
          asm volatile("s_nop 7\n\ts_nop 7" : "+v"(wacc[0]), "+v"(wacc[1]), "+v"(wacc[2]), "+v"(wacc[3]));
#pragma unroll
          for (int nt = 0; nt < 4; ++nt) { u32x2 w2; w2.x = pk2v(wacc[nt][0], wacc[nt][1]); w2.y = pk2v(wacc[nt][2], wacc[nt][3]); *(LAS u32x2*)(WTl + ((16 * nt + fr) * 16 + 4 * fq) * 2) = w2;
              bf16* gp_ = gwh + (4 * fq) * 64 + 16 * nt + fr; gp_[0] = (bf16)(w2.x & 0xffffu); gp_[64] = (bf16)(w2.x >> 16); gp_[128] = (bf16)(w2.y & 0xffffu); gp_[192] = (bf16)(w2.y >> 16); } }
        asm volatile("" : "+v"(fr), "+v"(fq), "+v"(lane));
        bf16x8 lkf, mbf, mkf, idf;
        { const u32x4 z4 = {0u, 0u, 0u, 0u};
          const u32x4 lk4 = *(const LAS u32x4*)(MX + (fr * 16 + 8 * fq1) * 2), mb4 = *(const LAS u32x4*)(MX + 512 + (fr * 16 + 8 * fq1) * 2), mk4 = *(const LAS u32x4*)(MX + 1024 + (fr * 16 + 8 * fq1) * 2);
          lkf = __builtin_bit_cast(bf16x8, (fq < 2) ? lk4 : z4);
          mbf = __builtin_bit_cast(bf16x8, mb4);
          mkf = __builtin_bit_cast(bf16x8, mk4);
          u32x4 id4; const int d = fr - 8 * fq1;
          id4.x = (d == 0 ? 0x3f80u : 0u) | (d == 1 ? 0x3f800000u : 0u); id4.y = (d == 2 ? 0x3f80u : 0u) | (d == 3 ? 0x3f800000u : 0u);
          id4.z = (d == 4 ? 0x3f80u : 0u) | (d == 5 ? 0x3f800000u : 0u); id4.w = (d == 6 ? 0x3f80u : 0u) | (d == 7 ? 0x3f800000u : 0u);
          idf = __builtin_bit_cast(bf16x8, id4); }
        LDS_WAIT(); asm volatile("" ::: "memory");
        f32x4 pacc[4];
#pragma unroll
        for (int nt = 0; nt < 4; ++nt) pacc[nt] = mfma16(lkf, *(const LAS bf16x8*)(VTl + (16 * nt + fr) * 32 + fq1 * 16), (f32x4){0.f, 0.f, 0.f, 0.f});
        asm volatile("" ::: "memory");
        asm volatile("s_nop 7\n\ts_nop 7" : "+v"(pacc[0]), "+v"(pacc[1]), "+v"(pacc[2]), "+v"(pacc[3]));
#pragma unroll
        for (int nt = 0; nt < 4; ++nt) { u32x2 w2; w2.x = pk2v(pacc[nt][0], pacc[nt][1]); w2.y = pk2v(pacc[nt][2], pacc[nt][3]); *(LAS u32x2*)(PT + ((16 * nt + fr) * 16 + 4 * fq) * 2) = w2; }
        LDS_WAIT(); asm volatile("" ::: "memory");
        f32x4 uacc[4];
#pragma unroll
        for (int nt = 0; nt < 4; ++nt) uacc[nt] = mfma16(tfrag, *(const LAS bf16x8*)(PT + (16 * nt + fr) * 32 + fq1 * 16), (f32x4){0.f, 0.f, 0.f, 0.f});
        asm volatile("" ::: "memory");
        asm volatile("s_nop 7\n\ts_nop 7" : "+v"(uacc[0]), "+v"(uacc[1]), "+v"(uacc[2]), "+v"(uacc[3]));
#pragma unroll
        for (int nt = 0; nt < 4; ++nt) { u32x2 w2; w2.x = pk2v(uacc[nt][0], uacc[nt][1]); w2.y = pk2v(uacc[nt][2], uacc[nt][3]); *(LAS u32x2*)(U0Tl + ((16 * nt + fr) * 16 + 4 * fq) * 2) = w2;
            { u32x2 w; w.x = pk2(uacc[nt][0], uacc[nt][1]); w.y = pk2(uacc[nt][2], uacc[nt][3]); *(GAS u32x2*)(s1 + S1_U0T + (((size_t)uidx * 64 + 16 * nt + fr) * 16 + 4 * fq) * 2) = w; } }
        LDS_WAIT(); asm volatile("" ::: "memory");
        { const bf16x8 aq = (fq < 2) ? mbf : idf, ay = (fq < 2) ? mbf : mkf;
          bf16* gqh = (bf16*)(s1 + S1_QH) + (size_t)uidx * 1024;
#pragma unroll
          for (int nt = 0; nt < 4; ++nt) { const int row = 16 * nt + fr;
              const bf16x8 bq = *(const LAS bf16x8*)(((fq < 2) ? WTl : RT) + row * 32 + fq1 * 16), by = *(const LAS bf16x8*)(((fq < 2) ? U0Tl : VTl) + row * 32 + fq1 * 16);
              const f32x4 qa = mfma16(aq, bq, (f32x4){0.f, 0.f, 0.f, 0.f}), ya = mfma16(ay, by, (f32x4){0.f, 0.f, 0.f, 0.f});
#pragma unroll
              for (int rg = 0; rg < 4; ++rg) gqh[(4 * fq + rg) * 64 + row] = (bf16)f2bf(qa[rg]);
              { u32x2 w; w.x = pk2(ya[0], ya[1]); w.y = pk2(ya[2], ya[3]); *(GAS u32x2*)(s1 + S1_Y0T + (((size_t)uidx * 64 + row) * 16 + 4 * fq) * 2) = w; } } }
        LDS_WAIT(); asm volatile("" ::: "memory");
        }
      }
    }
}

struct AttU { int b, gh, d, c, n; };
__device__ __forceinline__ AttU att_decode(int u) {
    AttU a; a.b = u / 384; const int r = u - a.b * 384; a.gh = r >> 5; const int idx = r & 31, g = a.gh >> 2;
    a.d = (g == 0) ? 1 : ((g == 1) ? 4 : 16); const int nb = 32 / a.d; a.c = idx / nb; a.n = idx - a.c * nb; return a;
}
typedef short v4i16_t __attribute__((ext_vector_type(4)));
__device__ __forceinline__ u32x2 vtr(const LAS unsigned char* p) { return __builtin_bit_cast(u32x2, __builtin_amdgcn_ds_read_tr16_b64_v4i16((LAS v4i16_t*)p)); }
__device__ __forceinline__ void att_load(const Ptrs& P, const AttU& a, int kblk, int skey, int spart, u32x4 (&kr)[4], u32x4 (&vr)[4]) {
#pragma unroll
    for (int i = 0; i < 4; ++i) { const size_t mk = (size_t)a.b * SEQ + (size_t)(kblk * 128 + skey + 32 * i) * a.d + a.c; const bf16* row = P.QKV + mk * QKVW + a.gh * 128 + spart * 8;
        kr[i] = *(const GAS u32x4*)(row + 1536); vr[i] = *(const GAS u32x4*)(row + 3072); }
}
__device__ __forceinline__ void att_write(LAS unsigned char* Kb, int kwo, int vwo, const u32x4 (&kr)[4], const u32x4 (&vr)[4]) {
#pragma unroll
    for (int i = 0; i < 4; ++i) { *(LAS u32x4*)(Kb + kwo + 8704 * i) = kr[i]; *(LAS u32x4*)(Kb + 34816 + vwo + 1024 * i) = vr[i]; }
}
__device__ __forceinline__ void att_pass(const LAS unsigned char* Kb, const int kb, const int lo, const int hi, const int qi, const int fr, const int fq, const int (&vro)[4],
                                         const bf16x8 (&qf)[4], f32x4 (&o)[8], float& mrun, float& lrun) {
    f32x4 s[8];
#pragma unroll
    for (int kt = 0; kt < 8; ++kt) { s[kt] = (f32x4){-1e30f, -1e30f, -1e30f, -1e30f};
        if (kt >= lo && kt < hi) { f32x4 t = {0.f, 0.f, 0.f, 0.f};
#pragma unroll
            for (int ks = 0; ks < 4; ++ks) { const bf16x8 af = *(const LAS bf16x8*)(Kb + (kt * 16 + fr) * 272 + (32 * ks + 8 * fq) * 2); t = mfma16(af, qf[ks], t); }
            s[kt] = t; } }
    float mx = -1e30f;
#pragma unroll
    for (int kt = 0; kt < 8; ++kt)
#pragma unroll
        for (int rg = 0; rg < 4; ++rg) { const int j = kt * 16 + 4 * fq + rg; const bool ok = (kb == 0) ? (j >= qi) : (j <= qi); const float sv = ok ? s[kt][rg] : -1e30f; s[kt][rg] = sv; mx = fmaxf(mx, sv); }
    mx = fmaxf(mx, __shfl_xor(mx, 16)); mx = fmaxf(mx, __shfl_xor(mx, 32));
    const float mnew = fmaxf(mrun, mx), alpha = __builtin_amdgcn_exp2f(mrun - mnew); mrun = mnew;
    float ls = 0.f;
#pragma unroll
    for (int kt = 0; kt < 8; ++kt)
#pragma unroll
        for (int rg = 0; rg < 4; ++rg) { const float p = __builtin_amdgcn_exp2f(s[kt][rg] - mnew); s[kt][rg] = p; ls += p; }
    lrun = lrun * alpha + ls;
#pragma unroll
    for (int dt = 0; dt < 8; ++dt) o[dt] = o[dt] * alpha;
#pragma unroll
    for (int pi = 0; pi < 4; ++pi) {
        if (2 * pi + 1 >= lo && 2 * pi < hi) {
            u32x4 bw; bw.x = pk2v(s[2 * pi][0], s[2 * pi][1]); bw.y = pk2v(s[2 * pi][2], s[2 * pi][3]); bw.z = pk2v(s[2 * pi + 1][0], s[2 * pi + 1][1]); bw.w = pk2v(s[2 * pi + 1][2], s[2 * pi + 1][3]);
            const bf16x8 bfrag = __builtin_bit_cast(bf16x8, bw);
#pragma unroll
            for (int dt = 0; dt < 8; ++dt) { const LAS unsigned char* vp = Kb + vro[dt & 3] + (dt >> 2) * 16384 + (2 * pi) * 512;
                const u32x2 lo_ = vtr(vp), hi_ = vtr(vp + 512);
                const u32x4 aw = {lo_.x, lo_.y, hi_.x, hi_.y}; o[dt] = mfma16(__builtin_bit_cast(bf16x8, aw), bfrag, o[dt]); } } }
}
__device__ __forceinline__ void p3_attention(const Ptrs& P, LAS unsigned char* lds, int tid, int wave, int lane) {
    const int fr = lane & 15, fq = lane >> 4;
    const int skey = tid >> 4, spart = tid & 15, sdt = spart >> 1;
    const int kwo = skey * 272 + spart * 16;
    const int vwo = (sdt * 32 + (skey >> 2)) * 128 + (((skey & 3) ^ (sdt & 3)) * 32) + (spart & 1) * 16;
    int vro[4];
#pragma unroll
    for (int x = 0; x < 4; ++x) vro[x] = 34816 + x * 4096 + fq * 128 + (((fr >> 2) ^ x) * 32) + (fr & 3) * 8;
    const int NU = NB * 12 * 32;
    int u = blockIdx.x;
    if (u >= NU) return;
    AttU a = att_decode(u);
    const int qi = wave * 16 + fr;
    u32x4 kr0[4], vr0[4], kr1[4], vr1[4]; bf16x8 qf[4], qn[4];
    __syncthreads();
    if (a.n > 0) att_load(P, a, a.n - 1, skey, spart, kr0, vr0);
    att_load(P, a, a.n, skey, spart, kr1, vr1);
    { const size_t mq = (size_t)a.b * SEQ + (size_t)(a.n * 128 + qi) * a.d + a.c; const bf16* qrow = P.QKV + mq * QKVW + a.gh * 128;
#pragma unroll
      for (int ks = 0; ks < 4; ++ks) qf[ks] = *(const GAS bf16x8*)(qrow + 32 * ks + 8 * fq); }
    if (a.n > 0) att_write(lds, kwo, vwo, kr0, vr0);
    att_write(lds + 67584, kwo, vwo, kr1, vr1);
    __syncthreads();
    while (true) {
        const int nu = u + gridDim.x; const bool hn = nu < NU; AttU na = a; if (hn) na = att_decode(nu);
        if (hn) { if (na.n > 0) att_load(P, na, na.n - 1, skey, spart, kr0, vr0);
            att_load(P, na, na.n, skey, spart, kr1, vr1);
            const size_t mq = (size_t)na.b * SEQ + (size_t)(na.n * 128 + qi) * na.d + na.c; const bf16* qrow = P.QKV + mq * QKVW + na.gh * 128;
#pragma unroll
            for (int ks = 0; ks < 4; ++ks) qn[ks] = *(const GAS bf16x8*)(qrow + 32 * ks + 8 * fq); }
        f32x4 o[8]; float mrun = -1e30f, lrun = 0.f;
#pragma unroll
        for (int dt = 0; dt < 8; ++dt) o[dt] = (f32x4){0.f, 0.f, 0.f, 0.f};
        if (a.n > 0) att_pass(lds, 0, wave, 8, qi, fr, fq, vro, qf, o, mrun, lrun);
        att_pass(lds + 67584, 1, 0, wave + 1, qi, fr, fq, vro, qf, o, mrun, lrun);
        { float lt = lrun; lt += __shfl_xor(lt, 16); lt += __shfl_xor(lt, 32);
          const size_t mq = (size_t)a.b * SEQ + (size_t)(a.n * 128 + qi) * a.d + a.c;
          bf16* orow = P.ATTO + (mq * 12 + a.gh) * 128;
#pragma unroll
          for (int dt = 0; dt < 8; ++dt) { u32x2 w; w.x = pk2(o[dt][0], o[dt][1]); w.y = pk2(o[dt][2], o[dt][3]); *(GAS u32x2*)(orow + dt * 16 + 4 * fq) = w; }
          if (fq == 0) { P.ATTML[(mq * 12 + a.gh) * 2] = mrun; P.ATTML[(mq * 12 + a.gh) * 2 + 1] = lt; } }
        __syncthreads();
        if (!hn) break;
        if (na.n > 0) att_write(lds, kwo, vwo, kr0, vr0);
        att_write(lds + 67584, kwo, vwo, kr1, vr1);
#pragma unroll
        for (int ks = 0; ks < 4; ++ks) qf[ks] = qn[ks];
        __syncthreads();
        a = na; u = nu;
    }
}

struct S2Regs { u32x2 wf[4], qf[4], bt[4], kt[4], vt, u0w, y0w; f32x4 gm[4]; };
__device__ __forceinline__ void s2_load(S2Regs& R, const unsigned char* s1, size_t ui, int vg, int fr, int fq) {
    const unsigned char* wh = s1 + S1_WH + ui * 2048 + (fr * 64 + 4 * fq) * 2; const unsigned char* qh = s1 + S1_QH + ui * 2048 + (fr * 64 + 4 * fq) * 2;
#pragma unroll
    for (int ks = 0; ks < 2; ++ks) { R.wf[2 * ks] = *(const GAS u32x2*)(wh + ks * 64); R.wf[2 * ks + 1] = *(const GAS u32x2*)(wh + ks * 64 + 32); R.qf[2 * ks] = *(const GAS u32x2*)(qh + ks * 64); R.qf[2 * ks + 1] = *(const GAS u32x2*)(qh + ks * 64 + 32); }
#pragma unroll
    for (int mt = 0; mt < 4; ++mt) { R.bt[mt] = *(const GAS u32x2*)(s1 + S1_BT + ui * 2048 + ((16 * mt + fr) * 16 + 4 * fq) * 2); R.kt[mt] = *(const GAS u32x2*)(s1 + S1_KT + ui * 2048 + ((16 * mt + fr) * 16 + 4 * fq) * 2);
        R.gm[mt] = *(const GAS f32x4*)(s1 + S1_GAM + ui * 256 + (16 * mt + 4 * fq) * 4); }
    const size_t vr = ui * 64 + vg * 16 + fr;
    R.vt = *(const GAS u32x2*)(s1 + S1_VT + (vr * 16 + 4 * fq) * 2); { const u32x2 uw = *(const GAS u32x2*)(s1 + S1_U0T + (vr * 16 + 4 * fq) * 2), yw = *(const GAS u32x2*)(s1 + S1_Y0T + (vr * 16 + 4 * fq) * 2);
      R.u0w = uw; R.y0w = yw; }
}
__device__ __forceinline__ void s2_step(const S2Regs& R, f32x4 (&st4)[4], float* yp) {
    bf16x8 sf[2];
#pragma unroll
    for (int ks = 0; ks < 2; ++ks) sf[ks] = __builtin_bit_cast(bf16x8, pack8(st4[2 * ks], st4[2 * ks + 1]));
    f32x4 sa = (f32x4){bflo(R.u0w.x), bfhi(R.u0w.x), bflo(R.u0w.y), bfhi(R.u0w.y)}, y = (f32x4){bflo(R.y0w.x), bfhi(R.y0w.x), bflo(R.y0w.y), bfhi(R.y0w.y)};
#pragma unroll
    for (int ks = 0; ks < 2; ++ks) { sa = mfma16(__builtin_bit_cast(bf16x8, (u32x4){R.wf[2 * ks].x, R.wf[2 * ks].y, R.wf[2 * ks + 1].x, R.wf[2 * ks + 1].y}), sf[ks], sa);
        y = mfma16(__builtin_bit_cast(bf16x8, (u32x4){R.qf[2 * ks].x, R.qf[2 * ks].y, R.qf[2 * ks + 1].x, R.qf[2 * ks + 1].y}), sf[ks], y); }
#pragma unroll
    for (int rg = 0; rg < 4; ++rg) yp[(size_t)rg * RW] = y[rg];
    const bf16x8 ub = __builtin_bit_cast(bf16x8, (u32x4){pk2(sa[0], sa[1]), pk2(sa[2], sa[3]), R.vt.x, R.vt.y});
#pragma unroll
    for (int mt = 0; mt < 4; ++mt) st4[mt] = mfma16(__builtin_bit_cast(bf16x8, (u32x4){R.bt[mt].x, R.bt[mt].y, R.kt[mt].x, R.kt[mt].y}), ub, st4[mt] * R.gm[mt]);
}
__device__ __forceinline__ void p4b_scan(const Ptrs& P, unsigned char* ws, LAS unsigned char* lds, int tid, int wave, int lane) {
    if (wave == 0) {
        const int fr = lane & 15, fq = lane >> 4;
        const unsigned char* s1 = ws + WS_S1;
        for (int unit = blockIdx.x; unit < 256; unit += gridDim.x) {
            const int bh = unit >> 2, vg = unit & 3, b = bh >> 4, h = bh & 15;
            const size_t u0idx = (size_t)bh * 256;
            f32x4 st4[4];
#pragma unroll
            for (int mt = 0; mt < 4; ++mt) st4[mt] = (f32x4){0.f, 0.f, 0.f, 0.f};
            float* yb = P.Y + ((size_t)b * SEQ + 4 * fq) * RW + h * 64 + vg * 16 + fr;
            S2Regs RA, RB, RC;
            s2_load(RA, s1, u0idx, vg, fr, fq); s2_load(RB, s1, u0idx + 1, vg, fr, fq);
#pragma unroll 1
            for (int c = 0; c + 2 < 256; c += 3) {
                s2_load(RC, s1, u0idx + c + 2, vg, fr, fq);
                s2_step(RA, st4, yb + (size_t)(c * 16) * RW);
                s2_load(RA, s1, u0idx + ((c + 3 < 256) ? c + 3 : 255), vg, fr, fq);
                s2_step(RB, st4, yb + (size_t)((c + 1) * 16) * RW);
                s2_load(RB, s1, u0idx + ((c + 4 < 256) ? c + 4 : 255), vg, fr, fq);
                s2_step(RC, st4, yb + (size_t)((c + 2) * 16) * RW);
            }
            s2_step(RA, st4, yb + (size_t)(255 * 16) * RW);
        }
    } else {
        LAS float* scr = (LAS float*)(lds + (wave - 1) * 16896);
        const int gw = blockIdx.x * (NWAVES - 1) + (wave - 1), NGW = gridDim.x * (NWAVES - 1);
        constexpr int I_W1 = NE * 16 * 128, I_W2 = NE * 16 * 64;
        for (int it = gw; it < I_W1 + I_W2; it += NGW) {
            int r = it;
            if (r < I_W1) { const int e = r >> 11, q = r & 2047, kb = q >> 7, nb = q & 127, c0 = 32 * nb;
                tr8_tile(P.w1 + (size_t)e * D * 4096, 4096, 128 * kb, c0, (unsigned char*)P.W1, (size_t)e * 4096 + ((c0 & 2047) >> 7) * 256 + ((c0 & 127) >> 5) * 64 + (c0 >> 11) * 32, D, 32.0f, scr, lane); continue; }
            r -= I_W1;
            { const int e = r >> 10, q = r & 1023, kb = q >> 6, nb = q & 63; tr8_tile(P.w2 + (size_t)e * FF * D, D, 128 * kb, 32 * nb, (unsigned char*)P.W2, (size_t)e * D + 32 * nb, FF, 32.0f, scr, lane); }
        }
    }
}

__device__ __forceinline__ float sum4q(float x) { x += dppf<0xB1>(x); x += dppf<0x4E>(x); return x; }
__device__ __forceinline__ void p5_post(const Ptrs& P, int tid, int wave, int lane) {
    const int gw = blockIdx.x * NWAVES + wave, NGW = gridDim.x * NWAVES;
    const int c0 = 16 * lane, head = lane >> 2;
    for (int m = gw; m < T; m += NGW) {
        const size_t o = (size_t)m * RW + c0;
        f32x4 y[4], v[4];
#pragma unroll
        for (int q = 0; q < 4; ++q) y[q] = *(const GAS f32x4*)(P.Y + o + 4 * q);
        { const u32x4 v0 = *(const GAS u32x4*)(P.SCH + SH_V * SC_STRIDE + o), v1 = *(const GAS u32x4*)(P.SCH + SH_V * SC_STRIDE + o + 8); unpack8(v0, v[0], v[1]); unpack8(v1, v[2], v[3]); }
        const u32x4 g0 = *(const GAS u32x4*)(P.G + o), g1 = *(const GAS u32x4*)(P.G + o + 8);
        const float bon = P.BONUS[(size_t)m * NH + head];
        const int hh = lane >> 4, d0 = (lane & 15) * 8; float mm[3], ll[3]; u32x4 ow[3];
#pragma unroll
        for (int g = 0; g < 3; ++g) { const size_t q = (size_t)m * 12 + g * 4 + hh; mm[g] = P.ATTML[q * 2]; ll[g] = P.ATTML[q * 2 + 1]; ow[g] = *(const GAS u32x4*)(P.ATTO + q * 128 + d0); }
        float s = 0.f;
#pragma unroll
        for (int q = 0; q < 4; ++q) s += (y[q].x + y[q].y) + (y[q].z + y[q].w);
        const float mean = sum4q(s) * (1.0f / 64.0f); float s2 = 0.f;
#pragma unroll
        for (int q = 0; q < 4; ++q) { y[q] = y[q] - mean; s2 += (y[q].x * y[q].x + y[q].y * y[q].y) + (y[q].z * y[q].z + y[q].w * y[q].w); }
        const float rstd = 1.0f / sqrtf(sum4q(s2) * (1.0f / 64.0f) + GN_EPS);
        f32x4 gq[4]; unpack8(g0, gq[0], gq[1]); unpack8(g1, gq[2], gq[3]);
#pragma unroll
        for (int q = 0; q < 4; ++q) { const f32x4 lw = *(const GAS f32x4*)(P.ln_x_w + c0 + 4 * q), lb = *(const GAS f32x4*)(P.ln_x_b + c0 + 4 * q); y[q] = ((y[q] * rstd) * lw + lb + v[q] * bon) * gq[q]; }
        { bf16* ap = P.YAIN + (size_t)m * 1536 + c0; *(GAS u32x4*)ap = pack8(y[0], y[1]); *(GAS u32x4*)(ap + 8) = pack8(y[2], y[3]); }
        const float M = fmaxf(mm[0], fmaxf(mm[1], mm[2])); float den = 0.f; f32x4 n0 = {0.f, 0.f, 0.f, 0.f}, n1 = n0;
#pragma unroll
        for (int g = 0; g < 3; ++g) { const float wg = exp2f(mm[g] - M); den += wg * ll[g]; f32x4 a, b; unpack8(ow[g], a, b); n0 = n0 + a * wg; n1 = n1 + b * wg; }
        const float inv = 1.0f / den;
        *(GAS u32x4*)(P.YAIN + (size_t)m * 1536 + 1024 + 8 * lane) = pack8(n0 * inv, n1 * inv);
    }
}

template <int CTRL> __device__ __forceinline__ int dppi(int x) { return __builtin_amdgcn_mov_dpp(x, CTRL, 0xf, 0xf, true); }
__device__ __forceinline__ float row16_max(float x) { x = fmaxf(x, dppf<0xB1>(x)); x = fmaxf(x, dppf<0x4E>(x)); x = fmaxf(x, dppf<0x141>(x)); x = fmaxf(x, dppf<0x140>(x)); return x; }
__device__ __forceinline__ int row16_min(int x) { x = min(x, dppi<0xB1>(x)); x = min(x, dppi<0x4E>(x)); x = min(x, dppi<0x141>(x)); x = min(x, dppi<0x140>(x)); return x; }
__device__ __forceinline__ void p8_router(const Ptrs& P, LAS unsigned char* lds, int tid, int wave, int lane, int cnt_base = CW_CNT) {
    LAS float* rsv = (LAS float*)lds;
    LAS float* part = (LAS float*)(lds + 1024);
    LAS int* picks = (LAS int*)(lds + 1024 + 8192); LAS int* pbase = picks + 256; LAS float* pgate = (LAS float*)(pbase + 64);
    const int fr = lane & 15, fq = lane >> 4;
    for (int grp = blockIdx.x; grp < T / 64; grp += gridDim.x) {
        const int mb = grp * 64;
        __syncthreads();
        const int tt = wave & 3, kh = wave >> 2;
        f32x4 acc[2] = {{0.f, 0.f, 0.f, 0.f}, {0.f, 0.f, 0.f, 0.f}};
        const bf16* xa = P.X1 + (size_t)(mb + tt * 16 + fr) * D + kh * 1024 + 8 * fq; const bf16* wh = P.WRH + (size_t)fr * D + kh * 1024 + 8 * fq; const bf16* wl = P.WRL + (size_t)fr * D + kh * 1024 + 8 * fq;
        f32x4 gvr[8];
#pragma unroll
        for (int j = 0; j < 8; ++j) gvr[j] = *(const GAS f32x4*)(P.norm_ffn + 4 * lane + 256 * j);
#pragma unroll 2
        for (int tk = 0; tk < 8; ++tk) { const int m = mb + wave * 8 + tk; const bf16* xr = P.X1 + (size_t)m * D; u32x2 xw[8];
#pragma unroll
            for (int j = 0; j < 8; ++j) xw[j] = *(const GAS u32x2*)(xr + 4 * lane + 256 * j);
#pragma unroll
            for (int q = 0; q < 4; ++q) { const int ks = 4 * tk + q; const bf16x8 ah = *(const GAS bf16x8*)(xa + 32 * ks);
#pragma unroll
                for (int nt = 0; nt < 2; ++nt) { const bf16x8 bh = *(const GAS bf16x8*)(wh + (size_t)nt * 16 * D + 32 * ks), bl = *(const GAS bf16x8*)(wl + (size_t)nt * 16 * D + 32 * ks);
                    acc[nt] = mfma16(ah, bh, acc[nt]); acc[nt] = mfma16(ah, bl, acc[nt]); } }
            f32x4 v[8]; float s = 0.f;
#pragma unroll
            for (int j = 0; j < 8; ++j) { v[j] = (f32x4){bflo(xw[j].x), bfhi(xw[j].x), bflo(xw[j].y), bfhi(xw[j].y)}; s += (v[j].x * v[j].x + v[j].y * v[j].y) + (v[j].z * v[j].z + v[j].w * v[j].w); }
            const float r = 1.0f / sqrtf(wave_sum(s) * (1.0f / D) + NORM_EPS); if (lane == 0) rsv[wave * 8 + tk] = r;
            unsigned char* hr = (unsigned char*)P.H + (size_t)m * D;
#pragma unroll
            for (int j = 0; j < 8; ++j) *(GAS unsigned*)(hr + 4 * lane + 256 * j) = pk4_fp8(v[j].x * r * gvr[j].x, v[j].y * r * gvr[j].y, v[j].z * r * gvr[j].z, v[j].w * r * gvr[j].w); }
        if (kh == 1) { *(LAS f32x4*)(part + ((tt * 2 + 0) * 64 + lane) * 4) = acc[0]; *(LAS f32x4*)(part + ((tt * 2 + 1) * 64 + lane) * 4) = acc[1]; }
        __syncthreads();
        if (kh == 0) {
            acc[0] = acc[0] + *(const LAS f32x4*)(part + ((tt * 2 + 0) * 64 + lane) * 4); acc[1] = acc[1] + *(const LAS f32x4*)(part + ((tt * 2 + 1) * 64 + lane) * 4);
            const float b0 = P.b_router[fr], b1 = P.b_router[16 + fr];
#pragma unroll
            for (int rg = 0; rg < 4; ++rg) { const int tl = tt * 16 + 4 * fq + rg; const float r = rsv[tl];
                float v0 = acc[0][rg] * r + b0, v1 = acc[1][rg] * r + b1; int sel[4]; float val[4];
#pragma unroll
                for (int k = 0; k < 4; ++k) { const float mx = row16_max(fmaxf(v0, v1)); const int cand = (v0 == mx) ? fr : ((v1 == mx) ? 16 + fr : 99); const int s_ = row16_min(cand);
                    sel[k] = s_; val[k] = mx; v0 = (s_ == fr) ? -3.0e38f : v0; v1 = (s_ == 16 + fr) ? -3.0e38f : v1; }
                const float e1 = __expf(val[1] - val[0]), e2 = __expf(val[2] - val[0]), e3 = __expf(val[3] - val[0]); const float inv = 1.0f / (1.0f + e1 + e2 + e3);
                const float gate[4] = {inv, e1 * inv, e2 * inv, e3 * inv};
                if (fr == 0) { const int m = mb + tl;
#pragma unroll
                    for (int k = 0; k < 4; ++k) { picks[tl * 4 + k] = sel[k]; pgate[tl * 4 + k] = gate[k]; P.TOPK_E[m * 4 + k] = sel[k]; P.TOPK_GATE[m * 4 + k] = gate[k]; } } }
        }
        __syncthreads();
        if (tid < 32) { int cnt = 0;
            for (int j = 0; j < 256; ++j) cnt += (picks[j] == tid) ? 1 : 0;
            pbase[tid] = (int)__hip_atomic_fetch_add((unsigned*)(P.ctl + cnt_base + 64 * tid), (unsigned)cnt, RLX_AGENT); }
        __syncthreads();
        if (tid < 256) { const int mine = picks[tid]; int rank = 0;
            for (int j = 0; j < tid; ++j) rank += (picks[j] == mine) ? 1 : 0;
            const int pos = pbase[mine] + rank; P.TOPK_POS[mb * 4 + tid] = pos;
            P.RT2[mine * 16384 + pos] = mb * 4 + tid; P.RG2[mine * 16384 + pos] = pgate[tid]; }
    }
}

__device__ __forceinline__ void moe_tables(const Ptrs& P, LAS int* tab, int tid) {
    if (tid < 32) { const int c = (int)__hip_atomic_load((unsigned*)(P.ctl + CW_CNT + 64 * tid), RLX_AGENT); const int t = (c + 255) >> 8;
        int x = t;
#pragma unroll
        for (int d = 1; d < 32; d <<= 1) { const int y = __shfl_up(x, d); if (tid >= d) x += y; }
        tab[tid] = x - t; tab[64 + tid] = c; if (tid == 31) tab[32] = x; }
    __syncthreads();
}

__device__ __forceinline__ void p9_gather(const Ptrs& P, LAS unsigned char* lds, int tid, int wave, int lane) {
    LAS int* tab = (LAS int*)(lds + TAB_OFF);
    moe_tables(P, tab, tid);
    const int gw = blockIdx.x * NWAVES + wave, NGW = gridDim.x * NWAVES;
    for (int p = gw; p < T * 4; p += NGW) { const int e = P.TOPK_E[p], pos = P.TOPK_POS[p]; const int row = tab[e] * 256 + pos;
        const GAS u32x4* src = (const GAS u32x4*)((const unsigned char*)P.H + (size_t)(p >> 2) * D); GAS u32x4* dst = (GAS u32x4*)((unsigned char*)P.XS + (size_t)row * D);
#pragma unroll
        for (int i = 0; i < 2; ++i) dst[lane + 64 * i] = src[lane + 64 * i];
        if (lane == 0) { P.ROWTOK[row] = p; P.ROWGATE[row] = P.TOPK_GATE[p]; } }
    for (int e = blockIdx.x; e < NE; e += gridDim.x) { const int cnt = tab[64 + e], r0 = tab[e] * 256, rend = tab[e + 1] * 256;
        for (int r = r0 + cnt + tid; r < rend; r += NTHREADS) { P.ROWTOK[r] = -1; P.ROWGATE[r] = 0.f; } }
}

__device__ __forceinline__ void p12_final(const Ptrs& P, int tid, int wave, int lane) {
    const int gw = blockIdx.x * NWAVES + wave, NGW = gridDim.x * NWAVES;
    for (int m = gw; m < T; m += NGW) {
        f32x4 v[8]; float s = 0.f;
#pragma unroll
        for (int j = 0; j < 8; ++j) { const int col = 4 * lane + 256 * j; { const u32x2 xw = *(const GAS u32x2*)(P.X1 + (size_t)m * D + col); v[j] = (f32x4){bflo(xw.x), bfhi(xw.x), bflo(xw.y), bfhi(xw.y)}; }
            f32x4 mo = {0.f, 0.f, 0.f, 0.f};
#pragma unroll
            for (int k = 0; k < 4; ++k) { const unsigned w = *(const GAS unsigned*)((const unsigned char*)P.OUTK + ((size_t)m * 4 + k) * D + col);
                const f32x2 lo = __builtin_amdgcn_cvt_pk_f32_fp8((int)w, false), hi = __builtin_amdgcn_cvt_pk_f32_fp8((int)w, true); mo.x += lo[0]; mo.y += lo[1]; mo.z += hi[0]; mo.w += hi[1]; }
            v[j] = v[j] + mo * 0.03125f;
            s += (v[j].x * v[j].x + v[j].y * v[j].y) + (v[j].z * v[j].z + v[j].w * v[j].w); }
        const float rs = 1.0f / sqrtf(wave_sum(s) * (1.0f / D) + NORM_EPS);
#pragma unroll
        for (int j = 0; j < 8; ++j) { const int col = 4 * lane + 256 * j; const f32x4 g = *(const GAS f32x4*)(P.norm_final + col); *(GAS f32x4*)(P.out + (size_t)m * D + col) = v[j] * rs * g; }
    }
}

struct Args { const void* in[26]; float* out; unsigned char* ws; int ph_lo, ph_hi; };
__global__ void __launch_bounds__(NTHREADS, 2) fwd(Args args) {
    extern __shared__ __attribute__((aligned(16))) unsigned char lds_raw[];
    LAS unsigned char* lds = (LAS unsigned char*)lds_raw;
    const int tid = threadIdx.x, lane = tid & 63, wave = __builtin_amdgcn_readfirstlane(tid >> 6);
    unsigned char* ws = args.ws;
    Ptrs P;
    P.x = (const float*)args.in[0]; P.positions = (const int*)args.in[1]; P.norm_mix = (const float*)args.in[2]; P.w_in = (const float*)args.in[3]; P.shift_mu = (const float*)args.in[4];
    P.w0 = (const float*)args.in[5]; P.w2_decay = (const float*)args.in[6]; P.a0 = (const float*)args.in[7]; P.a2_iclr = (const float*)args.in[8]; P.g2_gate = (const float*)args.in[9];
    P.k_k = (const float*)args.in[10]; P.k_a = (const float*)args.in[11]; P.r_k = (const float*)args.in[12]; P.ln_x_w = (const float*)args.in[13]; P.ln_x_b = (const float*)args.in[14];
    P.w_o_rwkv = (const float*)args.in[15]; P.w_o_attn = (const float*)args.in[16]; P.w_out = (const float*)args.in[17]; P.norm_ffn = (const float*)args.in[18]; P.w_router = (const float*)args.in[19];
    P.b_router = (const float*)args.in[20]; P.w1 = (const float*)args.in[21]; P.b1 = (const float*)args.in[22]; P.w2 = (const float*)args.in[23]; P.b2 = (const float*)args.in[24]; P.norm_final = (const float*)args.in[25];
    P.out = args.out; P.ctl = (gu32*)(ws + WS_CTL);
    P.WIN = (bf16*)(ws + WS_WIN); P.W1 = (bf16*)(ws + WS_W1); P.W2 = (bf16*)(ws + WS_W2); P.WOR = (bf16*)(ws + WS_WOR); P.WOA = (bf16*)(ws + WS_WOA); P.WOUT = (bf16*)(ws + WS_WOUT);
    P.H = (bf16*)(ws + WS_H); P.ZP = (bf16*)(ws + WS_ZP); P.QKV = (bf16*)(ws + WS_QKV); P.GATES = (bf16*)(ws + WS_GATES); P.ROT = (float*)(ws + WS_ROT); P.SC = (float*)(ws + WS_SC); P.SCH = (bf16*)(ws + WS_SC + 64 * MiB);
    P.G = (bf16*)(ws + WS_G); P.BONUS = (float*)(ws + WS_BONUS); P.Y = (float*)(ws + WS_Y); P.ATTO = (bf16*)(ws + WS_ATTO); P.ATTML = (float*)(ws + WS_ATTML); P.YAIN = (bf16*)(ws + WS_YAIN);
    P.OIN = (bf16*)(ws + WS_OIN); P.MERGED = (bf16*)(ws + WS_MERGED); P.X1 = (bf16*)(ws + WS_X1);
    P.TOPK_E = (int*)(ws + WS_TOPK); P.TOPK_POS = P.TOPK_E + T * 4; P.TOPK_GATE = (float*)(P.TOPK_POS + T * 4);
    P.ROWTOK = (int*)(ws + WS_ROWS); P.ROWGATE = (float*)(P.ROWTOK + XS_ROWS); P.RT2 = (int*)(ws + WS_ROWS2); P.RG2 = (float*)(P.RT2 + NE * 16384);
    P.LW = (bf16*)(ws + WS_LORA); P.LA = P.LW + 1024 * 64; P.LG = P.LA + 1024 * 64; P.WRH = P.LG + 1024 * 160; P.WRL = P.WRH + NE * D;
    P.XS = (bf16*)(ws + WS_XS); P.ACT = (bf16*)(ws + WS_ACT); P.OUTK = (bf16*)(ws + WS_OUTK);

    for (int u = tid; u < (LDS_BYTES - TAB_OFF) / 4; u += NTHREADS) ((LAS unsigned*)(lds + TAB_OFF))[u] = 0u;
    __syncthreads();
#if MK_ONE_LAUNCH
    XcdBarrier bar = xcd_barrier_post((unsigned*)(P.ctl + CW_BAR), (volatile LAS unsigned*)(lds + MISC_OFF));
#define GRID_BAR() xcd_barrier(bar)
#else
#define GRID_BAR() do { } while (0)
#endif
    const int lo = args.ph_lo, hi = args.ph_hi;
#ifndef PHASE_MASK
#define PHASE_MASK 0x3fff
#endif
#define IN(k) (((PHASE_MASK >> (k)) & 1) && lo <= (k) && (k) < hi)
#define SEAM(k) do { if (IN(k) && IN((k) + 1)) GRID_BAR(); } while (0)
    const int G = gridDim.x, c = blockIdx.x;

#ifndef REP_MASK
#define REP_MASK 0
#endif
#define REPS(k) (1 + ((REP_MASK >> (k)) & 1))
#define PHASE(k, ...) do { if (IN(k)) { { __VA_ARGS__ } if (REPS(k) == 2) { GRID_BAR(); { __VA_ARGS__ } } SEAM(k); } } while (0)
    PHASE(0, p0_prologue(P, ws, lds, tid, wave, lane););
#ifdef PROBE_DRY
    if (IN(1)) { pg8::Gemm g{P.H, P.WIN, T, NPROJ, D}; pg8::StaticOrder S; S.init(T, NPROJ, G, c); EpiProj E{P.ZP, P.QKV, P.GATES, P.ROT, PROBE_DRY + (int)__hip_atomic_load(P.ctl + CW_TMO, RLX_AGENT)};
        pg8::gemm_phase<EpiProj, pg8::StaticOrder, true, true>(lds, g, S, E); GRID_BAR(); }
#endif
#ifndef P1_ALIGN
#define P1_ALIGN true
#endif
#ifndef STAG_US
#define STAG_US 0
#endif
    PHASE(1, { if (STAG_US > 0) { const unsigned long long t0_ = __builtin_amdgcn_s_memrealtime(), d_ = (unsigned long long)(((blockIdx.x >> 3) & 7) * STAG_US * 100);
            while (__builtin_amdgcn_s_memrealtime() - t0_ < d_) __builtin_amdgcn_s_sleep(8); }
        { pg8::Gemm g{P.H, P.WIN, T, 3072, D}; pg8::StaticOrder S; S.init(T, 3072, G, c); EpiProj E{P.ZP, P.QKV, P.GATES, P.ROT, 0, 0, 1.0f};
          pg8::gemm_phase<EpiProj, pg8::StaticOrder, P1_ALIGN, true>(lds, g, S, E); }
        __syncthreads();
        { pg8::Gemm g{(const bf16*)(ws + WS_H8), (const bf16*)(ws + WS_WG8B), T, 9216, D / 2}; pg8::StaticOrder S; S.init(T, 9216, G, c); EpiProj E{P.ZP, P.QKV, P.GATES, P.ROT, 0, 12, 0.03125f};
          pg8::gemm_phase<EpiProj, pg8::StaticOrder, P1_ALIGN, true, 127, 127>(lds, g, S, E); } });
#ifndef PROBE_SUB
#define PROBE_SUB 0
#endif
    PHASE(2, { p2_fused(P, ws, lds, tid, wave, lane); __syncthreads(); if (PROBE_SUB == 1) { p2_fused(P, ws, lds, tid, wave, lane); __syncthreads(); }
        p3_attention(P, lds, tid, wave, lane); if (PROBE_SUB == 2) { __syncthreads(); p3_attention(P, lds, tid, wave, lane); } });
    PHASE(5, p4b_scan(P, ws, lds, tid, wave, lane););
    PHASE(6, p5_post(P, tid, wave, lane););
    PHASE(7, {
        { pg8::Gemm g{P.YAIN, P.WOR, T, D, 1536}; pg8::StaticOrder S; S.init(T, D, G, c); EpiMerge2 E{P.GATES, ws + WS_MERGED8}; pg8::gemm_phase<EpiMerge2, pg8::StaticOrder, true, true, -1, -1, false, false, true>(lds, g, S, E); } });
    PHASE(8, { pg8::Gemm g{(const bf16*)(ws + WS_MERGED8), P.WOUT, T, D, D / 2}; pg8::StaticOrder S; S.init(T, D, G, c); EpiResid E{P.x, P.X1, 1.0f / 512.0f}; pg8::gemm_phase<EpiResid, pg8::StaticOrder, true, true, 127, 127>(lds, g, S, E); });
#ifdef ROUTER_TWICE
    if (IN(9)) { p8_router(P, lds, tid, wave, lane, CW_CNT + 4096); GRID_BAR(); }
#endif
    PHASE(9, p8_router(P, lds, tid, wave, lane););
#ifdef PROBE_DRY_MOE
#ifndef PROBE_FP8A
#define PROBE_FP8A 4
#endif
    if (IN(11)) { LAS int* tab = (LAS int*)(lds + TAB_OFF); moe_tables(P, tab, tid);
        if (PROBE_DRY_MOE & 1) { { pg8::Gemm g{P.XS, P.W1, XS_ROWS, NE * 4096, D / 2}; MoeOrder S{tab, 16, G, c}; EpiMoe1 E{P.ACT, P.b1, 1}; pg8::gemm_phase<EpiMoe1, MoeOrder, true, true, 122, PROBE_FP8A, true, false>(lds, g, S, E); }
        GRID_BAR(); }
        if (PROBE_DRY_MOE & 2) { { pg8::Gemm g{P.ACT, P.W2, XS_ROWS, NE * D, FF / 2}; MoeOrder S{tab, 8, G, c}; EpiMoe2 E{P.OUTK, P.b2, P.ROWTOK, P.ROWGATE, 1}; pg8::gemm_phase<EpiMoe2, MoeOrder, true, true, 122, PROBE_FP8A, true, false>(lds, g, S, E); }
        GRID_BAR(); } }
#endif
    PHASE(11, { LAS int* tab = (LAS int*)(lds + TAB_OFF); moe_tables(P, tab, tid);
        pg8::Gemm g{P.H, P.W1, XS_ROWS, NE * 4096, D / 2}; MoeOrder S{tab, 16, G, c}; EpiMoe1 E{P.ACT, P.b1, 0, P.RT2, tab};
        pg8::gemm_phase<EpiMoe1, MoeOrder, true, true, 122, 127, true, false, false, true>(lds, g, S, E); });
    PHASE(12, { LAS int* tab = (LAS int*)(lds + TAB_OFF); moe_tables(P, tab, tid);
        pg8::Gemm g{P.ACT, P.W2, XS_ROWS, NE * D, FF / 2}; MoeOrder S{tab, 8, G, c}; EpiMoe2 E{P.OUTK, P.b2, P.RT2, P.RG2, 0, tab};
        pg8::gemm_phase<EpiMoe2, MoeOrder, true, true, 122, 124, true, false>(lds, g, S, E); });
    PHASE(13, p12_final(P, tid, wave, lane););
#undef IN
#undef SEAM
}

extern "C" void kernel_launch(void* const* d_in, const int* in_sizes, int n_in, void* d_out, int out_size, void* d_ws, size_t ws_size, hipStream_t stream) {
    static int grid = 0;
    if (grid == 0) {
        if (n_in != 26 || out_size != T * D || ws_size < WS_END) { fprintf(stderr, "kernel_launch: unexpected shapes (n_in %d, out %d, ws %zu, need %zu); nothing launched\n", n_in, out_size, ws_size, (size_t)WS_END); grid = -1; return; }
        int dev = 0, cus = 0, per_cu = 0;
        if (hipGetDevice(&dev) != hipSuccess || hipDeviceGetAttribute(&cus, hipDeviceAttributeMultiprocessorCount, dev) != hipSuccess) { grid = -1; return; }
        if (hipFuncSetAttribute((const void*)fwd, hipFuncAttributeMaxDynamicSharedMemorySize, LDS_BYTES) != hipSuccess) { fprintf(stderr, "kernel_launch: hipFuncSetAttribute failed\n"); grid = -1; return; }
        if (hipOccupancyMaxActiveBlocksPerMultiprocessor(&per_cu, (const void*)fwd, NTHREADS, LDS_BYTES) != hipSuccess || per_cu < 1) fprintf(stderr, "kernel_launch: occupancy query says %d\n", per_cu);
        (void)hipGetLastError();
        grid = cus;
    }
    if (grid < 0) return;
    if (hipMemsetAsync((char*)d_ws + WS_CTL, 0, CTL_ZERO_BYTES, stream) != hipSuccess) return;
    Args a{};
    for (int i = 0; i < 26; ++i) a.in[i] = d_in[i];
    a.out = (float*)d_out; a.ws = (unsigned char*)d_ws;
#if MK_ONE_LAUNCH
    a.ph_lo = 0; a.ph_hi = NPHASES;
    hipLaunchKernelGGL(fwd, dim3(grid), dim3(NTHREADS), LDS_BYTES, stream, a);
#else
    for (int ph = 0; ph < NPHASES; ++ph) { a.ph_lo = ph; a.ph_hi = ph + 1; hipLaunchKernelGGL(fwd, dim3(grid), dim3(NTHREADS), LDS_BYTES, stream, a); }
#endif
}
```
